# Optimizing an MI355X kernel written in HIP

```python
import math
import jax
import jax.numpy as jnp
from jax import lax
import numpy as np

D_MODEL = 2048
BATCH = 8
SEQ = 4096
DEPTH = 4

ATTN_HEADS = 8
QK_NOPE_DIM = 128
QK_ROPE_DIM = 64
QK_HEAD_DIM = QK_NOPE_DIM + QK_ROPE_DIM
V_HEAD_DIM = 128
Q_LORA_RANK = 512
KV_LORA_RANK = 512
ATTN_WIDTH = ATTN_HEADS * V_HEAD_DIM
ROPE_THETA = 10000.0
Q_BLOCK = 128

LRU_WIDTH = D_MODEL - ATTN_WIDTH
LRU_BLOCKS = 8
LRU_BLOCK_DIM = LRU_WIDTH // LRU_BLOCKS
LRU_C = 8.0
CONV_WIDTH = 4
CONV_LEFT = 2
N_DIRS = 2

D_FF = 4 * D_MODEL

LN_EPS = 1e-5
RMS_EPS = 1e-6
DEEPNORM_ALPHA = (2.0 * DEPTH) ** 0.25
DEEPNORM_BETA = (8.0 * DEPTH) ** -0.25

IN_WIDTH = Q_LORA_RANK + KV_LORA_RANK + QK_ROPE_DIM + 2 * LRU_WIDTH
SPLIT_POINTS = (
    Q_LORA_RANK,
    Q_LORA_RANK + KV_LORA_RANK,
    Q_LORA_RANK + KV_LORA_RANK + QK_ROPE_DIM,
    Q_LORA_RANK + KV_LORA_RANK + QK_ROPE_DIM + LRU_WIDTH,
)

kernel_name = 'bidir_hybrid_mla_rglru_deepnorm'


def layer_norm(x, g, b):
    xf = x.astype(jnp.float32)
    mu = jnp.mean(xf, axis=-1, keepdims=True)
    xc = xf - mu
    var = jnp.mean(xc * xc, axis=-1, keepdims=True)
    return (xc * lax.rsqrt(var + LN_EPS) * g.astype(jnp.float32) + b.astype(jnp.float32)).astype(x.dtype)


def rms_norm(x, g):
    xf = x.astype(jnp.float32)
    ms = jnp.mean(xf * xf, axis=-1, keepdims=True)
    return (xf * lax.rsqrt(ms + RMS_EPS) * g.astype(jnp.float32)).astype(x.dtype)


def rope_tables(positions):
    inv_freq = ROPE_THETA ** (-jnp.arange(0, QK_ROPE_DIM, 2, dtype=jnp.float32) / QK_ROPE_DIM)
    ang = positions.astype(jnp.float32)[..., None] * inv_freq
    return jnp.cos(ang), jnp.sin(ang)


def apply_rotary(x, cos, sin):
    xf = x.astype(jnp.float32)
    x1, x2 = jnp.split(xf, 2, axis=-1)
    return jnp.concatenate([x1 * cos - x2 * sin, x2 * cos + x1 * sin], axis=-1).astype(x.dtype)


def mla_heads(c_q, c_kv, k_pe, cos, sin, q_norm_g, kv_norm_g, w_uq, w_ukv):
    B, S, _ = c_q.shape
    q = (rms_norm(c_q, q_norm_g) @ w_uq).reshape(B, S, ATTN_HEADS, QK_HEAD_DIM)
    q_nope, q_pe = jnp.split(q, [QK_NOPE_DIM], axis=-1)
    q_pe = apply_rotary(q_pe, cos[:, :, None, :], sin[:, :, None, :])
    q = jnp.concatenate([q_nope, q_pe], axis=-1)
    kv = (rms_norm(c_kv, kv_norm_g) @ w_ukv).reshape(B, S, ATTN_HEADS, QK_NOPE_DIM + V_HEAD_DIM)
    k_nope, v = jnp.split(kv, [QK_NOPE_DIM], axis=-1)
    k_pe = apply_rotary(k_pe, cos, sin)
    k = jnp.concatenate(
        [k_nope, jnp.broadcast_to(k_pe[:, :, None, :], (B, S, ATTN_HEADS, QK_ROPE_DIM))], axis=-1)
    scale = QK_HEAD_DIM ** -0.5
    n_blk = S // Q_BLOCK
    q_blocks = q.reshape(B, n_blk, Q_BLOCK, ATTN_HEADS, QK_HEAD_DIM).transpose(1, 0, 2, 3, 4)

    def attend_block(qb):
        s = jnp.einsum('bqhd,bkhd->bhqk', qb, k).astype(jnp.float32) * scale
        p = jax.nn.softmax(s, axis=-1).astype(v.dtype)
        return jnp.einsum('bhqk,bkhd->bqhd', p, v)

    o = lax.map(attend_block, q_blocks)
    return o.transpose(1, 0, 2, 3, 4).reshape(B, S, ATTN_WIDTH)


def centred_depthwise_conv(x, w, b):
    S = x.shape[1]
    xp = jnp.pad(x, ((0, 0), (CONV_LEFT, CONV_WIDTH - 1 - CONV_LEFT), (0, 0)))
    y = xp[:, 0:S] * w[0]
    for tap in range(1, CONV_WIDTH):
        y = y + xp[:, tap:tap + S] * w[tap]
    return y + b


def lru_combine(left, right):
    a1, b1 = left
    a2, b2 = right
    return a1 * a2, a2 * b1 + b2


def rg_lru_bidirectional(x, w_a, b_a, w_i, b_i, lam):
    B, S, W = x.shape
    xf = x.astype(jnp.float32)
    xb = xf.reshape(B, S, LRU_BLOCKS, LRU_BLOCK_DIM)
    outs = []
    for d in range(N_DIRS):
        r = jax.nn.sigmoid(jnp.einsum('bshi,hij->bshj', xb, w_a[d].astype(jnp.float32))
                           + b_a[d].astype(jnp.float32)).reshape(B, S, W)
        i = jax.nn.sigmoid(jnp.einsum('bshi,hij->bshj', xb, w_i[d].astype(jnp.float32))
                           + b_i[d].astype(jnp.float32)).reshape(B, S, W)
        log_a = -LRU_C * r * jax.nn.softplus(-lam[d].astype(jnp.float32))
        a = jnp.exp(log_a)
        u = jnp.sqrt(-jnp.expm1(2.0 * log_a)) * (i * xf)
        _, h = lax.associative_scan(lru_combine, (a, u), axis=1, reverse=(d == 1))
        outs.append(h)
    return (outs[0] + outs[1]).astype(x.dtype)


def setup_inputs(seed: int = 0) -> dict:
    key = jax.random.key(seed)
    ks = jax.random.split(key, 28)

    def normal(k, shape, std):
        return jax.random.normal(k, shape, jnp.float32) * std

    x = normal(ks[0], (BATCH, SEQ, D_MODEL), 1.0)
    offs = jax.random.randint(ks[1], (BATCH, 1), 0, SEQ, dtype=jnp.int32)
    positions = (jnp.arange(SEQ, dtype=jnp.int32)[None, :] + offs).astype(jnp.int32)
    ln_in_g = 1.0 + normal(ks[2], (D_MODEL,), 0.01)
    ln_in_b = normal(ks[3], (D_MODEL,), 0.01)

    w_in = normal(ks[4], (DEPTH, D_MODEL, IN_WIDTH), D_MODEL ** -0.5)
    q_norm_g = 1.0 + normal(ks[5], (DEPTH, Q_LORA_RANK), 0.01)
    kv_norm_g = 1.0 + normal(ks[6], (DEPTH, KV_LORA_RANK), 0.01)
    w_uq = normal(ks[7], (DEPTH, Q_LORA_RANK, ATTN_HEADS * QK_HEAD_DIM), Q_LORA_RANK ** -0.5)
    kv_col_scale = jnp.tile(jnp.concatenate([jnp.ones((QK_NOPE_DIM,), jnp.float32),
                                             jnp.full((V_HEAD_DIM,), DEEPNORM_BETA, jnp.float32)]),
                            ATTN_HEADS)
    w_ukv = normal(ks[8], (DEPTH, KV_LORA_RANK, ATTN_HEADS * (QK_NOPE_DIM + V_HEAD_DIM)),
                   KV_LORA_RANK ** -0.5) * kv_col_scale

    conv_w = normal(ks[9], (DEPTH, CONV_WIDTH, LRU_WIDTH), CONV_WIDTH ** -0.5)
    conv_b = normal(ks[10], (DEPTH, LRU_WIDTH), 0.01)
    rg_w_a = normal(ks[11], (DEPTH, N_DIRS, LRU_BLOCKS, LRU_BLOCK_DIM, LRU_BLOCK_DIM), LRU_BLOCK_DIM ** -0.5)
    rg_b_a = normal(ks[12], (DEPTH, N_DIRS, LRU_BLOCKS, LRU_BLOCK_DIM), 0.01)
    rg_w_i = normal(ks[13], (DEPTH, N_DIRS, LRU_BLOCKS, LRU_BLOCK_DIM, LRU_BLOCK_DIM), LRU_BLOCK_DIM ** -0.5)
    rg_b_i = normal(ks[14], (DEPTH, N_DIRS, LRU_BLOCKS, LRU_BLOCK_DIM), 0.01)
    a_c = jax.random.uniform(ks[15], (DEPTH, N_DIRS, LRU_WIDTH), jnp.float32, 0.9, 0.999)
    s = a_c ** (1.0 / LRU_C)
    rg_lambda = jnp.log(s) - jnp.log1p(-s)

    w_out = normal(ks[16], (DEPTH, D_MODEL, D_MODEL), D_MODEL ** -0.5 * DEEPNORM_BETA)
    ln1_g = 1.0 + normal(ks[17], (DEPTH, D_MODEL), 0.01)
    ln1_b = normal(ks[18], (DEPTH, D_MODEL), 0.01)
    w_up = normal(ks[19], (DEPTH, D_MODEL, D_FF), D_MODEL ** -0.5)
    w_down = normal(ks[20], (DEPTH, D_FF, D_MODEL), D_FF ** -0.5 * DEEPNORM_BETA)
    ln2_g = 1.0 + normal(ks[21], (DEPTH, D_MODEL), 0.01)
    ln2_b = normal(ks[22], (DEPTH, D_MODEL), 0.01)
    return {
        'x': x, 'positions': positions, 'ln_in_g': ln_in_g, 'ln_in_b': ln_in_b,
        'w_in': w_in, 'q_norm_g': q_norm_g, 'kv_norm_g': kv_norm_g, 'w_uq': w_uq, 'w_ukv': w_ukv,
        'conv_w': conv_w, 'conv_b': conv_b, 'rg_w_a': rg_w_a, 'rg_b_a': rg_b_a,
        'rg_w_i': rg_w_i, 'rg_b_i': rg_b_i, 'rg_lambda': rg_lambda,
        'w_out': w_out, 'ln1_g': ln1_g, 'ln1_b': ln1_b,
        'w_up': w_up, 'w_down': w_down, 'ln2_g': ln2_g, 'ln2_b': ln2_b,
    }


def reference(x, positions, ln_in_g, ln_in_b, w_in, q_norm_g, kv_norm_g, w_uq, w_ukv,
              conv_w, conv_b, rg_w_a, rg_b_a, rg_w_i, rg_b_i, rg_lambda,
              w_out, ln1_g, ln1_b, w_up, w_down, ln2_g, ln2_b):
    cos, sin = rope_tables(positions)
    h = layer_norm(x, ln_in_g, ln_in_b)
    for l in range(DEPTH):
        z = h @ w_in[l]
        c_q, c_kv, k_pe, x_lru, g_lru = jnp.split(z, SPLIT_POINTS, axis=-1)
        y_attn = mla_heads(c_q, c_kv, k_pe, cos, sin, q_norm_g[l], kv_norm_g[l], w_uq[l], w_ukv[l])
        x_conv = centred_depthwise_conv(x_lru, conv_w[l], conv_b[l])
        y_lru = jax.nn.gelu(g_lru) * rg_lru_bidirectional(
            x_conv, rg_w_a[l], rg_b_a[l], rg_w_i[l], rg_b_i[l], rg_lambda[l])
        y = jnp.concatenate([y_attn, y_lru], axis=-1) @ w_out[l]
        h = layer_norm(DEEPNORM_ALPHA * h + y, ln1_g[l], ln1_b[l])
        f = jnp.square(jax.nn.relu(h @ w_up[l])) @ w_down[l]
        h = layer_norm(DEEPNORM_ALPHA * h + f, ln2_g[l], ln2_b[l])
    return h
```

```cpp
#include <hip/hip_runtime.h>
#include <hip/hip_cooperative_groups.h>
#include <cstdio>
#include <cstdint>
namespace cg = cooperative_groups;

#define LAS __attribute__((address_space(3)))
typedef unsigned short bf16_t;
typedef short bf16x8 __attribute__((ext_vector_type(8)));
typedef short s16x4 __attribute__((ext_vector_type(4)));
typedef float f32x4 __attribute__((ext_vector_type(4)));
typedef float f32x2 __attribute__((ext_vector_type(2)));
typedef float f32x16 __attribute__((ext_vector_type(16)));
typedef unsigned u32x4 __attribute__((ext_vector_type(4)));
typedef unsigned u32x2 __attribute__((ext_vector_type(2)));

constexpr int M_ = 32768, DM = 2048, SEQ = 4096, NBATCH = 8, DEPTH = 4;
constexpr int NIN = 3136, NINP = 3328, DFF = 8192;
constexpr float ALPHA = 1.6817928305074290f;
constexpr float LN_EPS = 1e-5f, RMS_EPS = 1e-6f;
constexpr size_t MiB = 1ull << 20;
constexpr size_t WS_HB = 0;
constexpr size_t WS_W = 128 * MiB;
constexpr size_t W_IN = WS_W, W_UQ = W_IN + (size_t)NINP * 2048 * 2, W_UKV = W_UQ + 1536ull * 512 * 2, W_G = W_UKV + 2048ull * 512 * 2,
                 W_OUT = W_G + 8ull * 512 * 128 * 2, W_UP = W_OUT + 2048ull * 2048 * 2, W_DN = W_UP + 8192ull * 2048 * 2, W_END = W_DN + 8192ull * 2048 * 2;
static_assert(W_END <= 218 * MiB, "weights region");
constexpr size_t WS_COS = 218 * MiB, WS_SIN = 222 * MiB, WS_SP = 226 * MiB;
constexpr size_t WS_BIG = 228 * MiB;
constexpr size_t WS_F = WS_BIG;
constexpr size_t WS_GG = WS_BIG, WS_XC = WS_BIG + 64 * MiB, WS_YCAT = WS_BIG + 128 * MiB, WS_SSQ = WS_BIG + 256 * MiB, WS_KPE = WS_BIG + 258 * MiB,
                 WS_CQ = WS_BIG + 262 * MiB, WS_CKV = WS_BIG + 294 * MiB, WS_XL = WS_BIG + 326 * MiB, WS_AU = WS_BIG + 262 * MiB  ,
                 WS_Q = WS_BIG + 518 * MiB, WS_KV = WS_BIG + 614 * MiB, WS_PH = WS_BIG + 742 * MiB, WS_END = WS_BIG + 750 * MiB;
static_assert(WS_END <= 1024 * MiB, "workspace");

struct Params { const float* in[23]; float* out; unsigned char* ws; };

__device__ __forceinline__ int otid() { int t = threadIdx.x; asm volatile("" : "+v"(t)); return t; }
__device__ __forceinline__ unsigned cvt_pk_bf16(float lo, float hi) { unsigned r; asm volatile("v_cvt_pk_bf16_f32 %0, %1, %2" : "=v"(r) : "v"(lo), "v"(hi)); return r; }
__device__ __forceinline__ float bf_lo(unsigned w) { return __uint_as_float(w << 16); }
__device__ __forceinline__ float bf_hi(unsigned w) { return __uint_as_float(w & 0xffff0000u); }
__device__ __forceinline__ float sigmoidf_(float x) { return __builtin_amdgcn_rcpf(1.0f + __builtin_amdgcn_exp2f(-1.4426950408889634f * x)); }
__device__ __forceinline__ float gelu_tanh(float x) { const float z = 0.7978845608028654f * (x + 0.044715f * x * x * x); return x * sigmoidf_(2.0f * z); }
__device__ __forceinline__ u32x4 pack8(const f32x4 a, const f32x4 b) { u32x4 w; w.x = cvt_pk_bf16(a[0], a[1]); w.y = cvt_pk_bf16(a[2], a[3]); w.z = cvt_pk_bf16(b[0], b[1]); w.w = cvt_pk_bf16(b[2], b[3]); return w; }

namespace pg8 {
constexpr int BM = 256, BK = 64, HALF = 128, HTB = HALF * BK * 2, STAGE_BYTES = 8 * HTB, NXCD = 8, WGM = 8;
__host__ __device__ __forceinline__ int lds_byte(int r, int c) { const int st = (r >> 4) * 2 + (c >> 5), rr = r & 15, cc = c & 31, ob = rr * 64 + cc * 2; return st * 1024 + (ob ^ (((ob >> 9) & 1) << 5)); }
__host__ __device__ __forceinline__ void stage_rc(int b, int& R, int& C) { const int st = b / 1024, sb = b % 1024, swz = sb ^ (((sb >> 9) & 1) << 5); R = (st >> 1) * 16 + swz / 64; C = (st & 1) * 32 + (swz % 64) / 2; }
__host__ __device__ __forceinline__ int perm32(int rho) { const int n = rho >> 4, i = rho & 15; return 8 * (i >> 2) + 4 * n + (i & 3); }

struct Unit { int pm, pn, z; };
struct Order {
    int nM, nN, nZ, per, G, c;
    const char* A; const char* B; size_t a_pm, a_z, b_pn, b_z; int lda, ldb, K;
    __device__ __forceinline__ bool next(int i, Unit& u) const {
        const long L = (long)i * G + c; if (L >= (long)per * nZ) return false;
        u.z = (int)(L / per); int wgid = (int)(L % per);
        { const int q = per / NXCD, r = per % NXCD, xcd = wgid % NXCD, off = wgid / NXCD; wgid = (xcd < r ? xcd * (q + 1) : r * (q + 1) + (xcd - r) * q) + off; }
        const int nig = WGM * nN, gid = wgid / nig, fm = gid * WGM, gsz = (nM - fm) < WGM ? (nM - fm) : WGM;
        u.pm = fm + ((wgid % nig) % gsz); u.pn = (wgid % nig) / gsz; return true;
    }
    __device__ __forceinline__ const char* aptr(const Unit& u) const { return A + (size_t)u.pm * a_pm + (size_t)u.z * a_z; }
    __device__ __forceinline__ const char* bptr(const Unit& u) const { return B + (size_t)u.pn * b_pn + (size_t)u.z * b_z; }
};
__device__ __forceinline__ Order make_order(const void* A, int lda, const void* Bt, int ldb, int Mrows, int N, int K) {
    Order o; o.nM = Mrows / BM; o.nN = N / BM; o.nZ = 1; o.per = o.nM * o.nN; o.G = gridDim.x; o.c = blockIdx.x;
    o.A = (const char*)A; o.B = (const char*)Bt; o.a_pm = (size_t)BM * lda * 2; o.a_z = 0; o.b_pn = (size_t)BM * ldb * 2; o.b_z = 0; o.lda = lda; o.ldb = ldb; o.K = K; return o;
}

template <class Epi>
__device__ __forceinline__ void gemm_phase(LAS unsigned char* lds, const Order& S, const Epi& E) {
    const int tid = otid(), wid = __builtin_amdgcn_readfirstlane(tid >> 6), lane = tid & 63, wr = wid >> 2, wc = wid & 3, fr = lane & 15, fq = lane >> 4;
    const int nt = S.K / BK;
    unsigned voffA[2], voffB[2];
#pragma unroll
    for (int i = 0; i < 2; ++i) { int R, C; stage_rc(tid * 16 + i * 8192, R, C); const int Rb = Epi::PERM ? ((R & ~31) + perm32(R & 31)) : R;
        voffA[i] = (unsigned)(R * S.lda + C) * 2u; voffB[i] = (unsigned)(Rb * S.ldb + C) * 2u; }
    const size_t kstep = (size_t)(BK * 2);
    const size_t hstepA = (size_t)HALF * S.lda * 2, hstepB = (size_t)HALF * S.ldb * 2;
    const unsigned ldsw = (unsigned)wid * 1024u;
    const int aoff = lds_byte(wr * 64 + fr, fq * 8), boff = lds_byte(wc * 32 + fr, fq * 8);
#define PG8_SA(b, h) (((b) * 2 + (h)) * HTB)
#define PG8_SB(b, h) ((4 + (b) * 2 + (h)) * HTB)
#define PG8_STAGE(bufoff, gbase, voff) do { _Pragma("unroll") for (int _i = 0; _i < 2; ++_i) \
        __builtin_amdgcn_global_load_lds((const unsigned*)((const char*)(gbase) + (voff)[_i]), (LAS unsigned*)(lds + (bufoff) + ldsw + _i * 8192), 16, 0, 0); } while (0)
#define PG8_LDA(dst, b, h) do { _Pragma("unroll") for (int m = 0; m < 4; ++m) _Pragma("unroll") for (int k = 0; k < 2; ++k) dst[m][k] = *(const LAS bf16x8*)(lds + PG8_SA(b, h) + aoff + m * 2048 + k * 1024); } while (0)
#define PG8_LDB(dst, b, h) do { _Pragma("unroll") for (int n = 0; n < 2; ++n) _Pragma("unroll") for (int k = 0; k < 2; ++k) dst[n][k] = *(const LAS bf16x8*)(lds + PG8_SB(b, h) + boff + n * 2048 + k * 1024); } while (0)
#define PG8_MMA(ai, bj, At, Bt) do { __builtin_amdgcn_s_setprio(1); _Pragma("unroll") for (int m = 0; m < 4; ++m) _Pragma("unroll") for (int n = 0; n < 2; ++n) _Pragma("unroll") for (int k = 0; k < 2; ++k) \
        acc[ai][bj][m][n] = __builtin_amdgcn_mfma_f32_16x16x32_bf16(Bt[n][k], At[m][k], acc[ai][bj][m][n], 0, 0, 0); __builtin_amdgcn_s_setprio(0); } while (0)
#define PG8_WAIT_V(n) asm volatile("s_waitcnt vmcnt(" #n ")" ::: "memory")
#define PG8_WAIT_L(n) asm volatile("s_waitcnt lgkmcnt(" #n ")" ::: "memory")
#define PG8_BAR __builtin_amdgcn_s_barrier()
#define PG8_SCHED __builtin_amdgcn_sched_barrier(0)
    Unit cur, nxt; int ui = 0;
    if (!S.next(0, cur)) return;
    f32x4 acc[2][2][4][2];
#pragma unroll
    for (int a = 0; a < 2; ++a)
#pragma unroll
        for (int b = 0; b < 2; ++b)
#pragma unroll
            for (int m = 0; m < 4; ++m)
#pragma unroll
                for (int n = 0; n < 2; ++n) acc[a][b][m][n] = (f32x4){0.f, 0.f, 0.f, 0.f};
    bf16x8 At[4][2], B0[2][2], B1[2][2];
    const char* cA = S.aptr(cur); const char* cB = S.bptr(cur);
    PG8_STAGE(PG8_SB(0, 0), cB, voffB); PG8_STAGE(PG8_SA(0, 0), cA, voffA); PG8_STAGE(PG8_SB(0, 1), cB + hstepB, voffB); PG8_STAGE(PG8_SA(0, 1), cA + hstepA, voffA);
    if (wr == 1) PG8_BAR;
    PG8_WAIT_V(4); PG8_BAR;
    PG8_STAGE(PG8_SB(1, 0), cB + kstep, voffB); PG8_STAGE(PG8_SA(1, 0), cA + kstep, voffA); PG8_STAGE(PG8_SB(1, 1), cB + hstepB + kstep, voffB);
    PG8_WAIT_V(6); PG8_BAR;
    for (;;) {
        const bool has_next = S.next(ui + 1, nxt);
        const char* nA = has_next ? S.aptr(nxt) : cA; const char* nB = has_next ? S.bptr(nxt) : cB;
        for (int t = 0; t < nt; t += 2) {
            const bool last = (t == nt - 2);
            const char* a1 = cA + (size_t)(t + 1) * kstep;
            const char* a2 = last ? nA : cA + (size_t)(t + 2) * kstep; const char* b2 = last ? nB : cB + (size_t)(t + 2) * kstep;
            const char* a3 = a2 + kstep; const char* b3 = b2 + kstep;
            PG8_LDB(B0, 0, 0); PG8_SCHED; PG8_LDA(At, 0, 0); PG8_STAGE(PG8_SA(1, 1), a1 + hstepA, voffA);
            PG8_WAIT_L(8); PG8_BAR; PG8_WAIT_L(0); PG8_MMA(0, 0, At, B0); PG8_BAR; PG8_SCHED;
            PG8_LDB(B1, 0, 1); PG8_STAGE(PG8_SB(0, 0), b2, voffB);
            PG8_BAR; PG8_WAIT_L(0); PG8_MMA(0, 1, At, B1); PG8_BAR;
            PG8_LDA(At, 0, 1); PG8_STAGE(PG8_SA(0, 0), a2, voffA);
            PG8_BAR; PG8_WAIT_L(0); PG8_MMA(1, 0, At, B0); PG8_BAR; PG8_SCHED;
            PG8_STAGE(PG8_SB(0, 1), b2 + hstepB, voffB);
            PG8_WAIT_V(6); PG8_BAR; PG8_MMA(1, 1, At, B1); PG8_BAR;
            PG8_LDB(B0, 1, 0); PG8_SCHED; PG8_LDA(At, 1, 0); PG8_STAGE(PG8_SA(0, 1), a2 + hstepA, voffA);
            PG8_WAIT_L(8); PG8_BAR; PG8_WAIT_L(0); PG8_MMA(0, 0, At, B0); PG8_BAR; PG8_SCHED;
            PG8_LDB(B1, 1, 1); PG8_STAGE(PG8_SB(1, 0), b3, voffB);
            PG8_BAR; PG8_WAIT_L(0); PG8_MMA(0, 1, At, B1); PG8_BAR;
            PG8_LDA(At, 1, 1); PG8_STAGE(PG8_SA(1, 0), a3, voffA);
            PG8_BAR; PG8_WAIT_L(0); PG8_MMA(1, 0, At, B0); PG8_BAR; PG8_SCHED;
            PG8_STAGE(PG8_SB(1, 1), b3 + hstepB, voffB);
            PG8_WAIT_V(6); PG8_BAR; PG8_MMA(1, 1, At, B1); PG8_BAR;
        }
        E(acc, cur, wr, wc, fr, fq);
        if (!has_next) break;
#pragma unroll
        for (int a = 0; a < 2; ++a)
#pragma unroll
            for (int b = 0; b < 2; ++b)
#pragma unroll
                for (int m = 0; m < 4; ++m)
#pragma unroll
                    for (int n = 0; n < 2; ++n) acc[a][b][m][n] = (f32x4){0.f, 0.f, 0.f, 0.f};
        cur = nxt; cA = nA; cB = nB; ++ui;
    }
    PG8_WAIT_V(0);
    if (wr == 0) PG8_BAR;
    PG8_BAR;
#undef PG8_SA
#undef PG8_SB
#undef PG8_STAGE
#undef PG8_LDA
#undef PG8_LDB
#undef PG8_MMA
#undef PG8_WAIT_V
#undef PG8_WAIT_L
#undef PG8_BAR
#undef PG8_SCHED
}
}
using pg8::Unit;
typedef f32x4 Acc[2][2][4][2];

struct EpiIn {
    static constexpr bool PERM = true;
    bf16_t *cq, *ckv, *xl, *gg, *kpe; float* ssq; const float *cosT, *sinT;
    __device__ __forceinline__ void operator()(const Acc& acc, const Unit& u, int wr, int wc, int fr, int fq) const {
        const int row0 = u.pm * 256 + wr * 64 + fr, pn = u.pn;
        if (pn < 4) {
            bf16_t* base = (pn < 2 ? cq : ckv); const int col0 = (pn & 1) * 256 + wc * 32 + 8 * fq;
#pragma unroll
            for (int ai = 0; ai < 2; ++ai)
#pragma unroll
                for (int m = 0; m < 4; ++m) { const int row = row0 + ai * 128 + m * 16; float s = 0.f;
#pragma unroll
                    for (int bj = 0; bj < 2; ++bj) { const f32x4 v0 = acc[ai][bj][m][0], v1 = acc[ai][bj][m][1];
                        s += (v0[0] * v0[0] + v0[1] * v0[1]) + (v0[2] * v0[2] + v0[3] * v0[3]) + (v1[0] * v1[0] + v1[1] * v1[1]) + (v1[2] * v1[2] + v1[3] * v1[3]);
                        *(u32x4*)(base + (size_t)row * 512 + col0 + bj * 128) = pack8(v0, v1); }
                    s += __shfl_xor(s, 16); s += __shfl_xor(s, 32);
                    if (fq == 0) ssq[(size_t)row * 16 + pn * 4 + wc] = s; }
        } else if (pn < 8) {
            const int col0 = (pn - 4) * 256 + wc * 32 + 8 * fq;
#pragma unroll
            for (int ai = 0; ai < 2; ++ai)
#pragma unroll
                for (int m = 0; m < 4; ++m) { const int row = row0 + ai * 128 + m * 16;
#pragma unroll
                    for (int bj = 0; bj < 2; ++bj) *(u32x4*)(xl + (size_t)row * 1024 + col0 + bj * 128) = pack8(acc[ai][bj][m][0], acc[ai][bj][m][1]); }
        } else if (pn < 12) {
            const int col0 = (pn - 8) * 256 + wc * 32 + 8 * fq;
#pragma unroll
            for (int ai = 0; ai < 2; ++ai)
#pragma unroll
                for (int m = 0; m < 4; ++m) { const int row = row0 + ai * 128 + m * 16;
#pragma unroll
                    for (int bj = 0; bj < 2; ++bj) { f32x4 v0 = acc[ai][bj][m][0], v1 = acc[ai][bj][m][1];
#pragma unroll
                        for (int j = 0; j < 4; ++j) { v0[j] = gelu_tanh(v0[j]); v1[j] = gelu_tanh(v1[j]); }
                        *(u32x4*)(gg + (size_t)row * 1024 + col0 + bj * 128) = pack8(v0, v1); } }
        } else if (wc == 0) {
#pragma unroll
            for (int ai = 0; ai < 2; ++ai)
#pragma unroll
                for (int m = 0; m < 4; ++m) { const int row = row0 + ai * 128 + m * 16;
                    const f32x4 c0 = *(const f32x4*)(cosT + (size_t)row * 32 + 8 * fq), c1 = *(const f32x4*)(cosT + (size_t)row * 32 + 8 * fq + 4);
                    const f32x4 s0 = *(const f32x4*)(sinT + (size_t)row * 32 + 8 * fq), s1 = *(const f32x4*)(sinT + (size_t)row * 32 + 8 * fq + 4);
                    const f32x4 a0 = acc[ai][0][m][0], a1 = acc[ai][0][m][1], b0 = acc[ai][1][m][0], b1 = acc[ai][1][m][1];
                    *(u32x4*)(kpe + (size_t)row * 64 + 8 * fq) = pack8(a0 * c0 - b0 * s0, a1 * c1 - b1 * s1);
                    *(u32x4*)(kpe + (size_t)row * 64 + 32 + 8 * fq) = pack8(b0 * c0 + a0 * s0, b1 * c1 + a1 * s1); }
        }
    }
};
__device__ __forceinline__ float row_rstd(const float* ssq8) { const f32x4 a = *(const f32x4*)ssq8, b = *(const f32x4*)(ssq8 + 4);
    const float s = ((a[0] + a[1]) + (a[2] + a[3])) + ((b[0] + b[1]) + (b[2] + b[3])); return __builtin_amdgcn_rsqf(s * (1.0f / 512.0f) + RMS_EPS); }
struct EpiQ {
    static constexpr bool PERM = true;
    bf16_t* q; const float* ssq; const float *cosT, *sinT;
    __device__ __forceinline__ void operator()(const Acc& acc, const Unit& u, int wr, int wc, int fr, int fq) const {
        const int row0 = u.pm * 256 + wr * 64 + fr, pn = u.pn;
        if (pn < 4) {
            const int col0 = pn * 256 + wc * 32 + 8 * fq;
#pragma unroll
            for (int ai = 0; ai < 2; ++ai)
#pragma unroll
                for (int m = 0; m < 4; ++m) { const int row = row0 + ai * 128 + m * 16; const float rs = row_rstd(ssq + (size_t)row * 16);
#pragma unroll
                    for (int bj = 0; bj < 2; ++bj) *(u32x4*)(q + (size_t)row * 1536 + col0 + bj * 128) = pack8(acc[ai][bj][m][0] * rs, acc[ai][bj][m][1] * rs); }
        } else {
            const int head = 4 * (pn - 4) + wc;
#pragma unroll
            for (int ai = 0; ai < 2; ++ai)
#pragma unroll
                for (int m = 0; m < 4; ++m) { const int row = row0 + ai * 128 + m * 16; const float rs = row_rstd(ssq + (size_t)row * 16);
                    const f32x4 c0 = *(const f32x4*)(cosT + (size_t)row * 32 + 8 * fq), c1 = *(const f32x4*)(cosT + (size_t)row * 32 + 8 * fq + 4);
                    const f32x4 s0 = *(const f32x4*)(sinT + (size_t)row * 32 + 8 * fq), s1 = *(const f32x4*)(sinT + (size_t)row * 32 + 8 * fq + 4);
                    const f32x4 a0 = acc[ai][0][m][0] * rs, a1 = acc[ai][0][m][1] * rs, b0 = acc[ai][1][m][0] * rs, b1 = acc[ai][1][m][1] * rs;
                    *(u32x4*)(q + (size_t)row * 1536 + 1024 + head * 64 + 8 * fq) = pack8(a0 * c0 - b0 * s0, a1 * c1 - b1 * s1);
                    *(u32x4*)(q + (size_t)row * 1536 + 1024 + head * 64 + 32 + 8 * fq) = pack8(b0 * c0 + a0 * s0, b1 * c1 + a1 * s1); }
        }
    }
};
struct EpiKV {
    static constexpr bool PERM = true;
    bf16_t* kv; const float* ssq;
    __device__ __forceinline__ void operator()(const Acc& acc, const Unit& u, int wr, int wc, int fr, int fq) const {
        const int row0 = u.pm * 256 + wr * 64 + fr, col0 = u.pn * 256 + wc * 32 + 8 * fq;
#pragma unroll
        for (int ai = 0; ai < 2; ++ai)
#pragma unroll
            for (int m = 0; m < 4; ++m) { const int row = row0 + ai * 128 + m * 16; const float rs = row_rstd(ssq + (size_t)row * 16 + 8);
#pragma unroll
                for (int bj = 0; bj < 2; ++bj) *(u32x4*)(kv + (size_t)row * 2048 + col0 + bj * 128) = pack8(acc[ai][bj][m][0] * rs, acc[ai][bj][m][1] * rs); }
    }
};
struct EpiGate {
    static constexpr bool PERM = true;
    unsigned* au; const bf16_t* xc; const float *ba, *bi, *sp;
    __device__ __forceinline__ void operator()(const Acc& acc, const Unit& u, int wr, int wc, int fr, int fq) const {
        const int row0 = u.pm * 256 + wr * 64 + fr, d = u.pn, ch0 = u.z * 128 + wc * 32 + 8 * fq;
        unsigned* aud = au + (size_t)d * M_ * 1024;
#pragma unroll
        for (int n = 0; n < 2; ++n) {
            const int ch = ch0 + 4 * n;
            const f32x4 bav = *(const f32x4*)(ba + d * 1024 + ch), biv = *(const f32x4*)(bi + d * 1024 + ch), spv = *(const f32x4*)(sp + d * 1024 + ch) * (-8.0f * 1.4426950408889634f);
#pragma unroll
            for (int ai = 0; ai < 2; ++ai)
#pragma unroll
                for (int m = 0; m < 4; ++m) { const int row = row0 + ai * 128 + m * 16;
                    const u32x2 xw = *(const u32x2*)(xc + (size_t)row * 1024 + ch);
                    const float xv[4] = {bf_lo(xw.x), bf_hi(xw.x), bf_lo(xw.y), bf_hi(xw.y)};
                    u32x4 o;
#pragma unroll
                    for (int j = 0; j < 4; ++j) {
                        const float r = sigmoidf_(acc[ai][0][m][n][j] + bav[j]);
                        const float ig = sigmoidf_(acc[ai][1][m][n][j] + biv[j]);
                        const float a = __builtin_amdgcn_exp2f(r * spv[j]);
                        const float oma = 1.0f - a;
                        const float uu = __builtin_amdgcn_sqrtf(oma * (1.0f + a)) * ig * xv[j];
                        o[j] = cvt_pk_bf16(oma, uu); }
                    *(u32x4*)(aud + (size_t)row * 1024 + ch) = o; }
        }
    }
};
struct EpiRes {
    static constexpr bool PERM = false;
    float* out;
    __device__ __forceinline__ void operator()(const Acc& acc, const Unit& u, int wr, int wc, int fr, int fq) const {
        const int row0 = u.pm * 256 + wr * 64 + fr, col0 = u.pn * 256 + wc * 32 + 4 * fq;
#pragma unroll
        for (int ai = 0; ai < 2; ++ai)
#pragma unroll
            for (int m = 0; m < 4; ++m) { float* rowp = out + (size_t)(row0 + ai * 128 + m * 16) * 2048 + col0;
#pragma unroll
                for (int bj = 0; bj < 2; ++bj)
#pragma unroll
                    for (int n = 0; n < 2; ++n) { const f32x4 h = *(const f32x4*)(rowp + bj * 128 + n * 16); *(f32x4*)(rowp + bj * 128 + n * 16) = h * ALPHA + acc[ai][bj][m][n]; }
                asm volatile("" ::: "memory"); }
    }
};
struct EpiUp {
    static constexpr bool PERM = true;
    bf16_t* f;
    __device__ __forceinline__ void operator()(const Acc& acc, const Unit& u, int wr, int wc, int fr, int fq) const {
        const int row0 = u.pm * 256 + wr * 64 + fr, col0 = u.pn * 256 + wc * 32 + 8 * fq;
#pragma unroll
        for (int ai = 0; ai < 2; ++ai)
#pragma unroll
            for (int m = 0; m < 4; ++m) { const int row = row0 + ai * 128 + m * 16;
#pragma unroll
                for (int bj = 0; bj < 2; ++bj) { f32x4 v0 = acc[ai][bj][m][0], v1 = acc[ai][bj][m][1];
#pragma unroll
                    for (int j = 0; j < 4; ++j) { const float a = fmaxf(v0[j], 0.f), b = fmaxf(v1[j], 0.f); v0[j] = a * a; v1[j] = b * b; }
                    *(u32x4*)(f + (size_t)row * 8192 + col0 + bj * 128) = pack8(v0, v1); } }
    }
};

namespace att {
constexpr int NW = 8, QBLK = 32, KVBLK = 64;
constexpr float SCALE = 0.07216878364870323f;
constexpr float THR = 8.f;
#ifndef ATT_SDEPTH
#define ATT_SDEPTH 1
#endif
constexpr int SDEPTH = ATT_SDEPTH;
constexpr int SHM_V = KVBLK * 128 * 2, SHM_K = KVBLK * 128 * 2, SHM_R = KVBLK * 64 * 2;
constexpr int OFF_V = 0, OFF_K = 2 * SHM_V, OFF_R = OFF_K + 2 * SHM_K, OFF_WS = OFF_R + 2 * SHM_R, OFF_QR = OFF_WS + NW * 64 * 4, SHM_ATTN = OFF_QR + 256 * 128;
#define KSWZ(row, colB) ((row) * 256 + ((colB) ^ (((row) & 7) << 4)))
#define RSWZ(row, colB) ((row) * 128 + ((colB) ^ (((row) & 7) << 4)))
#define SBAR() __builtin_amdgcn_sched_barrier(0)
__device__ __forceinline__ int crow(int r, int hi) { return (r & 3) + 8 * (r >> 2) + 4 * hi; }
__device__ __forceinline__ void partialSM(f32x16& p0, f32x16& p1, float& m_reg, float& mn, float& alpha) {
    constexpr float C = SCALE * 1.4426950408889634f;
    float pmax = p0[0];
#pragma unroll
    for (int r = 1; r < 16; ++r) pmax = fmaxf(pmax, p0[r]);
#pragma unroll
    for (int r = 0; r < 16; ++r) pmax = fmaxf(pmax, p1[r]);
    { auto rr = __builtin_amdgcn_permlane32_swap(__float_as_uint(pmax), __float_as_uint(pmax), false, false);
      pmax = fmaxf(__uint_as_float(rr[0]), __uint_as_float(rr[1])); }
    if (__builtin_expect(__all(pmax - m_reg <= THR / SCALE), 1)) { mn = m_reg; alpha = 1.f; }
    else { mn = fmaxf(m_reg, pmax); alpha = __builtin_amdgcn_exp2f((m_reg - mn) * C); m_reg = mn; }
    const float mnC = -mn * C;
#pragma unroll
    for (int r = 0; r < 16; ++r) p0[r] = fmaf(p0[r], C, mnC);
#pragma unroll
    for (int r = 0; r < 16; ++r) p1[r] = fmaf(p1[r], C, mnC);
#pragma unroll
    for (int r = 0; r < 16; ++r) p0[r] = __builtin_amdgcn_exp2f(p0[r]);
}
__device__ __forceinline__ void finishSM(f32x16& p0, f32x16& p1, float alpha, float& l_reg, bf16x8& pa0, bf16x8& pa1, bf16x8& pa2, bf16x8& pa3) {
#pragma unroll
    for (int r = 0; r < 16; ++r) p1[r] = __builtin_amdgcn_exp2f(p1[r]);
    float ps = 0;
#pragma unroll
    for (int r = 0; r < 16; ++r) ps += p0[r];
#pragma unroll
    for (int r = 0; r < 16; ++r) ps += p1[r];
    { auto rr = __builtin_amdgcn_permlane32_swap(__float_as_uint(ps), __float_as_uint(ps), false, false);
      ps = __uint_as_float(rr[0]) + __uint_as_float(rr[1]); }
    l_reg = l_reg * alpha + ps;
#define PK4(P, BASE, OUT) do { unsigned a0 = cvt_pk_bf16(P[BASE + 0], P[BASE + 1]), a1 = cvt_pk_bf16(P[BASE + 2], P[BASE + 3]);   \
    unsigned b0 = cvt_pk_bf16(P[BASE + 4], P[BASE + 5]), b1 = cvt_pk_bf16(P[BASE + 6], P[BASE + 7]);                              \
    auto r0 = __builtin_amdgcn_permlane32_swap(a0, b0, false, false); auto r1 = __builtin_amdgcn_permlane32_swap(a1, b1, false, false); \
    u32x4 w = {r0[0], r1[0], r0[1], r1[1]}; OUT = *reinterpret_cast<bf16x8*>(&w); } while (0)
    PK4(p0, 0, pa0); PK4(p0, 8, pa1); PK4(p1, 0, pa2); PK4(p1, 8, pa3);
#undef PK4
}
__device__ __forceinline__ void qkt(f32x16& p0, f32x16& p1, const char* Ks, const char* Rs, const bf16x8* qr, const char* Qrl, int r32, int hi) {
    p0 = f32x16{}; p1 = f32x16{};
#pragma unroll
    for (int d0 = 0; d0 < 8; ++d0) { const int cb = (d0 * 16 + hi * 8) * 2;
        const bf16x8 b0 = *reinterpret_cast<const bf16x8*>(Ks + KSWZ(r32, cb));
        const bf16x8 b1 = *reinterpret_cast<const bf16x8*>(Ks + KSWZ(32 + r32, cb));
        p0 = __builtin_amdgcn_mfma_f32_32x32x16_bf16(b0, qr[d0], p0, 0, 0, 0);
        p1 = __builtin_amdgcn_mfma_f32_32x32x16_bf16(b1, qr[d0], p1, 0, 0, 0); }
#pragma unroll
    for (int d0 = 0; d0 < 4; ++d0) { const int cb = (d0 * 16 + hi * 8) * 2;
        const bf16x8 b0 = *reinterpret_cast<const bf16x8*>(Rs + RSWZ(r32, cb));
        const bf16x8 b1 = *reinterpret_cast<const bf16x8*>(Rs + RSWZ(32 + r32, cb));
        const bf16x8 qv = *reinterpret_cast<const bf16x8*>(Qrl + (cb ^ ((r32 & 7) << 4)));
        p0 = __builtin_amdgcn_mfma_f32_32x32x16_bf16(b0, qv, p0, 0, 0, 0);
        p1 = __builtin_amdgcn_mfma_f32_32x32x16_bf16(b1, qv, p1, 0, 0, 0); }
}
__device__ __forceinline__ int v_st(int k, int c) { const int kk = (k & ~0xC) | ((k & 4) << 1) | ((k & 8) >> 1); return ((kk >> 3) * 4 + (c >> 5)) * 512 + ((kk & 7) * 32 + (c & 31)) * 2; }
__device__ __forceinline__ int v_rd_base(int lane) { return ((lane & 3) << 3) | (((lane >> 2) & 3) << 6) | (((lane >> 4) & 1) << 5) | (((lane >> 5) & 1) << 8); }
constexpr int v_rd_off(int d0, int ks, int half) { return d0 * 512 + ks * 4096 + half * 2048; }
template <int OFF> __device__ __forceinline__ s16x4 tr_read(int vb) {
    s16x4 r; asm volatile("ds_read_b64_tr_b16 %0, %1 offset:%2" : "=&v"(r) : "v"(vb), "i"(OFF) : "memory"); return r;
}
template <int D0> __device__ __forceinline__ void pv_one(f32x16& od, int vb, bf16x8 pa0, bf16x8 pa1, bf16x8 pa2, bf16x8 pa3) {
    const s16x4 l0 = tr_read<v_rd_off(D0, 0, 0)>(vb), h0 = tr_read<v_rd_off(D0, 0, 1)>(vb), l1 = tr_read<v_rd_off(D0, 1, 0)>(vb), h1 = tr_read<v_rd_off(D0, 1, 1)>(vb);
    const s16x4 l2 = tr_read<v_rd_off(D0, 2, 0)>(vb), h2 = tr_read<v_rd_off(D0, 2, 1)>(vb), l3 = tr_read<v_rd_off(D0, 3, 0)>(vb), h3 = tr_read<v_rd_off(D0, 3, 1)>(vb);
    asm volatile("s_waitcnt lgkmcnt(0)" ::: "memory"); SBAR();
#define PK(L, H) (bf16x8){L[0], L[1], L[2], L[3], H[0], H[1], H[2], H[3]}
    od = __builtin_amdgcn_mfma_f32_32x32x16_bf16(pa0, PK(l0, h0), od, 0, 0, 0);
    od = __builtin_amdgcn_mfma_f32_32x32x16_bf16(pa1, PK(l1, h1), od, 0, 0, 0);
    od = __builtin_amdgcn_mfma_f32_32x32x16_bf16(pa2, PK(l2, h2), od, 0, 0, 0);
    od = __builtin_amdgcn_mfma_f32_32x32x16_bf16(pa3, PK(l3, h3), od, 0, 0, 0);
#undef PK
}
__device__ __forceinline__ void pv_d0(f32x16* o, int vb, bf16x8 pa0, bf16x8 pa1, bf16x8 pa2, bf16x8 pa3) {
    pv_one<0>(o[0], vb, pa0, pa1, pa2, pa3); pv_one<1>(o[1], vb, pa0, pa1, pa2, pa3); pv_one<2>(o[2], vb, pa0, pa1, pa2, pa3); pv_one<3>(o[3], vb, pa0, pa1, pa2, pa3);
}
__device__ __forceinline__ void attn_unit(const bf16_t* __restrict__ Qn, const bf16_t* __restrict__ Qr, const bf16_t* __restrict__ Kh, const bf16_t* __restrict__ Rh,
                                          bf16_t* __restrict__ Ob, int seq, char* lds) {
    const int tid = otid(), wid = tid >> 6, lane = tid & 63, r32 = lane & 31, hi = lane >> 5;
    char* V_lds = lds + OFF_V; char* K_lds = lds + OFF_K; char* R_lds = lds + OFF_R;
    float* ws = (float*)(lds + OFF_WS) + wid * 64; float* li_l = ws; float* al_l = ws + 32;
    float m_reg = -1e30f, l_reg = 0; f32x16 o[4] = {}; bf16x8 qr[8];
    char* Qrl = lds + OFF_QR + (wid * QBLK + r32) * 128;
    {
        const bf16_t* Qw = Qn + (size_t)(wid * QBLK + r32) * 1536 + hi * 8;
#pragma unroll
        for (int d0 = 0; d0 < 8; ++d0) qr[d0] = *reinterpret_cast<const bf16x8*>(Qw + d0 * 16);
        const bf16_t* Qw2 = Qr + (size_t)(wid * QBLK + r32) * 1536 + hi * 8;
#pragma unroll
        for (int d0 = 0; d0 < 4; ++d0) { const bf16x8 t = *reinterpret_cast<const bf16x8*>(Qw2 + d0 * 16); *reinterpret_cast<bf16x8*>(Qrl + (((d0 * 16 + hi * 8) * 2) ^ ((r32 & 7) << 4))) = t; }
    }
    const int sr = tid >> 4, sc = (tid & 15) * 8, vst0 = v_st(sr, sc), vst1 = v_st(32 + sr, sc);
    const int rr_ = tid >> 3, rc = (tid & 7) * 8;
    const int vb0 = (int)(uintptr_t)V_lds + v_rd_base(lane);
    struct { bf16x8 vs0, vs1, ks0, ks1, rs; } sr_[SDEPTH];
#define SLOAD(i, k0) do { sr_[i].vs0 = *(const bf16x8*)(&Kh[(size_t)((k0) + sr) * 2048 + 128 + sc]); sr_[i].vs1 = *(const bf16x8*)(&Kh[(size_t)((k0) + 32 + sr) * 2048 + 128 + sc]); \
    sr_[i].ks0 = *(const bf16x8*)(&Kh[(size_t)((k0) + sr) * 2048 + sc]); sr_[i].ks1 = *(const bf16x8*)(&Kh[(size_t)((k0) + 32 + sr) * 2048 + sc]); \
    sr_[i].rs = *(const bf16x8*)(&Rh[(size_t)((k0) + rr_) * 64 + rc]); } while (0)
#define SWRITE(b, i) do { *(bf16x8*)(V_lds + (b) * SHM_V + vst0) = sr_[i].vs0;          \
    *(bf16x8*)(V_lds + (b) * SHM_V + vst1) = sr_[i].vs1; const int kc = sc * 2;               \
    *(bf16x8*)(K_lds + (b) * SHM_K + KSWZ(sr, kc)) = sr_[i].ks0;                       \
    *(bf16x8*)(K_lds + (b) * SHM_K + KSWZ(32 + sr, kc)) = sr_[i].ks1;                  \
    *(bf16x8*)(R_lds + (b) * SHM_R + RSWZ(rr_, rc * 2)) = sr_[i].rs; } while (0)
#define SWAIT() do { if constexpr (SDEPTH == 2) asm volatile("s_waitcnt vmcnt(5)" ::: "memory"); else asm volatile("s_waitcnt vmcnt(0)" ::: "memory"); } while (0)
#define RESC(a) do { if (__any((a) < 1.f)) { if (hi == 0) al_l[r32] = (a); asm volatile("s_waitcnt lgkmcnt(0)" ::: "memory"); \
    _Pragma("unroll") for (int d = 0; d < 4; ++d) _Pragma("unroll") for (int r = 0; r < 16; ++r) o[d][r] *= al_l[crow(r, hi)]; } } while (0)
    f32x16 pA0, pA1, pB0, pB1; float mnA, mnB, alA, alB; bf16x8 pa0, pa1, pa2, pa3; const int NT = seq / KVBLK;
    constexpr int SE = 0, SO = SDEPTH - 1;
    SLOAD(SE, 0); asm volatile("s_waitcnt vmcnt(0)" ::: "memory"); SWRITE(0, SE); __syncthreads();
    qkt(pA0, pA1, K_lds, R_lds, qr, Qrl, r32, hi); partialSM(pA0, pA1, m_reg, mnA, alA);
    SLOAD(SO, KVBLK); if constexpr (SDEPTH == 2) { if (2 < NT) SLOAD(SE, 2 * KVBLK); }
    SWAIT(); SWRITE(1, SO); __syncthreads();
    for (int j = 1; j + 1 < NT; j += 2) {
        SBAR(); qkt(pB0, pB1, K_lds + SHM_K, R_lds + SHM_R, qr, Qrl, r32, hi);
        finishSM(pA0, pA1, alA, l_reg, pa0, pa1, pa2, pa3); SBAR();
        SLOAD(SO, (j + SDEPTH) * KVBLK); SBAR();
        pv_d0(o, vb0, pa0, pa1, pa2, pa3); partialSM(pB0, pB1, m_reg, mnB, alB);
        __syncthreads(); SWAIT(); SWRITE(0, SE);
        RESC(alB); __syncthreads();
        SBAR(); qkt(pA0, pA1, K_lds, R_lds, qr, Qrl, r32, hi);
        finishSM(pB0, pB1, alB, l_reg, pa0, pa1, pa2, pa3); SBAR();
        if (SDEPTH == 1 || j + 3 < NT) SLOAD(SE, (j + 1 + SDEPTH) * KVBLK); SBAR();
        pv_d0(o, vb0 + (int)SHM_V, pa0, pa1, pa2, pa3); partialSM(pA0, pA1, m_reg, mnA, alA);
        __syncthreads(); SWAIT(); SWRITE(1, SO);
        RESC(alA); __syncthreads();
    }
    SBAR(); qkt(pB0, pB1, K_lds + SHM_K, R_lds + SHM_R, qr, Qrl, r32, hi);
    finishSM(pA0, pA1, alA, l_reg, pa0, pa1, pa2, pa3); SBAR();
    pv_d0(o, vb0, pa0, pa1, pa2, pa3); partialSM(pB0, pB1, m_reg, mnB, alB);
    __syncthreads(); RESC(alB);
    finishSM(pB0, pB1, alB, l_reg, pa0, pa1, pa2, pa3); SBAR();
    pv_d0(o, vb0 + (int)SHM_V, pa0, pa1, pa2, pa3);
    if (hi == 0) li_l[r32] = l_reg; asm volatile("s_waitcnt lgkmcnt(0)" ::: "memory");
    float rli[16];
#pragma unroll
    for (int r = 0; r < 16; ++r) rli[r] = __builtin_amdgcn_rcpf(li_l[crow(r, hi)]);
    bf16_t* Ow = Ob + (size_t)(wid * QBLK) * 2048;
#pragma unroll
    for (int r = 0; r < 16; ++r) { const int orow = crow(r, hi);
#pragma unroll
        for (int d0 = 0; d0 < 4; ++d0) Ow[(size_t)orow * 2048 + d0 * 32 + r32] = (bf16_t)(cvt_pk_bf16(o[d0][r] * rli[r], 0.f) & 0xffffu); }
#undef SLOAD
#undef SWRITE
#undef SWAIT
#undef RESC
}
}

__device__ __forceinline__ void ln_rows(const float* src, float* dstf, bf16_t* dstb, const float* g, const float* b) {
    const int tid_ = otid(), lane = tid_ & 63, wave = tid_ >> 6;
    for (int row = blockIdx.x * 8 + wave; row < M_; row += gridDim.x * 8) {
        const float* s = src + (size_t)row * 2048; f32x4 v[8]; float sum = 0.f;
#pragma unroll
        for (int i = 0; i < 8; ++i) { v[i] = *(const f32x4*)(s + i * 256 + lane * 4); sum += (v[i][0] + v[i][1]) + (v[i][2] + v[i][3]); }
#pragma unroll
        for (int o = 32; o >= 1; o >>= 1) sum += __shfl_xor(sum, o);
        const float mu = sum * (1.0f / 2048.0f); float q = 0.f;
#pragma unroll
        for (int i = 0; i < 8; ++i) { v[i] = v[i] - mu; q += (v[i][0] * v[i][0] + v[i][1] * v[i][1]) + (v[i][2] * v[i][2] + v[i][3] * v[i][3]); }
#pragma unroll
        for (int o = 32; o >= 1; o >>= 1) q += __shfl_xor(q, o);
        const float rstd = 1.0f / sqrtf(q * (1.0f / 2048.0f) + LN_EPS);
#pragma unroll
        for (int i = 0; i < 8; ++i) { const int c = i * 256 + lane * 4; const f32x4 gv = *(const f32x4*)(g + c), bv = *(const f32x4*)(b + c);
            const f32x4 y = v[i] * rstd * gv + bv; *(f32x4*)(dstf + (size_t)row * 2048 + c) = y;
            u32x2 w; w.x = cvt_pk_bf16(y[0], y[1]); w.y = cvt_pk_bf16(y[2], y[3]); *(u32x2*)(dstb + (size_t)row * 2048 + c) = w; }
    }
}
__device__ __forceinline__ int colmap(int mode, int n) {
    if (mode == 0) { if (n < 1024) return n; if (n < 2048) return 1088 + (n - 1024); if (n < 3072) return 2112 + (n - 2048);
        const int t = n - 3072, bj = t >> 7, r = t & 127; return r < 32 ? 1024 + bj * 32 + r : -1; }
    if (mode == 1) { if (n < 1024) return (n >> 7) * 192 + (n & 127);
        const int t = n - 1024, tile = t >> 8, bj = (t >> 7) & 1, wc = (t >> 5) & 3, i = t & 31; return (4 * tile + wc) * 192 + 128 + bj * 32 + i; }
    return n;
}
__device__ __forceinline__ void cvt_tile(const float* W, int ldw, bf16_t* Bt, int ldb, int n0, int k0, int mode, const float* kscale, float* T) {
    const int tid = otid(), nn = tid & 63, src = colmap(mode, n0 + nn);
#pragma unroll
    for (int i = 0; i < 8; ++i) { const int kk = (tid >> 6) + 8 * i; float v = src >= 0 ? W[(size_t)(k0 + kk) * ldw + src] : 0.f; if (kscale) v *= kscale[k0 + kk]; T[nn * 65 + kk] = v; }
    __syncthreads();
    { const int n2 = tid >> 3, k2 = (tid & 7) * 8; const float* t = T + n2 * 65 + k2;
      u32x4 w; w.x = cvt_pk_bf16(t[0], t[1]); w.y = cvt_pk_bf16(t[2], t[3]); w.z = cvt_pk_bf16(t[4], t[5]); w.w = cvt_pk_bf16(t[6], t[7]);
      *(u32x4*)(Bt + (size_t)(n0 + n2) * ldb + k0 + k2) = w; }
    __syncthreads();
}
__device__ __forceinline__ void convert_weights(const Params& p, int l, float* T) {
    unsigned char* ws = p.ws;
    constexpr int T0 = 52 * 32, T1 = T0 + 24 * 8, T2 = T1 + 32 * 8, T3 = T2 + 128, T4 = T3 + 32 * 32, T5 = T4 + 128 * 32, T6 = T5 + 32 * 128;
    for (int t = blockIdx.x; t < T6; t += gridDim.x) {
        if (t < T0) { const int nt = t % 52, kt = t / 52; cvt_tile(p.in[4] + (size_t)l * 2048 * NIN, NIN, (bf16_t*)(ws + W_IN), 2048, nt * 64, kt * 64, 0, nullptr, T); }
        else if (t < T1) { const int u = t - T0, nt = u % 24, kt = u / 24; cvt_tile(p.in[7] + (size_t)l * 512 * 1536, 1536, (bf16_t*)(ws + W_UQ), 512, nt * 64, kt * 64, 1, p.in[5] + l * 512, T); }
        else if (t < T2) { const int u = t - T1, nt = u % 32, kt = u / 32; cvt_tile(p.in[8] + (size_t)l * 512 * 2048, 2048, (bf16_t*)(ws + W_UKV), 512, nt * 64, kt * 64, 2, p.in[6] + l * 512, T); }
        else if (t < T3) { const int u = t - T2, mat = u >> 2, nt = u & 1, kt = (u >> 1) & 1, gate = mat & 1, h = (mat >> 1) & 7, d = mat >> 4;
            cvt_tile((gate ? p.in[13] : p.in[11]) + ((size_t)((l * 2 + d) * 8 + h)) * 128 * 128, 128, (bf16_t*)(ws + W_G) + (size_t)(h * 512 + d * 256 + gate * 128) * 128, 128, nt * 64, kt * 64, 2, nullptr, T); }
        else if (t < T4) { const int u = t - T3, nt = u % 32, kt = u / 32; cvt_tile(p.in[16] + (size_t)l * 2048 * 2048, 2048, (bf16_t*)(ws + W_OUT), 2048, nt * 64, kt * 64, 2, nullptr, T); }
        else if (t < T5) { const int u = t - T4, nt = u % 128, kt = u / 128; cvt_tile(p.in[19] + (size_t)l * 2048 * 8192, 8192, (bf16_t*)(ws + W_UP), 2048, nt * 64, kt * 64, 2, nullptr, T); }
        else { const int u = t - T5, nt = u % 32, kt = u / 32; cvt_tile(p.in[20] + (size_t)l * 8192 * 2048, 2048, (bf16_t*)(ws + W_DN), 8192, nt * 64, kt * 64, 2, nullptr, T); }
    }
}
__device__ __forceinline__ void make_tables(const Params& p) {
    const int* pos = (const int*)p.in[1]; float* cosT = (float*)(p.ws + WS_COS); float* sinT = (float*)(p.ws + WS_SIN); float* sp = (float*)(p.ws + WS_SP);
    const int tid = otid();
    for (size_t i = (size_t)blockIdx.x * 512 + tid; i < (size_t)M_ * 32; i += (size_t)gridDim.x * 512) {
        const int row = (int)(i >> 5), k = (int)(i & 31); const float inv = powf(10000.0f, -(float)(2 * k) / 64.0f); const float ang = (float)pos[row] * inv;
        cosT[i] = cosf(ang); sinT[i] = sinf(ang); }
    for (int i = blockIdx.x * 512 + tid; i < DEPTH * 2 * 1024; i += gridDim.x * 512) { const float x = -p.in[15][i];
        sp[i] = fmaxf(x, 0.f) + log1pf(expf(-fabsf(x))); }
}
__device__ __forceinline__ void conv_phase(const Params& p, int l) {
    const bf16_t* xl = (const bf16_t*)(p.ws + WS_XL); bf16_t* xc = (bf16_t*)(p.ws + WS_XC);
    const float* cw = p.in[9] + (size_t)l * 4 * 1024; const float* cb = p.in[10] + (size_t)l * 1024;
    const int tid = otid();
    for (size_t i = (size_t)blockIdx.x * 512 + tid; i < (size_t)M_ * 128; i += (size_t)gridDim.x * 512) {
        const int row = (int)(i >> 7), c0 = (int)(i & 127) * 8, t = row & (SEQ - 1);
        float acc[8];
        { const f32x4 b0 = *(const f32x4*)(cb + c0), b1 = *(const f32x4*)(cb + c0 + 4); acc[0] = b0[0]; acc[1] = b0[1]; acc[2] = b0[2]; acc[3] = b0[3]; acc[4] = b1[0]; acc[5] = b1[1]; acc[6] = b1[2]; acc[7] = b1[3]; }
#pragma unroll
        for (int k = 0; k < 4; ++k) { const int tt = t - 2 + k; if (tt < 0 || tt >= SEQ) continue;
            const u32x4 xw = *(const u32x4*)(xl + (size_t)(row - 2 + k) * 1024 + c0);
            const f32x4 w0 = *(const f32x4*)(cw + k * 1024 + c0), w1 = *(const f32x4*)(cw + k * 1024 + c0 + 4);
            acc[0] += w0[0] * bf_lo(xw.x); acc[1] += w0[1] * bf_hi(xw.x); acc[2] += w0[2] * bf_lo(xw.y); acc[3] += w0[3] * bf_hi(xw.y);
            acc[4] += w1[0] * bf_lo(xw.z); acc[5] += w1[1] * bf_hi(xw.z); acc[6] += w1[2] * bf_lo(xw.w); acc[7] += w1[3] * bf_hi(xw.w); }
        u32x4 o; o.x = cvt_pk_bf16(acc[0], acc[1]); o.y = cvt_pk_bf16(acc[2], acc[3]); o.z = cvt_pk_bf16(acc[4], acc[5]); o.w = cvt_pk_bf16(acc[6], acc[7]);
        *(u32x4*)(xc + (size_t)row * 1024 + c0) = o;
    }
}
__device__ __forceinline__ void scan_local(const Params& p) {
    const unsigned* au = (const unsigned*)(p.ws + WS_AU); f32x2* ph = (f32x2*)(p.ws + WS_PH); const int tid = otid();
    for (int it = blockIdx.x; it < 2 * 8 * 64 * 2; it += gridDim.x) {
        const int half = it & 1, c = (it >> 1) & 63, b = (it >> 7) & 7, d = it >> 10, ch = half * 512 + tid;
        const unsigned* src = au + (size_t)d * M_ * 1024 + (size_t)(b * SEQ + c * 64) * 1024 + ch;
        float h = 0.f, P = 1.f;
#pragma unroll 16
        for (int s = 0; s < 64; ++s) { const int t = d ? 63 - s : s; const unsigned w = src[(size_t)t * 1024]; const float a = 1.0f - bf_lo(w), u = bf_hi(w); h = a * h + u; P *= a; }
        ph[(size_t)((d * 8 + b) * 64 + c) * 1024 + ch] = (f32x2){P, h};
    }
}
__device__ __forceinline__ void scan_apply(const Params& p) {
    const unsigned* au = (const unsigned*)(p.ws + WS_AU); const f32x2* ph = (const f32x2*)(p.ws + WS_PH);
    const bf16_t* gg = (const bf16_t*)(p.ws + WS_GG); bf16_t* ycat = (bf16_t*)(p.ws + WS_YCAT); const int tid = otid();
    for (int it = blockIdx.x; it < 8 * 64 * 2; it += gridDim.x) {
        const int half = it & 1, c = (it >> 1) & 63, b = it >> 7, ch = half * 512 + tid;
        float Hf = 0.f, Hb = 0.f;
        for (int cc = 0; cc < c; ++cc) { const f32x2 e = ph[(size_t)((0 * 8 + b) * 64 + cc) * 1024 + ch]; Hf = e.x * Hf + e.y; }
        for (int cc = 63; cc > c; --cc) { const f32x2 e = ph[(size_t)((1 * 8 + b) * 64 + cc) * 1024 + ch]; Hb = e.x * Hb + e.y; }
        const size_t r0 = (size_t)(b * SEQ + c * 64);
        const unsigned* s0 = au + r0 * 1024 + ch; const unsigned* s1 = au + (size_t)M_ * 1024 + r0 * 1024 + ch;
        float hf[64];
#pragma unroll
        for (int t = 0; t < 64; ++t) { const unsigned w = s0[(size_t)t * 1024]; Hf = (1.0f - bf_lo(w)) * Hf + bf_hi(w); hf[t] = Hf; }
#pragma unroll
        for (int s = 0; s < 64; ++s) { const int t = 63 - s; const unsigned w = s1[(size_t)t * 1024]; Hb = (1.0f - bf_lo(w)) * Hb + bf_hi(w);
            const float g = __uint_as_float((unsigned)gg[(r0 + t) * 1024 + ch] << 16);
            ycat[(r0 + t) * 2048 + 1024 + ch] = (bf16_t)(cvt_pk_bf16(g * (hf[t] + Hb), 0.f) & 0xffffu); }
    }
}

__global__ void __launch_bounds__(512, 2) mega_fwd(Params p) {
    extern __shared__ __attribute__((aligned(16))) unsigned char lds[];
    cg::grid_group grid = cg::this_grid();
    unsigned char* ws = p.ws;
    LAS unsigned char* ldsl = (LAS unsigned char*)lds;
    bf16_t* hb = (bf16_t*)(ws + WS_HB);
    const float* cosT = (const float*)(ws + WS_COS); const float* sinT = (const float*)(ws + WS_SIN);

    make_tables(p);
    ln_rows(p.in[0], p.out, hb, p.in[2], p.in[3]);
    convert_weights(p, 0, (float*)lds);
    grid.sync();

#pragma unroll 1
    for (int l = 0; l < DEPTH; ++l) {
        { pg8::Order S = pg8::make_order(hb, 2048, ws + W_IN, 2048, M_, NINP, 2048);
          EpiIn E{(bf16_t*)(ws + WS_CQ), (bf16_t*)(ws + WS_CKV), (bf16_t*)(ws + WS_XL), (bf16_t*)(ws + WS_GG), (bf16_t*)(ws + WS_KPE), (float*)(ws + WS_SSQ), cosT, sinT};
          pg8::gemm_phase(ldsl, S, E); }
        grid.sync();
        conv_phase(p, l);
        { pg8::Order S = pg8::make_order(ws + WS_CQ, 512, ws + W_UQ, 512, M_, 1536, 512);
          EpiQ E{(bf16_t*)(ws + WS_Q), (const float*)(ws + WS_SSQ), cosT, sinT};
          pg8::gemm_phase(ldsl, S, E); }
        { pg8::Order S = pg8::make_order(ws + WS_CKV, 512, ws + W_UKV, 512, M_, 2048, 512);
          EpiKV E{(bf16_t*)(ws + WS_KV), (const float*)(ws + WS_SSQ)};
          pg8::gemm_phase(ldsl, S, E); }
        grid.sync();
        {
            const bf16_t* Q = (const bf16_t*)(ws + WS_Q); const bf16_t* KV = (const bf16_t*)(ws + WS_KV); const bf16_t* KPE = (const bf16_t*)(ws + WS_KPE); bf16_t* ycat = (bf16_t*)(ws + WS_YCAT);
            const int G = gridDim.x, bx = blockIdx.x;
            for (int L = bx; L < 1024; L += G) {
                int pair, qb;
                if (G == 256) { const int i = L >> 8, c = L & 255, xcd = c & 7, j = c >> 3; pair = i * 16 + xcd * 2 + (j >> 4); qb = j & 15; } else { pair = L >> 4; qb = L & 15; }
                const int b = pair >> 3, h = pair & 7; const size_t row0 = (size_t)b * SEQ + (size_t)qb * 256;
                __syncthreads();
                att::attn_unit(Q + row0 * 1536 + h * 128, Q + row0 * 1536 + 1024 + h * 64, KV + (size_t)b * SEQ * 2048 + h * 256, KPE + (size_t)b * SEQ * 64, ycat + row0 * 2048 + h * 128, SEQ, (char*)lds);
            }
            __syncthreads();
        }
        { pg8::Order S = pg8::make_order(ws + WS_XC, 1024, ws + W_G, 128, M_, 512, 128);
          S.nZ = 8; S.a_z = 128 * 2; S.b_z = (size_t)512 * 128 * 2;
          EpiGate E{(unsigned*)(ws + WS_AU), (const bf16_t*)(ws + WS_XC), p.in[12] + (size_t)l * 2048, p.in[14] + (size_t)l * 2048, (const float*)(ws + WS_SP) + (size_t)l * 2048};
          pg8::gemm_phase(ldsl, S, E); }
        grid.sync();
        scan_local(p);
        grid.sync();
        scan_apply(p);
        grid.sync();
        { pg8::Order S = pg8::make_order(ws + WS_YCAT, 2048, ws + W_OUT, 2048, M_, 2048, 2048);
          EpiRes E{p.out}; pg8::gemm_phase(ldsl, S, E); }
        grid.sync();
        ln_rows(p.out, p.out, hb, p.in[17] + (size_t)l * 2048, p.in[18] + (size_t)l * 2048);
        grid.sync();
        { pg8::Order S = pg8::make_order(hb, 2048, ws + W_UP, 2048, M_, DFF, 2048);
          EpiUp E{(bf16_t*)(ws + WS_F)}; pg8::gemm_phase(ldsl, S, E); }
        grid.sync();
        { pg8::Order S = pg8::make_order(ws + WS_F, 8192, ws + W_DN, 8192, M_, 2048, 8192);
          EpiRes E{p.out}; pg8::gemm_phase(ldsl, S, E); }
        grid.sync();
        ln_rows(p.out, p.out, hb, p.in[21] + (size_t)l * 2048, p.in[22] + (size_t)l * 2048);
        if (l + 1 < DEPTH) { __syncthreads(); convert_weights(p, l + 1, (float*)lds); grid.sync(); }
    }
}

extern "C" void kernel_launch(void* const* d_in, const int* in_sizes, int n_in, void* d_out, int out_size, void* d_ws, size_t ws_size, hipStream_t stream) {
    constexpr int LDS_BYTES = pg8::STAGE_BYTES;
    static int grid_blocks = 0;
    if (grid_blocks == 0) {
        if (n_in != 23 || in_sizes[0] != M_ * DM || out_size != M_ * DM || ws_size < WS_END) {
            fprintf(stderr, "kernel_launch: shape mismatch (n_in %d, in0 %d, out %d, ws %zu, need %zu)\n", n_in, n_in > 0 ? in_sizes[0] : -1, out_size, ws_size, (size_t)WS_END); grid_blocks = -1; return; }
        int dev = 0, cus = 0, per_cu = 0;
        hipGetDevice(&dev); hipDeviceGetAttribute(&cus, hipDeviceAttributeMultiprocessorCount, dev);
        if (hipFuncSetAttribute((const void*)mega_fwd, hipFuncAttributeMaxDynamicSharedMemorySize, LDS_BYTES) != hipSuccess) { fprintf(stderr, "kernel_launch: hipFuncSetAttribute failed\n"); grid_blocks = -1; return; }
        if (hipOccupancyMaxActiveBlocksPerMultiprocessor(&per_cu, (const void*)mega_fwd, 512, LDS_BYTES) != hipSuccess || per_cu < 1) { fprintf(stderr, "kernel_launch: occupancy query says %d\n", per_cu); per_cu = 1; }
        (void)hipGetLastError();
        grid_blocks = cus * 1;
    }
    if (grid_blocks < 0) return;
    Params p{};
    for (int i = 0; i < 23; ++i) p.in[i] = (const float*)d_in[i];
    p.out = (float*)d_out; p.ws = (unsigned char*)d_ws;
    void* args[] = {&p};
    hipError_t e = hipLaunchCooperativeKernel((const void*)mega_fwd, dim3(grid_blocks), dim3(512), args, LDS_BYTES, stream);
    if (e != hipSuccess) fprintf(stderr, "kernel_launch: cooperative launch failed: %s (grid %d)\n", hipGetErrorString(e), grid_blocks);
}
```

```cpp
#include <hip/hip_runtime.h>
#include <hip/hip_cooperative_groups.h>
#include <cstdio>
#include <cstdint>
namespace cg = cooperative_groups;
#ifndef REP_THIN
#define REP_THIN 0
#endif
#ifndef REP_ATT
#define REP_ATT 0
#endif

#define LAS __attribute__((address_space(3)))
typedef unsigned short bf16_t;
typedef short bf16x8 __attribute__((ext_vector_type(8)));
typedef short s16x4 __attribute__((ext_vector_type(4)));
typedef float f32x4 __attribute__((ext_vector_type(4)));
typedef float f32x2 __attribute__((ext_vector_type(2)));
typedef float f32x16 __attribute__((ext_vector_type(16)));
typedef unsigned u32x4 __attribute__((ext_vector_type(4)));
typedef unsigned u32x2 __attribute__((ext_vector_type(2)));

constexpr int M_ = 32768, DM = 2048, SEQ = 4096, NBATCH = 8, DEPTH = 4;
constexpr int NIN = 3136, NINP = 3328, DFF = 8192;
constexpr float ALPHA = 1.6817928305074290f;
constexpr float LN_EPS = 1e-5f, RMS_EPS = 1e-6f;
constexpr size_t MiB = 1ull << 20;
constexpr size_t WS_HB = 0;
constexpr size_t WS_W = 128 * MiB;
constexpr size_t W_IN = WS_W, W_UQ = W_IN + (size_t)NINP * 2048 * 2, W_UKV = W_UQ + 1536ull * 512 * 2, W_G = W_UKV + 2048ull * 512 * 2,
                 W_OUT = W_G + 8ull * 512 * 128 * 2, W_UP = W_OUT + 2048ull * 2048 * 2, W_DN = W_UP + 8192ull * 2048 * 2, W_END = W_DN + 8192ull * 2048 * 2;
static_assert(W_END <= 218 * MiB, "weights region");
constexpr size_t WS_COS = 218 * MiB, WS_SIN = 222 * MiB, WS_SP = 226 * MiB;
constexpr size_t WS_BIG = 228 * MiB;
constexpr size_t WS_F = WS_BIG;
constexpr size_t WS_GG = WS_BIG, WS_XC = WS_BIG + 64 * MiB, WS_YCAT = WS_BIG + 128 * MiB, WS_SSQ = WS_BIG + 256 * MiB, WS_KPE = WS_BIG + 258 * MiB,
                 WS_CQ = WS_BIG + 262 * MiB, WS_CKV = WS_BIG + 294 * MiB, WS_XL = WS_BIG + 326 * MiB, WS_AU = WS_BIG + 262 * MiB  ,
                 WS_Q = WS_BIG + 518 * MiB, WS_KV = WS_BIG + 614 * MiB, WS_PH = WS_BIG + 742 * MiB, WS_END = WS_BIG + 750 * MiB;
static_assert(WS_END <= 1024 * MiB, "workspace");

struct Params { const float* in[23]; float* out; unsigned char* ws; };

__device__ __forceinline__ int otid() { int t = threadIdx.x; asm volatile("" : "+v"(t)); return t; }
__device__ __forceinline__ unsigned cvt_pk_bf16(float lo, float hi) { unsigned r; asm volatile("v_cvt_pk_bf16_f32 %0, %1, %2" : "=v"(r) : "v"(lo), "v"(hi)); return r; }
__device__ __forceinline__ float bf_lo(unsigned w) { return __uint_as_float(w << 16); }
__device__ __forceinline__ float bf_hi(unsigned w) { return __uint_as_float(w & 0xffff0000u); }
__device__ __forceinline__ float sigmoidf_(float x) { return __builtin_amdgcn_rcpf(1.0f + __builtin_amdgcn_exp2f(-1.4426950408889634f * x)); }
__device__ __forceinline__ float gelu_tanh(float x) { const float z = 0.7978845608028654f * (x + 0.044715f * x * x * x); return x * sigmoidf_(2.0f * z); }
__device__ __forceinline__ u32x4 pack8(const f32x4 a, const f32x4 b) { u32x4 w; w.x = cvt_pk_bf16(a[0], a[1]); w.y = cvt_pk_bf16(a[2], a[3]); w.z = cvt_pk_bf16(b[0], b[1]); w.w = cvt_pk_bf16(b[2], b[3]); return w; }

namespace pg8 {
constexpr int BM = 256, BK = 64, HALF = 128, HTB = HALF * BK * 2, STAGE_BYTES = 8 * HTB, NXCD = 8, WGM = 8;
__host__ __device__ __forceinline__ int lds_byte(int r, int c) { const int st = (r >> 4) * 2 + (c >> 5), rr = r & 15, cc = c & 31, ob = rr * 64 + cc * 2; return st * 1024 + (ob ^ (((ob >> 9) & 1) << 5)); }
__host__ __device__ __forceinline__ void stage_rc(int b, int& R, int& C) { const int st = b / 1024, sb = b % 1024, swz = sb ^ (((sb >> 9) & 1) << 5); R = (st >> 1) * 16 + swz / 64; C = (st & 1) * 32 + (swz % 64) / 2; }
__host__ __device__ __forceinline__ int perm32(int rho) { const int n = rho >> 4, i = rho & 15; return 8 * (i >> 2) + 4 * n + (i & 3); }

struct Unit { int pm, pn, z; };
struct Order {
    int nM, nN, nZ, per, G, c;
    const char* A; const char* B; size_t a_pm, a_z, b_pn, b_z; int lda, ldb, K;
    __device__ __forceinline__ bool next(int i, Unit& u) const {
        const long L = (long)i * G + c; if (L >= (long)per * nZ) return false;
        u.z = (int)(L / per); int wgid = (int)(L % per);
        { const int q = per / NXCD, r = per % NXCD, xcd = wgid % NXCD, off = wgid / NXCD; wgid = (xcd < r ? xcd * (q + 1) : r * (q + 1) + (xcd - r) * q) + off; }
        const int nig = WGM * nN, gid = wgid / nig, fm = gid * WGM, gsz = (nM - fm) < WGM ? (nM - fm) : WGM;
        u.pm = fm + ((wgid % nig) % gsz); u.pn = (wgid % nig) / gsz; return true;
    }
    __device__ __forceinline__ const char* aptr(const Unit& u) const { return A + (size_t)u.pm * a_pm + (size_t)u.z * a_z; }
    __device__ __forceinline__ const char* bptr(const Unit& u) const { return B + (size_t)u.pn * b_pn + (size_t)u.z * b_z; }
};
__device__ __forceinline__ Order make_order(const void* A, int lda, const void* Bt, int ldb, int Mrows, int N, int K) {
    Order o; o.nM = Mrows / BM; o.nN = N / BM; o.nZ = 1; o.per = o.nM * o.nN; o.G = gridDim.x; o.c = blockIdx.x;
    o.A = (const char*)A; o.B = (const char*)Bt; o.a_pm = (size_t)BM * lda * 2; o.a_z = 0; o.b_pn = (size_t)BM * ldb * 2; o.b_z = 0; o.lda = lda; o.ldb = ldb; o.K = K; return o;
}

template <class Epi>
__device__ __forceinline__ void gemm_phase(LAS unsigned char* lds, const Order& S, const Epi& E) {
    const int tid = otid(), wid = __builtin_amdgcn_readfirstlane(tid >> 6), lane = tid & 63, wr = wid >> 2, wc = wid & 3, fr = lane & 15, fq = lane >> 4;
    const int nt = S.K / BK;
    unsigned voffA[2], voffB[2];
#pragma unroll
    for (int i = 0; i < 2; ++i) { int R, C; stage_rc(tid * 16 + i * 8192, R, C); const int Rb = Epi::PERM ? ((R & ~31) + perm32(R & 31)) : R;
        voffA[i] = (unsigned)(R * S.lda + C) * 2u; voffB[i] = (unsigned)(Rb * S.ldb + C) * 2u; }
    const size_t kstep = (size_t)(BK * 2);
    const size_t hstepA = (size_t)HALF * S.lda * 2, hstepB = (size_t)HALF * S.ldb * 2;
    const unsigned ldsw = (unsigned)wid * 1024u;
    const int aoff = lds_byte(wr * 64 + fr, fq * 8), boff = lds_byte(wc * 32 + fr, fq * 8);
#define PG8_SA(b, h) (((b) * 2 + (h)) * HTB)
#define PG8_SB(b, h) ((4 + (b) * 2 + (h)) * HTB)
#define PG8_STAGE(bufoff, gbase, voff) do { _Pragma("unroll") for (int _i = 0; _i < 2; ++_i) \
        __builtin_amdgcn_global_load_lds((const unsigned*)((const char*)(gbase) + (voff)[_i]), (LAS unsigned*)(lds + (bufoff) + ldsw + _i * 8192), 16, 0, 0); } while (0)
#define PG8_LDA(dst, b, h) do { _Pragma("unroll") for (int m = 0; m < 4; ++m) _Pragma("unroll") for (int k = 0; k < 2; ++k) dst[m][k] = *(const LAS bf16x8*)(lds + PG8_SA(b, h) + aoff + m * 2048 + k * 1024); } while (0)
#define PG8_LDB(dst, b, h) do { _Pragma("unroll") for (int n = 0; n < 2; ++n) _Pragma("unroll") for (int k = 0; k < 2; ++k) dst[n][k] = *(const LAS bf16x8*)(lds + PG8_SB(b, h) + boff + n * 2048 + k * 1024); } while (0)
#define PG8_MMA(ai, bj, At, Bt) do { __builtin_amdgcn_s_setprio(1); _Pragma("unroll") for (int m = 0; m < 4; ++m) _Pragma("unroll") for (int n = 0; n < 2; ++n) _Pragma("unroll") for (int k = 0; k < 2; ++k) \
        acc[ai][bj][m][n] = __builtin_amdgcn_mfma_f32_16x16x32_bf16(Bt[n][k], At[m][k], acc[ai][bj][m][n], 0, 0, 0); __builtin_amdgcn_s_setprio(0); } while (0)
#define PG8_WAIT_V(n) asm volatile("s_waitcnt vmcnt(" #n ")" ::: "memory")
#define PG8_WAIT_L(n) asm volatile("s_waitcnt lgkmcnt(" #n ")" ::: "memory")
#define PG8_BAR __builtin_amdgcn_s_barrier()
#define PG8_SCHED __builtin_amdgcn_sched_barrier(0)
    Unit cur, nxt; int ui = 0;
    if (!S.next(0, cur)) return;
    f32x4 acc[2][2][4][2];
#pragma unroll
    for (int a = 0; a < 2; ++a)
#pragma unroll
        for (int b = 0; b < 2; ++b)
#pragma unroll
            for (int m = 0; m < 4; ++m)
#pragma unroll
                for (int n = 0; n < 2; ++n) acc[a][b][m][n] = (f32x4){0.f, 0.f, 0.f, 0.f};
    bf16x8 At[4][2], B0[2][2], B1[2][2];
    const char* cA = S.aptr(cur); const char* cB = S.bptr(cur);
    PG8_STAGE(PG8_SB(0, 0), cB, voffB); PG8_STAGE(PG8_SA(0, 0), cA, voffA); PG8_STAGE(PG8_SB(0, 1), cB + hstepB, voffB); PG8_STAGE(PG8_SA(0, 1), cA + hstepA, voffA);
    if (wr == 1) PG8_BAR;
    PG8_WAIT_V(4); PG8_BAR;
    PG8_STAGE(PG8_SB(1, 0), cB + kstep, voffB); PG8_STAGE(PG8_SA(1, 0), cA + kstep, voffA); PG8_STAGE(PG8_SB(1, 1), cB + hstepB + kstep, voffB);
    PG8_WAIT_V(6); PG8_BAR;
    for (;;) {
        const bool has_next = S.next(ui + 1, nxt);
        const char* nA = has_next ? S.aptr(nxt) : cA; const char* nB = has_next ? S.bptr(nxt) : cB;
        for (int t = 0; t < nt; t += 2) {
            const bool last = (t == nt - 2);
            const char* a1 = cA + (size_t)(t + 1) * kstep;
            const char* a2 = last ? nA : cA + (size_t)(t + 2) * kstep; const char* b2 = last ? nB : cB + (size_t)(t + 2) * kstep;
            const char* a3 = a2 + kstep; const char* b3 = b2 + kstep;
            PG8_LDB(B0, 0, 0); PG8_SCHED; PG8_LDA(At, 0, 0); PG8_STAGE(PG8_SA(1, 1), a1 + hstepA, voffA);
            PG8_WAIT_L(8); PG8_BAR; PG8_WAIT_L(0); PG8_MMA(0, 0, At, B0); PG8_BAR; PG8_SCHED;
            PG8_LDB(B1, 0, 1); PG8_STAGE(PG8_SB(0, 0), b2, voffB);
            PG8_BAR; PG8_WAIT_L(0); PG8_MMA(0, 1, At, B1); PG8_BAR;
            PG8_LDA(At, 0, 1); PG8_STAGE(PG8_SA(0, 0), a2, voffA);
            PG8_BAR; PG8_WAIT_L(0); PG8_MMA(1, 0, At, B0); PG8_BAR; PG8_SCHED;
            PG8_STAGE(PG8_SB(0, 1), b2 + hstepB, voffB);
            PG8_WAIT_V(6); PG8_BAR; PG8_MMA(1, 1, At, B1); PG8_BAR;
            PG8_LDB(B0, 1, 0); PG8_SCHED; PG8_LDA(At, 1, 0); PG8_STAGE(PG8_SA(0, 1), a2 + hstepA, voffA);
            PG8_WAIT_L(8); PG8_BAR; PG8_WAIT_L(0); PG8_MMA(0, 0, At, B0); PG8_BAR; PG8_SCHED;
            PG8_LDB(B1, 1, 1); PG8_STAGE(PG8_SB(1, 0), b3, voffB);
            PG8_BAR; PG8_WAIT_L(0); PG8_MMA(0, 1, At, B1); PG8_BAR;
            PG8_LDA(At, 1, 1); PG8_STAGE(PG8_SA(1, 0), a3, voffA);
            PG8_BAR; PG8_WAIT_L(0); PG8_MMA(1, 0, At, B0); PG8_BAR; PG8_SCHED;
            PG8_STAGE(PG8_SB(1, 1), b3 + hstepB, voffB);
            PG8_WAIT_V(6); PG8_BAR; PG8_MMA(1, 1, At, B1); PG8_BAR;
        }
        E(acc, cur, wr, wc, fr, fq);
        if (!has_next) break;
#pragma unroll
        for (int a = 0; a < 2; ++a)
#pragma unroll
            for (int b = 0; b < 2; ++b)
#pragma unroll
                for (int m = 0; m < 4; ++m)
#pragma unroll
                    for (int n = 0; n < 2; ++n) acc[a][b][m][n] = (f32x4){0.f, 0.f, 0.f, 0.f};
        cur = nxt; cA = nA; cB = nB; ++ui;
    }
    PG8_WAIT_V(0);
    if (wr == 0) PG8_BAR;
    PG8_BAR;
#undef PG8_SA
#undef PG8_SB
#undef PG8_STAGE
#undef PG8_LDA
#undef PG8_LDB
#undef PG8_MMA
#undef PG8_WAIT_V
#undef PG8_WAIT_L
#undef PG8_BAR
#undef PG8_SCHED
}
}
using pg8::Unit;
typedef f32x4 Acc[2][2][4][2];

struct EpiIn {
    static constexpr bool PERM = true;
    bf16_t *cq, *ckv, *xl, *gg, *kpe; float* ssq; const float *cosT, *sinT;
    __device__ __forceinline__ void operator()(const Acc& acc, const Unit& u, int wr, int wc, int fr, int fq) const {
        const int row0 = u.pm * 256 + wr * 64 + fr, pn = u.pn;
        if (pn < 4) {
            bf16_t* base = (pn < 2 ? cq : ckv); const int col0 = (pn & 1) * 256 + wc * 32 + 8 * fq;
#pragma unroll
            for (int ai = 0; ai < 2; ++ai)
#pragma unroll
                for (int m = 0; m < 4; ++m) { const int row = row0 + ai * 128 + m * 16; float s = 0.f;
#pragma unroll
                    for (int bj = 0; bj < 2; ++bj) { const f32x4 v0 = acc[ai][bj][m][0], v1 = acc[ai][bj][m][1];
                        s += (v0[0] * v0[0] + v0[1] * v0[1]) + (v0[2] * v0[2] + v0[3] * v0[3]) + (v1[0] * v1[0] + v1[1] * v1[1]) + (v1[2] * v1[2] + v1[3] * v1[3]);
                        *(u32x4*)(base + (size_t)row * 512 + col0 + bj * 128) = pack8(v0, v1); }
                    s += __shfl_xor(s, 16); s += __shfl_xor(s, 32);
                    if (fq == 0) ssq[(size_t)row * 16 + pn * 4 + wc] = s; }
        } else if (pn < 8) {
            const int col0 = (pn - 4) * 256 + wc * 32 + 8 * fq;
#pragma unroll
            for (int ai = 0; ai < 2; ++ai)
#pragma unroll
                for (int m = 0; m < 4; ++m) { const int row = row0 + ai * 128 + m * 16;
#pragma unroll
                    for (int bj = 0; bj < 2; ++bj) *(u32x4*)(xl + (size_t)row * 1024 + col0 + bj * 128) = pack8(acc[ai][bj][m][0], acc[ai][bj][m][1]); }
        } else if (pn < 12) {
            const int col0 = (pn - 8) * 256 + wc * 32 + 8 * fq;
#pragma unroll
            for (int ai = 0; ai < 2; ++ai)
#pragma unroll
                for (int m = 0; m < 4; ++m) { const int row = row0 + ai * 128 + m * 16;
#pragma unroll
                    for (int bj = 0; bj < 2; ++bj) { f32x4 v0 = acc[ai][bj][m][0], v1 = acc[ai][bj][m][1];
#pragma unroll
                        for (int j = 0; j < 4; ++j) { v0[j] = gelu_tanh(v0[j]); v1[j] = gelu_tanh(v1[j]); }
                        *(u32x4*)(gg + (size_t)row * 1024 + col0 + bj * 128) = pack8(v0, v1); } }
        } else if (wc == 0) {
#pragma unroll
            for (int ai = 0; ai < 2; ++ai)
#pragma unroll
                for (int m = 0; m < 4; ++m) { const int row = row0 + ai * 128 + m * 16;
                    const f32x4 c0 = *(const f32x4*)(cosT + (size_t)row * 32 + 8 * fq), c1 = *(const f32x4*)(cosT + (size_t)row * 32 + 8 * fq + 4);
                    const f32x4 s0 = *(const f32x4*)(sinT + (size_t)row * 32 + 8 * fq), s1 = *(const f32x4*)(sinT + (size_t)row * 32 + 8 * fq + 4);
                    const f32x4 a0 = acc[ai][0][m][0], a1 = acc[ai][0][m][1], b0 = acc[ai][1][m][0], b1 = acc[ai][1][m][1];
                    *(u32x4*)(kpe + (size_t)row * 64 + 8 * fq) = pack8(a0 * c0 - b0 * s0, a1 * c1 - b1 * s1);
                    *(u32x4*)(kpe + (size_t)row * 64 + 32 + 8 * fq) = pack8(b0 * c0 + a0 * s0, b1 * c1 + a1 * s1); }
        }
    }
};
__device__ __forceinline__ float row_rstd(const float* ssq8) { const f32x4 a = *(const f32x4*)ssq8, b = *(const f32x4*)(ssq8 + 4);
    const float s = ((a[0] + a[1]) + (a[2] + a[3])) + ((b[0] + b[1]) + (b[2] + b[3])); return __builtin_amdgcn_rsqf(s * (1.0f / 512.0f) + RMS_EPS); }
struct EpiQ {
    static constexpr bool PERM = true;
    bf16_t* q; const float* ssq; const float *cosT, *sinT;
    __device__ __forceinline__ void operator()(const Acc& acc, const Unit& u, int wr, int wc, int fr, int fq) const {
        const int row0 = u.pm * 256 + wr * 64 + fr, pn = u.pn;
        if (pn < 4) {
            const int col0 = pn * 256 + wc * 32 + 8 * fq;
#pragma unroll
            for (int ai = 0; ai < 2; ++ai)
#pragma unroll
                for (int m = 0; m < 4; ++m) { const int row = row0 + ai * 128 + m * 16; const float rs = row_rstd(ssq + (size_t)row * 16);
#pragma unroll
                    for (int bj = 0; bj < 2; ++bj) *(u32x4*)(q + (size_t)row * 1536 + col0 + bj * 128) = pack8(acc[ai][bj][m][0] * rs, acc[ai][bj][m][1] * rs); }
        } else {
            const int head = 4 * (pn - 4) + wc;
#pragma unroll
            for (int ai = 0; ai < 2; ++ai)
#pragma unroll
                for (int m = 0; m < 4; ++m) { const int row = row0 + ai * 128 + m * 16; const float rs = row_rstd(ssq + (size_t)row * 16);
                    const f32x4 c0 = *(const f32x4*)(cosT + (size_t)row * 32 + 8 * fq), c1 = *(const f32x4*)(cosT + (size_t)row * 32 + 8 * fq + 4);
                    const f32x4 s0 = *(const f32x4*)(sinT + (size_t)row * 32 + 8 * fq), s1 = *(const f32x4*)(sinT + (size_t)row * 32 + 8 * fq + 4);
                    const f32x4 a0 = acc[ai][0][m][0] * rs, a1 = acc[ai][0][m][1] * rs, b0 = acc[ai][1][m][0] * rs, b1 = acc[ai][1][m][1] * rs;
                    *(u32x4*)(q + (size_t)row * 1536 + 1024 + head * 64 + 8 * fq) = pack8(a0 * c0 - b0 * s0, a1 * c1 - b1 * s1);
                    *(u32x4*)(q + (size_t)row * 1536 + 1024 + head * 64 + 32 + 8 * fq) = pack8(b0 * c0 + a0 * s0, b1 * c1 + a1 * s1); }
        }
    }
};
struct EpiKV {
    static constexpr bool PERM = true;
    bf16_t* kv; const float* ssq;
    __device__ __forceinline__ void operator()(const Acc& acc, const Unit& u, int wr, int wc, int fr, int fq) const {
        const int row0 = u.pm * 256 + wr * 64 + fr, col0 = u.pn * 256 + wc * 32 + 8 * fq;
#pragma unroll
        for (int ai = 0; ai < 2; ++ai)
#pragma unroll
            for (int m = 0; m < 4; ++m) { const int row = row0 + ai * 128 + m * 16; const float rs = row_rstd(ssq + (size_t)row * 16 + 8);
#pragma unroll
                for (int bj = 0; bj < 2; ++bj) *(u32x4*)(kv + (size_t)row * 2048 + col0 + bj * 128) = pack8(acc[ai][bj][m][0] * rs, acc[ai][bj][m][1] * rs); }
    }
};
struct EpiGate {
    static constexpr bool PERM = true;
    unsigned* au; const bf16_t* xc; const float *ba, *bi, *sp;
    __device__ __forceinline__ void operator()(const Acc& acc, const Unit& u, int wr, int wc, int fr, int fq) const {
        const int row0 = u.pm * 256 + wr * 64 + fr, d = u.pn, ch0 = u.z * 128 + wc * 32 + 8 * fq;
        unsigned* aud = au + (size_t)d * M_ * 1024;
#pragma unroll
        for (int n = 0; n < 2; ++n) {
            const int ch = ch0 + 4 * n;
            const f32x4 bav = *(const f32x4*)(ba + d * 1024 + ch), biv = *(const f32x4*)(bi + d * 1024 + ch), spv = *(const f32x4*)(sp + d * 1024 + ch) * (-8.0f * 1.4426950408889634f);
#pragma unroll
            for (int ai = 0; ai < 2; ++ai)
#pragma unroll
                for (int m = 0; m < 4; ++m) { const int row = row0 + ai * 128 + m * 16;
                    const u32x2 xw = *(const u32x2*)(xc + (size_t)row * 1024 + ch);
                    const float xv[4] = {bf_lo(xw.x), bf_hi(xw.x), bf_lo(xw.y), bf_hi(xw.y)};
                    u32x4 o;
#pragma unroll
                    for (int j = 0; j < 4; ++j) {
                        const float r = sigmoidf_(acc[ai][0][m][n][j] + bav[j]);
                        const float ig = sigmoidf_(acc[ai][1][m][n][j] + biv[j]);
                        const float a = __builtin_amdgcn_exp2f(r * spv[j]);
                        const float oma = 1.0f - a;
                        const float uu = __builtin_amdgcn_sqrtf(oma * (1.0f + a)) * ig * xv[j];
                        o[j] = cvt_pk_bf16(oma, uu); }
                    *(u32x4*)(aud + (size_t)row * 1024 + ch) = o; }
        }
    }
};
struct EpiRes {
    static constexpr bool PERM = false;
    float* out;
    __device__ __forceinline__ void operator()(const Acc& acc, const Unit& u, int wr, int wc, int fr, int fq) const {
        const int row0 = u.pm * 256 + wr * 64 + fr, col0 = u.pn * 256 + wc * 32 + 4 * fq;
#pragma unroll
        for (int ai = 0; ai < 2; ++ai)
#pragma unroll
            for (int m = 0; m < 4; ++m) { float* rowp = out + (size_t)(row0 + ai * 128 + m * 16) * 2048 + col0;
#pragma unroll
                for (int bj = 0; bj < 2; ++bj)
#pragma unroll
                    for (int n = 0; n < 2; ++n) { const f32x4 h = *(const f32x4*)(rowp + bj * 128 + n * 16); *(f32x4*)(rowp + bj * 128 + n * 16) = h * ALPHA + acc[ai][bj][m][n]; }
                asm volatile("" ::: "memory"); }
    }
};
struct EpiUp {
    static constexpr bool PERM = true;
    bf16_t* f;
    __device__ __forceinline__ void operator()(const Acc& acc, const Unit& u, int wr, int wc, int fr, int fq) const {
        const int row0 = u.pm * 256 + wr * 64 + fr, col0 = u.pn * 256 + wc * 32 + 8 * fq;
#pragma unroll
        for (int ai = 0; ai < 2; ++ai)
#pragma unroll
            for (int m = 0; m < 4; ++m) { const int row = row0 + ai * 128 + m * 16;
#pragma unroll
                for (int bj = 0; bj < 2; ++bj) { f32x4 v0 = acc[ai][bj][m][0], v1 = acc[ai][bj][m][1];
#pragma unroll
                    for (int j = 0; j < 4; ++j) { const float a = fmaxf(v0[j], 0.f), b = fmaxf(v1[j], 0.f); v0[j] = a * a; v1[j] = b * b; }
                    *(u32x4*)(f + (size_t)row * 8192 + col0 + bj * 128) = pack8(v0, v1); } }
    }
};

namespace att {
constexpr int NW = 8, QBLK = 32, KVBLK = 64;
constexpr float SCALE = 0.07216878364870323f;
constexpr float THR = 8.f;
#ifndef ATT_SDEPTH
#define ATT_SDEPTH 1
#endif
constexpr int SDEPTH = ATT_SDEPTH;
constexpr int SHM_V = KVBLK * 128 * 2, SHM_K = KVBLK * 128 * 2, SHM_R = KVBLK * 64 * 2;
constexpr int OFF_V = 0, OFF_K = 2 * SHM_V, OFF_R = OFF_K + 2 * SHM_K, OFF_WS = OFF_R + 2 * SHM_R, OFF_QR = OFF_WS + NW * 64 * 4, SHM_ATTN = OFF_QR + 256 * 128;
#define KSWZ(row, colB) ((row) * 256 + ((colB) ^ (((row) & 7) << 4)))
#define RSWZ(row, colB) ((row) * 128 + ((colB) ^ (((row) & 7) << 4)))
#define SBAR() __builtin_amdgcn_sched_barrier(0)
__device__ __forceinline__ int crow(int r, int hi) { return (r & 3) + 8 * (r >> 2) + 4 * hi; }
__device__ __forceinline__ void partialSM(f32x16& p0, f32x16& p1, float& m_reg, float& mn, float& alpha) {
    constexpr float C = SCALE * 1.4426950408889634f;
    float pmax = p0[0];
#pragma unroll
    for (int r = 1; r < 16; ++r) pmax = fmaxf(pmax, p0[r]);
#pragma unroll
    for (int r = 0; r < 16; ++r) pmax = fmaxf(pmax, p1[r]);
    { auto rr = __builtin_amdgcn_permlane32_swap(__float_as_uint(pmax), __float_as_uint(pmax), false, false);
      pmax = fmaxf(__uint_as_float(rr[0]), __uint_as_float(rr[1])); }
    if (__builtin_expect(__all(pmax - m_reg <= THR / SCALE), 1)) { mn = m_reg; alpha = 1.f; }
    else { mn = fmaxf(m_reg, pmax); alpha = __builtin_amdgcn_exp2f((m_reg - mn) * C); m_reg = mn; }
    const float mnC = -mn * C;
#pragma unroll
    for (int r = 0; r < 16; ++r) p0[r] = fmaf(p0[r], C, mnC);
#pragma unroll
    for (int r = 0; r < 16; ++r) p1[r] = fmaf(p1[r], C, mnC);
#pragma unroll
    for (int r = 0; r < 16; ++r) p0[r] = __builtin_amdgcn_exp2f(p0[r]);
}
__device__ __forceinline__ void finishSM(f32x16& p0, f32x16& p1, float alpha, float& l_reg, bf16x8& pa0, bf16x8& pa1, bf16x8& pa2, bf16x8& pa3) {
#pragma unroll
    for (int r = 0; r < 16; ++r) p1[r] = __builtin_amdgcn_exp2f(p1[r]);
    float ps = 0;
#pragma unroll
    for (int r = 0; r < 16; ++r) ps += p0[r];
#pragma unroll
    for (int r = 0; r < 16; ++r) ps += p1[r];
    { auto rr = __builtin_amdgcn_permlane32_swap(__float_as_uint(ps), __float_as_uint(ps), false, false);
      ps = __uint_as_float(rr[0]) + __uint_as_float(rr[1]); }
    l_reg = l_reg * alpha + ps;
#define PK4(P, BASE, OUT) do { unsigned a0 = cvt_pk_bf16(P[BASE + 0], P[BASE + 1]), a1 = cvt_pk_bf16(P[BASE + 2], P[BASE + 3]);   \
    unsigned b0 = cvt_pk_bf16(P[BASE + 4], P[BASE + 5]), b1 = cvt_pk_bf16(P[BASE + 6], P[BASE + 7]);                              \
    auto r0 = __builtin_amdgcn_permlane32_swap(a0, b0, false, false); auto r1 = __builtin_amdgcn_permlane32_swap(a1, b1, false, false); \
    u32x4 w = {r0[0], r1[0], r0[1], r1[1]}; OUT = *reinterpret_cast<bf16x8*>(&w); } while (0)
    PK4(p0, 0, pa0); PK4(p0, 8, pa1); PK4(p1, 0, pa2); PK4(p1, 8, pa3);
#undef PK4
}
__device__ __forceinline__ void qkt(f32x16& p0, f32x16& p1, const char* Ks, const char* Rs, const bf16x8* qr, const char* Qrl, int r32, int hi) {
    p0 = f32x16{}; p1 = f32x16{};
#pragma unroll
    for (int d0 = 0; d0 < 8; ++d0) { const int cb = (d0 * 16 + hi * 8) * 2;
        const bf16x8 b0 = *reinterpret_cast<const bf16x8*>(Ks + KSWZ(r32, cb));
        const bf16x8 b1 = *reinterpret_cast<const bf16x8*>(Ks + KSWZ(32 + r32, cb));
        p0 = __builtin_amdgcn_mfma_f32_32x32x16_bf16(b0, qr[d0], p0, 0, 0, 0);
        p1 = __builtin_amdgcn_mfma_f32_32x32x16_bf16(b1, qr[d0], p1, 0, 0, 0); }
#pragma unroll
    for (int d0 = 0; d0 < 4; ++d0) { const int cb = (d0 * 16 + hi * 8) * 2;
        const bf16x8 b0 = *reinterpret_cast<const bf16x8*>(Rs + RSWZ(r32, cb));
        const bf16x8 b1 = *reinterpret_cast<const bf16x8*>(Rs + RSWZ(32 + r32, cb));
        const bf16x8 qv = *reinterpret_cast<const bf16x8*>(Qrl + (cb ^ ((r32 & 7) << 4)));
        p0 = __builtin_amdgcn_mfma_f32_32x32x16_bf16(b0, qv, p0, 0, 0, 0);
        p1 = __builtin_amdgcn_mfma_f32_32x32x16_bf16(b1, qv, p1, 0, 0, 0); }
}
__device__ __forceinline__ int v_st(int k, int c) { const int kk = (k & ~0xC) | ((k & 4) << 1) | ((k & 8) >> 1); return ((kk >> 3) * 4 + (c >> 5)) * 512 + ((kk & 7) * 32 + (c & 31)) * 2; }
__device__ __forceinline__ int v_rd_base(int lane) { return ((lane & 3) << 3) | (((lane >> 2) & 3) << 6) | (((lane >> 4) & 1) << 5) | (((lane >> 5) & 1) << 8); }
constexpr int v_rd_off(int d0, int ks, int half) { return d0 * 512 + ks * 4096 + half * 2048; }
template <int OFF> __device__ __forceinline__ s16x4 tr_read(int vb) {
    s16x4 r; asm volatile("ds_read_b64_tr_b16 %0, %1 offset:%2" : "=&v"(r) : "v"(vb), "i"(OFF) : "memory"); return r;
}
template <int D0> __device__ __forceinline__ void pv_one(f32x16& od, int vb, bf16x8 pa0, bf16x8 pa1, bf16x8 pa2, bf16x8 pa3) {
    const s16x4 l0 = tr_read<v_rd_off(D0, 0, 0)>(vb), h0 = tr_read<v_rd_off(D0, 0, 1)>(vb), l1 = tr_read<v_rd_off(D0, 1, 0)>(vb), h1 = tr_read<v_rd_off(D0, 1, 1)>(vb);
    const s16x4 l2 = tr_read<v_rd_off(D0, 2, 0)>(vb), h2 = tr_read<v_rd_off(D0, 2, 1)>(vb), l3 = tr_read<v_rd_off(D0, 3, 0)>(vb), h3 = tr_read<v_rd_off(D0, 3, 1)>(vb);
    asm volatile("s_waitcnt lgkmcnt(0)" ::: "memory"); SBAR();
#define PK(L, H) (bf16x8){L[0], L[1], L[2], L[3], H[0], H[1], H[2], H[3]}
    od = __builtin_amdgcn_mfma_f32_32x32x16_bf16(pa0, PK(l0, h0), od, 0, 0, 0);
    od = __builtin_amdgcn_mfma_f32_32x32x16_bf16(pa1, PK(l1, h1), od, 0, 0, 0);
    od = __builtin_amdgcn_mfma_f32_32x32x16_bf16(pa2, PK(l2, h2), od, 0, 0, 0);
    od = __builtin_amdgcn_mfma_f32_32x32x16_bf16(pa3, PK(l3, h3), od, 0, 0, 0);
#undef PK
}
__device__ __forceinline__ void pv_d0(f32x16* o, int vb, bf16x8 pa0, bf16x8 pa1, bf16x8 pa2, bf16x8 pa3) {
    pv_one<0>(o[0], vb, pa0, pa1, pa2, pa3); pv_one<1>(o[1], vb, pa0, pa1, pa2, pa3); pv_one<2>(o[2], vb, pa0, pa1, pa2, pa3); pv_one<3>(o[3], vb, pa0, pa1, pa2, pa3);
}
__device__ __forceinline__ void attn_unit(const bf16_t* __restrict__ Qn, const bf16_t* __restrict__ Qr, const bf16_t* __restrict__ Kh, const bf16_t* __restrict__ Rh,
                                          bf16_t* __restrict__ Ob, int seq, char* lds) {
    const int tid = otid(), wid = tid >> 6, lane = tid & 63, r32 = lane & 31, hi = lane >> 5;
    char* V_lds = lds + OFF_V; char* K_lds = lds + OFF_K; char* R_lds = lds + OFF_R;
    float* ws = (float*)(lds + OFF_WS) + wid * 64; float* li_l = ws; float* al_l = ws + 32;
    float m_reg = -1e30f, l_reg = 0; f32x16 o[4] = {}; bf16x8 qr[8];
    char* Qrl = lds + OFF_QR + (wid * QBLK + r32) * 128;
    {
        const bf16_t* Qw = Qn + (size_t)(wid * QBLK + r32) * 1536 + hi * 8;
#pragma unroll
        for (int d0 = 0; d0 < 8; ++d0) qr[d0] = *reinterpret_cast<const bf16x8*>(Qw + d0 * 16);
        const bf16_t* Qw2 = Qr + (size_t)(wid * QBLK + r32) * 1536 + hi * 8;
#pragma unroll
        for (int d0 = 0; d0 < 4; ++d0) { const bf16x8 t = *reinterpret_cast<const bf16x8*>(Qw2 + d0 * 16); *reinterpret_cast<bf16x8*>(Qrl + (((d0 * 16 + hi * 8) * 2) ^ ((r32 & 7) << 4))) = t; }
    }
    const int sr = tid >> 4, sc = (tid & 15) * 8, vst0 = v_st(sr, sc), vst1 = v_st(32 + sr, sc);
    const int rr_ = tid >> 3, rc = (tid & 7) * 8;
    const int vb0 = (int)(uintptr_t)V_lds + v_rd_base(lane);
    struct { bf16x8 vs0, vs1, ks0, ks1, rs; } sr_[SDEPTH];
#define SLOAD(i, k0) do { sr_[i].vs0 = *(const bf16x8*)(&Kh[(size_t)((k0) + sr) * 2048 + 128 + sc]); sr_[i].vs1 = *(const bf16x8*)(&Kh[(size_t)((k0) + 32 + sr) * 2048 + 128 + sc]); \
    sr_[i].ks0 = *(const bf16x8*)(&Kh[(size_t)((k0) + sr) * 2048 + sc]); sr_[i].ks1 = *(const bf16x8*)(&Kh[(size_t)((k0) + 32 + sr) * 2048 + sc]); \
    sr_[i].rs = *(const bf16x8*)(&Rh[(size_t)((k0) + rr_) * 64 + rc]); } while (0)
#define SWRITE(b, i) do { *(bf16x8*)(V_lds + (b) * SHM_V + vst0) = sr_[i].vs0;          \
    *(bf16x8*)(V_lds + (b) * SHM_V + vst1) = sr_[i].vs1; const int kc = sc * 2;               \
    *(bf16x8*)(K_lds + (b) * SHM_K + KSWZ(sr, kc)) = sr_[i].ks0;                       \
    *(bf16x8*)(K_lds + (b) * SHM_K + KSWZ(32 + sr, kc)) = sr_[i].ks1;                  \
    *(bf16x8*)(R_lds + (b) * SHM_R + RSWZ(rr_, rc * 2)) = sr_[i].rs; } while (0)
#define SWAIT() do { if constexpr (SDEPTH == 2) asm volatile("s_waitcnt vmcnt(5)" ::: "memory"); else asm volatile("s_waitcnt vmcnt(0)" ::: "memory"); } while (0)
#define RESC(a) do { if (__any((a) < 1.f)) { if (hi == 0) al_l[r32] = (a); asm volatile("s_waitcnt lgkmcnt(0)" ::: "memory"); \
    _Pragma("unroll") for (int d = 0; d < 4; ++d) _Pragma("unroll") for (int r = 0; r < 16; ++r) o[d][r] *= al_l[crow(r, hi)]; } } while (0)
    f32x16 pA0, pA1, pB0, pB1; float mnA, mnB, alA, alB; bf16x8 pa0, pa1, pa2, pa3; const int NT = seq / KVBLK;
    constexpr int SE = 0, SO = SDEPTH - 1;
    SLOAD(SE, 0); asm volatile("s_waitcnt vmcnt(0)" ::: "memory"); SWRITE(0, SE); __syncthreads();
    qkt(pA0, pA1, K_lds, R_lds, qr, Qrl, r32, hi); partialSM(pA0, pA1, m_reg, mnA, alA);
    SLOAD(SO, KVBLK); if constexpr (SDEPTH == 2) { if (2 < NT) SLOAD(SE, 2 * KVBLK); }
    SWAIT(); SWRITE(1, SO); __syncthreads();
    for (int j = 1; j + 1 < NT; j += 2) {
        SBAR(); qkt(pB0, pB1, K_lds + SHM_K, R_lds + SHM_R, qr, Qrl, r32, hi);
        finishSM(pA0, pA1, alA, l_reg, pa0, pa1, pa2, pa3); SBAR();
        SLOAD(SO, (j + SDEPTH) * KVBLK); SBAR();
        pv_d0(o, vb0, pa0, pa1, pa2, pa3); partialSM(pB0, pB1, m_reg, mnB, alB);
        __syncthreads(); SWAIT(); SWRITE(0, SE);
        RESC(alB); __syncthreads();
        SBAR(); qkt(pA0, pA1, K_lds, R_lds, qr, Qrl, r32, hi);
        finishSM(pB0, pB1, alB, l_reg, pa0, pa1, pa2, pa3); SBAR();
        if (SDEPTH == 1 || j + 3 < NT) SLOAD(SE, (j + 1 + SDEPTH) * KVBLK); SBAR();
        pv_d0(o, vb0 + (int)SHM_V, pa0, pa1, pa2, pa3); partialSM(pA0, pA1, m_reg, mnA, alA);
        __syncthreads(); SWAIT(); SWRITE(1, SO);
        RESC(alA); __syncthreads();
    }
    SBAR(); qkt(pB0, pB1, K_lds + SHM_K, R_lds + SHM_R, qr, Qrl, r32, hi);
    finishSM(pA0, pA1, alA, l_reg, pa0, pa1, pa2, pa3); SBAR();
    pv_d0(o, vb0, pa0, pa1, pa2, pa3); partialSM(pB0, pB1, m_reg, mnB, alB);
    __syncthreads(); RESC(alB);
    finishSM(pB0, pB1, alB, l_reg, pa0, pa1, pa2, pa3); SBAR();
    pv_d0(o, vb0 + (int)SHM_V, pa0, pa1, pa2, pa3);
    if (hi == 0) li_l[r32] = l_reg; asm volatile("s_waitcnt lgkmcnt(0)" ::: "memory");
    float rli[16];
#pragma unroll
    for (int r = 0; r < 16; ++r) rli[r] = __builtin_amdgcn_rcpf(li_l[crow(r, hi)]);
    bf16_t* Ow = Ob + (size_t)(wid * QBLK) * 2048;
#pragma unroll
    for (int r = 0; r < 16; ++r) { const int orow = crow(r, hi);
#pragma unroll
        for (int d0 = 0; d0 < 4; ++d0) Ow[(size_t)orow * 2048 + d0 * 32 + r32] = (bf16_t)(cvt_pk_bf16(o[d0][r] * rli[r], 0.f) & 0xffffu); }
#undef SLOAD
#undef SWRITE
#undef SWAIT
#undef RESC
}
}

__device__ __forceinline__ void ln_rows(const float* src, float* dstf, bf16_t* dstb, const float* g, const float* b) {
    const int tid_ = otid(), lane = tid_ & 63, wave = tid_ >> 6;
    for (int row = blockIdx.x * 8 + wave; row < M_; row += gridDim.x * 8) {
        const float* s = src + (size_t)row * 2048; f32x4 v[8]; float sum = 0.f;
#pragma unroll
        for (int i = 0; i < 8; ++i) { v[i] = *(const f32x4*)(s + i * 256 + lane * 4); sum += (v[i][0] + v[i][1]) + (v[i][2] + v[i][3]); }
#pragma unroll
        for (int o = 32; o >= 1; o >>= 1) sum += __shfl_xor(sum, o);
        const float mu = sum * (1.0f / 2048.0f); float q = 0.f;
#pragma unroll
        for (int i = 0; i < 8; ++i) { v[i] = v[i] - mu; q += (v[i][0] * v[i][0] + v[i][1] * v[i][1]) + (v[i][2] * v[i][2] + v[i][3] * v[i][3]); }
#pragma unroll
        for (int o = 32; o >= 1; o >>= 1) q += __shfl_xor(q, o);
        const float rstd = 1.0f / sqrtf(q * (1.0f / 2048.0f) + LN_EPS);
#pragma unroll
        for (int i = 0; i < 8; ++i) { const int c = i * 256 + lane * 4; const f32x4 gv = *(const f32x4*)(g + c), bv = *(const f32x4*)(b + c);
            const f32x4 y = v[i] * rstd * gv + bv; *(f32x4*)(dstf + (size_t)row * 2048 + c) = y;
            u32x2 w; w.x = cvt_pk_bf16(y[0], y[1]); w.y = cvt_pk_bf16(y[2], y[3]); *(u32x2*)(dstb + (size_t)row * 2048 + c) = w; }
    }
}
__device__ __forceinline__ int colmap(int mode, int n) {
    if (mode == 0) { if (n < 1024) return n; if (n < 2048) return 1088 + (n - 1024); if (n < 3072) return 2112 + (n - 2048);
        const int t = n - 3072, bj = t >> 7, r = t & 127; return r < 32 ? 1024 + bj * 32 + r : -1; }
    if (mode == 1) { if (n < 1024) return (n >> 7) * 192 + (n & 127);
        const int t = n - 1024, tile = t >> 8, bj = (t >> 7) & 1, wc = (t >> 5) & 3, i = t & 31; return (4 * tile + wc) * 192 + 128 + bj * 32 + i; }
    return n;
}
__device__ __forceinline__ void cvt_tile(const float* W, int ldw, bf16_t* Bt, int ldb, int n0, int k0, int mode, const float* kscale, float* T) {
    const int tid = otid(), n4 = (tid & 31) * 4, kq = tid >> 5, src = colmap(mode, n0 + n4);
    f32x4 v[8];
#pragma unroll
    for (int i = 0; i < 8; ++i) { const int kk = kq + 16 * i; v[i] = src >= 0 ? *(const f32x4*)(W + (size_t)(k0 + kk) * ldw + src) : (f32x4){0.f, 0.f, 0.f, 0.f}; }
    if (kscale) {
#pragma unroll
        for (int i = 0; i < 8; ++i) v[i] = v[i] * kscale[k0 + kq + 16 * i]; }
#pragma unroll
    for (int i = 0; i < 8; ++i)
#pragma unroll
        for (int j = 0; j < 4; ++j) T[(n4 + j) * 129 + kq + 16 * i] = v[i][j];
    __syncthreads();
    { const int n2 = tid >> 2, ks = (tid & 3) * 32; const float* t = T + n2 * 129 + ks; bf16_t* dst = Bt + (size_t)(n0 + n2) * ldb + k0 + ks;
#pragma unroll
      for (int i = 0; i < 4; ++i) { u32x4 w; w.x = cvt_pk_bf16(t[i * 8 + 0], t[i * 8 + 1]); w.y = cvt_pk_bf16(t[i * 8 + 2], t[i * 8 + 3]); w.z = cvt_pk_bf16(t[i * 8 + 4], t[i * 8 + 5]); w.w = cvt_pk_bf16(t[i * 8 + 6], t[i * 8 + 7]);
          *(u32x4*)(dst + i * 8) = w; } }
    __syncthreads();
}
__device__ __forceinline__ void convert_weights(const Params& p, int l, float* T) {
    unsigned char* ws = p.ws;
    constexpr int T0 = 26 * 16, T1 = T0 + 12 * 4, T2 = T1 + 16 * 4, T3 = T2 + 32, T4 = T3 + 16 * 16, T5 = T4 + 64 * 16, T6 = T5 + 16 * 64;
    for (int t = blockIdx.x; t < T6; t += gridDim.x) {
        if (t < T0) { const int nt = t % 26, kt = t / 26; cvt_tile(p.in[4] + (size_t)l * 2048 * NIN, NIN, (bf16_t*)(ws + W_IN), 2048, nt * 128, kt * 128, 0, nullptr, T); }
        else if (t < T1) { const int u = t - T0, nt = u % 12, kt = u / 12; cvt_tile(p.in[7] + (size_t)l * 512 * 1536, 1536, (bf16_t*)(ws + W_UQ), 512, nt * 128, kt * 128, 1, p.in[5] + l * 512, T); }
        else if (t < T2) { const int u = t - T1, nt = u % 16, kt = u / 16; cvt_tile(p.in[8] + (size_t)l * 512 * 2048, 2048, (bf16_t*)(ws + W_UKV), 512, nt * 128, kt * 128, 2, p.in[6] + l * 512, T); }
        else if (t < T3) { const int mat = t - T2, gate = mat & 1, h = (mat >> 1) & 7, d = mat >> 4;
            cvt_tile((gate ? p.in[13] : p.in[11]) + ((size_t)((l * 2 + d) * 8 + h)) * 128 * 128, 128, (bf16_t*)(ws + W_G) + (size_t)(h * 512 + d * 256 + gate * 128) * 128, 128, 0, 0, 2, nullptr, T); }
        else if (t < T4) { const int u = t - T3, nt = u % 16, kt = u / 16; cvt_tile(p.in[16] + (size_t)l * 2048 * 2048, 2048, (bf16_t*)(ws + W_OUT), 2048, nt * 128, kt * 128, 2, nullptr, T); }
        else if (t < T5) { const int u = t - T4, nt = u % 64, kt = u / 64; cvt_tile(p.in[19] + (size_t)l * 2048 * 8192, 8192, (bf16_t*)(ws + W_UP), 2048, nt * 128, kt * 128, 2, nullptr, T); }
        else { const int u = t - T5, nt = u % 16, kt = u / 16; cvt_tile(p.in[20] + (size_t)l * 8192 * 2048, 2048, (bf16_t*)(ws + W_DN), 8192, nt * 128, kt * 128, 2, nullptr, T); }
    }
}
__device__ __forceinline__ void make_tables(const Params& p) {
    const int* pos = (const int*)p.in[1]; float* cosT = (float*)(p.ws + WS_COS); float* sinT = (float*)(p.ws + WS_SIN); float* sp = (float*)(p.ws + WS_SP);
    const int tid = otid();
    for (size_t i = (size_t)blockIdx.x * 512 + tid; i < (size_t)M_ * 32; i += (size_t)gridDim.x * 512) {
        const int row = (int)(i >> 5), k = (int)(i & 31); const float inv = powf(10000.0f, -(float)(2 * k) / 64.0f); const float ang = (float)pos[row] * inv;
        cosT[i] = cosf(ang); sinT[i] = sinf(ang); }
    for (int i = blockIdx.x * 512 + tid; i < DEPTH * 2 * 1024; i += gridDim.x * 512) { const float x = -p.in[15][i];
        sp[i] = fmaxf(x, 0.f) + log1pf(expf(-fabsf(x))); }
}
__device__ __forceinline__ void conv_phase(const Params& p, int l) {
    const bf16_t* xl = (const bf16_t*)(p.ws + WS_XL); bf16_t* xc = (bf16_t*)(p.ws + WS_XC);
    const float* cw = p.in[9] + (size_t)l * 4 * 1024; const float* cb = p.in[10] + (size_t)l * 1024;
    const int tid = otid();
    for (size_t i = (size_t)blockIdx.x * 512 + tid; i < (size_t)M_ * 128; i += (size_t)gridDim.x * 512) {
        const int row = (int)(i >> 7), c0 = (int)(i & 127) * 8, t = row & (SEQ - 1);
        float acc[8];
        { const f32x4 b0 = *(const f32x4*)(cb + c0), b1 = *(const f32x4*)(cb + c0 + 4); acc[0] = b0[0]; acc[1] = b0[1]; acc[2] = b0[2]; acc[3] = b0[3]; acc[4] = b1[0]; acc[5] = b1[1]; acc[6] = b1[2]; acc[7] = b1[3]; }
#pragma unroll
        for (int k = 0; k < 4; ++k) { const int tt = t - 2 + k; if (tt < 0 || tt >= SEQ) continue;
            const u32x4 xw = *(const u32x4*)(xl + (size_t)(row - 2 + k) * 1024 + c0);
            const f32x4 w0 = *(const f32x4*)(cw + k * 1024 + c0), w1 = *(const f32x4*)(cw + k * 1024 + c0 + 4);
            acc[0] += w0[0] * bf_lo(xw.x); acc[1] += w0[1] * bf_hi(xw.x); acc[2] += w0[2] * bf_lo(xw.y); acc[3] += w0[3] * bf_hi(xw.y);
            acc[4] += w1[0] * bf_lo(xw.z); acc[5] += w1[1] * bf_hi(xw.z); acc[6] += w1[2] * bf_lo(xw.w); acc[7] += w1[3] * bf_hi(xw.w); }
        u32x4 o; o.x = cvt_pk_bf16(acc[0], acc[1]); o.y = cvt_pk_bf16(acc[2], acc[3]); o.z = cvt_pk_bf16(acc[4], acc[5]); o.w = cvt_pk_bf16(acc[6], acc[7]);
        *(u32x4*)(xc + (size_t)row * 1024 + c0) = o;
    }
}
__device__ __forceinline__ void scan_local(const Params& p) {
    const unsigned* au = (const unsigned*)(p.ws + WS_AU); f32x4* ph = (f32x4*)(p.ws + WS_PH); const int tid = otid();
    for (int it = blockIdx.x; it < 2 * 8 * 64; it += gridDim.x) {
        const int c = it & 63, b = (it >> 6) & 7, d = it >> 9;
        const u32x2* src = (const u32x2*)(au + (size_t)d * M_ * 1024 + (size_t)(b * SEQ + c * 64) * 1024) + tid;
        float h0 = 0.f, h1 = 0.f, P0 = 1.f, P1 = 1.f;
#pragma unroll 16
        for (int s = 0; s < 64; ++s) { const int t = d ? 63 - s : s; const u32x2 w = src[(size_t)t * 512];
            const float a0 = 1.0f - bf_lo(w.x), a1 = 1.0f - bf_lo(w.y); h0 = a0 * h0 + bf_hi(w.x); h1 = a1 * h1 + bf_hi(w.y); P0 *= a0; P1 *= a1; }
        ph[(size_t)((d * 8 + b) * 64 + c) * 512 + tid] = (f32x4){P0, h0, P1, h1};
    }
}
__device__ __forceinline__ void scan_apply(const Params& p) {
    const unsigned* au = (const unsigned*)(p.ws + WS_AU); const f32x4* ph = (const f32x4*)(p.ws + WS_PH);
    const bf16_t* gg = (const bf16_t*)(p.ws + WS_GG); bf16_t* ycat = (bf16_t*)(p.ws + WS_YCAT); const int tid = otid();
    for (int it = blockIdx.x; it < 8 * 64; it += gridDim.x) {
        const int c = it & 63, b = it >> 6;
        float Hf0 = 0.f, Hf1 = 0.f, Hb0 = 0.f, Hb1 = 0.f;
        { const f32x4* pf = ph + (size_t)((0 * 8 + b) * 64) * 512 + tid;
          for (int c0 = 0; c0 < c; c0 += 8) { f32x4 e[8];
#pragma unroll
              for (int j = 0; j < 8; ++j) e[j] = (c0 + j < c) ? pf[(size_t)(c0 + j) * 512] : (f32x4){1.f, 0.f, 1.f, 0.f};
#pragma unroll
              for (int j = 0; j < 8; ++j) { Hf0 = e[j][0] * Hf0 + e[j][1]; Hf1 = e[j][2] * Hf1 + e[j][3]; } }
          const f32x4* pb = ph + (size_t)((1 * 8 + b) * 64) * 512 + tid;
          for (int c0 = 63; c0 > c; c0 -= 8) { f32x4 e[8];
#pragma unroll
              for (int j = 0; j < 8; ++j) e[j] = (c0 - j > c) ? pb[(size_t)(c0 - j) * 512] : (f32x4){1.f, 0.f, 1.f, 0.f};
#pragma unroll
              for (int j = 0; j < 8; ++j) { Hb0 = e[j][0] * Hb0 + e[j][1]; Hb1 = e[j][2] * Hb1 + e[j][3]; } } }
        const size_t r0 = (size_t)(b * SEQ + c * 64);
        const u32x2* s0 = (const u32x2*)(au + r0 * 1024) + tid; const u32x2* s1 = (const u32x2*)(au + (size_t)M_ * 1024 + r0 * 1024) + tid;
        const unsigned* gp = (const unsigned*)(gg + r0 * 1024) + tid; unsigned* yp = (unsigned*)(ycat + r0 * 2048 + 1024) + tid;
        float hf0[64], hf1[64];
#pragma unroll
        for (int t = 0; t < 64; ++t) { const u32x2 w = s0[(size_t)t * 512]; Hf0 = (1.0f - bf_lo(w.x)) * Hf0 + bf_hi(w.x); Hf1 = (1.0f - bf_lo(w.y)) * Hf1 + bf_hi(w.y); hf0[t] = Hf0; hf1[t] = Hf1; }
#pragma unroll
        for (int s = 0; s < 64; ++s) { const int t = 63 - s; const u32x2 w = s1[(size_t)t * 512]; Hb0 = (1.0f - bf_lo(w.x)) * Hb0 + bf_hi(w.x); Hb1 = (1.0f - bf_lo(w.y)) * Hb1 + bf_hi(w.y);
            const unsigned g = gp[(size_t)t * 512];
            yp[(size_t)t * 1024] = cvt_pk_bf16(bf_lo(g) * (hf0[t] + Hb0), bf_hi(g) * (hf1[t] + Hb1)); }
    }
}

__global__ void __launch_bounds__(512, 2) mega_fwd(Params p) {
    extern __shared__ __attribute__((aligned(16))) unsigned char lds[];
    cg::grid_group grid = cg::this_grid();
    unsigned char* ws = p.ws;
    LAS unsigned char* ldsl = (LAS unsigned char*)lds;
    bf16_t* hb = (bf16_t*)(ws + WS_HB);
    const float* cosT = (const float*)(ws + WS_COS); const float* sinT = (const float*)(ws + WS_SIN);

    for (int rep = 0; rep <= REP_THIN; ++rep) {
    make_tables(p);
    ln_rows(p.in[0], p.out, hb, p.in[2], p.in[3]);
    convert_weights(p, 0, (float*)lds);
    }
    grid.sync();

#pragma unroll 1
    for (int l = 0; l < DEPTH; ++l) {
        { pg8::Order S = pg8::make_order(hb, 2048, ws + W_IN, 2048, M_, NINP, 2048);
          EpiIn E{(bf16_t*)(ws + WS_CQ), (bf16_t*)(ws + WS_CKV), (bf16_t*)(ws + WS_XL), (bf16_t*)(ws + WS_GG), (bf16_t*)(ws + WS_KPE), (float*)(ws + WS_SSQ), cosT, sinT};
          pg8::gemm_phase(ldsl, S, E); }
        grid.sync();
        for (int rep = 0; rep <= REP_THIN; ++rep) conv_phase(p, l);
        { pg8::Order S = pg8::make_order(ws + WS_CQ, 512, ws + W_UQ, 512, M_, 1536, 512);
          EpiQ E{(bf16_t*)(ws + WS_Q), (const float*)(ws + WS_SSQ), cosT, sinT};
          pg8::gemm_phase(ldsl, S, E); }
        { pg8::Order S = pg8::make_order(ws + WS_CKV, 512, ws + W_UKV, 512, M_, 2048, 512);
          EpiKV E{(bf16_t*)(ws + WS_KV), (const float*)(ws + WS_SSQ)};
          pg8::gemm_phase(ldsl, S, E); }
        grid.sync();
        {
            const bf16_t* Q = (const bf16_t*)(ws + WS_Q); const bf16_t* KV = (const bf16_t*)(ws + WS_KV); const bf16_t* KPE = (const bf16_t*)(ws + WS_KPE); bf16_t* ycat = (bf16_t*)(ws + WS_YCAT);
            const int G = gridDim.x, bx = blockIdx.x;
            for (int rep = 0; rep <= REP_ATT; ++rep)
            for (int L = bx; L < 1024; L += G) {
                int pair, qb;
                if (G == 256) { const int i = L >> 8, c = L & 255, xcd = c & 7, j = c >> 3; pair = i * 16 + xcd * 2 + (j >> 4); qb = j & 15; } else { pair = L >> 4; qb = L & 15; }
                const int b = pair >> 3, h = pair & 7; const size_t row0 = (size_t)b * SEQ + (size_t)qb * 256;
                __syncthreads();
                att::attn_unit(Q + row0 * 1536 + h * 128, Q + row0 * 1536 + 1024 + h * 64, KV + (size_t)b * SEQ * 2048 + h * 256, KPE + (size_t)b * SEQ * 64, ycat + row0 * 2048 + h * 128, SEQ, (char*)lds);
            }
            __syncthreads();
        }
        { pg8::Order S = pg8::make_order(ws + WS_XC, 1024, ws + W_G, 128, M_, 512, 128);
          S.nZ = 8; S.a_z = 128 * 2; S.b_z = (size_t)512 * 128 * 2;
          EpiGate E{(unsigned*)(ws + WS_AU), (const bf16_t*)(ws + WS_XC), p.in[12] + (size_t)l * 2048, p.in[14] + (size_t)l * 2048, (const float*)(ws + WS_SP) + (size_t)l * 2048};
          pg8::gemm_phase(ldsl, S, E); }
        grid.sync();
        for (int rep = 0; rep <= REP_THIN; ++rep) scan_local(p);
        grid.sync();
        for (int rep = 0; rep <= REP_THIN; ++rep) scan_apply(p);
        grid.sync();
        { pg8::Order S = pg8::make_order(ws + WS_YCAT, 2048, ws + W_OUT, 2048, M_, 2048, 2048);
          EpiRes E{p.out}; pg8::gemm_phase(ldsl, S, E); }
        grid.sync();
        if (REP_THIN) ln_rows(p.out, (float*)(ws + WS_F), (bf16_t*)(ws + WS_F + 256 * MiB), p.in[17] + (size_t)l * 2048, p.in[18] + (size_t)l * 2048);
        ln_rows(p.out, p.out, hb, p.in[17] + (size_t)l * 2048, p.in[18] + (size_t)l * 2048);
        grid.sync();
        { pg8::Order S = pg8::make_order(hb, 2048, ws + W_UP, 2048, M_, DFF, 2048);
          EpiUp E{(bf16_t*)(ws + WS_F)}; pg8::gemm_phase(ldsl, S, E); }
        grid.sync();
        { pg8::Order S = pg8::make_order(ws + WS_F, 8192, ws + W_DN, 8192, M_, 2048, 8192);
          EpiRes E{p.out}; pg8::gemm_phase(ldsl, S, E); }
        grid.sync();
        if (REP_THIN) ln_rows(p.out, (float*)(ws + WS_F), (bf16_t*)(ws + WS_F + 256 * MiB), p.in[21] + (size_t)l * 2048, p.in[22] + (size_t)l * 2048);
        ln_rows(p.out, p.out, hb, p.in[21] + (size_t)l * 2048, p.in[22] + (size_t)l * 2048);
        if (l + 1 < DEPTH) { __syncthreads(); for (int rep = 0; rep <= REP_THIN; ++rep) convert_weights(p, l + 1, (float*)lds); grid.sync(); }
    }
}

extern "C" void kernel_launch(void* const* d_in, const int* in_sizes, int n_in, void* d_out, int out_size, void* d_ws, size_t ws_size, hipStream_t stream) {
    constexpr int LDS_BYTES = pg8::STAGE_BYTES;
    static int grid_blocks = 0;
    if (grid_blocks == 0) {
        if (n_in != 23 || in_sizes[0] != M_ * DM || out_size != M_ * DM || ws_size < WS_END) {
            fprintf(stderr, "kernel_launch: shape mismatch (n_in %d, in0 %d, out %d, ws %zu, need %zu)\n", n_in, n_in > 0 ? in_sizes[0] : -1, out_size, ws_size, (size_t)WS_END); grid_blocks = -1; return; }
        int dev = 0, cus = 0, per_cu = 0;
        hipGetDevice(&dev); hipDeviceGetAttribute(&cus, hipDeviceAttributeMultiprocessorCount, dev);
        if (hipFuncSetAttribute((const void*)mega_fwd, hipFuncAttributeMaxDynamicSharedMemorySize, LDS_BYTES) != hipSuccess) { fprintf(stderr, "kernel_launch: hipFuncSetAttribute failed\n"); grid_blocks = -1; return; }
        if (hipOccupancyMaxActiveBlocksPerMultiprocessor(&per_cu, (const void*)mega_fwd, 512, LDS_BYTES) != hipSuccess || per_cu < 1) { fprintf(stderr, "kernel_launch: occupancy query says %d\n", per_cu); per_cu = 1; }
        (void)hipGetLastError();
        grid_blocks = cus * 1;
    }
    if (grid_blocks < 0) return;
    Params p{};
    for (int i = 0; i < 23; ++i) p.in[i] = (const float*)d_in[i];
    p.out = (float*)d_out; p.ws = (unsigned char*)d_ws;
    void* args[] = {&p};
    hipError_t e = hipLaunchCooperativeKernel((const void*)mega_fwd, dim3(grid_blocks), dim3(512), args, LDS_BYTES, stream);
    if (e != hipSuccess) fprintf(stderr, "kernel_launch: cooperative launch failed: %s (grid %d)\n", hipGetErrorString(e), grid_blocks);
}
```

```cpp
#include <hip/hip_runtime.h>
#include <hip/hip_cooperative_groups.h>
#include <cstdio>
#include <cstdint>
namespace cg = cooperative_groups;

#define LAS __attribute__((address_space(3)))
typedef unsigned short bf16_t;
typedef short bf16x8 __attribute__((ext_vector_type(8)));
typedef short s16x4 __attribute__((ext_vector_type(4)));
typedef float f32x4 __attribute__((ext_vector_type(4)));
typedef float f32x2 __attribute__((ext_vector_type(2)));
typedef float f32x16 __attribute__((ext_vector_type(16)));
typedef unsigned u32x4 __attribute__((ext_vector_type(4)));
typedef unsigned u32x2 __attribute__((ext_vector_type(2)));

constexpr int M_ = 32768, DM = 2048, SEQ = 4096, NBATCH = 8, DEPTH = 4;
constexpr int NIN = 3136, NINP = 3328, DFF = 8192;
constexpr float ALPHA = 1.6817928305074290f;
constexpr float LN_EPS = 1e-5f, RMS_EPS = 1e-6f;
constexpr size_t MiB = 1ull << 20;
constexpr size_t WS_HB = 0;
constexpr size_t WS_W = 128 * MiB;
constexpr size_t W_IN = WS_W, W_UQ = W_IN + (size_t)NINP * 2048 * 2, W_UKV = W_UQ + 1536ull * 512 * 2, W_G = W_UKV + 2048ull * 512 * 2,
                 W_OUT = W_G + 8ull * 512 * 128 * 2, W_UP = W_OUT + 2048ull * 2048 * 2, W_DN = W_UP + 8192ull * 2048 * 2, W_END = W_DN + 8192ull * 2048 * 2;
static_assert(W_END <= 218 * MiB, "weights region");
constexpr size_t WS_COS = 218 * MiB, WS_SIN = 222 * MiB, WS_SP = 226 * MiB;
constexpr size_t WS_CSB = 226 * MiB + 65536;
constexpr int CSB_L = 2 * 3328 + 2 * 8192, CSB_IN = 0, CSB_UP = 2 * 3328;
constexpr size_t WS_ST = 227 * MiB;
constexpr size_t WS_BIG = 232 * MiB;
constexpr size_t WS_F = WS_BIG;
constexpr size_t WS_GG = WS_BIG, WS_XC = WS_BIG + 64 * MiB, WS_YCAT = WS_BIG + 128 * MiB, WS_SSQ = WS_BIG + 256 * MiB, WS_KPE = WS_BIG + 258 * MiB,
                 WS_CQ = WS_BIG + 262 * MiB, WS_CKV = WS_BIG + 294 * MiB, WS_XL = WS_BIG + 326 * MiB, WS_AU = WS_BIG + 262 * MiB  ,
                 WS_Q = WS_BIG + 518 * MiB, WS_KV = WS_BIG + 614 * MiB, WS_PH = WS_BIG + 742 * MiB, WS_END = WS_BIG + 750 * MiB;
static_assert(WS_END <= 1024 * MiB, "workspace");

struct Params { const float* in[23]; float* out; unsigned char* ws; };

__device__ __forceinline__ int otid() { int t = threadIdx.x; asm volatile("" : "+v"(t)); return t; }
__device__ __forceinline__ unsigned cvt_pk_bf16(float lo, float hi) { unsigned r; asm volatile("v_cvt_pk_bf16_f32 %0, %1, %2" : "=v"(r) : "v"(lo), "v"(hi)); return r; }
__device__ __forceinline__ float sum_fq(float x) {
    auto a = __builtin_amdgcn_permlane16_swap(__float_as_uint(x), __float_as_uint(x), false, false); x = __uint_as_float(a[0]) + __uint_as_float(a[1]);
    auto b = __builtin_amdgcn_permlane32_swap(__float_as_uint(x), __float_as_uint(x), false, false); return __uint_as_float(b[0]) + __uint_as_float(b[1]); }
__device__ __forceinline__ float wave_sum(float x, int lane) {
#pragma unroll
    for (int o = 32; o >= 1; o >>= 1) x += __int_as_float(__builtin_amdgcn_ds_bpermute((lane ^ o) << 2, __float_as_int(x)));
    return x; }
__device__ __forceinline__ float bf_lo(unsigned w) { return __uint_as_float(w << 16); }
__device__ __forceinline__ float bf_hi(unsigned w) { return __uint_as_float(w & 0xffff0000u); }
__device__ __forceinline__ float sigmoidf_(float x) { return __builtin_amdgcn_rcpf(1.0f + __builtin_amdgcn_exp2f(-1.4426950408889634f * x)); }
__device__ __forceinline__ float gelu_tanh(float x) { const float z = 0.7978845608028654f * (x + 0.044715f * x * x * x); return x * sigmoidf_(2.0f * z); }
__device__ __forceinline__ u32x4 pack8(const f32x4 a, const f32x4 b) { u32x4 w; w.x = cvt_pk_bf16(a[0], a[1]); w.y = cvt_pk_bf16(a[2], a[3]); w.z = cvt_pk_bf16(b[0], b[1]); w.w = cvt_pk_bf16(b[2], b[3]); return w; }

namespace pg8 {
constexpr int BM = 256, BK = 64, HALF = 128, HTB = HALF * BK * 2, STAGE_BYTES = 8 * HTB, NXCD = 8, WGM = 8;
__host__ __device__ __forceinline__ int lds_byte(int r, int c) { const int st = (r >> 4) * 2 + (c >> 5), rr = r & 15, cc = c & 31, ob = rr * 64 + cc * 2; return st * 1024 + (ob ^ (((ob >> 9) & 1) << 5)); }
__host__ __device__ __forceinline__ void stage_rc(int b, int& R, int& C) { const int st = b / 1024, sb = b % 1024, swz = sb ^ (((sb >> 9) & 1) << 5); R = (st >> 1) * 16 + swz / 64; C = (st & 1) * 32 + (swz % 64) / 2; }
__host__ __device__ __forceinline__ int perm32(int rho) { const int n = rho >> 4, i = rho & 15; return 8 * (i >> 2) + 4 * n + (i & 3); }

struct Unit { int pm, pn, z; };
struct Order {
    int nM, nN, nZ, per, G, c;
    const char* A; const char* B; size_t a_pm, a_z, b_pn, b_z; int lda, ldb, K;
    __device__ __forceinline__ bool next(int i, Unit& u) const {
        const long L = (long)i * G + c; if (L >= (long)per * nZ) return false;
        u.z = (int)(L / per); int wgid = (int)(L % per);
        { const int q = per / NXCD, r = per % NXCD, xcd = wgid % NXCD, off = wgid / NXCD; wgid = (xcd < r ? xcd * (q + 1) : r * (q + 1) + (xcd - r) * q) + off; }
        const int nig = WGM * nN, gid = wgid / nig, fm = gid * WGM, gsz = (nM - fm) < WGM ? (nM - fm) : WGM;
        u.pm = fm + ((wgid % nig) % gsz); u.pn = (wgid % nig) / gsz; return true;
    }
    __device__ __forceinline__ const char* aptr(const Unit& u) const { return A + (size_t)u.pm * a_pm + (size_t)u.z * a_z; }
    __device__ __forceinline__ const char* bptr(const Unit& u) const { return B + (size_t)u.pn * b_pn + (size_t)u.z * b_z; }
};
__device__ __forceinline__ Order make_order(const void* A, int lda, const void* Bt, int ldb, int Mrows, int N, int K) {
    Order o; o.nM = Mrows / BM; o.nN = N / BM; o.nZ = 1; o.per = o.nM * o.nN; o.G = gridDim.x; o.c = blockIdx.x;
    o.A = (const char*)A; o.B = (const char*)Bt; o.a_pm = (size_t)BM * lda * 2; o.a_z = 0; o.b_pn = (size_t)BM * ldb * 2; o.b_z = 0; o.lda = lda; o.ldb = ldb; o.K = K; return o;
}

template <class Epi>
__device__ __forceinline__ void gemm_phase(LAS unsigned char* lds, const Order& S, const Epi& E) {
    const int tid = otid(), wid = __builtin_amdgcn_readfirstlane(tid >> 6), lane = tid & 63, wr = wid >> 2, wc = wid & 3, fr = lane & 15, fq = lane >> 4;
    const int nt = S.K / BK;
    unsigned voffA[2], voffB[2];
#pragma unroll
    for (int i = 0; i < 2; ++i) { int R, C; stage_rc(tid * 16 + i * 8192, R, C); const int Rb = Epi::PERM ? ((R & ~31) + perm32(R & 31)) : R;
        voffA[i] = (unsigned)(R * S.lda + C) * 2u; voffB[i] = (unsigned)(Rb * S.ldb + C) * 2u; }
    const size_t kstep = (size_t)(BK * 2);
    const size_t hstepA = (size_t)HALF * S.lda * 2, hstepB = (size_t)HALF * S.ldb * 2;
    const unsigned ldsw = (unsigned)wid * 1024u;
    const int aoff = lds_byte(wr * 64 + fr, fq * 8), boff = lds_byte(wc * 32 + fr, fq * 8);
#define PG8_SA(b, h) (((b) * 2 + (h)) * HTB)
#define PG8_SB(b, h) ((4 + (b) * 2 + (h)) * HTB)
#define PG8_STAGE(bufoff, gbase, voff) do { _Pragma("unroll") for (int _i = 0; _i < 2; ++_i) \
        __builtin_amdgcn_global_load_lds((const unsigned*)((const char*)(gbase) + (voff)[_i]), (LAS unsigned*)(lds + (bufoff) + ldsw + _i * 8192), 16, 0, 0); } while (0)
#define PG8_LDA(dst, b, h) do { _Pragma("unroll") for (int m = 0; m < 4; ++m) _Pragma("unroll") for (int k = 0; k < 2; ++k) dst[m][k] = *(const LAS bf16x8*)(lds + PG8_SA(b, h) + aoff + m * 2048 + k * 1024); } while (0)
#define PG8_LDB(dst, b, h) do { _Pragma("unroll") for (int n = 0; n < 2; ++n) _Pragma("unroll") for (int k = 0; k < 2; ++k) dst[n][k] = *(const LAS bf16x8*)(lds + PG8_SB(b, h) + boff + n * 2048 + k * 1024); } while (0)
#define PG8_MMA(ai, bj, At, Bt) do { __builtin_amdgcn_s_setprio(1); _Pragma("unroll") for (int m = 0; m < 4; ++m) _Pragma("unroll") for (int n = 0; n < 2; ++n) _Pragma("unroll") for (int k = 0; k < 2; ++k) \
        acc[ai][bj][m][n] = __builtin_amdgcn_mfma_f32_16x16x32_bf16(Bt[n][k], At[m][k], acc[ai][bj][m][n], 0, 0, 0); __builtin_amdgcn_s_setprio(0); } while (0)
#define PG8_WAIT_V(n) asm volatile("s_waitcnt vmcnt(" #n ")" ::: "memory")
#define PG8_WAIT_L(n) asm volatile("s_waitcnt lgkmcnt(" #n ")" ::: "memory")
#define PG8_BAR __builtin_amdgcn_s_barrier()
#define PG8_SCHED __builtin_amdgcn_sched_barrier(0)
    Unit cur, nxt; int ui = 0;
    if (!S.next(0, cur)) return;
    f32x4 acc[2][2][4][2];
#pragma unroll
    for (int a = 0; a < 2; ++a)
#pragma unroll
        for (int b = 0; b < 2; ++b)
#pragma unroll
            for (int m = 0; m < 4; ++m)
#pragma unroll
                for (int n = 0; n < 2; ++n) acc[a][b][m][n] = (f32x4){0.f, 0.f, 0.f, 0.f};
    bf16x8 At[4][2], B0[2][2], B1[2][2];
    const char* cA = S.aptr(cur); const char* cB = S.bptr(cur);
    PG8_STAGE(PG8_SB(0, 0), cB, voffB); PG8_STAGE(PG8_SA(0, 0), cA, voffA); PG8_STAGE(PG8_SB(0, 1), cB + hstepB, voffB); PG8_STAGE(PG8_SA(0, 1), cA + hstepA, voffA);
    if (wr == 1) PG8_BAR;
    PG8_WAIT_V(4); PG8_BAR;
    PG8_STAGE(PG8_SB(1, 0), cB + kstep, voffB); PG8_STAGE(PG8_SA(1, 0), cA + kstep, voffA); PG8_STAGE(PG8_SB(1, 1), cB + hstepB + kstep, voffB);
    PG8_WAIT_V(6); PG8_BAR;
    for (;;) {
        const bool has_next = S.next(ui + 1, nxt);
        const char* nA = has_next ? S.aptr(nxt) : cA; const char* nB = has_next ? S.bptr(nxt) : cB;
        for (int t = 0; t < nt; t += 2) {
            const bool last = (t == nt - 2);
            const char* a1 = cA + (size_t)(t + 1) * kstep;
            const char* a2 = last ? nA : cA + (size_t)(t + 2) * kstep; const char* b2 = last ? nB : cB + (size_t)(t + 2) * kstep;
            const char* a3 = a2 + kstep; const char* b3 = b2 + kstep;
            PG8_LDB(B0, 0, 0); PG8_SCHED; PG8_LDA(At, 0, 0); PG8_STAGE(PG8_SA(1, 1), a1 + hstepA, voffA);
            PG8_WAIT_L(8); PG8_BAR; PG8_WAIT_L(0); PG8_MMA(0, 0, At, B0); PG8_BAR; PG8_SCHED;
            PG8_LDB(B1, 0, 1); PG8_STAGE(PG8_SB(0, 0), b2, voffB);
            PG8_BAR; PG8_WAIT_L(0); PG8_MMA(0, 1, At, B1); PG8_BAR;
            PG8_LDA(At, 0, 1); PG8_STAGE(PG8_SA(0, 0), a2, voffA);
            PG8_BAR; PG8_WAIT_L(0); PG8_MMA(1, 0, At, B0); PG8_BAR; PG8_SCHED;
            PG8_STAGE(PG8_SB(0, 1), b2 + hstepB, voffB);
            PG8_WAIT_V(6); PG8_BAR; PG8_MMA(1, 1, At, B1); PG8_BAR;
            PG8_LDB(B0, 1, 0); PG8_SCHED; PG8_LDA(At, 1, 0); PG8_STAGE(PG8_SA(0, 1), a2 + hstepA, voffA);
            PG8_WAIT_L(8); PG8_BAR; PG8_WAIT_L(0); PG8_MMA(0, 0, At, B0); PG8_BAR; PG8_SCHED;
            PG8_LDB(B1, 1, 1); PG8_STAGE(PG8_SB(1, 0), b3, voffB);
            PG8_BAR; PG8_WAIT_L(0); PG8_MMA(0, 1, At, B1); PG8_BAR;
            PG8_LDA(At, 1, 1); PG8_STAGE(PG8_SA(1, 0), a3, voffA);
            PG8_BAR; PG8_WAIT_L(0); PG8_MMA(1, 0, At, B0); PG8_BAR; PG8_SCHED;
            PG8_STAGE(PG8_SB(1, 1), b3 + hstepB, voffB);
            PG8_WAIT_V(6); PG8_BAR; PG8_MMA(1, 1, At, B1); PG8_BAR;
        }
        E(acc, cur, wr, wc, fr, fq);
        if (!has_next) break;
#pragma unroll
        for (int a = 0; a < 2; ++a)
#pragma unroll
            for (int b = 0; b < 2; ++b)
#pragma unroll
                for (int m = 0; m < 4; ++m)
#pragma unroll
                    for (int n = 0; n < 2; ++n) acc[a][b][m][n] = (f32x4){0.f, 0.f, 0.f, 0.f};
        cur = nxt; cA = nA; cB = nB; ++ui;
    }
    PG8_WAIT_V(0);
    if (wr == 0) PG8_BAR;
    PG8_BAR;
#undef PG8_SA
#undef PG8_SB
#undef PG8_STAGE
#undef PG8_LDA
#undef PG8_LDB
#undef PG8_MMA
#undef PG8_WAIT_V
#undef PG8_WAIT_L
#undef PG8_BAR
#undef PG8_SCHED
}
}
using pg8::Unit;
typedef f32x4 Acc[2][2][4][2];

typedef unsigned long long fix_t;
__device__ __forceinline__ fix_t to_fix(float v) { return (fix_t)(long long)(v * 4294967296.0f); }
__device__ __forceinline__ float from_fix(fix_t v) { return fmaf((float)(unsigned)v, 2.3283064365386963e-10f, (float)(int)(v >> 32)); }
__device__ __forceinline__ void fix_add(fix_t* p, float v) { __hip_atomic_fetch_add(p, to_fix(v), __ATOMIC_RELAXED, __HIP_MEMORY_SCOPE_AGENT); }
__device__ __forceinline__ f32x4 ld_fix4(const fix_t* p) { typedef unsigned long long u64x2 __attribute__((ext_vector_type(2))); const u64x2 a = *(const u64x2*)p, b = *(const u64x2*)(p + 2);
    return (f32x4){from_fix(a.x), from_fix(a.y), from_fix(b.x), from_fix(b.y)}; }
__device__ __forceinline__ void row_ln(const fix_t* st, int row, float& mu, float& rs) { const float s1 = from_fix(st[row]), s2 = from_fix(st[M_ + row]); mu = s1 * (1.0f / 2048.0f); rs = __builtin_amdgcn_rsqf(s2 * (1.0f / 2048.0f) - mu * mu + LN_EPS); }
template <bool PERM>
__device__ __forceinline__ void ln_correct(f32x4 (&acc)[2][2][4][2], const fix_t* st, const float* cs, const float* bw, int row0, int colbase) {
    f32x4 c4[2][2], b4[2][2];
#pragma unroll
    for (int bj = 0; bj < 2; ++bj)
#pragma unroll
        for (int n = 0; n < 2; ++n) { const int col = colbase + bj * 128 + (PERM ? 4 * n : 16 * n); c4[bj][n] = *(const f32x4*)(cs + col); b4[bj][n] = *(const f32x4*)(bw + col); }
#pragma unroll
    for (int ai = 0; ai < 2; ++ai) { fix_t r1[4], r2[4];
#pragma unroll
        for (int m = 0; m < 4; ++m) { const int row = row0 + ai * 128 + m * 16; r1[m] = st[row]; r2[m] = st[M_ + row]; }
#pragma unroll
        for (int m = 0; m < 4; ++m) { const float mu = from_fix(r1[m]) * (1.0f / 2048.0f), rs = __builtin_amdgcn_rsqf(from_fix(r2[m]) * (1.0f / 2048.0f) - mu * mu + LN_EPS);
#pragma unroll
            for (int bj = 0; bj < 2; ++bj)
#pragma unroll
                for (int n = 0; n < 2; ++n) acc[ai][bj][m][n] = (acc[ai][bj][m][n] - c4[bj][n] * mu) * rs + b4[bj][n]; } }
}

struct EpiIn {
    static constexpr bool PERM = true;
    bf16_t *cq, *ckv, *xl, *gg, *kpe; float* ssq; const float *cosT, *sinT; const fix_t* st; const float *cs, *bw;
    __device__ __forceinline__ void operator()(Acc& acc, const Unit& u, int wr, int wc, int fr, int fq) const {
        const int row0 = u.pm * 256 + wr * 64 + fr, pn = u.pn;
        ln_correct<true>(acc, st, cs, bw, row0, pn * 256 + wc * 32 + 8 * fq);
        if (pn < 4) {
            bf16_t* base = (pn < 2 ? cq : ckv); const int col0 = (pn & 1) * 256 + wc * 32 + 8 * fq;
#pragma unroll
            for (int ai = 0; ai < 2; ++ai)
#pragma unroll
                for (int m = 0; m < 4; ++m) { const int row = row0 + ai * 128 + m * 16; float s = 0.f;
#pragma unroll
                    for (int bj = 0; bj < 2; ++bj) { const f32x4 v0 = acc[ai][bj][m][0], v1 = acc[ai][bj][m][1];
                        s += (v0[0] * v0[0] + v0[1] * v0[1]) + (v0[2] * v0[2] + v0[3] * v0[3]) + (v1[0] * v1[0] + v1[1] * v1[1]) + (v1[2] * v1[2] + v1[3] * v1[3]);
                        *(u32x4*)(base + (size_t)row * 512 + col0 + bj * 128) = pack8(v0, v1); }
                    s = sum_fq(s);
                    if (fq == 0) ssq[(size_t)row * 16 + pn * 4 + wc] = s; }
        } else if (pn < 8) {
            const int col0 = (pn - 4) * 256 + wc * 32 + 8 * fq;
#pragma unroll
            for (int ai = 0; ai < 2; ++ai)
#pragma unroll
                for (int m = 0; m < 4; ++m) { const int row = row0 + ai * 128 + m * 16;
#pragma unroll
                    for (int bj = 0; bj < 2; ++bj) *(u32x4*)(xl + (size_t)row * 1024 + col0 + bj * 128) = pack8(acc[ai][bj][m][0], acc[ai][bj][m][1]); }
        } else if (pn < 12) {
            const int col0 = (pn - 8) * 256 + wc * 32 + 8 * fq;
#pragma unroll
            for (int ai = 0; ai < 2; ++ai)
#pragma unroll
                for (int m = 0; m < 4; ++m) { const int row = row0 + ai * 128 + m * 16;
#pragma unroll
                    for (int bj = 0; bj < 2; ++bj) { f32x4 v0 = acc[ai][bj][m][0], v1 = acc[ai][bj][m][1];
#pragma unroll
                        for (int j = 0; j < 4; ++j) { v0[j] = gelu_tanh(v0[j]); v1[j] = gelu_tanh(v1[j]); }
                        *(u32x4*)(gg + (size_t)row * 1024 + col0 + bj * 128) = pack8(v0, v1); } }
        } else if (wc == 0) {
#pragma unroll
            for (int ai = 0; ai < 2; ++ai) { f32x4 c0[4], c1[4], s0[4], s1[4];
#pragma unroll
                for (int m = 0; m < 4; ++m) { const size_t t = (size_t)(row0 + ai * 128 + m * 16) * 32 + 8 * fq;
                    c0[m] = *(const f32x4*)(cosT + t); c1[m] = *(const f32x4*)(cosT + t + 4); s0[m] = *(const f32x4*)(sinT + t); s1[m] = *(const f32x4*)(sinT + t + 4); }
#pragma unroll
                for (int m = 0; m < 4; ++m) { const int row = row0 + ai * 128 + m * 16;
                    const f32x4 a0 = acc[ai][0][m][0], a1 = acc[ai][0][m][1], b0 = acc[ai][1][m][0], b1 = acc[ai][1][m][1];
                    *(u32x4*)(kpe + (size_t)row * 64 + 8 * fq) = pack8(a0 * c0[m] - b0 * s0[m], a1 * c1[m] - b1 * s1[m]);
                    *(u32x4*)(kpe + (size_t)row * 64 + 32 + 8 * fq) = pack8(b0 * c0[m] + a0 * s0[m], b1 * c1[m] + a1 * s1[m]); } }
        }
    }
};
__device__ __forceinline__ void rows_rstd(const float* ssq8, int row0, float (&rs)[8]) {
#pragma unroll
    for (int h = 0; h < 2; ++h) { f32x4 a[4], b[4];
#pragma unroll
        for (int k = 0; k < 4; ++k) { const float* p = ssq8 + (size_t)(row0 + h * 128 + k * 16) * 16; a[k] = *(const f32x4*)p; b[k] = *(const f32x4*)(p + 4); }
#pragma unroll
        for (int k = 0; k < 4; ++k) { const float s = ((a[k][0] + a[k][1]) + (a[k][2] + a[k][3])) + ((b[k][0] + b[k][1]) + (b[k][2] + b[k][3])); rs[h * 4 + k] = __builtin_amdgcn_rsqf(s * (1.0f / 512.0f) + RMS_EPS); } }
}
struct EpiQ {
    static constexpr bool PERM = true;
    bf16_t* q; const float* ssq; const float *cosT, *sinT;
    __device__ __forceinline__ void operator()(Acc& acc, const Unit& u, int wr, int wc, int fr, int fq) const {
        const int row0 = u.pm * 256 + wr * 64 + fr, pn = u.pn;
        float rs[8]; rows_rstd(ssq, row0, rs);
        if (pn < 4) {
            const int col0 = pn * 256 + wc * 32 + 8 * fq;
#pragma unroll
            for (int ai = 0; ai < 2; ++ai)
#pragma unroll
                for (int m = 0; m < 4; ++m) { const int row = row0 + ai * 128 + m * 16; const float r = rs[ai * 4 + m];
#pragma unroll
                    for (int bj = 0; bj < 2; ++bj) *(u32x4*)(q + (size_t)row * 1536 + col0 + bj * 128) = pack8(acc[ai][bj][m][0] * r, acc[ai][bj][m][1] * r); }
        } else {
            const int head = 4 * (pn - 4) + wc;
#pragma unroll
            for (int kb = 0; kb < 4; ++kb) { f32x4 c0[2], c1[2], s0[2], s1[2];
#pragma unroll
                for (int j = 0; j < 2; ++j) { const int k = kb * 2 + j; const size_t t = (size_t)(row0 + (k >> 2) * 128 + (k & 3) * 16) * 32 + 8 * fq;
                    c0[j] = *(const f32x4*)(cosT + t); c1[j] = *(const f32x4*)(cosT + t + 4); s0[j] = *(const f32x4*)(sinT + t); s1[j] = *(const f32x4*)(sinT + t + 4); }
#pragma unroll
                for (int j = 0; j < 2; ++j) { const int k = kb * 2 + j, ai = k >> 2, m = k & 3; const int row = row0 + ai * 128 + m * 16; const float r = rs[k];
                    const f32x4 a0 = acc[ai][0][m][0] * r, a1 = acc[ai][0][m][1] * r, b0 = acc[ai][1][m][0] * r, b1 = acc[ai][1][m][1] * r;
                    *(u32x4*)(q + (size_t)row * 1536 + 1024 + head * 64 + 8 * fq) = pack8(a0 * c0[j] - b0 * s0[j], a1 * c1[j] - b1 * s1[j]);
                    *(u32x4*)(q + (size_t)row * 1536 + 1024 + head * 64 + 32 + 8 * fq) = pack8(b0 * c0[j] + a0 * s0[j], b1 * c1[j] + a1 * s1[j]); } }
        }
    }
};
struct EpiKV {
    static constexpr bool PERM = true;
    bf16_t* kv; const float* ssq;
    __device__ __forceinline__ void operator()(Acc& acc, const Unit& u, int wr, int wc, int fr, int fq) const {
        const int row0 = u.pm * 256 + wr * 64 + fr, col0 = u.pn * 256 + wc * 32 + 8 * fq;
        float rs[8]; rows_rstd(ssq + 8, row0, rs);
#pragma unroll
        for (int ai = 0; ai < 2; ++ai)
#pragma unroll
            for (int m = 0; m < 4; ++m) { const int row = row0 + ai * 128 + m * 16; const float r = rs[ai * 4 + m];
#pragma unroll
                for (int bj = 0; bj < 2; ++bj) *(u32x4*)(kv + (size_t)row * 2048 + col0 + bj * 128) = pack8(acc[ai][bj][m][0] * r, acc[ai][bj][m][1] * r); }
    }
};
struct EpiGate {
    static constexpr bool PERM = true;
    unsigned* au; const bf16_t* xc; const float *ba, *bi, *sp;
    __device__ __forceinline__ void operator()(Acc& acc, const Unit& u, int wr, int wc, int fr, int fq) const {
        const int row0 = u.pm * 256 + wr * 64 + fr, d = u.pn, ch0 = u.z * 128 + wc * 32 + 8 * fq;
        unsigned* aud = au + (size_t)d * M_ * 1024;
#pragma unroll
        for (int n = 0; n < 2; ++n) {
            const int ch = ch0 + 4 * n;
            const f32x4 bav = *(const f32x4*)(ba + d * 1024 + ch), biv = *(const f32x4*)(bi + d * 1024 + ch), spv = *(const f32x4*)(sp + d * 1024 + ch) * (-8.0f * 1.4426950408889634f);
            u32x2 xws[8];
#pragma unroll
            for (int k = 0; k < 8; ++k) xws[k] = *(const u32x2*)(xc + (size_t)(row0 + (k >> 2) * 128 + (k & 3) * 16) * 1024 + ch);
#pragma unroll
            for (int ai = 0; ai < 2; ++ai)
#pragma unroll
                for (int m = 0; m < 4; ++m) { const int row = row0 + ai * 128 + m * 16;
                    const u32x2 xw = xws[ai * 4 + m];
                    const float xv[4] = {bf_lo(xw.x), bf_hi(xw.x), bf_lo(xw.y), bf_hi(xw.y)};
                    u32x4 o;
#pragma unroll
                    for (int j = 0; j < 4; ++j) {
                        const float r = sigmoidf_(acc[ai][0][m][n][j] + bav[j]);
                        const float ig = sigmoidf_(acc[ai][1][m][n][j] + biv[j]);
                        const float a = __builtin_amdgcn_exp2f(r * spv[j]);
                        const float oma = 1.0f - a;
                        const float uu = __builtin_amdgcn_sqrtf(oma * (1.0f + a)) * ig * xv[j];
                        o[j] = cvt_pk_bf16(oma, uu); }
                    *(u32x4*)(aud + (size_t)row * 1024 + ch) = o; }
        }
    }
};
#ifndef RES_PF
#define RES_PF 1
#endif
struct EpiRes {
    static constexpr bool PERM = false;
    const float* src; float* out; bf16_t* hb; const fix_t* st_old; const float *g, *b; fix_t* st_new;
    __device__ __forceinline__ void operator()(Acc& acc, const Unit& u, int wr, int wc, int fr, int fq) const {
        const int row0 = u.pm * 256 + wr * 64 + fr, col0 = u.pn * 256 + wc * 32 + 4 * fq;
        f32x4 gv[4], bv[4], P[RES_PF + 1][4]; float mus[8], rss[8];
#pragma unroll
        for (int h = 0; h < 2; ++h) { fix_t r1[4], r2[4];
#pragma unroll
            for (int k = 0; k < 4; ++k) { const int row = row0 + h * 128 + k * 16; r1[k] = st_old[row]; r2[k] = st_old[M_ + row]; }
#pragma unroll
            for (int k = 0; k < 4; ++k) { mus[h * 4 + k] = from_fix(r1[k]) * (1.0f / 2048.0f); rss[h * 4 + k] = __builtin_amdgcn_rsqf(from_fix(r2[k]) * (1.0f / 2048.0f) - mus[h * 4 + k] * mus[h * 4 + k] + LN_EPS); } }
#pragma unroll
        for (int c = 0; c < 4; ++c) { gv[c] = *(const f32x4*)(g + col0 + (c >> 1) * 128 + (c & 1) * 16); bv[c] = *(const f32x4*)(b + col0 + (c >> 1) * 128 + (c & 1) * 16); }
#define RES_LOAD(k) do { const size_t off_ = (size_t)(row0 + ((k) >> 2) * 128 + ((k) & 3) * 16) * 2048 + col0; _Pragma("unroll") for (int c = 0; c < 4; ++c) P[(k) % (RES_PF + 1)][c] = *(const f32x4*)(src + off_ + (c >> 1) * 128 + (c & 1) * 16); } while (0)
#pragma unroll
        for (int k = 0; k < RES_PF; ++k) RES_LOAD(k);
#pragma unroll
        for (int k = 0; k < 8; ++k) {
            if (k + RES_PF < 8) RES_LOAD(k + RES_PF);
            const int ai = k >> 2, m = k & 3; const size_t off = (size_t)(row0 + ai * 128 + m * 16) * 2048 + col0;
            const float mu = mus[k], rs = rss[k];
            float a1 = 0.f, a2 = 0.f;
#pragma unroll
            for (int c = 0; c < 4; ++c) { const int cc = (c >> 1) * 128 + (c & 1) * 16;
                const f32x4 v = ((P[k % (RES_PF + 1)][c] - mu) * rs * gv[c] + bv[c]) * ALPHA + acc[ai][c >> 1][m][c & 1];
                *(f32x4*)(out + off + cc) = v; u32x2 w; w.x = cvt_pk_bf16(v[0], v[1]); w.y = cvt_pk_bf16(v[2], v[3]); *(u32x2*)(hb + off + cc) = w;
                a1 += (v[0] + v[1]) + (v[2] + v[3]); a2 += (v[0] * v[0] + v[1] * v[1]) + (v[2] * v[2] + v[3] * v[3]); }
            a1 = sum_fq(a1); a2 = sum_fq(a2);
            { const int row = row0 + ai * 128 + m * 16; if (fq == 0) fix_add(st_new + row, a1); else if (fq == 1) fix_add(st_new + M_ + row, a2); }
        }
#undef RES_LOAD
    }
};
struct EpiUp {
    static constexpr bool PERM = true;
    bf16_t* f; const fix_t* st; const float *cs, *bw;
    __device__ __forceinline__ void operator()(Acc& acc, const Unit& u, int wr, int wc, int fr, int fq) const {
        const int row0 = u.pm * 256 + wr * 64 + fr, col0 = u.pn * 256 + wc * 32 + 8 * fq;
        ln_correct<true>(acc, st, cs, bw, row0, col0);
#pragma unroll
        for (int ai = 0; ai < 2; ++ai)
#pragma unroll
            for (int m = 0; m < 4; ++m) { const int row = row0 + ai * 128 + m * 16;
#pragma unroll
                for (int bj = 0; bj < 2; ++bj) { f32x4 v0 = acc[ai][bj][m][0], v1 = acc[ai][bj][m][1];
#pragma unroll
                    for (int j = 0; j < 4; ++j) { const float a = fmaxf(v0[j], 0.f), b = fmaxf(v1[j], 0.f); v0[j] = a * a; v1[j] = b * b; }
                    *(u32x4*)(f + (size_t)row * 8192 + col0 + bj * 128) = pack8(v0, v1); } }
    }
};

namespace att {
constexpr int NW = 8, QBLK = 32, KVBLK = 64;
constexpr float SCALE = 0.07216878364870323f;
constexpr float THR = 8.f;
#ifndef ATT_SDEPTH
#define ATT_SDEPTH 1
#endif
constexpr int SDEPTH = ATT_SDEPTH;
constexpr int SHM_V = KVBLK * 128 * 2, SHM_K = KVBLK * 128 * 2, SHM_R = KVBLK * 64 * 2;
constexpr int OFF_V = 0, OFF_K = 2 * SHM_V, OFF_R = OFF_K + 2 * SHM_K, OFF_WS = OFF_R + 2 * SHM_R, OFF_QR = OFF_WS + NW * 64 * 4, SHM_ATTN = OFF_QR + 256 * 128;
#define KSWZ(row, colB) ((row) * 256 + ((colB) ^ (((row) & 7) << 4)))
#define RSWZ(row, colB) ((row) * 128 + ((colB) ^ (((row) & 7) << 4)))
#define SBAR() __builtin_amdgcn_sched_barrier(0)
__device__ __forceinline__ int crow(int r, int hi) { return (r & 3) + 8 * (r >> 2) + 4 * hi; }
__device__ __forceinline__ void partialSM(f32x16& p0, f32x16& p1, float& m_reg, float& mn, float& alpha) {
    constexpr float C = SCALE * 1.4426950408889634f;
    float pmax = p0[0];
#pragma unroll
    for (int r = 1; r < 16; ++r) pmax = fmaxf(pmax, p0[r]);
#pragma unroll
    for (int r = 0; r < 16; ++r) pmax = fmaxf(pmax, p1[r]);
    { auto rr = __builtin_amdgcn_permlane32_swap(__float_as_uint(pmax), __float_as_uint(pmax), false, false);
      pmax = fmaxf(__uint_as_float(rr[0]), __uint_as_float(rr[1])); }
    if (__builtin_expect(__all(pmax - m_reg <= THR / SCALE), 1)) { mn = m_reg; alpha = 1.f; }
    else { mn = fmaxf(m_reg, pmax); alpha = __builtin_amdgcn_exp2f((m_reg - mn) * C); m_reg = mn; }
    const float mnC = -mn * C;
#pragma unroll
    for (int r = 0; r < 16; ++r) p0[r] = fmaf(p0[r], C, mnC);
#pragma unroll
    for (int r = 0; r < 16; ++r) p1[r] = fmaf(p1[r], C, mnC);
#pragma unroll
    for (int r = 0; r < 16; ++r) p0[r] = __builtin_amdgcn_exp2f(p0[r]);
}
__device__ __forceinline__ void finishSM(f32x16& p0, f32x16& p1, float alpha, float& l_reg, bf16x8& pa0, bf16x8& pa1, bf16x8& pa2, bf16x8& pa3) {
#pragma unroll
    for (int r = 0; r < 16; ++r) p1[r] = __builtin_amdgcn_exp2f(p1[r]);
    float ps = 0;
#pragma unroll
    for (int r = 0; r < 16; ++r) ps += p0[r];
#pragma unroll
    for (int r = 0; r < 16; ++r) ps += p1[r];
    { auto rr = __builtin_amdgcn_permlane32_swap(__float_as_uint(ps), __float_as_uint(ps), false, false);
      ps = __uint_as_float(rr[0]) + __uint_as_float(rr[1]); }
    l_reg = l_reg * alpha + ps;
#define PK4(P, BASE, OUT) do { unsigned a0 = cvt_pk_bf16(P[BASE + 0], P[BASE + 1]), a1 = cvt_pk_bf16(P[BASE + 2], P[BASE + 3]);   \
    unsigned b0 = cvt_pk_bf16(P[BASE + 4], P[BASE + 5]), b1 = cvt_pk_bf16(P[BASE + 6], P[BASE + 7]);                              \
    auto r0 = __builtin_amdgcn_permlane32_swap(a0, b0, false, false); auto r1 = __builtin_amdgcn_permlane32_swap(a1, b1, false, false); \
    u32x4 w = {r0[0], r1[0], r0[1], r1[1]}; OUT = *reinterpret_cast<bf16x8*>(&w); } while (0)
    PK4(p0, 0, pa0); PK4(p0, 8, pa1); PK4(p1, 0, pa2); PK4(p1, 8, pa3);
#undef PK4
}
__device__ __forceinline__ void qkt(f32x16& p0, f32x16& p1, const char* Ks, const char* Rs, const bf16x8* qr, const char* Qrl, int r32, int hi) {
    p0 = f32x16{}; p1 = f32x16{};
#pragma unroll
    for (int d0 = 0; d0 < 8; ++d0) { const int cb = (d0 * 16 + hi * 8) * 2;
        const bf16x8 b0 = *reinterpret_cast<const bf16x8*>(Ks + KSWZ(r32, cb));
        const bf16x8 b1 = *reinterpret_cast<const bf16x8*>(Ks + KSWZ(32 + r32, cb));
        p0 = __builtin_amdgcn_mfma_f32_32x32x16_bf16(b0, qr[d0], p0, 0, 0, 0);
        p1 = __builtin_amdgcn_mfma_f32_32x32x16_bf16(b1, qr[d0], p1, 0, 0, 0); }
#pragma unroll
    for (int d0 = 0; d0 < 4; ++d0) { const int cb = (d0 * 16 + hi * 8) * 2;
        const bf16x8 b0 = *reinterpret_cast<const bf16x8*>(Rs + RSWZ(r32, cb));
        const bf16x8 b1 = *reinterpret_cast<const bf16x8*>(Rs + RSWZ(32 + r32, cb));
        const bf16x8 qv = *reinterpret_cast<const bf16x8*>(Qrl + (cb ^ ((r32 & 7) << 4)));
        p0 = __builtin_amdgcn_mfma_f32_32x32x16_bf16(b0, qv, p0, 0, 0, 0);
        p1 = __builtin_amdgcn_mfma_f32_32x32x16_bf16(b1, qv, p1, 0, 0, 0); }
}
__device__ __forceinline__ int v_st(int k, int c) { const int kk = (k & ~0xC) | ((k & 4) << 1) | ((k & 8) >> 1); return ((kk >> 3) * 4 + (c >> 5)) * 512 + ((kk & 7) * 32 + (c & 31)) * 2; }
__device__ __forceinline__ int v_rd_base(int lane) { return ((lane & 3) << 3) | (((lane >> 2) & 3) << 6) | (((lane >> 4) & 1) << 5) | (((lane >> 5) & 1) << 8); }
constexpr int v_rd_off(int d0, int ks, int half) { return d0 * 512 + ks * 4096 + half * 2048; }
template <int OFF> __device__ __forceinline__ s16x4 tr_read(int vb) {
    s16x4 r; asm volatile("ds_read_b64_tr_b16 %0, %1 offset:%2" : "=&v"(r) : "v"(vb), "i"(OFF) : "memory"); return r;
}
template <int D0> __device__ __forceinline__ void pv_one(f32x16& od, int vb, bf16x8 pa0, bf16x8 pa1, bf16x8 pa2, bf16x8 pa3) {
    const s16x4 l0 = tr_read<v_rd_off(D0, 0, 0)>(vb), h0 = tr_read<v_rd_off(D0, 0, 1)>(vb), l1 = tr_read<v_rd_off(D0, 1, 0)>(vb), h1 = tr_read<v_rd_off(D0, 1, 1)>(vb);
    const s16x4 l2 = tr_read<v_rd_off(D0, 2, 0)>(vb), h2 = tr_read<v_rd_off(D0, 2, 1)>(vb), l3 = tr_read<v_rd_off(D0, 3, 0)>(vb), h3 = tr_read<v_rd_off(D0, 3, 1)>(vb);
    asm volatile("s_waitcnt lgkmcnt(0)" ::: "memory"); SBAR();
#define PK(L, H) (bf16x8){L[0], L[1], L[2], L[3], H[0], H[1], H[2], H[3]}
    od = __builtin_amdgcn_mfma_f32_32x32x16_bf16(pa0, PK(l0, h0), od, 0, 0, 0);
    od = __builtin_amdgcn_mfma_f32_32x32x16_bf16(pa1, PK(l1, h1), od, 0, 0, 0);
    od = __builtin_amdgcn_mfma_f32_32x32x16_bf16(pa2, PK(l2, h2), od, 0, 0, 0);
    od = __builtin_amdgcn_mfma_f32_32x32x16_bf16(pa3, PK(l3, h3), od, 0, 0, 0);
#undef PK
}
__device__ __forceinline__ void pv_d0(f32x16* o, int vb, bf16x8 pa0, bf16x8 pa1, bf16x8 pa2, bf16x8 pa3) {
    pv_one<0>(o[0], vb, pa0, pa1, pa2, pa3); pv_one<1>(o[1], vb, pa0, pa1, pa2, pa3); pv_one<2>(o[2], vb, pa0, pa1, pa2, pa3); pv_one<3>(o[3], vb, pa0, pa1, pa2, pa3);
}
__device__ __forceinline__ void attn_unit(const bf16_t* __restrict__ Qn, const bf16_t* __restrict__ Qr, const bf16_t* __restrict__ Kh, const bf16_t* __restrict__ Rh,
                                          bf16_t* __restrict__ Ob, int seq, char* lds) {
    const int tid = otid(), wid = tid >> 6, lane = tid & 63, r32 = lane & 31, hi = lane >> 5;
    char* V_lds = lds + OFF_V; char* K_lds = lds + OFF_K; char* R_lds = lds + OFF_R;
    float* ws = (float*)(lds + OFF_WS) + wid * 64; float* li_l = ws; float* al_l = ws + 32;
    float m_reg = -1e30f, l_reg = 0; f32x16 o[4] = {}; bf16x8 qr[8];
    char* Qrl = lds + OFF_QR + (wid * QBLK + r32) * 128;
    {
        const bf16_t* Qw = Qn + (size_t)(wid * QBLK + r32) * 1536 + hi * 8;
#pragma unroll
        for (int d0 = 0; d0 < 8; ++d0) qr[d0] = *reinterpret_cast<const bf16x8*>(Qw + d0 * 16);
        const bf16_t* Qw2 = Qr + (size_t)(wid * QBLK + r32) * 1536 + hi * 8;
#pragma unroll
        for (int d0 = 0; d0 < 4; ++d0) { const bf16x8 t = *reinterpret_cast<const bf16x8*>(Qw2 + d0 * 16); *reinterpret_cast<bf16x8*>(Qrl + (((d0 * 16 + hi * 8) * 2) ^ ((r32 & 7) << 4))) = t; }
    }
    const int sr = tid >> 4, sc = (tid & 15) * 8, vst0 = v_st(sr, sc), vst1 = v_st(32 + sr, sc);
    const int rr_ = tid >> 3, rc = (tid & 7) * 8;
    const int vb0 = (int)(uintptr_t)V_lds + v_rd_base(lane);
    struct { bf16x8 vs0, vs1, ks0, ks1, rs; } sr_[SDEPTH];
#define SLOAD(i, k0) do { sr_[i].vs0 = *(const bf16x8*)(&Kh[(size_t)((k0) + sr) * 2048 + 128 + sc]); sr_[i].vs1 = *(const bf16x8*)(&Kh[(size_t)((k0) + 32 + sr) * 2048 + 128 + sc]); \
    sr_[i].ks0 = *(const bf16x8*)(&Kh[(size_t)((k0) + sr) * 2048 + sc]); sr_[i].ks1 = *(const bf16x8*)(&Kh[(size_t)((k0) + 32 + sr) * 2048 + sc]); \
    sr_[i].rs = *(const bf16x8*)(&Rh[(size_t)((k0) + rr_) * 64 + rc]); } while (0)
#define SWRITE(b, i) do { *(bf16x8*)(V_lds + (b) * SHM_V + vst0) = sr_[i].vs0;          \
    *(bf16x8*)(V_lds + (b) * SHM_V + vst1) = sr_[i].vs1; const int kc = sc * 2;               \
    *(bf16x8*)(K_lds + (b) * SHM_K + KSWZ(sr, kc)) = sr_[i].ks0;                       \
    *(bf16x8*)(K_lds + (b) * SHM_K + KSWZ(32 + sr, kc)) = sr_[i].ks1;                  \
    *(bf16x8*)(R_lds + (b) * SHM_R + RSWZ(rr_, rc * 2)) = sr_[i].rs; } while (0)
#define SWAIT() do { if constexpr (SDEPTH == 2) asm volatile("s_waitcnt vmcnt(5)" ::: "memory"); else asm volatile("s_waitcnt vmcnt(0)" ::: "memory"); } while (0)
#define RESC(a) do { if (__any((a) < 1.f)) { if (hi == 0) al_l[r32] = (a); asm volatile("s_waitcnt lgkmcnt(0)" ::: "memory"); \
    _Pragma("unroll") for (int d = 0; d < 4; ++d) _Pragma("unroll") for (int r = 0; r < 16; ++r) o[d][r] *= al_l[crow(r, hi)]; } } while (0)
    f32x16 pA0, pA1, pB0, pB1; float mnA, mnB, alA, alB; bf16x8 pa0, pa1, pa2, pa3; const int NT = seq / KVBLK;
    constexpr int SE = 0, SO = SDEPTH - 1;
    SLOAD(SE, 0); asm volatile("s_waitcnt vmcnt(0)" ::: "memory"); SWRITE(0, SE); __syncthreads();
    qkt(pA0, pA1, K_lds, R_lds, qr, Qrl, r32, hi); partialSM(pA0, pA1, m_reg, mnA, alA);
    SLOAD(SO, KVBLK); if constexpr (SDEPTH == 2) { if (2 < NT) SLOAD(SE, 2 * KVBLK); }
    SWAIT(); SWRITE(1, SO); __syncthreads();
    for (int j = 1; j + 1 < NT; j += 2) {
        SBAR(); qkt(pB0, pB1, K_lds + SHM_K, R_lds + SHM_R, qr, Qrl, r32, hi);
        finishSM(pA0, pA1, alA, l_reg, pa0, pa1, pa2, pa3); SBAR();
        SLOAD(SO, (j + SDEPTH) * KVBLK); SBAR();
        pv_d0(o, vb0, pa0, pa1, pa2, pa3); partialSM(pB0, pB1, m_reg, mnB, alB);
        __syncthreads(); SWAIT(); SWRITE(0, SE);
        RESC(alB); __syncthreads();
        SBAR(); qkt(pA0, pA1, K_lds, R_lds, qr, Qrl, r32, hi);
        finishSM(pB0, pB1, alB, l_reg, pa0, pa1, pa2, pa3); SBAR();
        if (SDEPTH == 1 || j + 3 < NT) SLOAD(SE, (j + 1 + SDEPTH) * KVBLK); SBAR();
        pv_d0(o, vb0 + (int)SHM_V, pa0, pa1, pa2, pa3); partialSM(pA0, pA1, m_reg, mnA, alA);
        __syncthreads(); SWAIT(); SWRITE(1, SO);
        RESC(alA); __syncthreads();
    }
    SBAR(); qkt(pB0, pB1, K_lds + SHM_K, R_lds + SHM_R, qr, Qrl, r32, hi);
    finishSM(pA0, pA1, alA, l_reg, pa0, pa1, pa2, pa3); SBAR();
    pv_d0(o, vb0, pa0, pa1, pa2, pa3); partialSM(pB0, pB1, m_reg, mnB, alB);
    __syncthreads(); RESC(alB);
    finishSM(pB0, pB1, alB, l_reg, pa0, pa1, pa2, pa3); SBAR();
    pv_d0(o, vb0 + (int)SHM_V, pa0, pa1, pa2, pa3);
    if (hi == 0) li_l[r32] = l_reg; asm volatile("s_waitcnt lgkmcnt(0)" ::: "memory");
    float rli[16];
#pragma unroll
    for (int r = 0; r < 16; ++r) rli[r] = __builtin_amdgcn_rcpf(li_l[crow(r, hi)]);
    bf16_t* Ow = Ob + (size_t)(wid * QBLK) * 2048;
#pragma unroll
    for (int r = 0; r < 16; ++r) { const int orow = crow(r, hi);
#pragma unroll
        for (int d0 = 0; d0 < 4; ++d0) Ow[(size_t)orow * 2048 + d0 * 32 + r32] = (bf16_t)(cvt_pk_bf16(o[d0][r] * rli[r], 0.f) & 0xffffu); }
#undef SLOAD
#undef SWRITE
#undef SWAIT
#undef RESC
}
}

__device__ __forceinline__ void x_pass(const float* src, bf16_t* dstb, fix_t* st) {
    const int tid_ = otid(), lane = tid_ & 63, wave = tid_ >> 6;
    for (int row = blockIdx.x * 8 + wave; row < M_; row += gridDim.x * 8) {
        const float* s = src + (size_t)row * 2048; f32x4 v[8]; float s1 = 0.f, s2 = 0.f;
#pragma unroll
        for (int i = 0; i < 8; ++i) { v[i] = *(const f32x4*)(s + i * 256 + lane * 4); s1 += (v[i][0] + v[i][1]) + (v[i][2] + v[i][3]); s2 += (v[i][0] * v[i][0] + v[i][1] * v[i][1]) + (v[i][2] * v[i][2] + v[i][3] * v[i][3]); }
        s1 = wave_sum(s1, lane); s2 = wave_sum(s2, lane);
        if (lane == 0) { st[row] = to_fix(s1); st[M_ + row] = to_fix(s2); }
#pragma unroll
        for (int i = 0; i < 8; ++i) { u32x2 w; w.x = cvt_pk_bf16(v[i][0], v[i][1]); w.y = cvt_pk_bf16(v[i][2], v[i][3]); *(u32x2*)(dstb + (size_t)row * 2048 + i * 256 + lane * 4) = w; }
    }
}
__device__ __forceinline__ void ln_final(float* out, const fix_t* st, const float* g, const float* b) {
    const int tid = otid();
    for (size_t i = (size_t)blockIdx.x * 512 + tid; i < (size_t)M_ * 512; i += (size_t)gridDim.x * 512) {
        const int row = (int)(i >> 9), c = (int)(i & 511) * 4; float mu, rs; row_ln(st, row, mu, rs);
        const f32x4 P = *(const f32x4*)(out + i * 4), g4 = *(const f32x4*)(g + c), b4 = *(const f32x4*)(b + c);
        *(f32x4*)(out + i * 4) = (P - mu) * rs * g4 + b4;
    }
}
__device__ __forceinline__ int colmap(int mode, int n) {
    if (mode == 0) { if (n < 1024) return n; if (n < 2048) return 1088 + (n - 1024); if (n < 3072) return 2112 + (n - 2048);
        const int t = n - 3072, bj = t >> 7, r = t & 127; return r < 32 ? 1024 + bj * 32 + r : -1; }
    if (mode == 1) { if (n < 1024) return (n >> 7) * 192 + (n & 127);
        const int t = n - 1024, tile = t >> 8, bj = (t >> 7) & 1, wc = (t >> 5) & 3, i = t & 31; return (4 * tile + wc) * 192 + 128 + bj * 32 + i; }
    return n;
}
__device__ __forceinline__ void cvt_tile(const float* W, int ldw, bf16_t* Bt, int ldb, int n0, int k0, int mode, const float* kscale, float* T) {
    const int tid = otid(), n4 = (tid & 31) * 4, kq = tid >> 5, src = colmap(mode, n0 + n4);
    f32x4 v[8];
#pragma unroll
    for (int i = 0; i < 8; ++i) { const int kk = kq + 16 * i; v[i] = src >= 0 ? *(const f32x4*)(W + (size_t)(k0 + kk) * ldw + src) : (f32x4){0.f, 0.f, 0.f, 0.f}; }
    if (kscale) {
#pragma unroll
        for (int i = 0; i < 8; ++i) v[i] = v[i] * kscale[k0 + kq + 16 * i]; }
#pragma unroll
    for (int i = 0; i < 8; ++i)
#pragma unroll
        for (int j = 0; j < 4; ++j) T[(n4 + j) * 129 + kq + 16 * i] = v[i][j];
    __syncthreads();
    { const int n2 = tid >> 2, ks = (tid & 3) * 32; const float* t = T + n2 * 129 + ks; bf16_t* dst = Bt + (size_t)(n0 + n2) * ldb + k0 + ks;
#pragma unroll
      for (int i = 0; i < 4; ++i) { u32x4 w; w.x = cvt_pk_bf16(t[i * 8 + 0], t[i * 8 + 1]); w.y = cvt_pk_bf16(t[i * 8 + 2], t[i * 8 + 3]); w.z = cvt_pk_bf16(t[i * 8 + 4], t[i * 8 + 5]); w.w = cvt_pk_bf16(t[i * 8 + 6], t[i * 8 + 7]);
          *(u32x4*)(dst + i * 8) = w; } }
    __syncthreads();
}
constexpr int CT0 = 26 * 16, CT1 = CT0 + 12 * 4, CT2 = CT1 + 16 * 4, CT3 = CT2 + 32, CT4 = CT3 + 16 * 16, CT5 = CT4 + 64 * 16, CT6 = CT5 + 16 * 64;
__device__ __forceinline__ void convert_weights(const Params& p, int l, int t0, int t1, float* T) {
    unsigned char* ws = p.ws;
    const float* ing = l == 0 ? p.in[2] : p.in[21] + (size_t)(l - 1) * 2048;
    for (int t = t0 + blockIdx.x; t < t1; t += gridDim.x) {
        if (t < CT0) { const int nt = t % 26, kt = t / 26; cvt_tile(p.in[4] + (size_t)l * 2048 * NIN, NIN, (bf16_t*)(ws + W_IN), 2048, nt * 128, kt * 128, 0, ing, T); }
        else if (t < CT1) { const int u = t - CT0, nt = u % 12, kt = u / 12; cvt_tile(p.in[7] + (size_t)l * 512 * 1536, 1536, (bf16_t*)(ws + W_UQ), 512, nt * 128, kt * 128, 1, p.in[5] + l * 512, T); }
        else if (t < CT2) { const int u = t - CT1, nt = u % 16, kt = u / 16; cvt_tile(p.in[8] + (size_t)l * 512 * 2048, 2048, (bf16_t*)(ws + W_UKV), 512, nt * 128, kt * 128, 2, p.in[6] + l * 512, T); }
        else if (t < CT3) { const int mat = t - CT2, gate = mat & 1, h = (mat >> 1) & 7, d = mat >> 4;
            cvt_tile((gate ? p.in[13] : p.in[11]) + ((size_t)((l * 2 + d) * 8 + h)) * 128 * 128, 128, (bf16_t*)(ws + W_G) + (size_t)(h * 512 + d * 256 + gate * 128) * 128, 128, 0, 0, 2, nullptr, T); }
        else if (t < CT4) { const int u = t - CT3, nt = u % 16, kt = u / 16; cvt_tile(p.in[16] + (size_t)l * 2048 * 2048, 2048, (bf16_t*)(ws + W_OUT), 2048, nt * 128, kt * 128, 2, nullptr, T); }
        else if (t < CT5) { const int u = t - CT4, nt = u % 64, kt = u / 64; cvt_tile(p.in[19] + (size_t)l * 2048 * 8192, 8192, (bf16_t*)(ws + W_UP), 2048, nt * 128, kt * 128, 2, p.in[17] + (size_t)l * 2048, T); }
        else { const int u = t - CT5, nt = u % 16, kt = u / 16; cvt_tile(p.in[20] + (size_t)l * 8192 * 2048, 2048, (bf16_t*)(ws + W_DN), 8192, nt * 128, kt * 128, 2, nullptr, T); }
    }
}
__device__ __forceinline__ void colsum_pass(const bf16_t* Bt, int N, const float* lg, const float* lb, float* cs, float* bw) {
    const int tid = otid(), lane = tid & 63, wave = tid >> 6;
    float ratio[32];
#pragma unroll
    for (int i = 0; i < 4; ++i)
#pragma unroll
        for (int j = 0; j < 8; ++j) { const int k = i * 512 + lane * 8 + j; ratio[i * 8 + j] = lb[k] * __builtin_amdgcn_rcpf(lg[k]); }
    for (int n = blockIdx.x * 8 + wave; n < N; n += gridDim.x * 8) {
        u32x4 w[4];
#pragma unroll
        for (int i = 0; i < 4; ++i) w[i] = *(const u32x4*)(Bt + (size_t)n * 2048 + i * 512 + lane * 8);
        float c = 0.f, bb = 0.f;
#pragma unroll
        for (int i = 0; i < 4; ++i) { const float v[8] = {bf_lo(w[i].x), bf_hi(w[i].x), bf_lo(w[i].y), bf_hi(w[i].y), bf_lo(w[i].z), bf_hi(w[i].z), bf_lo(w[i].w), bf_hi(w[i].w)};
#pragma unroll
            for (int j = 0; j < 8; ++j) { c += v[j]; bb += v[j] * ratio[i * 8 + j]; } }
        c = wave_sum(c, lane); bb = wave_sum(bb, lane);
        if (lane == 0) { cs[n] = c; bw[n] = bb; }
    }
}
__device__ __forceinline__ void colsum_in(const Params& p, int l) { float* csb = (float*)(p.ws + WS_CSB) + (size_t)l * CSB_L;
    colsum_pass((const bf16_t*)(p.ws + W_IN), NINP, l == 0 ? p.in[2] : p.in[21] + (size_t)(l - 1) * 2048, l == 0 ? p.in[3] : p.in[22] + (size_t)(l - 1) * 2048, csb + CSB_IN, csb + CSB_IN + NINP); }
__device__ __forceinline__ void colsum_up(const Params& p, int l) { float* csb = (float*)(p.ws + WS_CSB) + (size_t)l * CSB_L;
    colsum_pass((const bf16_t*)(p.ws + W_UP), DFF, p.in[17] + (size_t)l * 2048, p.in[18] + (size_t)l * 2048, csb + CSB_UP, csb + CSB_UP + DFF); }
__device__ __forceinline__ void make_tables(const Params& p) {
    const int* pos = (const int*)p.in[1]; float* cosT = (float*)(p.ws + WS_COS); float* sinT = (float*)(p.ws + WS_SIN); float* sp = (float*)(p.ws + WS_SP);
    const int tid = otid();
    for (size_t i = (size_t)blockIdx.x * 512 + tid; i < (size_t)M_ * 32; i += (size_t)gridDim.x * 512) {
        const int row = (int)(i >> 5), k = (int)(i & 31); const float inv = powf(10000.0f, -(float)(2 * k) / 64.0f); const float ang = (float)pos[row] * inv;
        cosT[i] = cosf(ang); sinT[i] = sinf(ang); }
    for (int i = blockIdx.x * 512 + tid; i < DEPTH * 2 * 1024; i += gridDim.x * 512) { const float x = -p.in[15][i];
        sp[i] = fmaxf(x, 0.f) + log1pf(expf(-fabsf(x))); }
}
__device__ __forceinline__ void conv_phase(const Params& p, int l) {
    const bf16_t* xl = (const bf16_t*)(p.ws + WS_XL); bf16_t* xc = (bf16_t*)(p.ws + WS_XC);
    const float* cw = p.in[9] + (size_t)l * 4 * 1024; const float* cb = p.in[10] + (size_t)l * 1024;
    const int tid = otid();
    for (size_t i = (size_t)blockIdx.x * 512 + tid; i < (size_t)M_ * 128; i += (size_t)gridDim.x * 512) {
        const int row = (int)(i >> 7), c0 = (int)(i & 127) * 8, t = row & (SEQ - 1);
        float acc[8];
        { const f32x4 b0 = *(const f32x4*)(cb + c0), b1 = *(const f32x4*)(cb + c0 + 4); acc[0] = b0[0]; acc[1] = b0[1]; acc[2] = b0[2]; acc[3] = b0[3]; acc[4] = b1[0]; acc[5] = b1[1]; acc[6] = b1[2]; acc[7] = b1[3]; }
#pragma unroll
        for (int k = 0; k < 4; ++k) { const int tt = t - 2 + k; if (tt < 0 || tt >= SEQ) continue;
            const u32x4 xw = *(const u32x4*)(xl + (size_t)(row - 2 + k) * 1024 + c0);
            const f32x4 w0 = *(const f32x4*)(cw + k * 1024 + c0), w1 = *(const f32x4*)(cw + k * 1024 + c0 + 4);
            acc[0] += w0[0] * bf_lo(xw.x); acc[1] += w0[1] * bf_hi(xw.x); acc[2] += w0[2] * bf_lo(xw.y); acc[3] += w0[3] * bf_hi(xw.y);
            acc[4] += w1[0] * bf_lo(xw.z); acc[5] += w1[1] * bf_hi(xw.z); acc[6] += w1[2] * bf_lo(xw.w); acc[7] += w1[3] * bf_hi(xw.w); }
        u32x4 o; o.x = cvt_pk_bf16(acc[0], acc[1]); o.y = cvt_pk_bf16(acc[2], acc[3]); o.z = cvt_pk_bf16(acc[4], acc[5]); o.w = cvt_pk_bf16(acc[6], acc[7]);
        *(u32x4*)(xc + (size_t)row * 1024 + c0) = o;
    }
}
__device__ __forceinline__ void scan_local(const Params& p) {
    const unsigned* au = (const unsigned*)(p.ws + WS_AU); f32x4* ph = (f32x4*)(p.ws + WS_PH); const int tid = otid();
    for (int it = blockIdx.x; it < 2 * 8 * 64; it += gridDim.x) {
        const int c = it & 63, b = (it >> 6) & 7, d = it >> 9;
        const u32x2* src = (const u32x2*)(au + (size_t)d * M_ * 1024 + (size_t)(b * SEQ + c * 64) * 1024) + tid;
        float h0 = 0.f, h1 = 0.f, P0 = 1.f, P1 = 1.f;
#pragma unroll 16
        for (int s = 0; s < 64; ++s) { const int t = d ? 63 - s : s; const u32x2 w = src[(size_t)t * 512];
            const float a0 = 1.0f - bf_lo(w.x), a1 = 1.0f - bf_lo(w.y); h0 = a0 * h0 + bf_hi(w.x); h1 = a1 * h1 + bf_hi(w.y); P0 *= a0; P1 *= a1; }
        ph[(size_t)((d * 8 + b) * 64 + c) * 512 + tid] = (f32x4){P0, h0, P1, h1};
    }
}
__device__ __forceinline__ void scan_apply(const Params& p) {
    const unsigned* au = (const unsigned*)(p.ws + WS_AU); const f32x4* ph = (const f32x4*)(p.ws + WS_PH);
    const bf16_t* gg = (const bf16_t*)(p.ws + WS_GG); bf16_t* ycat = (bf16_t*)(p.ws + WS_YCAT); const int tid = otid();
    for (int it = blockIdx.x; it < 8 * 64; it += gridDim.x) {
        const int c = it & 63, b = it >> 6;
        float Hf0 = 0.f, Hf1 = 0.f, Hb0 = 0.f, Hb1 = 0.f;
        { const f32x4* pf = ph + (size_t)((0 * 8 + b) * 64) * 512 + tid;
          for (int c0 = 0; c0 < c; c0 += 8) { f32x4 e[8];
#pragma unroll
              for (int j = 0; j < 8; ++j) e[j] = (c0 + j < c) ? pf[(size_t)(c0 + j) * 512] : (f32x4){1.f, 0.f, 1.f, 0.f};
#pragma unroll
              for (int j = 0; j < 8; ++j) { Hf0 = e[j][0] * Hf0 + e[j][1]; Hf1 = e[j][2] * Hf1 + e[j][3]; } }
          const f32x4* pb = ph + (size_t)((1 * 8 + b) * 64) * 512 + tid;
          for (int c0 = 63; c0 > c; c0 -= 8) { f32x4 e[8];
#pragma unroll
              for (int j = 0; j < 8; ++j) e[j] = (c0 - j > c) ? pb[(size_t)(c0 - j) * 512] : (f32x4){1.f, 0.f, 1.f, 0.f};
#pragma unroll
              for (int j = 0; j < 8; ++j) { Hb0 = e[j][0] * Hb0 + e[j][1]; Hb1 = e[j][2] * Hb1 + e[j][3]; } } }
        const size_t r0 = (size_t)(b * SEQ + c * 64);
        const u32x2* s0 = (const u32x2*)(au + r0 * 1024) + tid; const u32x2* s1 = (const u32x2*)(au + (size_t)M_ * 1024 + r0 * 1024) + tid;
        const unsigned* gp = (const unsigned*)(gg + r0 * 1024) + tid; unsigned* yp = (unsigned*)(ycat + r0 * 2048 + 1024) + tid;
        float hf0[64], hf1[64];
#pragma unroll
        for (int t = 0; t < 64; ++t) { const u32x2 w = s0[(size_t)t * 512]; Hf0 = (1.0f - bf_lo(w.x)) * Hf0 + bf_hi(w.x); Hf1 = (1.0f - bf_lo(w.y)) * Hf1 + bf_hi(w.y); hf0[t] = Hf0; hf1[t] = Hf1; }
#pragma unroll
        for (int s = 0; s < 64; ++s) { const int t = 63 - s; const u32x2 w = s1[(size_t)t * 512]; Hb0 = (1.0f - bf_lo(w.x)) * Hb0 + bf_hi(w.x); Hb1 = (1.0f - bf_lo(w.y)) * Hb1 + bf_hi(w.y);
            const unsigned g = gp[(size_t)t * 512];
            yp[(size_t)t * 1024] = cvt_pk_bf16(bf_lo(g) * (hf0[t] + Hb0), bf_hi(g) * (hf1[t] + Hb1)); }
    }
}

__global__ void __launch_bounds__(512, 2) mega_fwd(Params p) {
    extern __shared__ __attribute__((aligned(16))) unsigned char lds[];
    cg::grid_group grid = cg::this_grid();
    unsigned char* ws = p.ws;
    LAS unsigned char* ldsl = (LAS unsigned char*)lds;
    bf16_t* hb = (bf16_t*)(ws + WS_HB);
    const float* cosT = (const float*)(ws + WS_COS); const float* sinT = (const float*)(ws + WS_SIN);

    fix_t* stats0 = (fix_t*)(ws + WS_ST);
#define stats stats0
    { const int tid = otid();
      for (size_t i = (size_t)blockIdx.x * 512 + tid; i < (size_t)8 * 2 * M_; i += (size_t)gridDim.x * 512) stats[(size_t)2 * M_ + i] = 0ull;
    }
    make_tables(p);
    x_pass(p.in[0], hb, stats);
    grid.sync();
    convert_weights(p, 0, 0, CT6, (float*)lds);
    grid.sync();
    colsum_in(p, 0); colsum_up(p, 0);
    grid.sync();

#pragma unroll 1
    for (int l = 0; l < DEPTH; ++l) {
        const float* csb = (const float*)(ws + WS_CSB) + (size_t)l * CSB_L;
        fix_t* st0 = (fix_t*)(ws + WS_ST) + (size_t)(2 * l) * 2 * M_; fix_t* st1 = st0 + 2 * M_; fix_t* st2 = st1 + 2 * M_;
        if (l > 0) { colsum_up(p, l); convert_weights(p, l, CT5, CT6, (float*)lds); }
        { pg8::Order S = pg8::make_order(hb, 2048, ws + W_IN, 2048, M_, NINP, 2048);
          EpiIn E{(bf16_t*)(ws + WS_CQ), (bf16_t*)(ws + WS_CKV), (bf16_t*)(ws + WS_XL), (bf16_t*)(ws + WS_GG), (bf16_t*)(ws + WS_KPE), (float*)(ws + WS_SSQ), cosT, sinT, st0, csb + CSB_IN, csb + CSB_IN + NINP};
          pg8::gemm_phase(ldsl, S, E); }
        grid.sync();
        conv_phase(p, l);
        { pg8::Order S = pg8::make_order(ws + WS_CQ, 512, ws + W_UQ, 512, M_, 1536, 512);
          EpiQ E{(bf16_t*)(ws + WS_Q), (const float*)(ws + WS_SSQ), cosT, sinT};
          pg8::gemm_phase(ldsl, S, E); }
        { pg8::Order S = pg8::make_order(ws + WS_CKV, 512, ws + W_UKV, 512, M_, 2048, 512);
          EpiKV E{(bf16_t*)(ws + WS_KV), (const float*)(ws + WS_SSQ)};
          pg8::gemm_phase(ldsl, S, E); }
        grid.sync();
        {
            const bf16_t* Q = (const bf16_t*)(ws + WS_Q); const bf16_t* KV = (const bf16_t*)(ws + WS_KV); const bf16_t* KPE = (const bf16_t*)(ws + WS_KPE); bf16_t* ycat = (bf16_t*)(ws + WS_YCAT);
            const int G = gridDim.x, bx = blockIdx.x;
            for (int L = bx; L < 1024; L += G) {
                int pair, qb;
                if (G == 256) { const int i = L >> 8, c = L & 255, xcd = c & 7, j = c >> 3; pair = i * 16 + xcd * 2 + (j >> 4); qb = j & 15; } else { pair = L >> 4; qb = L & 15; }
                const int b = pair >> 3, h = pair & 7; const size_t row0 = (size_t)b * SEQ + (size_t)qb * 256;
                __syncthreads();
                att::attn_unit(Q + row0 * 1536 + h * 128, Q + row0 * 1536 + 1024 + h * 64, KV + (size_t)b * SEQ * 2048 + h * 256, KPE + (size_t)b * SEQ * 64, ycat + row0 * 2048 + h * 128, SEQ, (char*)lds);
            }
            __syncthreads();
        }
        { pg8::Order S = pg8::make_order(ws + WS_XC, 1024, ws + W_G, 128, M_, 512, 128);
          S.nZ = 8; S.a_z = 128 * 2; S.b_z = (size_t)512 * 128 * 2;
          EpiGate E{(unsigned*)(ws + WS_AU), (const bf16_t*)(ws + WS_XC), p.in[12] + (size_t)l * 2048, p.in[14] + (size_t)l * 2048, (const float*)(ws + WS_SP) + (size_t)l * 2048};
          pg8::gemm_phase(ldsl, S, E); }
        grid.sync();
        scan_local(p);
        if (l + 1 < DEPTH) { __syncthreads(); convert_weights(p, l + 1, 0, CT3, (float*)lds); }
        grid.sync();
        if (l + 1 < DEPTH) colsum_in(p, l + 1);
        scan_apply(p);
        grid.sync();
        { pg8::Order S = pg8::make_order(ws + WS_YCAT, 2048, ws + W_OUT, 2048, M_, 2048, 2048);
          EpiRes E{l == 0 ? p.in[0] : p.out, p.out, hb, st0, l == 0 ? p.in[2] : p.in[21] + (size_t)(l - 1) * 2048, l == 0 ? p.in[3] : p.in[22] + (size_t)(l - 1) * 2048, st1};
          pg8::gemm_phase(ldsl, S, E); }
        grid.sync();
        if (l + 1 < DEPTH) { convert_weights(p, l + 1, CT3, CT4, (float*)lds); }
        { pg8::Order S = pg8::make_order(hb, 2048, ws + W_UP, 2048, M_, DFF, 2048);
          EpiUp E{(bf16_t*)(ws + WS_F), st1, csb + CSB_UP, csb + CSB_UP + DFF}; pg8::gemm_phase(ldsl, S, E); }
        grid.sync();
        if (l + 1 < DEPTH) { convert_weights(p, l + 1, CT4, CT5, (float*)lds); }
        { pg8::Order S = pg8::make_order(ws + WS_F, 8192, ws + W_DN, 8192, M_, 2048, 8192);
          EpiRes E{p.out, p.out, hb, st1, p.in[17] + (size_t)l * 2048, p.in[18] + (size_t)l * 2048, st2};
          pg8::gemm_phase(ldsl, S, E); }
        grid.sync();
    }
    ln_final(p.out, (const fix_t*)(p.ws + WS_ST) + (size_t)(2 * DEPTH) * 2 * M_, p.in[21] + (size_t)(DEPTH - 1) * 2048, p.in[22] + (size_t)(DEPTH - 1) * 2048);
}

extern "C" void kernel_launch(void* const* d_in, const int* in_sizes, int n_in, void* d_out, int out_size, void* d_ws, size_t ws_size, hipStream_t stream) {
    constexpr int LDS_BYTES = pg8::STAGE_BYTES;
    static int grid_blocks = 0;
    if (grid_blocks == 0) {
        if (n_in != 23 || in_sizes[0] != M_ * DM || out_size != M_ * DM || ws_size < WS_END) {
            fprintf(stderr, "kernel_launch: shape mismatch (n_in %d, in0 %d, out %d, ws %zu, need %zu)\n", n_in, n_in > 0 ? in_sizes[0] : -1, out_size, ws_size, (size_t)WS_END); grid_blocks = -1; return; }
        int dev = 0, cus = 0, per_cu = 0;
        hipGetDevice(&dev); hipDeviceGetAttribute(&cus, hipDeviceAttributeMultiprocessorCount, dev);
        if (hipFuncSetAttribute((const void*)mega_fwd, hipFuncAttributeMaxDynamicSharedMemorySize, LDS_BYTES) != hipSuccess) { fprintf(stderr, "kernel_launch: hipFuncSetAttribute failed\n"); grid_blocks = -1; return; }
        if (hipOccupancyMaxActiveBlocksPerMultiprocessor(&per_cu, (const void*)mega_fwd, 512, LDS_BYTES) != hipSuccess || per_cu < 1) { fprintf(stderr, "kernel_launch: occupancy query says %d\n", per_cu); per_cu = 1; }
        (void)hipGetLastError();
        grid_blocks = cus * 1;
    }
    if (grid_blocks < 0) return;
    Params p{};
    for (int i = 0; i < 23; ++i) p.in[i] = (const float*)d_in[i];
    p.out = (float*)d_out; p.ws = (unsigned char*)d_ws;
    void* args[] = {&p};
    hipError_t e = hipLaunchCooperativeKernel((const void*)mega_fwd, dim3(grid_blocks), dim3(512), args, LDS_BYTES, stream);
    if (e != hipSuccess) fprintf(stderr, "kernel_launch: cooperative launch failed: %s (grid %d)\n", hipGetErrorString(e), grid_blocks);
}
```

```cpp
#include <hip/hip_runtime.h>
#include <hip/hip_cooperative_groups.h>
#include <cstdio>
#include <cstdint>
namespace cg = cooperative_groups;

#define LAS __attribute__((address_space(3)))
typedef unsigned short bf16_t;
typedef short bf16x8 __attribute__((ext_vector_type(8)));
typedef short s16x4 __attribute__((ext_vector_type(4)));
typedef float f32x4 __attribute__((ext_vector_type(4)));
typedef float f32x2 __attribute__((ext_vector_type(2)));
typedef float f32x16 __attribute__((ext_vector_type(16)));
typedef unsigned u32x4 __attribute__((ext_vector_type(4)));
typedef unsigned u32x2 __attribute__((ext_vector_type(2)));

constexpr int M_ = 32768, DM = 2048, SEQ = 4096, NBATCH = 8, DEPTH = 4;
constexpr int NIN = 3136, NINP = 3328, DFF = 8192;
constexpr float ALPHA = 1.6817928305074290f;
constexpr float LN_EPS = 1e-5f, RMS_EPS = 1e-6f;
constexpr size_t MiB = 1ull << 20;
constexpr size_t WS_HB = 0;
constexpr size_t WS_W = 128 * MiB;
constexpr size_t W_IN = WS_W, W_UQ = W_IN + (size_t)NINP * 2048 * 2, W_UKV = W_UQ + 1536ull * 512 * 2, W_G = W_UKV + 2048ull * 512 * 2,
                 W_OUT = W_G + 8ull * 512 * 128 * 2, W_UP = W_OUT + 2048ull * 2048 * 2, W_DN = W_UP + 8192ull * 2048 * 2, W_END = W_DN + 8192ull * 2048 * 2;
static_assert(W_END <= 218 * MiB, "weights region");
constexpr size_t WS_COS = 218 * MiB, WS_SIN = 222 * MiB, WS_SP = 226 * MiB;
constexpr size_t WS_CSB = 226 * MiB + 65536;
constexpr int CSB_L = 2 * 3328 + 2 * 8192, CSB_IN = 0, CSB_UP = 2 * 3328;
constexpr size_t WS_BAR = 226 * MiB + 49152;
constexpr size_t WS_ST = 227 * MiB;
constexpr size_t WS_BIG = 232 * MiB;
constexpr size_t WS_F = WS_BIG;
constexpr size_t WS_GG = WS_BIG, WS_XC = WS_BIG + 64 * MiB, WS_YCAT = WS_BIG + 128 * MiB, WS_SSQ = WS_BIG + 256 * MiB, WS_KPE = WS_BIG + 258 * MiB,
                 WS_CQ = WS_BIG + 262 * MiB, WS_CKV = WS_BIG + 294 * MiB, WS_XL = WS_BIG + 326 * MiB, WS_AU = WS_BIG + 262 * MiB  ,
                 WS_Q = WS_BIG + 518 * MiB, WS_KV = WS_BIG + 614 * MiB, WS_PH = WS_BIG + 742 * MiB, WS_END = WS_BIG + 750 * MiB;
static_assert(WS_END <= 1024 * MiB, "workspace");

struct Params { const float* in[23]; float* out; unsigned char* ws; };

__device__ __forceinline__ int otid() { int t = threadIdx.x; asm volatile("" : "+v"(t)); return t; }
__device__ __forceinline__ unsigned cvt_pk_bf16(float lo, float hi) { unsigned r; asm volatile("v_cvt_pk_bf16_f32 %0, %1, %2" : "=v"(r) : "v"(lo), "v"(hi)); return r; }
__device__ __forceinline__ float sum_fq(float x) {
    auto a = __builtin_amdgcn_permlane16_swap(__float_as_uint(x), __float_as_uint(x), false, false); x = __uint_as_float(a[0]) + __uint_as_float(a[1]);
    auto b = __builtin_amdgcn_permlane32_swap(__float_as_uint(x), __float_as_uint(x), false, false); return __uint_as_float(b[0]) + __uint_as_float(b[1]); }
__device__ __forceinline__ float wave_sum(float x, int lane) {
#pragma unroll
    for (int o = 32; o >= 1; o >>= 1) x += __int_as_float(__builtin_amdgcn_ds_bpermute((lane ^ o) << 2, __float_as_int(x)));
    return x; }
__device__ __forceinline__ float bf_lo(unsigned w) { return __uint_as_float(w << 16); }
__device__ __forceinline__ float bf_hi(unsigned w) { return __uint_as_float(w & 0xffff0000u); }
__device__ __forceinline__ float sigmoidf_(float x) { return __builtin_amdgcn_rcpf(1.0f + __builtin_amdgcn_exp2f(-1.4426950408889634f * x)); }
__device__ __forceinline__ float gelu_tanh(float x) { const float z = 0.7978845608028654f * (x + 0.044715f * x * x * x); return x * sigmoidf_(2.0f * z); }
__device__ __forceinline__ u32x4 pack8(const f32x4 a, const f32x4 b) { u32x4 w; w.x = cvt_pk_bf16(a[0], a[1]); w.y = cvt_pk_bf16(a[2], a[3]); w.z = cvt_pk_bf16(b[0], b[1]); w.w = cvt_pk_bf16(b[2], b[3]); return w; }

namespace pg8 {
constexpr int BM = 256, BK = 64, HALF = 128, HTB = HALF * BK * 2, STAGE_BYTES = 8 * HTB, NXCD = 8, WGM = 8;
__host__ __device__ __forceinline__ int lds_byte(int r, int c) { const int st = (r >> 4) * 2 + (c >> 5), rr = r & 15, cc = c & 31, ob = rr * 64 + cc * 2; return st * 1024 + (ob ^ (((ob >> 9) & 1) << 5)); }
__host__ __device__ __forceinline__ void stage_rc(int b, int& R, int& C) { const int st = b / 1024, sb = b % 1024, swz = sb ^ (((sb >> 9) & 1) << 5); R = (st >> 1) * 16 + swz / 64; C = (st & 1) * 32 + (swz % 64) / 2; }
__host__ __device__ __forceinline__ int perm32(int rho) { const int n = rho >> 4, i = rho & 15; return 8 * (i >> 2) + 4 * n + (i & 3); }

struct Unit { int pm, pn, z; };
struct Order {
    int nM, nN, nZ, per, G, c;
    const char* A; const char* B; size_t a_pm, a_z, b_pn, b_z; int lda, ldb, K;
    __device__ __forceinline__ bool next(int i, Unit& u) const {
        const long L = (long)i * G + c; if (L >= (long)per * nZ) return false;
        u.z = (int)(L / per); int wgid = (int)(L % per);
        { const int q = per / NXCD, r = per % NXCD, xcd = wgid % NXCD, off = wgid / NXCD; wgid = (xcd < r ? xcd * (q + 1) : r * (q + 1) + (xcd - r) * q) + off; }
        const int nig = WGM * nN, gid = wgid / nig, fm = gid * WGM, gsz = (nM - fm) < WGM ? (nM - fm) : WGM;
        u.pm = fm + ((wgid % nig) % gsz); u.pn = (wgid % nig) / gsz; return true;
    }
    __device__ __forceinline__ const char* aptr(const Unit& u) const { return A + (size_t)u.pm * a_pm + (size_t)u.z * a_z; }
    __device__ __forceinline__ const char* bptr(const Unit& u) const { return B + (size_t)u.pn * b_pn + (size_t)u.z * b_z; }
};
__device__ __forceinline__ Order make_order(const void* A, int lda, const void* Bt, int ldb, int Mrows, int N, int K) {
    Order o; o.nM = Mrows / BM; o.nN = N / BM; o.nZ = 1; o.per = o.nM * o.nN; o.G = gridDim.x; o.c = blockIdx.x;
    o.A = (const char*)A; o.B = (const char*)Bt; o.a_pm = (size_t)BM * lda * 2; o.a_z = 0; o.b_pn = (size_t)BM * ldb * 2; o.b_z = 0; o.lda = lda; o.ldb = ldb; o.K = K; return o;
}

template <class Epi>
__device__ __forceinline__ void gemm_phase(LAS unsigned char* lds, const Order& S, const Epi& E) {
    const int tid = otid(), wid = __builtin_amdgcn_readfirstlane(tid >> 6), lane = tid & 63, wr = wid >> 2, wc = wid & 3, fr = lane & 15, fq = lane >> 4;
    const int nt = S.K / BK;
    unsigned voffA[2], voffB[2];
#pragma unroll
    for (int i = 0; i < 2; ++i) { int R, C; stage_rc(tid * 16 + i * 8192, R, C); const int Rb = Epi::PERM ? ((R & ~31) + perm32(R & 31)) : R;
        voffA[i] = (unsigned)(R * S.lda + C) * 2u; voffB[i] = (unsigned)(Rb * S.ldb + C) * 2u; }
    const size_t kstep = (size_t)(BK * 2);
    const size_t hstepA = (size_t)HALF * S.lda * 2, hstepB = (size_t)HALF * S.ldb * 2;
    const unsigned ldsw = (unsigned)wid * 1024u;
    const int aoff = lds_byte(wr * 64 + fr, fq * 8), boff = lds_byte(wc * 32 + fr, fq * 8);
#define PG8_SA(b, h) (((b) * 2 + (h)) * HTB)
#define PG8_SB(b, h) ((4 + (b) * 2 + (h)) * HTB)
#define PG8_STAGE(bufoff, gbase, voff) do { _Pragma("unroll") for (int _i = 0; _i < 2; ++_i) \
        __builtin_amdgcn_global_load_lds((const unsigned*)((const char*)(gbase) + (voff)[_i]), (LAS unsigned*)(lds + (bufoff) + ldsw + _i * 8192), 16, 0, 0); } while (0)
#define PG8_LDA(dst, b, h) do { _Pragma("unroll") for (int m = 0; m < 4; ++m) _Pragma("unroll") for (int k = 0; k < 2; ++k) dst[m][k] = *(const LAS bf16x8*)(lds + PG8_SA(b, h) + aoff + m * 2048 + k * 1024); } while (0)
#define PG8_LDB(dst, b, h) do { _Pragma("unroll") for (int n = 0; n < 2; ++n) _Pragma("unroll") for (int k = 0; k < 2; ++k) dst[n][k] = *(const LAS bf16x8*)(lds + PG8_SB(b, h) + boff + n * 2048 + k * 1024); } while (0)
#define PG8_MMA(ai, bj, At, Bt) do { __builtin_amdgcn_s_setprio(1); _Pragma("unroll") for (int m = 0; m < 4; ++m) _Pragma("unroll") for (int n = 0; n < 2; ++n) _Pragma("unroll") for (int k = 0; k < 2; ++k) \
        acc[ai][bj][m][n] = __builtin_amdgcn_mfma_f32_16x16x32_bf16(Bt[n][k], At[m][k], acc[ai][bj][m][n], 0, 0, 0); __builtin_amdgcn_s_setprio(0); } while (0)
#define PG8_WAIT_V(n) asm volatile("s_waitcnt vmcnt(" #n ")" ::: "memory")
#define PG8_WAIT_L(n) asm volatile("s_waitcnt lgkmcnt(" #n ")" ::: "memory")
#define PG8_BAR __builtin_amdgcn_s_barrier()
#define PG8_SCHED __builtin_amdgcn_sched_barrier(0)
    Unit cur, nxt; int ui = 0;
    if (!S.next(0, cur)) return;
    f32x4 acc[2][2][4][2];
#pragma unroll
    for (int a = 0; a < 2; ++a)
#pragma unroll
        for (int b = 0; b < 2; ++b)
#pragma unroll
            for (int m = 0; m < 4; ++m)
#pragma unroll
                for (int n = 0; n < 2; ++n) acc[a][b][m][n] = (f32x4){0.f, 0.f, 0.f, 0.f};
    bf16x8 At[4][2], B0[2][2], B1[2][2];
    const char* cA = S.aptr(cur); const char* cB = S.bptr(cur);
    PG8_STAGE(PG8_SB(0, 0), cB, voffB); PG8_STAGE(PG8_SA(0, 0), cA, voffA); PG8_STAGE(PG8_SB(0, 1), cB + hstepB, voffB); PG8_STAGE(PG8_SA(0, 1), cA + hstepA, voffA);
    if (wr == 1) PG8_BAR;
    PG8_WAIT_V(4); PG8_BAR;
    PG8_STAGE(PG8_SB(1, 0), cB + kstep, voffB); PG8_STAGE(PG8_SA(1, 0), cA + kstep, voffA); PG8_STAGE(PG8_SB(1, 1), cB + hstepB + kstep, voffB);
    PG8_WAIT_V(6); PG8_BAR;
    for (;;) {
        const bool has_next = S.next(ui + 1, nxt);
        const char* nA = has_next ? S.aptr(nxt) : cA; const char* nB = has_next ? S.bptr(nxt) : cB;
        for (int t = 0; t < nt; t += 2) {
            const bool last = (t == nt - 2);
            const char* a1 = cA + (size_t)(t + 1) * kstep;
            const char* a2 = last ? nA : cA + (size_t)(t + 2) * kstep; const char* b2 = last ? nB : cB + (size_t)(t + 2) * kstep;
            const char* a3 = a2 + kstep; const char* b3 = b2 + kstep;
            PG8_LDB(B0, 0, 0); PG8_SCHED; PG8_LDA(At, 0, 0); PG8_STAGE(PG8_SA(1, 1), a1 + hstepA, voffA);
            PG8_WAIT_L(8); PG8_BAR; PG8_WAIT_L(0); PG8_MMA(0, 0, At, B0); PG8_BAR; PG8_SCHED;
            PG8_LDB(B1, 0, 1); PG8_STAGE(PG8_SB(0, 0), b2, voffB);
            PG8_BAR; PG8_WAIT_L(0); PG8_MMA(0, 1, At, B1); PG8_BAR;
            PG8_LDA(At, 0, 1); PG8_STAGE(PG8_SA(0, 0), a2, voffA);
            PG8_BAR; PG8_WAIT_L(0); PG8_MMA(1, 0, At, B0); PG8_BAR; PG8_SCHED;
            PG8_STAGE(PG8_SB(0, 1), b2 + hstepB, voffB);
            PG8_WAIT_V(6); PG8_BAR; PG8_MMA(1, 1, At, B1); PG8_BAR;
            PG8_LDB(B0, 1, 0); PG8_SCHED; PG8_LDA(At, 1, 0); PG8_STAGE(PG8_SA(0, 1), a2 + hstepA, voffA);
            PG8_WAIT_L(8); PG8_BAR; PG8_WAIT_L(0); PG8_MMA(0, 0, At, B0); PG8_BAR; PG8_SCHED;
            PG8_LDB(B1, 1, 1); PG8_STAGE(PG8_SB(1, 0), b3, voffB);
            PG8_BAR; PG8_WAIT_L(0); PG8_MMA(0, 1, At, B1); PG8_BAR;
            PG8_LDA(At, 1, 1); PG8_STAGE(PG8_SA(1, 0), a3, voffA);
            PG8_BAR; PG8_WAIT_L(0); PG8_MMA(1, 0, At, B0); PG8_BAR; PG8_SCHED;
            PG8_STAGE(PG8_SB(1, 1), b3 + hstepB, voffB);
            PG8_WAIT_V(6); PG8_BAR; PG8_MMA(1, 1, At, B1); PG8_BAR;
        }
        E(acc, cur, wr, wc, fr, fq);
        if (!has_next) break;
#pragma unroll
        for (int a = 0; a < 2; ++a)
#pragma unroll
            for (int b = 0; b < 2; ++b)
#pragma unroll
                for (int m = 0; m < 4; ++m)
#pragma unroll
                    for (int n = 0; n < 2; ++n) acc[a][b][m][n] = (f32x4){0.f, 0.f, 0.f, 0.f};
        cur = nxt; cA = nA; cB = nB; ++ui;
    }
    PG8_WAIT_V(0);
    if (wr == 0) PG8_BAR;
    PG8_BAR;
#undef PG8_SA
#undef PG8_SB
#undef PG8_STAGE
#undef PG8_LDA
#undef PG8_LDB
#undef PG8_MMA
#undef PG8_WAIT_V
#undef PG8_WAIT_L
#undef PG8_BAR
#undef PG8_SCHED
}
}
using pg8::Unit;
typedef f32x4 Acc[2][2][4][2];

typedef unsigned long long fix_t;
__device__ __forceinline__ fix_t to_fix(float v) { return (fix_t)(long long)(v * 4294967296.0f); }
__device__ __forceinline__ float from_fix(fix_t v) { return fmaf((float)(unsigned)v, 2.3283064365386963e-10f, (float)(int)(v >> 32)); }
__device__ __forceinline__ void fix_add(fix_t* p, float v) { __hip_atomic_fetch_add(p, to_fix(v), __ATOMIC_RELAXED, __HIP_MEMORY_SCOPE_AGENT); }
__device__ __forceinline__ f32x4 ld_fix4(const fix_t* p) { typedef unsigned long long u64x2 __attribute__((ext_vector_type(2))); const u64x2 a = *(const u64x2*)p, b = *(const u64x2*)(p + 2);
    return (f32x4){from_fix(a.x), from_fix(a.y), from_fix(b.x), from_fix(b.y)}; }
__device__ __forceinline__ void row_ln(const fix_t* st, int row, float& mu, float& rs) { const float s1 = from_fix(st[row]), s2 = from_fix(st[M_ + row]); mu = s1 * (1.0f / 2048.0f); rs = __builtin_amdgcn_rsqf(s2 * (1.0f / 2048.0f) - mu * mu + LN_EPS); }
template <bool PERM>
__device__ __forceinline__ void ln_correct(f32x4 (&acc)[2][2][4][2], const fix_t* st, const float* cs, const float* bw, int row0, int colbase) {
    f32x4 c4[2][2], b4[2][2];
#pragma unroll
    for (int bj = 0; bj < 2; ++bj)
#pragma unroll
        for (int n = 0; n < 2; ++n) { const int col = colbase + bj * 128 + (PERM ? 4 * n : 16 * n); c4[bj][n] = *(const f32x4*)(cs + col); b4[bj][n] = *(const f32x4*)(bw + col); }
#pragma unroll
    for (int ai = 0; ai < 2; ++ai) { fix_t r1[4], r2[4];
#pragma unroll
        for (int m = 0; m < 4; ++m) { const int row = row0 + ai * 128 + m * 16; r1[m] = st[row]; r2[m] = st[M_ + row]; }
#pragma unroll
        for (int m = 0; m < 4; ++m) { const float mu = from_fix(r1[m]) * (1.0f / 2048.0f), rs = __builtin_amdgcn_rsqf(from_fix(r2[m]) * (1.0f / 2048.0f) - mu * mu + LN_EPS);
#pragma unroll
            for (int bj = 0; bj < 2; ++bj)
#pragma unroll
                for (int n = 0; n < 2; ++n) acc[ai][bj][m][n] = (acc[ai][bj][m][n] - c4[bj][n] * mu) * rs + b4[bj][n]; } }
}

struct EpiIn {
    static constexpr bool PERM = true;
    bf16_t *cq, *ckv, *xl, *gg, *kpe; float* ssq; const float *cosT, *sinT; const fix_t* st; const float *cs, *bw;
    __device__ __forceinline__ void operator()(Acc& acc, const Unit& u, int wr, int wc, int fr, int fq) const {
        const int row0 = u.pm * 256 + wr * 64 + fr, pn = u.pn;
        ln_correct<true>(acc, st, cs, bw, row0, pn * 256 + wc * 32 + 8 * fq);
        if (pn < 4) {
            bf16_t* base = (pn < 2 ? cq : ckv); const int col0 = (pn & 1) * 256 + wc * 32 + 8 * fq;
#pragma unroll
            for (int ai = 0; ai < 2; ++ai)
#pragma unroll
                for (int m = 0; m < 4; ++m) { const int row = row0 + ai * 128 + m * 16; float s = 0.f;
#pragma unroll
                    for (int bj = 0; bj < 2; ++bj) { const f32x4 v0 = acc[ai][bj][m][0], v1 = acc[ai][bj][m][1];
                        s += (v0[0] * v0[0] + v0[1] * v0[1]) + (v0[2] * v0[2] + v0[3] * v0[3]) + (v1[0] * v1[0] + v1[1] * v1[1]) + (v1[2] * v1[2] + v1[3] * v1[3]);
                        *(u32x4*)(base + (size_t)row * 512 + col0 + bj * 128) = pack8(v0, v1); }
                    s = sum_fq(s);
                    if (fq == 0) ssq[(size_t)row * 16 + pn * 4 + wc] = s; }
        } else if (pn < 8) {
            const int col0 = (pn - 4) * 256 + wc * 32 + 8 * fq;
#pragma unroll
            for (int ai = 0; ai < 2; ++ai)
#pragma unroll
                for (int m = 0; m < 4; ++m) { const int row = row0 + ai * 128 + m * 16;
#pragma unroll
                    for (int bj = 0; bj < 2; ++bj) *(u32x4*)(xl + (size_t)row * 1024 + col0 + bj * 128) = pack8(acc[ai][bj][m][0], acc[ai][bj][m][1]); }
        } else if (pn < 12) {
            const int col0 = (pn - 8) * 256 + wc * 32 + 8 * fq;
#pragma unroll
            for (int ai = 0; ai < 2; ++ai)
#pragma unroll
                for (int m = 0; m < 4; ++m) { const int row = row0 + ai * 128 + m * 16;
#pragma unroll
                    for (int bj = 0; bj < 2; ++bj) { f32x4 v0 = acc[ai][bj][m][0], v1 = acc[ai][bj][m][1];
#pragma unroll
                        for (int j = 0; j < 4; ++j) { v0[j] = gelu_tanh(v0[j]); v1[j] = gelu_tanh(v1[j]); }
                        *(u32x4*)(gg + (size_t)row * 1024 + col0 + bj * 128) = pack8(v0, v1); } }
        } else if (wc == 0) {
#pragma unroll
            for (int ai = 0; ai < 2; ++ai) { f32x4 c0[4], c1[4], s0[4], s1[4];
#pragma unroll
                for (int m = 0; m < 4; ++m) { const size_t t = (size_t)(row0 + ai * 128 + m * 16) * 32 + 8 * fq;
                    c0[m] = *(const f32x4*)(cosT + t); c1[m] = *(const f32x4*)(cosT + t + 4); s0[m] = *(const f32x4*)(sinT + t); s1[m] = *(const f32x4*)(sinT + t + 4); }
#pragma unroll
                for (int m = 0; m < 4; ++m) { const int row = row0 + ai * 128 + m * 16;
                    const f32x4 a0 = acc[ai][0][m][0], a1 = acc[ai][0][m][1], b0 = acc[ai][1][m][0], b1 = acc[ai][1][m][1];
                    *(u32x4*)(kpe + (size_t)row * 64 + 8 * fq) = pack8(a0 * c0[m] - b0 * s0[m], a1 * c1[m] - b1 * s1[m]);
                    *(u32x4*)(kpe + (size_t)row * 64 + 32 + 8 * fq) = pack8(b0 * c0[m] + a0 * s0[m], b1 * c1[m] + a1 * s1[m]); } }
        }
    }
};
__device__ __forceinline__ void rows_rstd(const float* ssq8, int row0, float (&rs)[8]) {
#pragma unroll
    for (int h = 0; h < 2; ++h) { f32x4 a[4], b[4];
#pragma unroll
        for (int k = 0; k < 4; ++k) { const float* p = ssq8 + (size_t)(row0 + h * 128 + k * 16) * 16; a[k] = *(const f32x4*)p; b[k] = *(const f32x4*)(p + 4); }
#pragma unroll
        for (int k = 0; k < 4; ++k) { const float s = ((a[k][0] + a[k][1]) + (a[k][2] + a[k][3])) + ((b[k][0] + b[k][1]) + (b[k][2] + b[k][3])); rs[h * 4 + k] = __builtin_amdgcn_rsqf(s * (1.0f / 512.0f) + RMS_EPS); } }
}
struct EpiQ {
    static constexpr bool PERM = true;
    bf16_t* q; const float* ssq; const float *cosT, *sinT;
    __device__ __forceinline__ void operator()(Acc& acc, const Unit& u, int wr, int wc, int fr, int fq) const {
        const int row0 = u.pm * 256 + wr * 64 + fr, pn = u.pn;
        float rs[8]; rows_rstd(ssq, row0, rs);
        if (pn < 4) {
            const int col0 = pn * 256 + wc * 32 + 8 * fq;
#pragma unroll
            for (int ai = 0; ai < 2; ++ai)
#pragma unroll
                for (int m = 0; m < 4; ++m) { const int row = row0 + ai * 128 + m * 16; const float r = rs[ai * 4 + m];
#pragma unroll
                    for (int bj = 0; bj < 2; ++bj) *(u32x4*)(q + (size_t)row * 1536 + col0 + bj * 128) = pack8(acc[ai][bj][m][0] * r, acc[ai][bj][m][1] * r); }
        } else {
            const int head = 4 * (pn - 4) + wc;
#pragma unroll
            for (int kb = 0; kb < 4; ++kb) { f32x4 c0[2], c1[2], s0[2], s1[2];
#pragma unroll
                for (int j = 0; j < 2; ++j) { const int k = kb * 2 + j; const size_t t = (size_t)(row0 + (k >> 2) * 128 + (k & 3) * 16) * 32 + 8 * fq;
                    c0[j] = *(const f32x4*)(cosT + t); c1[j] = *(const f32x4*)(cosT + t + 4); s0[j] = *(const f32x4*)(sinT + t); s1[j] = *(const f32x4*)(sinT + t + 4); }
#pragma unroll
                for (int j = 0; j < 2; ++j) { const int k = kb * 2 + j, ai = k >> 2, m = k & 3; const int row = row0 + ai * 128 + m * 16; const float r = rs[k];
                    const f32x4 a0 = acc[ai][0][m][0] * r, a1 = acc[ai][0][m][1] * r, b0 = acc[ai][1][m][0] * r, b1 = acc[ai][1][m][1] * r;
                    *(u32x4*)(q + (size_t)row * 1536 + 1024 + head * 64 + 8 * fq) = pack8(a0 * c0[j] - b0 * s0[j], a1 * c1[j] - b1 * s1[j]);
                    *(u32x4*)(q + (size_t)row * 1536 + 1024 + head * 64 + 32 + 8 * fq) = pack8(b0 * c0[j] + a0 * s0[j], b1 * c1[j] + a1 * s1[j]); } }
        }
    }
};
struct EpiKV {
    static constexpr bool PERM = true;
    bf16_t* kv; const float* ssq;
    __device__ __forceinline__ void operator()(Acc& acc, const Unit& u, int wr, int wc, int fr, int fq) const {
        const int row0 = u.pm * 256 + wr * 64 + fr, col0 = u.pn * 256 + wc * 32 + 8 * fq;
        float rs[8]; rows_rstd(ssq + 8, row0, rs);
#pragma unroll
        for (int ai = 0; ai < 2; ++ai)
#pragma unroll
            for (int m = 0; m < 4; ++m) { const int row = row0 + ai * 128 + m * 16; const float r = rs[ai * 4 + m];
#pragma unroll
                for (int bj = 0; bj < 2; ++bj) *(u32x4*)(kv + (size_t)row * 2048 + col0 + bj * 128) = pack8(acc[ai][bj][m][0] * r, acc[ai][bj][m][1] * r); }
    }
};
struct EpiGate {
    static constexpr bool PERM = true;
    unsigned* au; const bf16_t* xc; const float *ba, *bi, *sp;
    __device__ __forceinline__ void operator()(Acc& acc, const Unit& u, int wr, int wc, int fr, int fq) const {
        const int row0 = u.pm * 256 + wr * 64 + fr, d = u.pn, ch0 = u.z * 128 + wc * 32 + 8 * fq;
        unsigned* aud = au + (size_t)d * M_ * 1024;
#pragma unroll
        for (int n = 0; n < 2; ++n) {
            const int ch = ch0 + 4 * n;
            const f32x4 bav = *(const f32x4*)(ba + d * 1024 + ch), biv = *(const f32x4*)(bi + d * 1024 + ch), spv = *(const f32x4*)(sp + d * 1024 + ch) * (-8.0f * 1.4426950408889634f);
            u32x2 xws[8];
#pragma unroll
            for (int k = 0; k < 8; ++k) xws[k] = *(const u32x2*)(xc + (size_t)(row0 + (k >> 2) * 128 + (k & 3) * 16) * 1024 + ch);
#pragma unroll
            for (int ai = 0; ai < 2; ++ai)
#pragma unroll
                for (int m = 0; m < 4; ++m) { const int row = row0 + ai * 128 + m * 16;
                    const u32x2 xw = xws[ai * 4 + m];
                    const float xv[4] = {bf_lo(xw.x), bf_hi(xw.x), bf_lo(xw.y), bf_hi(xw.y)};
                    u32x4 o;
#pragma unroll
                    for (int j = 0; j < 4; ++j) {
                        const float r = sigmoidf_(acc[ai][0][m][n][j] + bav[j]);
                        const float ig = sigmoidf_(acc[ai][1][m][n][j] + biv[j]);
                        const float a = __builtin_amdgcn_exp2f(r * spv[j]);
                        const float oma = 1.0f - a;
                        const float uu = __builtin_amdgcn_sqrtf(oma * (1.0f + a)) * ig * xv[j];
                        o[j] = cvt_pk_bf16(oma, uu); }
                    *(u32x4*)(aud + (size_t)row * 1024 + ch) = o; }
        }
    }
};
#ifndef RES_PF
#define RES_PF 1
#endif
struct EpiRes {
    static constexpr bool PERM = false;
    const float* src; float* out; bf16_t* hb; const fix_t* st_old; const float *g, *b; fix_t* st_new;
    __device__ __forceinline__ void operator()(Acc& acc, const Unit& u, int wr, int wc, int fr, int fq) const {
        const int row0 = u.pm * 256 + wr * 64 + fr, col0 = u.pn * 256 + wc * 32 + 4 * fq;
        f32x4 gv[4], bv[4], P[RES_PF + 1][4]; float mus[8], rss[8];
#pragma unroll
        for (int h = 0; h < 2; ++h) { fix_t r1[4], r2[4];
#pragma unroll
            for (int k = 0; k < 4; ++k) { const int row = row0 + h * 128 + k * 16; r1[k] = st_old[row]; r2[k] = st_old[M_ + row]; }
#pragma unroll
            for (int k = 0; k < 4; ++k) { mus[h * 4 + k] = from_fix(r1[k]) * (1.0f / 2048.0f); rss[h * 4 + k] = __builtin_amdgcn_rsqf(from_fix(r2[k]) * (1.0f / 2048.0f) - mus[h * 4 + k] * mus[h * 4 + k] + LN_EPS); } }
#pragma unroll
        for (int c = 0; c < 4; ++c) { gv[c] = *(const f32x4*)(g + col0 + (c >> 1) * 128 + (c & 1) * 16); bv[c] = *(const f32x4*)(b + col0 + (c >> 1) * 128 + (c & 1) * 16); }
#define RES_LOAD(k) do { const size_t off_ = (size_t)(row0 + ((k) >> 2) * 128 + ((k) & 3) * 16) * 2048 + col0; _Pragma("unroll") for (int c = 0; c < 4; ++c) P[(k) % (RES_PF + 1)][c] = *(const f32x4*)(src + off_ + (c >> 1) * 128 + (c & 1) * 16); } while (0)
#pragma unroll
        for (int k = 0; k < RES_PF; ++k) RES_LOAD(k);
#pragma unroll
        for (int k = 0; k < 8; ++k) {
            if (k + RES_PF < 8) RES_LOAD(k + RES_PF);
            const int ai = k >> 2, m = k & 3; const size_t off = (size_t)(row0 + ai * 128 + m * 16) * 2048 + col0;
            const float mu = mus[k], rs = rss[k];
            float a1 = 0.f, a2 = 0.f;
#pragma unroll
            for (int c = 0; c < 4; ++c) { const int cc = (c >> 1) * 128 + (c & 1) * 16;
                const f32x4 v = ((P[k % (RES_PF + 1)][c] - mu) * rs * gv[c] + bv[c]) * ALPHA + acc[ai][c >> 1][m][c & 1];
                *(f32x4*)(out + off + cc) = v; u32x2 w; w.x = cvt_pk_bf16(v[0], v[1]); w.y = cvt_pk_bf16(v[2], v[3]); *(u32x2*)(hb + off + cc) = w;
                a1 += (v[0] + v[1]) + (v[2] + v[3]); a2 += (v[0] * v[0] + v[1] * v[1]) + (v[2] * v[2] + v[3] * v[3]); }
            a1 = sum_fq(a1); a2 = sum_fq(a2);
            { const int row = row0 + ai * 128 + m * 16; if (fq == 0) fix_add(st_new + row, a1); else if (fq == 1) fix_add(st_new + M_ + row, a2); }
        }
#undef RES_LOAD
    }
};
struct EpiUp {
    static constexpr bool PERM = true;
    bf16_t* f; const fix_t* st; const float *cs, *bw;
    __device__ __forceinline__ void operator()(Acc& acc, const Unit& u, int wr, int wc, int fr, int fq) const {
        const int row0 = u.pm * 256 + wr * 64 + fr, col0 = u.pn * 256 + wc * 32 + 8 * fq;
        ln_correct<true>(acc, st, cs, bw, row0, col0);
#pragma unroll
        for (int ai = 0; ai < 2; ++ai)
#pragma unroll
            for (int m = 0; m < 4; ++m) { const int row = row0 + ai * 128 + m * 16;
#pragma unroll
                for (int bj = 0; bj < 2; ++bj) { f32x4 v0 = acc[ai][bj][m][0], v1 = acc[ai][bj][m][1];
#pragma unroll
                    for (int j = 0; j < 4; ++j) { const float a = fmaxf(v0[j], 0.f), b = fmaxf(v1[j], 0.f); v0[j] = a * a; v1[j] = b * b; }
                    *(u32x4*)(f + (size_t)row * 8192 + col0 + bj * 128) = pack8(v0, v1); } }
    }
};

namespace att {
constexpr int NW = 8, QBLK = 32, KVBLK = 64;
constexpr float SCALE = 0.07216878364870323f;
constexpr float THR = 8.f;
#ifndef ATT_SDEPTH
#define ATT_SDEPTH 1
#endif
constexpr int SDEPTH = ATT_SDEPTH;
constexpr int SHM_V = KVBLK * 128 * 2, SHM_K = KVBLK * 128 * 2, SHM_R = KVBLK * 64 * 2;
constexpr int OFF_V = 0, OFF_K = 2 * SHM_V, OFF_R = OFF_K + 2 * SHM_K, OFF_WS = OFF_R + 2 * SHM_R, OFF_QR = OFF_WS + NW * 64 * 4, SHM_ATTN = OFF_QR + 256 * 128;
#define KSWZ(row, colB) ((row) * 256 + ((colB) ^ (((row) & 7) << 4)))
#define RSWZ(row, colB) ((row) * 128 + ((colB) ^ (((row) & 7) << 4)))
#define SBAR() __builtin_amdgcn_sched_barrier(0)
__device__ __forceinline__ int crow(int r, int hi) { return (r & 3) + 8 * (r >> 2) + 4 * hi; }
__device__ __forceinline__ void partialSM(f32x16& p0, f32x16& p1, float& m_reg, float& mn, float& alpha) {
    constexpr float C = SCALE * 1.4426950408889634f;
    float pmax = p0[0];
#pragma unroll
    for (int r = 1; r < 16; ++r) pmax = fmaxf(pmax, p0[r]);
#pragma unroll
    for (int r = 0; r < 16; ++r) pmax = fmaxf(pmax, p1[r]);
    { auto rr = __builtin_amdgcn_permlane32_swap(__float_as_uint(pmax), __float_as_uint(pmax), false, false);
      pmax = fmaxf(__uint_as_float(rr[0]), __uint_as_float(rr[1])); }
    if (__builtin_expect(__all(pmax - m_reg <= THR / SCALE), 1)) { mn = m_reg; alpha = 1.f; }
    else { mn = fmaxf(m_reg, pmax); alpha = __builtin_amdgcn_exp2f((m_reg - mn) * C); m_reg = mn; }
    const float mnC = -mn * C;
#pragma unroll
    for (int r = 0; r < 16; ++r) p0[r] = fmaf(p0[r], C, mnC);
#pragma unroll
    for (int r = 0; r < 16; ++r) p1[r] = fmaf(p1[r], C, mnC);
#pragma unroll
    for (int r = 0; r < 16; ++r) p0[r] = __builtin_amdgcn_exp2f(p0[r]);
}
__device__ __forceinline__ void finishSM(f32x16& p0, f32x16& p1, float alpha, float& l_reg, bf16x8& pa0, bf16x8& pa1, bf16x8& pa2, bf16x8& pa3) {
#pragma unroll
    for (int r = 0; r < 16; ++r) p1[r] = __builtin_amdgcn_exp2f(p1[r]);
    float ps = 0;
#pragma unroll
    for (int r = 0; r < 16; ++r) ps += p0[r];
#pragma unroll
    for (int r = 0; r < 16; ++r) ps += p1[r];
    { auto rr = __builtin_amdgcn_permlane32_swap(__float_as_uint(ps), __float_as_uint(ps), false, false);
      ps = __uint_as_float(rr[0]) + __uint_as_float(rr[1]); }
    l_reg = l_reg * alpha + ps;
#define PK4(P, BASE, OUT) do { unsigned a0 = cvt_pk_bf16(P[BASE + 0], P[BASE + 1]), a1 = cvt_pk_bf16(P[BASE + 2], P[BASE + 3]);   \
    unsigned b0 = cvt_pk_bf16(P[BASE + 4], P[BASE + 5]), b1 = cvt_pk_bf16(P[BASE + 6], P[BASE + 7]);                              \
    auto r0 = __builtin_amdgcn_permlane32_swap(a0, b0, false, false); auto r1 = __builtin_amdgcn_permlane32_swap(a1, b1, false, false); \
    u32x4 w = {r0[0], r1[0], r0[1], r1[1]}; OUT = *reinterpret_cast<bf16x8*>(&w); } while (0)
    PK4(p0, 0, pa0); PK4(p0, 8, pa1); PK4(p1, 0, pa2); PK4(p1, 8, pa3);
#undef PK4
}
__device__ __forceinline__ void qkt(f32x16& p0, f32x16& p1, const char* Ks, const char* Rs, const bf16x8* qr, const char* Qrl, int r32, int hi) {
    p0 = f32x16{}; p1 = f32x16{};
#pragma unroll
    for (int d0 = 0; d0 < 8; ++d0) { const int cb = (d0 * 16 + hi * 8) * 2;
        const bf16x8 b0 = *reinterpret_cast<const bf16x8*>(Ks + KSWZ(r32, cb));
        const bf16x8 b1 = *reinterpret_cast<const bf16x8*>(Ks + KSWZ(32 + r32, cb));
        p0 = __builtin_amdgcn_mfma_f32_32x32x16_bf16(b0, qr[d0], p0, 0, 0, 0);
        p1 = __builtin_amdgcn_mfma_f32_32x32x16_bf16(b1, qr[d0], p1, 0, 0, 0); }
#pragma unroll
    for (int d0 = 0; d0 < 4; ++d0) { const int cb = (d0 * 16 + hi * 8) * 2;
        const bf16x8 b0 = *reinterpret_cast<const bf16x8*>(Rs + RSWZ(r32, cb));
        const bf16x8 b1 = *reinterpret_cast<const bf16x8*>(Rs + RSWZ(32 + r32, cb));
        const bf16x8 qv = *reinterpret_cast<const bf16x8*>(Qrl + (cb ^ ((r32 & 7) << 4)));
        p0 = __builtin_amdgcn_mfma_f32_32x32x16_bf16(b0, qv, p0, 0, 0, 0);
        p1 = __builtin_amdgcn_mfma_f32_32x32x16_bf16(b1, qv, p1, 0, 0, 0); }
}
__device__ __forceinline__ int v_st(int k, int c) { const int kk = (k & ~0xC) | ((k & 4) << 1) | ((k & 8) >> 1); return ((kk >> 3) * 4 + (c >> 5)) * 512 + ((kk & 7) * 32 + (c & 31)) * 2; }
__device__ __forceinline__ int v_rd_base(int lane) { return ((lane & 3) << 3) | (((lane >> 2) & 3) << 6) | (((lane >> 4) & 1) << 5) | (((lane >> 5) & 1) << 8); }
constexpr int v_rd_off(int d0, int ks, int half) { return d0 * 512 + ks * 4096 + half * 2048; }
template <int OFF> __device__ __forceinline__ s16x4 tr_read(int vb) {
    s16x4 r; asm volatile("ds_read_b64_tr_b16 %0, %1 offset:%2" : "=&v"(r) : "v"(vb), "i"(OFF) : "memory"); return r;
}
template <int D0> __device__ __forceinline__ void pv_one(f32x16& od, int vb, bf16x8 pa0, bf16x8 pa1, bf16x8 pa2, bf16x8 pa3) {
    const s16x4 l0 = tr_read<v_rd_off(D0, 0, 0)>(vb), h0 = tr_read<v_rd_off(D0, 0, 1)>(vb), l1 = tr_read<v_rd_off(D0, 1, 0)>(vb), h1 = tr_read<v_rd_off(D0, 1, 1)>(vb);
    const s16x4 l2 = tr_read<v_rd_off(D0, 2, 0)>(vb), h2 = tr_read<v_rd_off(D0, 2, 1)>(vb), l3 = tr_read<v_rd_off(D0, 3, 0)>(vb), h3 = tr_read<v_rd_off(D0, 3, 1)>(vb);
    asm volatile("s_waitcnt lgkmcnt(0)" ::: "memory"); SBAR();
#define PK(L, H) (bf16x8){L[0], L[1], L[2], L[3], H[0], H[1], H[2], H[3]}
    od = __builtin_amdgcn_mfma_f32_32x32x16_bf16(pa0, PK(l0, h0), od, 0, 0, 0);
    od = __builtin_amdgcn_mfma_f32_32x32x16_bf16(pa1, PK(l1, h1), od, 0, 0, 0);
    od = __builtin_amdgcn_mfma_f32_32x32x16_bf16(pa2, PK(l2, h2), od, 0, 0, 0);
    od = __builtin_amdgcn_mfma_f32_32x32x16_bf16(pa3, PK(l3, h3), od, 0, 0, 0);
#undef PK
}
__device__ __forceinline__ void pv_d0(f32x16* o, int vb, bf16x8 pa0, bf16x8 pa1, bf16x8 pa2, bf16x8 pa3) {
    pv_one<0>(o[0], vb, pa0, pa1, pa2, pa3); pv_one<1>(o[1], vb, pa0, pa1, pa2, pa3); pv_one<2>(o[2], vb, pa0, pa1, pa2, pa3); pv_one<3>(o[3], vb, pa0, pa1, pa2, pa3);
}
__device__ __forceinline__ void attn_unit(const bf16_t* __restrict__ Qn, const bf16_t* __restrict__ Qr, const bf16_t* __restrict__ Kh, const bf16_t* __restrict__ Rh,
                                          bf16_t* __restrict__ Ob, int seq, char* lds) {
    const int tid = otid(), wid = tid >> 6, lane = tid & 63, r32 = lane & 31, hi = lane >> 5;
    char* V_lds = lds + OFF_V; char* K_lds = lds + OFF_K; char* R_lds = lds + OFF_R;
    float* ws = (float*)(lds + OFF_WS) + wid * 64; float* li_l = ws; float* al_l = ws + 32;
    float m_reg = -1e30f, l_reg = 0; f32x16 o[4] = {}; bf16x8 qr[8];
    char* Qrl = lds + OFF_QR + (wid * QBLK + r32) * 128;
    {
        const bf16_t* Qw = Qn + (size_t)(wid * QBLK + r32) * 1536 + hi * 8;
#pragma unroll
        for (int d0 = 0; d0 < 8; ++d0) qr[d0] = *reinterpret_cast<const bf16x8*>(Qw + d0 * 16);
        const bf16_t* Qw2 = Qr + (size_t)(wid * QBLK + r32) * 1536 + hi * 8;
#pragma unroll
        for (int d0 = 0; d0 < 4; ++d0) { const bf16x8 t = *reinterpret_cast<const bf16x8*>(Qw2 + d0 * 16); *reinterpret_cast<bf16x8*>(Qrl + (((d0 * 16 + hi * 8) * 2) ^ ((r32 & 7) << 4))) = t; }
    }
    const int sr = tid >> 4, sc = (tid & 15) * 8, vst0 = v_st(sr, sc), vst1 = v_st(32 + sr, sc);
    const int rr_ = tid >> 3, rc = (tid & 7) * 8;
    const int vb0 = (int)(uintptr_t)V_lds + v_rd_base(lane);
    struct { bf16x8 vs0, vs1, ks0, ks1, rs; } sr_[SDEPTH];
#define SLOAD(i, k0) do { sr_[i].vs0 = *(const bf16x8*)(&Kh[(size_t)((k0) + sr) * 2048 + 128 + sc]); sr_[i].vs1 = *(const bf16x8*)(&Kh[(size_t)((k0) + 32 + sr) * 2048 + 128 + sc]); \
    sr_[i].ks0 = *(const bf16x8*)(&Kh[(size_t)((k0) + sr) * 2048 + sc]); sr_[i].ks1 = *(const bf16x8*)(&Kh[(size_t)((k0) + 32 + sr) * 2048 + sc]); \
    sr_[i].rs = *(const bf16x8*)(&Rh[(size_t)((k0) + rr_) * 64 + rc]); } while (0)
#define SWRITE(b, i) do { *(bf16x8*)(V_lds + (b) * SHM_V + vst0) = sr_[i].vs0;          \
    *(bf16x8*)(V_lds + (b) * SHM_V + vst1) = sr_[i].vs1; const int kc = sc * 2;               \
    *(bf16x8*)(K_lds + (b) * SHM_K + KSWZ(sr, kc)) = sr_[i].ks0;                       \
    *(bf16x8*)(K_lds + (b) * SHM_K + KSWZ(32 + sr, kc)) = sr_[i].ks1;                  \
    *(bf16x8*)(R_lds + (b) * SHM_R + RSWZ(rr_, rc * 2)) = sr_[i].rs; } while (0)
#define SWAIT() do { if constexpr (SDEPTH == 2) asm volatile("s_waitcnt vmcnt(5)" ::: "memory"); else asm volatile("s_waitcnt vmcnt(0)" ::: "memory"); } while (0)
#define RESC(a) do { if (__any((a) < 1.f)) { if (hi == 0) al_l[r32] = (a); asm volatile("s_waitcnt lgkmcnt(0)" ::: "memory"); \
    _Pragma("unroll") for (int d = 0; d < 4; ++d) _Pragma("unroll") for (int r = 0; r < 16; ++r) o[d][r] *= al_l[crow(r, hi)]; } } while (0)
    f32x16 pA0, pA1, pB0, pB1; float mnA, mnB, alA, alB; bf16x8 pa0, pa1, pa2, pa3; const int NT = seq / KVBLK;
    constexpr int SE = 0, SO = SDEPTH - 1;
    SLOAD(SE, 0); asm volatile("s_waitcnt vmcnt(0)" ::: "memory"); SWRITE(0, SE); __syncthreads();
    qkt(pA0, pA1, K_lds, R_lds, qr, Qrl, r32, hi); partialSM(pA0, pA1, m_reg, mnA, alA);
    SLOAD(SO, KVBLK); if constexpr (SDEPTH == 2) { if (2 < NT) SLOAD(SE, 2 * KVBLK); }
    SWAIT(); SWRITE(1, SO); __syncthreads();
    for (int j = 1; j + 1 < NT; j += 2) {
        SBAR(); qkt(pB0, pB1, K_lds + SHM_K, R_lds + SHM_R, qr, Qrl, r32, hi);
        finishSM(pA0, pA1, alA, l_reg, pa0, pa1, pa2, pa3); SBAR();
        SLOAD(SO, (j + SDEPTH) * KVBLK); SBAR();
        pv_d0(o, vb0, pa0, pa1, pa2, pa3); partialSM(pB0, pB1, m_reg, mnB, alB);
        __syncthreads(); SWAIT(); SWRITE(0, SE);
        RESC(alB); __syncthreads();
        SBAR(); qkt(pA0, pA1, K_lds, R_lds, qr, Qrl, r32, hi);
        finishSM(pB0, pB1, alB, l_reg, pa0, pa1, pa2, pa3); SBAR();
        if (SDEPTH == 1 || j + 3 < NT) SLOAD(SE, (j + 1 + SDEPTH) * KVBLK); SBAR();
        pv_d0(o, vb0 + (int)SHM_V, pa0, pa1, pa2, pa3); partialSM(pA0, pA1, m_reg, mnA, alA);
        __syncthreads(); SWAIT(); SWRITE(1, SO);
        RESC(alA); __syncthreads();
    }
    SBAR(); qkt(pB0, pB1, K_lds + SHM_K, R_lds + SHM_R, qr, Qrl, r32, hi);
    finishSM(pA0, pA1, alA, l_reg, pa0, pa1, pa2, pa3); SBAR();
    pv_d0(o, vb0, pa0, pa1, pa2, pa3); partialSM(pB0, pB1, m_reg, mnB, alB);
    __syncthreads(); RESC(alB);
    finishSM(pB0, pB1, alB, l_reg, pa0, pa1, pa2, pa3); SBAR();
    pv_d0(o, vb0 + (int)SHM_V, pa0, pa1, pa2, pa3);
    if (hi == 0) li_l[r32] = l_reg; asm volatile("s_waitcnt lgkmcnt(0)" ::: "memory");
    float rli[16];
#pragma unroll
    for (int r = 0; r < 16; ++r) rli[r] = __builtin_amdgcn_rcpf(li_l[crow(r, hi)]);
    bf16_t* Ow = Ob + (size_t)(wid * QBLK) * 2048;
#pragma unroll
    for (int r = 0; r < 16; ++r) { const int orow = crow(r, hi);
#pragma unroll
        for (int d0 = 0; d0 < 4; ++d0) Ow[(size_t)orow * 2048 + d0 * 32 + r32] = (bf16_t)(cvt_pk_bf16(o[d0][r] * rli[r], 0.f) & 0xffffu); }
#undef SLOAD
#undef SWRITE
#undef SWAIT
#undef RESC
}
}

__device__ __forceinline__ void x_pass(const float* src, bf16_t* dstb, fix_t* st) {
    const int tid_ = otid(), lane = tid_ & 63, wave = tid_ >> 6;
    for (int row = blockIdx.x * 8 + wave; row < M_; row += gridDim.x * 8) {
        const float* s = src + (size_t)row * 2048; f32x4 v[8]; float s1 = 0.f, s2 = 0.f;
#pragma unroll
        for (int i = 0; i < 8; ++i) { v[i] = *(const f32x4*)(s + i * 256 + lane * 4); s1 += (v[i][0] + v[i][1]) + (v[i][2] + v[i][3]); s2 += (v[i][0] * v[i][0] + v[i][1] * v[i][1]) + (v[i][2] * v[i][2] + v[i][3] * v[i][3]); }
        s1 = wave_sum(s1, lane); s2 = wave_sum(s2, lane);
        if (lane == 0) { st[row] = to_fix(s1); st[M_ + row] = to_fix(s2); }
#pragma unroll
        for (int i = 0; i < 8; ++i) { u32x2 w; w.x = cvt_pk_bf16(v[i][0], v[i][1]); w.y = cvt_pk_bf16(v[i][2], v[i][3]); *(u32x2*)(dstb + (size_t)row * 2048 + i * 256 + lane * 4) = w; }
    }
}
__device__ __forceinline__ void ln_final(float* out, const fix_t* st, const float* g, const float* b) {
    const int tid = otid();
    for (size_t i = (size_t)blockIdx.x * 512 + tid; i < (size_t)M_ * 512; i += (size_t)gridDim.x * 512) {
        const int row = (int)(i >> 9), c = (int)(i & 511) * 4; float mu, rs; row_ln(st, row, mu, rs);
        const f32x4 P = *(const f32x4*)(out + i * 4), g4 = *(const f32x4*)(g + c), b4 = *(const f32x4*)(b + c);
        *(f32x4*)(out + i * 4) = (P - mu) * rs * g4 + b4;
    }
}
__device__ __forceinline__ int colmap(int mode, int n) {
    if (mode == 0) { if (n < 1024) return n; if (n < 2048) return 1088 + (n - 1024); if (n < 3072) return 2112 + (n - 2048);
        const int t = n - 3072, bj = t >> 7, r = t & 127; return r < 32 ? 1024 + bj * 32 + r : -1; }
    if (mode == 1) { if (n < 1024) return (n >> 7) * 192 + (n & 127);
        const int t = n - 1024, tile = t >> 8, bj = (t >> 7) & 1, wc = (t >> 5) & 3, i = t & 31; return (4 * tile + wc) * 192 + 128 + bj * 32 + i; }
    return n;
}
__device__ __forceinline__ void cvt_tile(const float* W, int ldw, bf16_t* Bt, int ldb, int n0, int k0, int mode, const float* kscale, float* T) {
    const int tid = otid(), n4 = (tid & 31) * 4, kq = tid >> 5, src = colmap(mode, n0 + n4);
    f32x4 v[8];
#pragma unroll
    for (int i = 0; i < 8; ++i) { const int kk = kq + 16 * i; v[i] = src >= 0 ? *(const f32x4*)(W + (size_t)(k0 + kk) * ldw + src) : (f32x4){0.f, 0.f, 0.f, 0.f}; }
    if (kscale) {
#pragma unroll
        for (int i = 0; i < 8; ++i) v[i] = v[i] * kscale[k0 + kq + 16 * i]; }
#pragma unroll
    for (int i = 0; i < 8; ++i)
#pragma unroll
        for (int j = 0; j < 4; ++j) T[(n4 + j) * 129 + kq + 16 * i] = v[i][j];
    __syncthreads();
    { const int n2 = tid >> 2, ks = (tid & 3) * 32; const float* t = T + n2 * 129 + ks; bf16_t* dst = Bt + (size_t)(n0 + n2) * ldb + k0 + ks;
#pragma unroll
      for (int i = 0; i < 4; ++i) { u32x4 w; w.x = cvt_pk_bf16(t[i * 8 + 0], t[i * 8 + 1]); w.y = cvt_pk_bf16(t[i * 8 + 2], t[i * 8 + 3]); w.z = cvt_pk_bf16(t[i * 8 + 4], t[i * 8 + 5]); w.w = cvt_pk_bf16(t[i * 8 + 6], t[i * 8 + 7]);
          *(u32x4*)(dst + i * 8) = w; } }
    __syncthreads();
}
constexpr int CT0 = 26 * 16, CT1 = CT0 + 12 * 4, CT2 = CT1 + 16 * 4, CT3 = CT2 + 32, CT4 = CT3 + 16 * 16, CT5 = CT4 + 64 * 16, CT6 = CT5 + 16 * 64;
__device__ __forceinline__ void convert_weights(const Params& p, int l, int t0, int t1, float* T) {
    unsigned char* ws = p.ws;
    const float* ing = l == 0 ? p.in[2] : p.in[21] + (size_t)(l - 1) * 2048;
    for (int t = t0 + blockIdx.x; t < t1; t += gridDim.x) {
        if (t < CT0) { const int nt = t % 26, kt = t / 26; cvt_tile(p.in[4] + (size_t)l * 2048 * NIN, NIN, (bf16_t*)(ws + W_IN), 2048, nt * 128, kt * 128, 0, ing, T); }
        else if (t < CT1) { const int u = t - CT0, nt = u % 12, kt = u / 12; cvt_tile(p.in[7] + (size_t)l * 512 * 1536, 1536, (bf16_t*)(ws + W_UQ), 512, nt * 128, kt * 128, 1, p.in[5] + l * 512, T); }
        else if (t < CT2) { const int u = t - CT1, nt = u % 16, kt = u / 16; cvt_tile(p.in[8] + (size_t)l * 512 * 2048, 2048, (bf16_t*)(ws + W_UKV), 512, nt * 128, kt * 128, 2, p.in[6] + l * 512, T); }
        else if (t < CT3) { const int mat = t - CT2, gate = mat & 1, h = (mat >> 1) & 7, d = mat >> 4;
            cvt_tile((gate ? p.in[13] : p.in[11]) + ((size_t)((l * 2 + d) * 8 + h)) * 128 * 128, 128, (bf16_t*)(ws + W_G) + (size_t)(h * 512 + d * 256 + gate * 128) * 128, 128, 0, 0, 2, nullptr, T); }
        else if (t < CT4) { const int u = t - CT3, nt = u % 16, kt = u / 16; cvt_tile(p.in[16] + (size_t)l * 2048 * 2048, 2048, (bf16_t*)(ws + W_OUT), 2048, nt * 128, kt * 128, 2, nullptr, T); }
        else if (t < CT5) { const int u = t - CT4, nt = u % 64, kt = u / 64; cvt_tile(p.in[19] + (size_t)l * 2048 * 8192, 8192, (bf16_t*)(ws + W_UP), 2048, nt * 128, kt * 128, 2, p.in[17] + (size_t)l * 2048, T); }
        else { const int u = t - CT5, nt = u % 16, kt = u / 16; cvt_tile(p.in[20] + (size_t)l * 8192 * 2048, 2048, (bf16_t*)(ws + W_DN), 8192, nt * 128, kt * 128, 2, nullptr, T); }
    }
}
__device__ __forceinline__ void colsum_pass(const bf16_t* Bt, int N, const float* lg, const float* lb, float* cs, float* bw) {
    const int tid = otid(), lane = tid & 63, wave = tid >> 6;
    float ratio[32];
#pragma unroll
    for (int i = 0; i < 4; ++i)
#pragma unroll
        for (int j = 0; j < 8; ++j) { const int k = i * 512 + lane * 8 + j; ratio[i * 8 + j] = lb[k] * __builtin_amdgcn_rcpf(lg[k]); }
    for (int n = blockIdx.x * 8 + wave; n < N; n += gridDim.x * 8) {
        u32x4 w[4];
#pragma unroll
        for (int i = 0; i < 4; ++i) w[i] = *(const u32x4*)(Bt + (size_t)n * 2048 + i * 512 + lane * 8);
        float c = 0.f, bb = 0.f;
#pragma unroll
        for (int i = 0; i < 4; ++i) { const float v[8] = {bf_lo(w[i].x), bf_hi(w[i].x), bf_lo(w[i].y), bf_hi(w[i].y), bf_lo(w[i].z), bf_hi(w[i].z), bf_lo(w[i].w), bf_hi(w[i].w)};
#pragma unroll
            for (int j = 0; j < 8; ++j) { c += v[j]; bb += v[j] * ratio[i * 8 + j]; } }
        c = wave_sum(c, lane); bb = wave_sum(bb, lane);
        if (lane == 0) { cs[n] = c; bw[n] = bb; }
    }
}
__device__ __forceinline__ void colsum_in(const Params& p, int l) { float* csb = (float*)(p.ws + WS_CSB) + (size_t)l * CSB_L;
    colsum_pass((const bf16_t*)(p.ws + W_IN), NINP, l == 0 ? p.in[2] : p.in[21] + (size_t)(l - 1) * 2048, l == 0 ? p.in[3] : p.in[22] + (size_t)(l - 1) * 2048, csb + CSB_IN, csb + CSB_IN + NINP); }
__device__ __forceinline__ void colsum_up(const Params& p, int l) { float* csb = (float*)(p.ws + WS_CSB) + (size_t)l * CSB_L;
    colsum_pass((const bf16_t*)(p.ws + W_UP), DFF, p.in[17] + (size_t)l * 2048, p.in[18] + (size_t)l * 2048, csb + CSB_UP, csb + CSB_UP + DFF); }
__device__ __forceinline__ void make_tables(const Params& p) {
    const int* pos = (const int*)p.in[1]; float* cosT = (float*)(p.ws + WS_COS); float* sinT = (float*)(p.ws + WS_SIN); float* sp = (float*)(p.ws + WS_SP);
    const int tid = otid();
    for (size_t i = (size_t)blockIdx.x * 512 + tid; i < (size_t)M_ * 32; i += (size_t)gridDim.x * 512) {
        const int row = (int)(i >> 5), k = (int)(i & 31); const float inv = powf(10000.0f, -(float)(2 * k) / 64.0f); const float ang = (float)pos[row] * inv;
        cosT[i] = cosf(ang); sinT[i] = sinf(ang); }
    for (int i = blockIdx.x * 512 + tid; i < DEPTH * 2 * 1024; i += gridDim.x * 512) { const float x = -p.in[15][i];
        sp[i] = fmaxf(x, 0.f) + log1pf(expf(-fabsf(x))); }
}
__device__ __forceinline__ void conv_phase(const Params& p, int l) {
    const bf16_t* xl = (const bf16_t*)(p.ws + WS_XL); bf16_t* xc = (bf16_t*)(p.ws + WS_XC);
    const float* cw = p.in[9] + (size_t)l * 4 * 1024; const float* cb = p.in[10] + (size_t)l * 1024;
    const int tid = otid();
    for (size_t i = (size_t)blockIdx.x * 512 + tid; i < (size_t)M_ * 128; i += (size_t)gridDim.x * 512) {
        const int row = (int)(i >> 7), c0 = (int)(i & 127) * 8, t = row & (SEQ - 1);
        float acc[8];
        { const f32x4 b0 = *(const f32x4*)(cb + c0), b1 = *(const f32x4*)(cb + c0 + 4); acc[0] = b0[0]; acc[1] = b0[1]; acc[2] = b0[2]; acc[3] = b0[3]; acc[4] = b1[0]; acc[5] = b1[1]; acc[6] = b1[2]; acc[7] = b1[3]; }
#pragma unroll
        for (int k = 0; k < 4; ++k) { const int tt = t - 2 + k; if (tt < 0 || tt >= SEQ) continue;
            const u32x4 xw = *(const u32x4*)(xl + (size_t)(row - 2 + k) * 1024 + c0);
            const f32x4 w0 = *(const f32x4*)(cw + k * 1024 + c0), w1 = *(const f32x4*)(cw + k * 1024 + c0 + 4);
            acc[0] += w0[0] * bf_lo(xw.x); acc[1] += w0[1] * bf_hi(xw.x); acc[2] += w0[2] * bf_lo(xw.y); acc[3] += w0[3] * bf_hi(xw.y);
            acc[4] += w1[0] * bf_lo(xw.z); acc[5] += w1[1] * bf_hi(xw.z); acc[6] += w1[2] * bf_lo(xw.w); acc[7] += w1[3] * bf_hi(xw.w); }
        u32x4 o; o.x = cvt_pk_bf16(acc[0], acc[1]); o.y = cvt_pk_bf16(acc[2], acc[3]); o.z = cvt_pk_bf16(acc[4], acc[5]); o.w = cvt_pk_bf16(acc[6], acc[7]);
        *(u32x4*)(xc + (size_t)row * 1024 + c0) = o;
    }
}
__device__ __forceinline__ void scan_local(const Params& p) {
    const unsigned* au = (const unsigned*)(p.ws + WS_AU); f32x4* ph = (f32x4*)(p.ws + WS_PH); const int tid = otid();
    for (int it = blockIdx.x; it < 2 * 8 * 64; it += gridDim.x) {
        const int c = it & 63, b = (it >> 6) & 7, d = it >> 9;
        const u32x2* src = (const u32x2*)(au + (size_t)d * M_ * 1024 + (size_t)(b * SEQ + c * 64) * 1024) + tid;
        float h0 = 0.f, h1 = 0.f, P0 = 1.f, P1 = 1.f;
#pragma unroll 16
        for (int s = 0; s < 64; ++s) { const int t = d ? 63 - s : s; const u32x2 w = src[(size_t)t * 512];
            const float a0 = 1.0f - bf_lo(w.x), a1 = 1.0f - bf_lo(w.y); h0 = a0 * h0 + bf_hi(w.x); h1 = a1 * h1 + bf_hi(w.y); P0 *= a0; P1 *= a1; }
        ph[(size_t)((d * 8 + b) * 64 + c) * 512 + tid] = (f32x4){P0, h0, P1, h1};
    }
}
__device__ __forceinline__ void scan_apply(const Params& p) {
    const unsigned* au = (const unsigned*)(p.ws + WS_AU); const f32x4* ph = (const f32x4*)(p.ws + WS_PH);
    const bf16_t* gg = (const bf16_t*)(p.ws + WS_GG); bf16_t* ycat = (bf16_t*)(p.ws + WS_YCAT); const int tid = otid();
    for (int it = blockIdx.x; it < 8 * 64; it += gridDim.x) {
        const int c = it & 63, b = it >> 6;
        float Hf0 = 0.f, Hf1 = 0.f, Hb0 = 0.f, Hb1 = 0.f;
        { const f32x4* pf = ph + (size_t)((0 * 8 + b) * 64) * 512 + tid;
          for (int c0 = 0; c0 < c; c0 += 8) { f32x4 e[8];
#pragma unroll
              for (int j = 0; j < 8; ++j) e[j] = (c0 + j < c) ? pf[(size_t)(c0 + j) * 512] : (f32x4){1.f, 0.f, 1.f, 0.f};
#pragma unroll
              for (int j = 0; j < 8; ++j) { Hf0 = e[j][0] * Hf0 + e[j][1]; Hf1 = e[j][2] * Hf1 + e[j][3]; } }
          const f32x4* pb = ph + (size_t)((1 * 8 + b) * 64) * 512 + tid;
          for (int c0 = 63; c0 > c; c0 -= 8) { f32x4 e[8];
#pragma unroll
              for (int j = 0; j < 8; ++j) e[j] = (c0 - j > c) ? pb[(size_t)(c0 - j) * 512] : (f32x4){1.f, 0.f, 1.f, 0.f};
#pragma unroll
              for (int j = 0; j < 8; ++j) { Hb0 = e[j][0] * Hb0 + e[j][1]; Hb1 = e[j][2] * Hb1 + e[j][3]; } } }
        const size_t r0 = (size_t)(b * SEQ + c * 64);
        const u32x2* s0 = (const u32x2*)(au + r0 * 1024) + tid; const u32x2* s1 = (const u32x2*)(au + (size_t)M_ * 1024 + r0 * 1024) + tid;
        const unsigned* gp = (const unsigned*)(gg + r0 * 1024) + tid; unsigned* yp = (unsigned*)(ycat + r0 * 2048 + 1024) + tid;
        float hf0[64], hf1[64];
#pragma unroll
        for (int t = 0; t < 64; ++t) { const u32x2 w = s0[(size_t)t * 512]; Hf0 = (1.0f - bf_lo(w.x)) * Hf0 + bf_hi(w.x); Hf1 = (1.0f - bf_lo(w.y)) * Hf1 + bf_hi(w.y); hf0[t] = Hf0; hf1[t] = Hf1; }
#pragma unroll
        for (int s = 0; s < 64; ++s) { const int t = 63 - s; const u32x2 w = s1[(size_t)t * 512]; Hb0 = (1.0f - bf_lo(w.x)) * Hb0 + bf_hi(w.x); Hb1 = (1.0f - bf_lo(w.y)) * Hb1 + bf_hi(w.y);
            const unsigned g = gp[(size_t)t * 512];
            yp[(size_t)t * 1024] = cvt_pk_bf16(bf_lo(g) * (hf0[t] + Hb0), bf_hi(g) * (hf1[t] + Hb1)); }
    }
}

__device__ __forceinline__ void grid_bar(unsigned* ctr, unsigned epoch) {
    asm volatile("s_waitcnt vmcnt(0) lgkmcnt(0)" ::: "memory");
    __syncthreads();
    if (otid() == 0) {
        __builtin_amdgcn_fence(__ATOMIC_RELEASE, "agent");
        asm volatile("s_waitcnt vmcnt(0)" ::: "memory");
        __hip_atomic_fetch_add(ctr, 1u, __ATOMIC_RELAXED, __HIP_MEMORY_SCOPE_AGENT);
        const unsigned target = (epoch + 1u) * gridDim.x;
        while (__hip_atomic_load(ctr, __ATOMIC_RELAXED, __HIP_MEMORY_SCOPE_AGENT) < target) __builtin_amdgcn_s_sleep(1);
        __builtin_amdgcn_fence(__ATOMIC_ACQUIRE, "agent");
        asm volatile("s_waitcnt vmcnt(0)" ::: "memory");
    }
    __syncthreads();
}
__global__ void __launch_bounds__(512, 2) mega_fwd(Params p) {
    extern __shared__ __attribute__((aligned(16))) unsigned char lds[];
    cg::grid_group grid = cg::this_grid();
    unsigned char* ws = p.ws;
    LAS unsigned char* ldsl = (LAS unsigned char*)lds;
    bf16_t* hb = (bf16_t*)(ws + WS_HB);
    const float* cosT = (const float*)(ws + WS_COS); const float* sinT = (const float*)(ws + WS_SIN);

    unsigned* bar_ctr = (unsigned*)(ws + WS_BAR);
    fix_t* stats0 = (fix_t*)(ws + WS_ST);
#define stats stats0
    { const int tid = otid();
      for (size_t i = (size_t)blockIdx.x * 512 + tid; i < (size_t)8 * 2 * M_; i += (size_t)gridDim.x * 512) stats[(size_t)2 * M_ + i] = 0ull;
    }
    make_tables(p);
    x_pass(p.in[0], hb, stats);
    grid.sync();
    convert_weights(p, 0, 0, CT6, (float*)lds);
    grid_bar(bar_ctr, 0u);
    colsum_in(p, 0); colsum_up(p, 0);
    grid_bar(bar_ctr, 1u);

#pragma unroll 1
    for (int l = 0; l < DEPTH; ++l) {
        const float* csb = (const float*)(ws + WS_CSB) + (size_t)l * CSB_L;
        fix_t* st0 = (fix_t*)(ws + WS_ST) + (size_t)(2 * l) * 2 * M_; fix_t* st1 = st0 + 2 * M_; fix_t* st2 = st1 + 2 * M_;
        if (l > 0) { colsum_up(p, l); convert_weights(p, l, CT5, CT6, (float*)lds); }
        { pg8::Order S = pg8::make_order(hb, 2048, ws + W_IN, 2048, M_, NINP, 2048);
          EpiIn E{(bf16_t*)(ws + WS_CQ), (bf16_t*)(ws + WS_CKV), (bf16_t*)(ws + WS_XL), (bf16_t*)(ws + WS_GG), (bf16_t*)(ws + WS_KPE), (float*)(ws + WS_SSQ), cosT, sinT, st0, csb + CSB_IN, csb + CSB_IN + NINP};
          pg8::gemm_phase(ldsl, S, E); }
        grid_bar(bar_ctr, 2u + 8u * (unsigned)l + 0u);
        conv_phase(p, l);
        { pg8::Order S = pg8::make_order(ws + WS_CQ, 512, ws + W_UQ, 512, M_, 1536, 512);
          EpiQ E{(bf16_t*)(ws + WS_Q), (const float*)(ws + WS_SSQ), cosT, sinT};
          pg8::gemm_phase(ldsl, S, E); }
        { pg8::Order S = pg8::make_order(ws + WS_CKV, 512, ws + W_UKV, 512, M_, 2048, 512);
          EpiKV E{(bf16_t*)(ws + WS_KV), (const float*)(ws + WS_SSQ)};
          pg8::gemm_phase(ldsl, S, E); }
        grid_bar(bar_ctr, 2u + 8u * (unsigned)l + 1u);
        {
            const bf16_t* Q = (const bf16_t*)(ws + WS_Q); const bf16_t* KV = (const bf16_t*)(ws + WS_KV); const bf16_t* KPE = (const bf16_t*)(ws + WS_KPE); bf16_t* ycat = (bf16_t*)(ws + WS_YCAT);
            const int G = gridDim.x, bx = blockIdx.x;
            for (int L = bx; L < 1024; L += G) {
                int pair, qb;
                if (G == 256) { const int i = L >> 8, c = L & 255, xcd = c & 7, j = c >> 3; pair = i * 16 + xcd * 2 + (j >> 4); qb = j & 15; } else { pair = L >> 4; qb = L & 15; }
                const int b = pair >> 3, h = pair & 7; const size_t row0 = (size_t)b * SEQ + (size_t)qb * 256;
                __syncthreads();
                att::attn_unit(Q + row0 * 1536 + h * 128, Q + row0 * 1536 + 1024 + h * 64, KV + (size_t)b * SEQ * 2048 + h * 256, KPE + (size_t)b * SEQ * 64, ycat + row0 * 2048 + h * 128, SEQ, (char*)lds);
            }
            __syncthreads();
        }
        { pg8::Order S = pg8::make_order(ws + WS_XC, 1024, ws + W_G, 128, M_, 512, 128);
          S.nZ = 8; S.a_z = 128 * 2; S.b_z = (size_t)512 * 128 * 2;
          EpiGate E{(unsigned*)(ws + WS_AU), (const bf16_t*)(ws + WS_XC), p.in[12] + (size_t)l * 2048, p.in[14] + (size_t)l * 2048, (const float*)(ws + WS_SP) + (size_t)l * 2048};
          pg8::gemm_phase(ldsl, S, E); }
        grid_bar(bar_ctr, 2u + 8u * (unsigned)l + 2u);
        scan_local(p);
        if (l + 1 < DEPTH) { __syncthreads(); convert_weights(p, l + 1, 0, CT3, (float*)lds); }
        grid_bar(bar_ctr, 2u + 8u * (unsigned)l + 3u);
        if (l + 1 < DEPTH) colsum_in(p, l + 1);
        scan_apply(p);
        grid_bar(bar_ctr, 2u + 8u * (unsigned)l + 4u);
        { pg8::Order S = pg8::make_order(ws + WS_YCAT, 2048, ws + W_OUT, 2048, M_, 2048, 2048);
          EpiRes E{l == 0 ? p.in[0] : p.out, p.out, hb, st0, l == 0 ? p.in[2] : p.in[21] + (size_t)(l - 1) * 2048, l == 0 ? p.in[3] : p.in[22] + (size_t)(l - 1) * 2048, st1};
          pg8::gemm_phase(ldsl, S, E); }
        grid_bar(bar_ctr, 2u + 8u * (unsigned)l + 5u);
        if (l + 1 < DEPTH) { convert_weights(p, l + 1, CT3, CT4, (float*)lds); }
        { pg8::Order S = pg8::make_order(hb, 2048, ws + W_UP, 2048, M_, DFF, 2048);
          EpiUp E{(bf16_t*)(ws + WS_F), st1, csb + CSB_UP, csb + CSB_UP + DFF}; pg8::gemm_phase(ldsl, S, E); }
        grid_bar(bar_ctr, 2u + 8u * (unsigned)l + 6u);
        if (l + 1 < DEPTH) { convert_weights(p, l + 1, CT4, CT5, (float*)lds); }
        { pg8::Order S = pg8::make_order(ws + WS_F, 8192, ws + W_DN, 8192, M_, 2048, 8192);
          EpiRes E{p.out, p.out, hb, st1, p.in[17] + (size_t)l * 2048, p.in[18] + (size_t)l * 2048, st2};
          pg8::gemm_phase(ldsl, S, E); }
        grid_bar(bar_ctr, 2u + 8u * (unsigned)l + 7u);
    }
    ln_final(p.out, (const fix_t*)(p.ws + WS_ST) + (size_t)(2 * DEPTH) * 2 * M_, p.in[21] + (size_t)(DEPTH - 1) * 2048, p.in[22] + (size_t)(DEPTH - 1) * 2048);
}

extern "C" void kernel_launch(void* const* d_in, const int* in_sizes, int n_in, void* d_out, int out_size, void* d_ws, size_t ws_size, hipStream_t stream) {
    constexpr int LDS_BYTES = pg8::STAGE_BYTES;
    static int grid_blocks = 0;
    if (grid_blocks == 0) {
        if (n_in != 23 || in_sizes[0] != M_ * DM || out_size != M_ * DM || ws_size < WS_END) {
            fprintf(stderr, "kernel_launch: shape mismatch (n_in %d, in0 %d, out %d, ws %zu, need %zu)\n", n_in, n_in > 0 ? in_sizes[0] : -1, out_size, ws_size, (size_t)WS_END); grid_blocks = -1; return; }
        int dev = 0, cus = 0, per_cu = 0;
        hipGetDevice(&dev); hipDeviceGetAttribute(&cus, hipDeviceAttributeMultiprocessorCount, dev);
        if (hipFuncSetAttribute((const void*)mega_fwd, hipFuncAttributeMaxDynamicSharedMemorySize, LDS_BYTES) != hipSuccess) { fprintf(stderr, "kernel_launch: hipFuncSetAttribute failed\n"); grid_blocks = -1; return; }
        if (hipOccupancyMaxActiveBlocksPerMultiprocessor(&per_cu, (const void*)mega_fwd, 512, LDS_BYTES) != hipSuccess || per_cu < 1) { fprintf(stderr, "kernel_launch: occupancy query says %d\n", per_cu); per_cu = 1; }
        (void)hipGetLastError();
        grid_blocks = cus * 1;
    }
    if (grid_blocks < 0) return;
    Params p{};
    for (int i = 0; i < 23; ++i) p.in[i] = (const float*)d_in[i];
    p.out = (float*)d_out; p.ws = (unsigned char*)d_ws;
    (void)hipMemsetAsync((char*)d_ws + WS_BAR, 0, 256, stream);
    void* args[] = {&p};
    hipError_t e = hipLaunchCooperativeKernel((const void*)mega_fwd, dim3(grid_blocks), dim3(512), args, LDS_BYTES, stream);
    if (e != hipSuccess) fprintf(stderr, "kernel_launch: cooperative launch failed: %s (grid %d)\n", hipGetErrorString(e), grid_blocks);
}
```

```cpp
#include <hip/hip_runtime.h>
#include <hip/hip_cooperative_groups.h>
#include <cstdio>
#include <cstdint>
namespace cg = cooperative_groups;

#define LAS __attribute__((address_space(3)))
typedef unsigned short bf16_t;
typedef short bf16x8 __attribute__((ext_vector_type(8)));
typedef short s16x4 __attribute__((ext_vector_type(4)));
typedef float f32x4 __attribute__((ext_vector_type(4)));
typedef float f32x2 __attribute__((ext_vector_type(2)));
typedef float f32x16 __attribute__((ext_vector_type(16)));
typedef unsigned u32x4 __attribute__((ext_vector_type(4)));
typedef unsigned u32x2 __attribute__((ext_vector_type(2)));

constexpr int M_ = 32768, DM = 2048, SEQ = 4096, NBATCH = 8, DEPTH = 4;
constexpr int NIN = 3136, NINP = 3328, DFF = 8192;
constexpr float ALPHA = 1.6817928305074290f;
constexpr float LN_EPS = 1e-5f, RMS_EPS = 1e-6f;
constexpr size_t MiB = 1ull << 20;
constexpr size_t WS_HB = 0;
constexpr size_t WS_W = 128 * MiB;
constexpr size_t W_IN = WS_W, W_UQ = W_IN + (size_t)NINP * 2048 * 2, W_UKV = W_UQ + 1536ull * 512 * 2, W_G = W_UKV + 2048ull * 512 * 2,
                 W_OUT = W_G + 8ull * 512 * 128 * 2, W_UP = W_OUT + 2048ull * 2048 * 2, W_DN = W_UP + 8192ull * 2048 * 2, W_END = W_DN + 8192ull * 2048 * 2;
static_assert(W_END <= 218 * MiB, "weights region");
constexpr size_t WS_COS = 218 * MiB, WS_SIN = 222 * MiB, WS_SP = 226 * MiB;
constexpr size_t WS_CSB = 226 * MiB + 65536;
constexpr int CSB_L = 2 * 3328 + 2 * 8192, CSB_IN = 0, CSB_UP = 2 * 3328;
constexpr size_t WS_BAR = 226 * MiB + 49152;
constexpr size_t WS_ST = 227 * MiB;
constexpr size_t WS_BIG = 232 * MiB;
constexpr size_t WS_F = WS_BIG;
constexpr size_t WS_GG = WS_BIG, WS_XC = WS_BIG + 64 * MiB, WS_YCAT = WS_BIG + 128 * MiB, WS_SSQ = WS_BIG + 256 * MiB, WS_KPE = WS_BIG + 258 * MiB,
                 WS_CQ = WS_BIG + 262 * MiB, WS_CKV = WS_BIG + 294 * MiB, WS_XL = WS_BIG + 326 * MiB, WS_AU = WS_BIG + 262 * MiB  ,
                 WS_Q = WS_BIG + 518 * MiB, WS_KV = WS_BIG + 614 * MiB, WS_PH = WS_BIG + 742 * MiB, WS_END = WS_BIG + 750 * MiB;
static_assert(WS_END <= 1024 * MiB, "workspace");

struct Params { const float* in[23]; float* out; unsigned char* ws; };

__device__ __forceinline__ int otid() { int t = threadIdx.x; asm volatile("" : "+v"(t)); return t; }
__device__ __forceinline__ unsigned cvt_pk_bf16(float lo, float hi) { unsigned r; asm volatile("v_cvt_pk_bf16_f32 %0, %1, %2" : "=v"(r) : "v"(lo), "v"(hi)); return r; }
__device__ __forceinline__ float sum_fq(float x) {
    auto a = __builtin_amdgcn_permlane16_swap(__float_as_uint(x), __float_as_uint(x), false, false); x = __uint_as_float(a[0]) + __uint_as_float(a[1]);
    auto b = __builtin_amdgcn_permlane32_swap(__float_as_uint(x), __float_as_uint(x), false, false); return __uint_as_float(b[0]) + __uint_as_float(b[1]); }
__device__ __forceinline__ float wave_sum(float x, int lane) {
#pragma unroll
    for (int o = 32; o >= 1; o >>= 1) x += __int_as_float(__builtin_amdgcn_ds_bpermute((lane ^ o) << 2, __float_as_int(x)));
    return x; }
__device__ __forceinline__ float bf_lo(unsigned w) { return __uint_as_float(w << 16); }
__device__ __forceinline__ float bf_hi(unsigned w) { return __uint_as_float(w & 0xffff0000u); }
__device__ __forceinline__ float sigmoidf_(float x) { return __builtin_amdgcn_rcpf(1.0f + __builtin_amdgcn_exp2f(-1.4426950408889634f * x)); }
__device__ __forceinline__ float gelu_tanh(float x) { const float z = 0.7978845608028654f * (x + 0.044715f * x * x * x); return x * sigmoidf_(2.0f * z); }
__device__ __forceinline__ u32x4 pack8(const f32x4 a, const f32x4 b) { u32x4 w; w.x = cvt_pk_bf16(a[0], a[1]); w.y = cvt_pk_bf16(a[2], a[3]); w.z = cvt_pk_bf16(b[0], b[1]); w.w = cvt_pk_bf16(b[2], b[3]); return w; }

namespace pg8 {
constexpr int BM = 256, BK = 64, HALF = 128, HTB = HALF * BK * 2, STAGE_BYTES = 8 * HTB, NXCD = 8, WGM = 8;
__host__ __device__ __forceinline__ int lds_byte(int r, int c) { const int st = (r >> 4) * 2 + (c >> 5), rr = r & 15, cc = c & 31, ob = rr * 64 + cc * 2; return st * 1024 + (ob ^ (((ob >> 9) & 1) << 5)); }
__host__ __device__ __forceinline__ void stage_rc(int b, int& R, int& C) { const int st = b / 1024, sb = b % 1024, swz = sb ^ (((sb >> 9) & 1) << 5); R = (st >> 1) * 16 + swz / 64; C = (st & 1) * 32 + (swz % 64) / 2; }
__host__ __device__ __forceinline__ int perm32(int rho) { const int n = rho >> 4, i = rho & 15; return 8 * (i >> 2) + 4 * n + (i & 3); }

struct Unit { int pm, pn, z; };
struct Order {
    int nM, nN, nZ, per, G, c;
    const char* A; const char* B; size_t a_pm, a_z, b_pn, b_z; int lda, ldb, K;
    __device__ __forceinline__ bool next(int i, Unit& u) const {
        const long L = (long)i * G + c; if (L >= (long)per * nZ) return false;
        u.z = (int)(L / per); int wgid = (int)(L % per);
        { const int q = per / NXCD, r = per % NXCD, xcd = wgid % NXCD, off = wgid / NXCD; wgid = (xcd < r ? xcd * (q + 1) : r * (q + 1) + (xcd - r) * q) + off; }
        const int nig = WGM * nN, gid = wgid / nig, fm = gid * WGM, gsz = (nM - fm) < WGM ? (nM - fm) : WGM;
        u.pm = fm + ((wgid % nig) % gsz); u.pn = (wgid % nig) / gsz; return true;
    }
    __device__ __forceinline__ const char* aptr(const Unit& u) const { return A + (size_t)u.pm * a_pm + (size_t)u.z * a_z; }
    __device__ __forceinline__ const char* bptr(const Unit& u) const { return B + (size_t)u.pn * b_pn + (size_t)u.z * b_z; }
};
__device__ __forceinline__ Order make_order(const void* A, int lda, const void* Bt, int ldb, int Mrows, int N, int K) {
    Order o; o.nM = Mrows / BM; o.nN = N / BM; o.nZ = 1; o.per = o.nM * o.nN; o.G = gridDim.x; o.c = blockIdx.x;
    o.A = (const char*)A; o.B = (const char*)Bt; o.a_pm = (size_t)BM * lda * 2; o.a_z = 0; o.b_pn = (size_t)BM * ldb * 2; o.b_z = 0; o.lda = lda; o.ldb = ldb; o.K = K; return o;
}

template <class Epi>
__device__ __forceinline__ void gemm_phase(LAS unsigned char* lds, const Order& S, const Epi& E) {
    const int tid = otid(), wid = __builtin_amdgcn_readfirstlane(tid >> 6), lane = tid & 63, wr = wid >> 2, wc = wid & 3, fr = lane & 15, fq = lane >> 4;
    const int nt = S.K / BK;
    unsigned voffA[2], voffB[2];
#pragma unroll
    for (int i = 0; i < 2; ++i) { int R, C; stage_rc(tid * 16 + i * 8192, R, C); const int Rb = Epi::PERM ? ((R & ~31) + perm32(R & 31)) : R;
        voffA[i] = (unsigned)(R * S.lda + C) * 2u; voffB[i] = (unsigned)(Rb * S.ldb + C) * 2u; }
    const size_t kstep = (size_t)(BK * 2);
    const size_t hstepA = (size_t)HALF * S.lda * 2, hstepB = (size_t)HALF * S.ldb * 2;
    const unsigned ldsw = (unsigned)wid * 1024u;
    const int aoff = lds_byte(wr * 64 + fr, fq * 8), boff = lds_byte(wc * 32 + fr, fq * 8);
#define PG8_SA(b, h) (((b) * 2 + (h)) * HTB)
#define PG8_SB(b, h) ((4 + (b) * 2 + (h)) * HTB)
#define PG8_STAGE(bufoff, gbase, voff) do { _Pragma("unroll") for (int _i = 0; _i < 2; ++_i) \
        __builtin_amdgcn_global_load_lds((const unsigned*)((const char*)(gbase) + (voff)[_i]), (LAS unsigned*)(lds + (bufoff) + ldsw + _i * 8192), 16, 0, 0); } while (0)
#define PG8_LDA(dst, b, h) do { _Pragma("unroll") for (int m = 0; m < 4; ++m) _Pragma("unroll") for (int k = 0; k < 2; ++k) dst[m][k] = *(const LAS bf16x8*)(lds + PG8_SA(b, h) + aoff + m * 2048 + k * 1024); } while (0)
#define PG8_LDB(dst, b, h) do { _Pragma("unroll") for (int n = 0; n < 2; ++n) _Pragma("unroll") for (int k = 0; k < 2; ++k) dst[n][k] = *(const LAS bf16x8*)(lds + PG8_SB(b, h) + boff + n * 2048 + k * 1024); } while (0)
#define PG8_MMA(ai, bj, At, Bt) do { __builtin_amdgcn_s_setprio(1); _Pragma("unroll") for (int m = 0; m < 4; ++m) _Pragma("unroll") for (int n = 0; n < 2; ++n) _Pragma("unroll") for (int k = 0; k < 2; ++k) \
        acc[ai][bj][m][n] = __builtin_amdgcn_mfma_f32_16x16x32_bf16(Bt[n][k], At[m][k], acc[ai][bj][m][n], 0, 0, 0); __builtin_amdgcn_s_setprio(0); } while (0)
#define PG8_WAIT_V(n) asm volatile("s_waitcnt vmcnt(" #n ")" ::: "memory")
#define PG8_WAIT_L(n) asm volatile("s_waitcnt lgkmcnt(" #n ")" ::: "memory")
#define PG8_BAR __builtin_amdgcn_s_barrier()
#define PG8_SCHED __builtin_amdgcn_sched_barrier(0)
    Unit cur, nxt; int ui = 0;
    if (!S.next(0, cur)) return;
    f32x4 acc[2][2][4][2];
#pragma unroll
    for (int a = 0; a < 2; ++a)
#pragma unroll
        for (int b = 0; b < 2; ++b)
#pragma unroll
            for (int m = 0; m < 4; ++m)
#pragma unroll
                for (int n = 0; n < 2; ++n) acc[a][b][m][n] = (f32x4){0.f, 0.f, 0.f, 0.f};
    bf16x8 At[4][2], B0[2][2], B1[2][2];
    const char* cA = S.aptr(cur); const char* cB = S.bptr(cur);
    PG8_STAGE(PG8_SB(0, 0), cB, voffB); PG8_STAGE(PG8_SA(0, 0), cA, voffA); PG8_STAGE(PG8_SB(0, 1), cB + hstepB, voffB); PG8_STAGE(PG8_SA(0, 1), cA + hstepA, voffA);
    if (wr == 1) PG8_BAR;
    PG8_WAIT_V(4); PG8_BAR;
    PG8_STAGE(PG8_SB(1, 0), cB + kstep, voffB); PG8_STAGE(PG8_SA(1, 0), cA + kstep, voffA); PG8_STAGE(PG8_SB(1, 1), cB + hstepB + kstep, voffB);
    PG8_WAIT_V(6); PG8_BAR;
    for (;;) {
        const bool has_next = S.next(ui + 1, nxt);
        const char* nA = has_next ? S.aptr(nxt) : cA; const char* nB = has_next ? S.bptr(nxt) : cB;
        for (int t = 0; t < nt; t += 2) {
            const bool last = (t == nt - 2);
            const char* a1 = cA + (size_t)(t + 1) * kstep;
            const char* a2 = last ? nA : cA + (size_t)(t + 2) * kstep; const char* b2 = last ? nB : cB + (size_t)(t + 2) * kstep;
            const char* a3 = a2 + kstep; const char* b3 = b2 + kstep;
            PG8_LDB(B0, 0, 0); PG8_SCHED; PG8_LDA(At, 0, 0); PG8_STAGE(PG8_SA(1, 1), a1 + hstepA, voffA);
            PG8_WAIT_L(8); PG8_BAR; PG8_WAIT_L(0); PG8_MMA(0, 0, At, B0); PG8_BAR; PG8_SCHED;
            PG8_LDB(B1, 0, 1); PG8_STAGE(PG8_SB(0, 0), b2, voffB);
            PG8_BAR; PG8_WAIT_L(0); PG8_MMA(0, 1, At, B1); PG8_BAR;
            PG8_LDA(At, 0, 1); PG8_STAGE(PG8_SA(0, 0), a2, voffA);
            PG8_BAR; PG8_WAIT_L(0); PG8_MMA(1, 0, At, B0); PG8_BAR; PG8_SCHED;
            PG8_STAGE(PG8_SB(0, 1), b2 + hstepB, voffB);
            PG8_WAIT_V(6); PG8_BAR; PG8_MMA(1, 1, At, B1); PG8_BAR;
            PG8_LDB(B0, 1, 0); PG8_SCHED; PG8_LDA(At, 1, 0); PG8_STAGE(PG8_SA(0, 1), a2 + hstepA, voffA);
            PG8_WAIT_L(8); PG8_BAR; PG8_WAIT_L(0); PG8_MMA(0, 0, At, B0); PG8_BAR; PG8_SCHED;
            PG8_LDB(B1, 1, 1); PG8_STAGE(PG8_SB(1, 0), b3, voffB);
            PG8_BAR; PG8_WAIT_L(0); PG8_MMA(0, 1, At, B1); PG8_BAR;
            PG8_LDA(At, 1, 1); PG8_STAGE(PG8_SA(1, 0), a3, voffA);
            PG8_BAR; PG8_WAIT_L(0); PG8_MMA(1, 0, At, B0); PG8_BAR; PG8_SCHED;
            PG8_STAGE(PG8_SB(1, 1), b3 + hstepB, voffB);
            PG8_WAIT_V(6); PG8_BAR; PG8_MMA(1, 1, At, B1); PG8_BAR;
        }
        E(acc, cur, wr, wc, fr, fq);
        if (!has_next) break;
#pragma unroll
        for (int a = 0; a < 2; ++a)
#pragma unroll
            for (int b = 0; b < 2; ++b)
#pragma unroll
                for (int m = 0; m < 4; ++m)
#pragma unroll
                    for (int n = 0; n < 2; ++n) acc[a][b][m][n] = (f32x4){0.f, 0.f, 0.f, 0.f};
        cur = nxt; cA = nA; cB = nB; ++ui;
    }
    PG8_WAIT_V(0);
    if (wr == 0) PG8_BAR;
    PG8_BAR;
#undef PG8_SA
#undef PG8_SB
#undef PG8_STAGE
#undef PG8_LDA
#undef PG8_LDB
#undef PG8_MMA
#undef PG8_WAIT_V
#undef PG8_WAIT_L
#undef PG8_BAR
#undef PG8_SCHED
}
}
using pg8::Unit;
typedef f32x4 Acc[2][2][4][2];

typedef unsigned long long fix_t;
__device__ __forceinline__ fix_t to_fix(float v) { return (fix_t)(long long)(v * 4294967296.0f); }
__device__ __forceinline__ float from_fix(fix_t v) { return fmaf((float)(unsigned)v, 2.3283064365386963e-10f, (float)(int)(v >> 32)); }
__device__ __forceinline__ void fix_add(fix_t* p, float v) { __hip_atomic_fetch_add(p, to_fix(v), __ATOMIC_RELAXED, __HIP_MEMORY_SCOPE_AGENT); }
__device__ __forceinline__ f32x4 ld_fix4(const fix_t* p) { typedef unsigned long long u64x2 __attribute__((ext_vector_type(2))); const u64x2 a = *(const u64x2*)p, b = *(const u64x2*)(p + 2);
    return (f32x4){from_fix(a.x), from_fix(a.y), from_fix(b.x), from_fix(b.y)}; }
__device__ __forceinline__ void row_ln(const fix_t* st, int row, float& mu, float& rs) { const float s1 = from_fix(st[row]), s2 = from_fix(st[M_ + row]); mu = s1 * (1.0f / 2048.0f); rs = __builtin_amdgcn_rsqf(s2 * (1.0f / 2048.0f) - mu * mu + LN_EPS); }
template <bool PERM>
__device__ __forceinline__ void ln_correct(f32x4 (&acc)[2][2][4][2], const fix_t* st, const float* cs, const float* bw, int row0, int colbase) {
    f32x4 c4[2][2], b4[2][2];
#pragma unroll
    for (int bj = 0; bj < 2; ++bj)
#pragma unroll
        for (int n = 0; n < 2; ++n) { const int col = colbase + bj * 128 + (PERM ? 4 * n : 16 * n); c4[bj][n] = *(const f32x4*)(cs + col); b4[bj][n] = *(const f32x4*)(bw + col); }
#pragma unroll
    for (int ai = 0; ai < 2; ++ai) { fix_t r1[4], r2[4];
#pragma unroll
        for (int m = 0; m < 4; ++m) { const int row = row0 + ai * 128 + m * 16; r1[m] = st[row]; r2[m] = st[M_ + row]; }
#pragma unroll
        for (int m = 0; m < 4; ++m) { const float mu = from_fix(r1[m]) * (1.0f / 2048.0f), rs = __builtin_amdgcn_rsqf(from_fix(r2[m]) * (1.0f / 2048.0f) - mu * mu + LN_EPS);
#pragma unroll
            for (int bj = 0; bj < 2; ++bj)
#pragma unroll
                for (int n = 0; n < 2; ++n) acc[ai][bj][m][n] = (acc[ai][bj][m][n] - c4[bj][n] * mu) * rs + b4[bj][n]; } }
}

struct EpiIn {
    static constexpr bool PERM = true;
    bf16_t *cq, *ckv, *xl, *gg, *kpe; float* ssq; const float *cosT, *sinT; const fix_t* st; const float *cs, *bw;
    __device__ __forceinline__ void operator()(Acc& acc, const Unit& u, int wr, int wc, int fr, int fq) const {
        const int row0 = u.pm * 256 + wr * 64 + fr, pn = u.pn;
        ln_correct<true>(acc, st, cs, bw, row0, pn * 256 + wc * 32 + 8 * fq);
        if (pn < 4) {
            bf16_t* base = (pn < 2 ? cq : ckv); const int col0 = (pn & 1) * 256 + wc * 32 + 8 * fq;
#pragma unroll
            for (int ai = 0; ai < 2; ++ai)
#pragma unroll
                for (int m = 0; m < 4; ++m) { const int row = row0 + ai * 128 + m * 16; float s = 0.f;
#pragma unroll
                    for (int bj = 0; bj < 2; ++bj) { const f32x4 v0 = acc[ai][bj][m][0], v1 = acc[ai][bj][m][1];
                        s += (v0[0] * v0[0] + v0[1] * v0[1]) + (v0[2] * v0[2] + v0[3] * v0[3]) + (v1[0] * v1[0] + v1[1] * v1[1]) + (v1[2] * v1[2] + v1[3] * v1[3]);
                        *(u32x4*)(base + (size_t)row * 512 + col0 + bj * 128) = pack8(v0, v1); }
                    s = sum_fq(s);
                    if (fq == 0) ssq[(size_t)row * 16 + pn * 4 + wc] = s; }
        } else if (pn < 8) {
            const int col0 = (pn - 4) * 256 + wc * 32 + 8 * fq;
#pragma unroll
            for (int ai = 0; ai < 2; ++ai)
#pragma unroll
                for (int m = 0; m < 4; ++m) { const int row = row0 + ai * 128 + m * 16;
#pragma unroll
                    for (int bj = 0; bj < 2; ++bj) *(u32x4*)(xl + (size_t)row * 1024 + col0 + bj * 128) = pack8(acc[ai][bj][m][0], acc[ai][bj][m][1]); }
        } else if (pn < 12) {
            const int col0 = (pn - 8) * 256 + wc * 32 + 8 * fq;
#pragma unroll
            for (int ai = 0; ai < 2; ++ai)
#pragma unroll
                for (int m = 0; m < 4; ++m) { const int row = row0 + ai * 128 + m * 16;
#pragma unroll
                    for (int bj = 0; bj < 2; ++bj) { f32x4 v0 = acc[ai][bj][m][0], v1 = acc[ai][bj][m][1];
#pragma unroll
                        for (int j = 0; j < 4; ++j) { v0[j] = gelu_tanh(v0[j]); v1[j] = gelu_tanh(v1[j]); }
                        *(u32x4*)(gg + (size_t)row * 1024 + col0 + bj * 128) = pack8(v0, v1); } }
        } else if (wc == 0) {
#pragma unroll
            for (int ai = 0; ai < 2; ++ai) { f32x4 c0[4], c1[4], s0[4], s1[4];
#pragma unroll
                for (int m = 0; m < 4; ++m) { const size_t t = (size_t)(row0 + ai * 128 + m * 16) * 32 + 8 * fq;
                    c0[m] = *(const f32x4*)(cosT + t); c1[m] = *(const f32x4*)(cosT + t + 4); s0[m] = *(const f32x4*)(sinT + t); s1[m] = *(const f32x4*)(sinT + t + 4); }
#pragma unroll
                for (int m = 0; m < 4; ++m) { const int row = row0 + ai * 128 + m * 16;
                    const f32x4 a0 = acc[ai][0][m][0], a1 = acc[ai][0][m][1], b0 = acc[ai][1][m][0], b1 = acc[ai][1][m][1];
                    *(u32x4*)(kpe + (size_t)row * 64 + 8 * fq) = pack8(a0 * c0[m] - b0 * s0[m], a1 * c1[m] - b1 * s1[m]);
                    *(u32x4*)(kpe + (size_t)row * 64 + 32 + 8 * fq) = pack8(b0 * c0[m] + a0 * s0[m], b1 * c1[m] + a1 * s1[m]); } }
        }
    }
};
__device__ __forceinline__ void rows_rstd(const float* ssq8, int row0, float (&rs)[8]) {
#pragma unroll
    for (int h = 0; h < 2; ++h) { f32x4 a[4], b[4];
#pragma unroll
        for (int k = 0; k < 4; ++k) { const float* p = ssq8 + (size_t)(row0 + h * 128 + k * 16) * 16; a[k] = *(const f32x4*)p; b[k] = *(const f32x4*)(p + 4); }
#pragma unroll
        for (int k = 0; k < 4; ++k) { const float s = ((a[k][0] + a[k][1]) + (a[k][2] + a[k][3])) + ((b[k][0] + b[k][1]) + (b[k][2] + b[k][3])); rs[h * 4 + k] = __builtin_amdgcn_rsqf(s * (1.0f / 512.0f) + RMS_EPS); } }
}
struct EpiQ {
    static constexpr bool PERM = true;
    bf16_t* q; const float* ssq; const float *cosT, *sinT;
    __device__ __forceinline__ void operator()(Acc& acc, const Unit& u, int wr, int wc, int fr, int fq) const {
        const int row0 = u.pm * 256 + wr * 64 + fr, pn = u.pn;
        float rs[8]; rows_rstd(ssq, row0, rs);
        if (pn < 4) {
            const int col0 = pn * 256 + wc * 32 + 8 * fq;
#pragma unroll
            for (int ai = 0; ai < 2; ++ai)
#pragma unroll
                for (int m = 0; m < 4; ++m) { const int row = row0 + ai * 128 + m * 16; const float r = rs[ai * 4 + m];
#pragma unroll
                    for (int bj = 0; bj < 2; ++bj) *(u32x4*)(q + (size_t)row * 1536 + col0 + bj * 128) = pack8(acc[ai][bj][m][0] * r, acc[ai][bj][m][1] * r); }
        } else {
            const int head = 4 * (pn - 4) + wc;
#pragma unroll
            for (int kb = 0; kb < 4; ++kb) { f32x4 c0[2], c1[2], s0[2], s1[2];
#pragma unroll
                for (int j = 0; j < 2; ++j) { const int k = kb * 2 + j; const size_t t = (size_t)(row0 + (k >> 2) * 128 + (k & 3) * 16) * 32 + 8 * fq;
                    c0[j] = *(const f32x4*)(cosT + t); c1[j] = *(const f32x4*)(cosT + t + 4); s0[j] = *(const f32x4*)(sinT + t); s1[j] = *(const f32x4*)(sinT + t + 4); }
#pragma unroll
                for (int j = 0; j < 2; ++j) { const int k = kb * 2 + j, ai = k >> 2, m = k & 3; const int row = row0 + ai * 128 + m * 16; const float r = rs[k];
                    const f32x4 a0 = acc[ai][0][m][0] * r, a1 = acc[ai][0][m][1] * r, b0 = acc[ai][1][m][0] * r, b1 = acc[ai][1][m][1] * r;
                    *(u32x4*)(q + (size_t)row * 1536 + 1024 + head * 64 + 8 * fq) = pack8(a0 * c0[j] - b0 * s0[j], a1 * c1[j] - b1 * s1[j]);
                    *(u32x4*)(q + (size_t)row * 1536 + 1024 + head * 64 + 32 + 8 * fq) = pack8(b0 * c0[j] + a0 * s0[j], b1 * c1[j] + a1 * s1[j]); } }
        }
    }
};
struct EpiKV {
    static constexpr bool PERM = true;
    bf16_t* kv; const float* ssq;
    __device__ __forceinline__ void operator()(Acc& acc, const Unit& u, int wr, int wc, int fr, int fq) const {
        const int row0 = u.pm * 256 + wr * 64 + fr, col0 = u.pn * 256 + wc * 32 + 8 * fq;
        float rs[8]; rows_rstd(ssq + 8, row0, rs);
#pragma unroll
        for (int ai = 0; ai < 2; ++ai)
#pragma unroll
            for (int m = 0; m < 4; ++m) { const int row = row0 + ai * 128 + m * 16; const float r = rs[ai * 4 + m];
#pragma unroll
                for (int bj = 0; bj < 2; ++bj) *(u32x4*)(kv + (size_t)row * 2048 + col0 + bj * 128) = pack8(acc[ai][bj][m][0] * r, acc[ai][bj][m][1] * r); }
    }
};
struct EpiGate {
    static constexpr bool PERM = true;
    unsigned* au; const bf16_t* xc; const float *ba, *bi, *sp;
    __device__ __forceinline__ void operator()(Acc& acc, const Unit& u, int wr, int wc, int fr, int fq) const {
        const int row0 = u.pm * 256 + wr * 64 + fr, d = u.pn, ch0 = u.z * 128 + wc * 32 + 8 * fq;
        unsigned* aud = au + (size_t)d * M_ * 1024;
#pragma unroll
        for (int n = 0; n < 2; ++n) {
            const int ch = ch0 + 4 * n;
            const f32x4 bav = *(const f32x4*)(ba + d * 1024 + ch), biv = *(const f32x4*)(bi + d * 1024 + ch), spv = *(const f32x4*)(sp + d * 1024 + ch) * (-8.0f * 1.4426950408889634f);
            u32x2 xws[8];
#pragma unroll
            for (int k = 0; k < 8; ++k) xws[k] = *(const u32x2*)(xc + (size_t)(row0 + (k >> 2) * 128 + (k & 3) * 16) * 1024 + ch);
#pragma unroll
            for (int ai = 0; ai < 2; ++ai)
#pragma unroll
                for (int m = 0; m < 4; ++m) { const int row = row0 + ai * 128 + m * 16;
                    const u32x2 xw = xws[ai * 4 + m];
                    const float xv[4] = {bf_lo(xw.x), bf_hi(xw.x), bf_lo(xw.y), bf_hi(xw.y)};
                    u32x4 o;
#pragma unroll
                    for (int j = 0; j < 4; ++j) {
                        const float r = sigmoidf_(acc[ai][0][m][n][j] + bav[j]);
                        const float ig = sigmoidf_(acc[ai][1][m][n][j] + biv[j]);
                        const float a = __builtin_amdgcn_exp2f(r * spv[j]);
                        const float oma = 1.0f - a;
                        const float uu = __builtin_amdgcn_sqrtf(oma * (1.0f + a)) * ig * xv[j];
                        o[j] = cvt_pk_bf16(oma, uu); }
                    *(u32x4*)(aud + (size_t)row * 1024 + ch) = o; }
        }
    }
};
#ifndef RES_PF
#define RES_PF 1
#endif
struct EpiRes {
    static constexpr bool PERM = false;
    const float* src; float* out; bf16_t* hb; const fix_t* st_old; const float *g, *b; fix_t* st_new;
    __device__ __forceinline__ void operator()(Acc& acc, const Unit& u, int wr, int wc, int fr, int fq) const {
        const int row0 = u.pm * 256 + wr * 64 + fr, col0 = u.pn * 256 + wc * 32 + 4 * fq;
        f32x4 gv[4], bv[4], P[RES_PF + 1][4]; float mus[8], rss[8];
#pragma unroll
        for (int h = 0; h < 2; ++h) { fix_t r1[4], r2[4];
#pragma unroll
            for (int k = 0; k < 4; ++k) { const int row = row0 + h * 128 + k * 16; r1[k] = st_old[row]; r2[k] = st_old[M_ + row]; }
#pragma unroll
            for (int k = 0; k < 4; ++k) { mus[h * 4 + k] = from_fix(r1[k]) * (1.0f / 2048.0f); rss[h * 4 + k] = __builtin_amdgcn_rsqf(from_fix(r2[k]) * (1.0f / 2048.0f) - mus[h * 4 + k] * mus[h * 4 + k] + LN_EPS); } }
#pragma unroll
        for (int c = 0; c < 4; ++c) { gv[c] = *(const f32x4*)(g + col0 + (c >> 1) * 128 + (c & 1) * 16); bv[c] = *(const f32x4*)(b + col0 + (c >> 1) * 128 + (c & 1) * 16); }
#define RES_LOAD(k) do { const size_t off_ = (size_t)(row0 + ((k) >> 2) * 128 + ((k) & 3) * 16) * 2048 + col0; _Pragma("unroll") for (int c = 0; c < 4; ++c) P[(k) % (RES_PF + 1)][c] = *(const f32x4*)(src + off_ + (c >> 1) * 128 + (c & 1) * 16); } while (0)
#pragma unroll
        for (int k = 0; k < RES_PF; ++k) RES_LOAD(k);
#pragma unroll
        for (int k = 0; k < 8; ++k) {
            if (k + RES_PF < 8) RES_LOAD(k + RES_PF);
            const int ai = k >> 2, m = k & 3; const size_t off = (size_t)(row0 + ai * 128 + m * 16) * 2048 + col0;
            const float mu = mus[k], rs = rss[k];
            float a1 = 0.f, a2 = 0.f;
#pragma unroll
            for (int c = 0; c < 4; ++c) { const int cc = (c >> 1) * 128 + (c & 1) * 16;
                const f32x4 v = ((P[k % (RES_PF + 1)][c] - mu) * rs * gv[c] + bv[c]) * ALPHA + acc[ai][c >> 1][m][c & 1];
                *(f32x4*)(out + off + cc) = v; u32x2 w; w.x = cvt_pk_bf16(v[0], v[1]); w.y = cvt_pk_bf16(v[2], v[3]); *(u32x2*)(hb + off + cc) = w;
                a1 += (v[0] + v[1]) + (v[2] + v[3]); a2 += (v[0] * v[0] + v[1] * v[1]) + (v[2] * v[2] + v[3] * v[3]); }
            a1 = sum_fq(a1); a2 = sum_fq(a2);
            { const int row = row0 + ai * 128 + m * 16; if (fq == 0) fix_add(st_new + row, a1); else if (fq == 1) fix_add(st_new + M_ + row, a2); }
        }
#undef RES_LOAD
    }
};
struct EpiUp {
    static constexpr bool PERM = true;
    bf16_t* f; const fix_t* st; const float *cs, *bw;
    __device__ __forceinline__ void operator()(Acc& acc, const Unit& u, int wr, int wc, int fr, int fq) const {
        const int row0 = u.pm * 256 + wr * 64 + fr, col0 = u.pn * 256 + wc * 32 + 8 * fq;
        ln_correct<true>(acc, st, cs, bw, row0, col0);
#pragma unroll
        for (int ai = 0; ai < 2; ++ai)
#pragma unroll
            for (int m = 0; m < 4; ++m) { const int row = row0 + ai * 128 + m * 16;
#pragma unroll
                for (int bj = 0; bj < 2; ++bj) { f32x4 v0 = acc[ai][bj][m][0], v1 = acc[ai][bj][m][1];
#pragma unroll
                    for (int j = 0; j < 4; ++j) { const float a = fmaxf(v0[j], 0.f), b = fmaxf(v1[j], 0.f); v0[j] = a * a; v1[j] = b * b; }
                    *(u32x4*)(f + (size_t)row * 8192 + col0 + bj * 128) = pack8(v0, v1); } }
    }
};

namespace att {
constexpr int NW = 8, QBLK = 32, KVBLK = 64;
constexpr float SCALE = 0.07216878364870323f;
constexpr float THR = 8.f;
#ifndef ATT_SDEPTH
#define ATT_SDEPTH 1
#endif
constexpr int SDEPTH = ATT_SDEPTH;
constexpr int SHM_V = KVBLK * 128 * 2, SHM_K = KVBLK * 128 * 2, SHM_R = KVBLK * 64 * 2;
constexpr int OFF_V = 0, OFF_K = 2 * SHM_V, OFF_R = OFF_K + 2 * SHM_K, OFF_WS = OFF_R + 2 * SHM_R, OFF_QR = OFF_WS + NW * 64 * 4, SHM_ATTN = OFF_QR + 256 * 128;
#define KSWZ(row, colB) ((row) * 256 + ((colB) ^ (((row) & 7) << 4)))
#define RSWZ(row, colB) ((row) * 128 + ((colB) ^ (((row) & 7) << 4)))
#define SBAR() __builtin_amdgcn_sched_barrier(0)
__device__ __forceinline__ int crow(int r, int hi) { return (r & 3) + 8 * (r >> 2) + 4 * hi; }
__device__ __forceinline__ void partialSM(f32x16& p0, f32x16& p1, float& m_reg, float& mn, float& alpha) {
    constexpr float C = SCALE * 1.4426950408889634f;
    float pmax = p0[0];
#pragma unroll
    for (int r = 1; r < 16; ++r) pmax = fmaxf(pmax, p0[r]);
#pragma unroll
    for (int r = 0; r < 16; ++r) pmax = fmaxf(pmax, p1[r]);
    { auto rr = __builtin_amdgcn_permlane32_swap(__float_as_uint(pmax), __float_as_uint(pmax), false, false);
      pmax = fmaxf(__uint_as_float(rr[0]), __uint_as_float(rr[1])); }
    if (__builtin_expect(__all(pmax - m_reg <= THR / SCALE), 1)) { mn = m_reg; alpha = 1.f; }
    else { mn = fmaxf(m_reg, pmax); alpha = __builtin_amdgcn_exp2f((m_reg - mn) * C); m_reg = mn; }
    const float mnC = -mn * C;
#pragma unroll
    for (int r = 0; r < 16; ++r) p0[r] = fmaf(p0[r], C, mnC);
#pragma unroll
    for (int r = 0; r < 16; ++r) p1[r] = fmaf(p1[r], C, mnC);
#pragma unroll
    for (int r = 0; r < 16; ++r) p0[r] = __builtin_amdgcn_exp2f(p0[r]);
}
__device__ __forceinline__ void finishSM(f32x16& p0, f32x16& p1, float alpha, float& l_reg, bf16x8& pa0, bf16x8& pa1, bf16x8& pa2, bf16x8& pa3) {
#pragma unroll
    for (int r = 0; r < 16; ++r) p1[r] = __builtin_amdgcn_exp2f(p1[r]);
    float ps = 0;
#pragma unroll
    for (int r = 0; r < 16; ++r) ps += p0[r];
#pragma unroll
    for (int r = 0; r < 16; ++r) ps += p1[r];
    { auto rr = __builtin_amdgcn_permlane32_swap(__float_as_uint(ps), __float_as_uint(ps), false, false);
      ps = __uint_as_float(rr[0]) + __uint_as_float(rr[1]); }
    l_reg = l_reg * alpha + ps;
#define PK4(P, BASE, OUT) do { unsigned a0 = cvt_pk_bf16(P[BASE + 0], P[BASE + 1]), a1 = cvt_pk_bf16(P[BASE + 2], P[BASE + 3]);   \
    unsigned b0 = cvt_pk_bf16(P[BASE + 4], P[BASE + 5]), b1 = cvt_pk_bf16(P[BASE + 6], P[BASE + 7]);                              \
    auto r0 = __builtin_amdgcn_permlane32_swap(a0, b0, false, false); auto r1 = __builtin_amdgcn_permlane32_swap(a1, b1, false, false); \
    u32x4 w = {r0[0], r1[0], r0[1], r1[1]}; OUT = *reinterpret_cast<bf16x8*>(&w); } while (0)
    PK4(p0, 0, pa0); PK4(p0, 8, pa1); PK4(p1, 0, pa2); PK4(p1, 8, pa3);
#undef PK4
}
__device__ __forceinline__ void qkt(f32x16& p0, f32x16& p1, const char* Ks, const char* Rs, const bf16x8* qr, const char* Qrl, int r32, int hi) {
    p0 = f32x16{}; p1 = f32x16{};
#pragma unroll
    for (int d0 = 0; d0 < 8; ++d0) { const int cb = (d0 * 16 + hi * 8) * 2;
        const bf16x8 b0 = *reinterpret_cast<const bf16x8*>(Ks + KSWZ(r32, cb));
        const bf16x8 b1 = *reinterpret_cast<const bf16x8*>(Ks + KSWZ(32 + r32, cb));
        p0 = __builtin_amdgcn_mfma_f32_32x32x16_bf16(b0, qr[d0], p0, 0, 0, 0);
        p1 = __builtin_amdgcn_mfma_f32_32x32x16_bf16(b1, qr[d0], p1, 0, 0, 0); }
#pragma unroll
    for (int d0 = 0; d0 < 4; ++d0) { const int cb = (d0 * 16 + hi * 8) * 2;
        const bf16x8 b0 = *reinterpret_cast<const bf16x8*>(Rs + RSWZ(r32, cb));
        const bf16x8 b1 = *reinterpret_cast<const bf16x8*>(Rs + RSWZ(32 + r32, cb));
        const bf16x8 qv = *reinterpret_cast<const bf16x8*>(Qrl + (cb ^ ((r32 & 7) << 4)));
        p0 = __builtin_amdgcn_mfma_f32_32x32x16_bf16(b0, qv, p0, 0, 0, 0);
        p1 = __builtin_amdgcn_mfma_f32_32x32x16_bf16(b1, qv, p1, 0, 0, 0); }
}
__device__ __forceinline__ int v_st(int k, int c) { const int kk = (k & ~0xC) | ((k & 4) << 1) | ((k & 8) >> 1); return ((kk >> 3) * 4 + (c >> 5)) * 512 + ((kk & 7) * 32 + (c & 31)) * 2; }
__device__ __forceinline__ int v_rd_base(int lane) { return ((lane & 3) << 3) | (((lane >> 2) & 3) << 6) | (((lane >> 4) & 1) << 5) | (((lane >> 5) & 1) << 8); }
constexpr int v_rd_off(int d0, int ks, int half) { return d0 * 512 + ks * 4096 + half * 2048; }
template <int OFF> __device__ __forceinline__ s16x4 tr_read(int vb) {
    s16x4 r; asm volatile("ds_read_b64_tr_b16 %0, %1 offset:%2" : "=&v"(r) : "v"(vb), "i"(OFF) : "memory"); return r;
}
template <int D0> __device__ __forceinline__ void pv_one(f32x16& od, int vb, bf16x8 pa0, bf16x8 pa1, bf16x8 pa2, bf16x8 pa3) {
    const s16x4 l0 = tr_read<v_rd_off(D0, 0, 0)>(vb), h0 = tr_read<v_rd_off(D0, 0, 1)>(vb), l1 = tr_read<v_rd_off(D0, 1, 0)>(vb), h1 = tr_read<v_rd_off(D0, 1, 1)>(vb);
    const s16x4 l2 = tr_read<v_rd_off(D0, 2, 0)>(vb), h2 = tr_read<v_rd_off(D0, 2, 1)>(vb), l3 = tr_read<v_rd_off(D0, 3, 0)>(vb), h3 = tr_read<v_rd_off(D0, 3, 1)>(vb);
    asm volatile("s_waitcnt lgkmcnt(0)" ::: "memory"); SBAR();
#define PK(L, H) (bf16x8){L[0], L[1], L[2], L[3], H[0], H[1], H[2], H[3]}
    od = __builtin_amdgcn_mfma_f32_32x32x16_bf16(pa0, PK(l0, h0), od, 0, 0, 0);
    od = __builtin_amdgcn_mfma_f32_32x32x16_bf16(pa1, PK(l1, h1), od, 0, 0, 0);
    od = __builtin_amdgcn_mfma_f32_32x32x16_bf16(pa2, PK(l2, h2), od, 0, 0, 0);
    od = __builtin_amdgcn_mfma_f32_32x32x16_bf16(pa3, PK(l3, h3), od, 0, 0, 0);
#undef PK
}
__device__ __forceinline__ void pv_d0(f32x16* o, int vb, bf16x8 pa0, bf16x8 pa1, bf16x8 pa2, bf16x8 pa3) {
    pv_one<0>(o[0], vb, pa0, pa1, pa2, pa3); pv_one<1>(o[1], vb, pa0, pa1, pa2, pa3); pv_one<2>(o[2], vb, pa0, pa1, pa2, pa3); pv_one<3>(o[3], vb, pa0, pa1, pa2, pa3);
}
__device__ __forceinline__ void attn_unit(const bf16_t* __restrict__ Qn, const bf16_t* __restrict__ Qr, const bf16_t* __restrict__ Kh, const bf16_t* __restrict__ Rh,
                                          bf16_t* __restrict__ Ob, int seq, char* lds) {
    const int tid = otid(), wid = tid >> 6, lane = tid & 63, r32 = lane & 31, hi = lane >> 5;
    char* V_lds = lds + OFF_V; char* K_lds = lds + OFF_K; char* R_lds = lds + OFF_R;
    float* ws = (float*)(lds + OFF_WS) + wid * 64; float* li_l = ws; float* al_l = ws + 32;
    float m_reg = -1e30f, l_reg = 0; f32x16 o[4] = {}; bf16x8 qr[8];
    char* Qrl = lds + OFF_QR + (wid * QBLK + r32) * 128;
    {
        const bf16_t* Qw = Qn + (size_t)(wid * QBLK + r32) * 1536 + hi * 8;
#pragma unroll
        for (int d0 = 0; d0 < 8; ++d0) qr[d0] = *reinterpret_cast<const bf16x8*>(Qw + d0 * 16);
        const bf16_t* Qw2 = Qr + (size_t)(wid * QBLK + r32) * 1536 + hi * 8;
#pragma unroll
        for (int d0 = 0; d0 < 4; ++d0) { const bf16x8 t = *reinterpret_cast<const bf16x8*>(Qw2 + d0 * 16); *reinterpret_cast<bf16x8*>(Qrl + (((d0 * 16 + hi * 8) * 2) ^ ((r32 & 7) << 4))) = t; }
    }
    const int sr = tid >> 4, sc = (tid & 15) * 8, vst0 = v_st(sr, sc), vst1 = v_st(32 + sr, sc);
    const int rr_ = tid >> 3, rc = (tid & 7) * 8;
    const int vb0 = (int)(uintptr_t)V_lds + v_rd_base(lane);
    struct { bf16x8 vs0, vs1, ks0, ks1, rs; } sr_[SDEPTH];
#define SLOAD(i, k0) do { sr_[i].vs0 = *(const bf16x8*)(&Kh[(size_t)((k0) + sr) * 2048 + 128 + sc]); sr_[i].vs1 = *(const bf16x8*)(&Kh[(size_t)((k0) + 32 + sr) * 2048 + 128 + sc]); \
    sr_[i].ks0 = *(const bf16x8*)(&Kh[(size_t)((k0) + sr) * 2048 + sc]); sr_[i].ks1 = *(const bf16x8*)(&Kh[(size_t)((k0) + 32 + sr) * 2048 + sc]); \
    sr_[i].rs = *(const bf16x8*)(&Rh[(size_t)((k0) + rr_) * 64 + rc]); } while (0)
#define SWRITE(b, i) do { *(bf16x8*)(V_lds + (b) * SHM_V + vst0) = sr_[i].vs0;          \
    *(bf16x8*)(V_lds + (b) * SHM_V + vst1) = sr_[i].vs1; const int kc = sc * 2;               \
    *(bf16x8*)(K_lds + (b) * SHM_K + KSWZ(sr, kc)) = sr_[i].ks0;                       \
    *(bf16x8*)(K_lds + (b) * SHM_K + KSWZ(32 + sr, kc)) = sr_[i].ks1;                  \
    *(bf16x8*)(R_lds + (b) * SHM_R + RSWZ(rr_, rc * 2)) = sr_[i].rs; } while (0)
#define SWAIT() do { if constexpr (SDEPTH == 2) asm volatile("s_waitcnt vmcnt(5)" ::: "memory"); else asm volatile("s_waitcnt vmcnt(0)" ::: "memory"); } while (0)
#define RESC(a) do { if (__any((a) < 1.f)) { if (hi == 0) al_l[r32] = (a); asm volatile("s_waitcnt lgkmcnt(0)" ::: "memory"); \
    _Pragma("unroll") for (int d = 0; d < 4; ++d) _Pragma("unroll") for (int r = 0; r < 16; ++r) o[d][r] *= al_l[crow(r, hi)]; } } while (0)
    f32x16 pA0, pA1, pB0, pB1; float mnA, mnB, alA, alB; bf16x8 pa0, pa1, pa2, pa3; const int NT = seq / KVBLK;
    constexpr int SE = 0, SO = SDEPTH - 1;
    SLOAD(SE, 0); asm volatile("s_waitcnt vmcnt(0)" ::: "memory"); SWRITE(0, SE); __syncthreads();
    qkt(pA0, pA1, K_lds, R_lds, qr, Qrl, r32, hi); partialSM(pA0, pA1, m_reg, mnA, alA);
    SLOAD(SO, KVBLK); if constexpr (SDEPTH == 2) { if (2 < NT) SLOAD(SE, 2 * KVBLK); }
    SWAIT(); SWRITE(1, SO); __syncthreads();
    for (int j = 1; j + 1 < NT; j += 2) {
        SBAR(); qkt(pB0, pB1, K_lds + SHM_K, R_lds + SHM_R, qr, Qrl, r32, hi);
        finishSM(pA0, pA1, alA, l_reg, pa0, pa1, pa2, pa3); SBAR();
        SLOAD(SO, (j + SDEPTH) * KVBLK); SBAR();
        pv_d0(o, vb0, pa0, pa1, pa2, pa3); partialSM(pB0, pB1, m_reg, mnB, alB);
        __syncthreads(); SWAIT(); SWRITE(0, SE);
        RESC(alB); __syncthreads();
        SBAR(); qkt(pA0, pA1, K_lds, R_lds, qr, Qrl, r32, hi);
        finishSM(pB0, pB1, alB, l_reg, pa0, pa1, pa2, pa3); SBAR();
        if (SDEPTH == 1 || j + 3 < NT) SLOAD(SE, (j + 1 + SDEPTH) * KVBLK); SBAR();
        pv_d0(o, vb0 + (int)SHM_V, pa0, pa1, pa2, pa3); partialSM(pA0, pA1, m_reg, mnA, alA);
        __syncthreads(); SWAIT(); SWRITE(1, SO);
        RESC(alA); __syncthreads();
    }
    SBAR(); qkt(pB0, pB1, K_lds + SHM_K, R_lds + SHM_R, qr, Qrl, r32, hi);
    finishSM(pA0, pA1, alA, l_reg, pa0, pa1, pa2, pa3); SBAR();
    pv_d0(o, vb0, pa0, pa1, pa2, pa3); partialSM(pB0, pB1, m_reg, mnB, alB);
    __syncthreads(); RESC(alB);
    finishSM(pB0, pB1, alB, l_reg, pa0, pa1, pa2, pa3); SBAR();
    pv_d0(o, vb0 + (int)SHM_V, pa0, pa1, pa2, pa3);
    if (hi == 0) li_l[r32] = l_reg; asm volatile("s_waitcnt lgkmcnt(0)" ::: "memory");
    float rli[16];
#pragma unroll
    for (int r = 0; r < 16; ++r) rli[r] = __builtin_amdgcn_rcpf(li_l[crow(r, hi)]);
    bf16_t* Ow = Ob + (size_t)(wid * QBLK) * 2048;
#pragma unroll
    for (int r = 0; r < 16; ++r) { const int orow = crow(r, hi);
#pragma unroll
        for (int d0 = 0; d0 < 4; ++d0) Ow[(size_t)orow * 2048 + d0 * 32 + r32] = (bf16_t)(cvt_pk_bf16(o[d0][r] * rli[r], 0.f) & 0xffffu); }
#undef SLOAD
#undef SWRITE
#undef SWAIT
#undef RESC
}
}

__device__ __forceinline__ void x_pass(const float* src, bf16_t* dstb, fix_t* st) {
    const int tid_ = otid(), lane = tid_ & 63, wave = tid_ >> 6;
    for (int row = blockIdx.x * 8 + wave; row < M_; row += gridDim.x * 8) {
        const float* s = src + (size_t)row * 2048; f32x4 v[8]; float s1 = 0.f, s2 = 0.f;
#pragma unroll
        for (int i = 0; i < 8; ++i) { v[i] = *(const f32x4*)(s + i * 256 + lane * 4); s1 += (v[i][0] + v[i][1]) + (v[i][2] + v[i][3]); s2 += (v[i][0] * v[i][0] + v[i][1] * v[i][1]) + (v[i][2] * v[i][2] + v[i][3] * v[i][3]); }
        s1 = wave_sum(s1, lane); s2 = wave_sum(s2, lane);
        if (lane == 0) { st[row] = to_fix(s1); st[M_ + row] = to_fix(s2); }
#pragma unroll
        for (int i = 0; i < 8; ++i) { u32x2 w; w.x = cvt_pk_bf16(v[i][0], v[i][1]); w.y = cvt_pk_bf16(v[i][2], v[i][3]); *(u32x2*)(dstb + (size_t)row * 2048 + i * 256 + lane * 4) = w; }
    }
}
__device__ __forceinline__ void ln_final(float* out, const fix_t* st, const float* g, const float* b) {
    const int tid = otid();
    for (size_t i = (size_t)blockIdx.x * 512 + tid; i < (size_t)M_ * 512; i += (size_t)gridDim.x * 512) {
        const int row = (int)(i >> 9), c = (int)(i & 511) * 4; float mu, rs; row_ln(st, row, mu, rs);
        const f32x4 P = *(const f32x4*)(out + i * 4), g4 = *(const f32x4*)(g + c), b4 = *(const f32x4*)(b + c);
        *(f32x4*)(out + i * 4) = (P - mu) * rs * g4 + b4;
    }
}
__device__ __forceinline__ int colmap(int mode, int n) {
    if (mode == 0) { if (n < 1024) return n; if (n < 2048) return 1088 + (n - 1024); if (n < 3072) return 2112 + (n - 2048);
        const int t = n - 3072, bj = t >> 7, r = t & 127; return r < 32 ? 1024 + bj * 32 + r : -1; }
    if (mode == 1) { if (n < 1024) return (n >> 7) * 192 + (n & 127);
        const int t = n - 1024, tile = t >> 8, bj = (t >> 7) & 1, wc = (t >> 5) & 3, i = t & 31; return (4 * tile + wc) * 192 + 128 + bj * 32 + i; }
    return n;
}
__device__ __forceinline__ void cvt_tile(const float* W, int ldw, bf16_t* Bt, int ldb, int n0, int k0, int mode, const float* kscale, float* T) {
    const int tid = otid(), n4 = (tid & 31) * 4, kq = tid >> 5, src = colmap(mode, n0 + n4);
    f32x4 v[8];
#pragma unroll
    for (int i = 0; i < 8; ++i) { const int kk = kq + 16 * i; v[i] = src >= 0 ? *(const f32x4*)(W + (size_t)(k0 + kk) * ldw + src) : (f32x4){0.f, 0.f, 0.f, 0.f}; }
    if (kscale) {
#pragma unroll
        for (int i = 0; i < 8; ++i) v[i] = v[i] * kscale[k0 + kq + 16 * i]; }
#pragma unroll
    for (int i = 0; i < 8; ++i)
#pragma unroll
        for (int j = 0; j < 4; ++j) T[(n4 + j) * 129 + kq + 16 * i] = v[i][j];
    __syncthreads();
    { const int n2 = tid >> 2, ks = (tid & 3) * 32; const float* t = T + n2 * 129 + ks; bf16_t* dst = Bt + (size_t)(n0 + n2) * ldb + k0 + ks;
#pragma unroll
      for (int i = 0; i < 4; ++i) { u32x4 w; w.x = cvt_pk_bf16(t[i * 8 + 0], t[i * 8 + 1]); w.y = cvt_pk_bf16(t[i * 8 + 2], t[i * 8 + 3]); w.z = cvt_pk_bf16(t[i * 8 + 4], t[i * 8 + 5]); w.w = cvt_pk_bf16(t[i * 8 + 6], t[i * 8 + 7]);
          *(u32x4*)(dst + i * 8) = w; } }
    __syncthreads();
}
constexpr int CT0 = 26 * 16, CT1 = CT0 + 12 * 4, CT2 = CT1 + 16 * 4, CT3 = CT2 + 32, CT4 = CT3 + 16 * 16, CT5 = CT4 + 64 * 16, CT6 = CT5 + 16 * 64;
__device__ __forceinline__ void convert_weights(const Params& p, int l, int t0, int t1, float* T) {
    unsigned char* ws = p.ws;
    const float* ing = l == 0 ? p.in[2] : p.in[21] + (size_t)(l - 1) * 2048;
    for (int t = t0 + blockIdx.x; t < t1; t += gridDim.x) {
        if (t < CT0) { const int nt = t % 26, kt = t / 26; cvt_tile(p.in[4] + (size_t)l * 2048 * NIN, NIN, (bf16_t*)(ws + W_IN), 2048, nt * 128, kt * 128, 0, ing, T); }
        else if (t < CT1) { const int u = t - CT0, nt = u % 12, kt = u / 12; cvt_tile(p.in[7] + (size_t)l * 512 * 1536, 1536, (bf16_t*)(ws + W_UQ), 512, nt * 128, kt * 128, 1, p.in[5] + l * 512, T); }
        else if (t < CT2) { const int u = t - CT1, nt = u % 16, kt = u / 16; cvt_tile(p.in[8] + (size_t)l * 512 * 2048, 2048, (bf16_t*)(ws + W_UKV), 512, nt * 128, kt * 128, 2, p.in[6] + l * 512, T); }
        else if (t < CT3) { const int mat = t - CT2, gate = mat & 1, h = (mat >> 1) & 7, d = mat >> 4;
            cvt_tile((gate ? p.in[13] : p.in[11]) + ((size_t)((l * 2 + d) * 8 + h)) * 128 * 128, 128, (bf16_t*)(ws + W_G) + (size_t)(h * 512 + d * 256 + gate * 128) * 128, 128, 0, 0, 2, nullptr, T); }
        else if (t < CT4) { const int u = t - CT3, nt = u % 16, kt = u / 16; cvt_tile(p.in[16] + (size_t)l * 2048 * 2048, 2048, (bf16_t*)(ws + W_OUT), 2048, nt * 128, kt * 128, 2, nullptr, T); }
        else if (t < CT5) { const int u = t - CT4, nt = u % 64, kt = u / 64; cvt_tile(p.in[19] + (size_t)l * 2048 * 8192, 8192, (bf16_t*)(ws + W_UP), 2048, nt * 128, kt * 128, 2, p.in[17] + (size_t)l * 2048, T); }
        else { const int u = t - CT5, nt = u % 16, kt = u / 16; cvt_tile(p.in[20] + (size_t)l * 8192 * 2048, 2048, (bf16_t*)(ws + W_DN), 8192, nt * 128, kt * 128, 2, nullptr, T); }
    }
}
__device__ __forceinline__ void colsum_pass(const bf16_t* Bt, int N, const float* lg, const float* lb, float* cs, float* bw) {
    const int tid = otid(), lane = tid & 63, wave = tid >> 6;
    float ratio[32];
#pragma unroll
    for (int i = 0; i < 4; ++i)
#pragma unroll
        for (int j = 0; j < 8; ++j) { const int k = i * 512 + lane * 8 + j; ratio[i * 8 + j] = lb[k] * __builtin_amdgcn_rcpf(lg[k]); }
    for (int n = blockIdx.x * 8 + wave; n < N; n += gridDim.x * 8) {
        u32x4 w[4];
#pragma unroll
        for (int i = 0; i < 4; ++i) w[i] = *(const u32x4*)(Bt + (size_t)n * 2048 + i * 512 + lane * 8);
        float c = 0.f, bb = 0.f;
#pragma unroll
        for (int i = 0; i < 4; ++i) { const float v[8] = {bf_lo(w[i].x), bf_hi(w[i].x), bf_lo(w[i].y), bf_hi(w[i].y), bf_lo(w[i].z), bf_hi(w[i].z), bf_lo(w[i].w), bf_hi(w[i].w)};
#pragma unroll
            for (int j = 0; j < 8; ++j) { c += v[j]; bb += v[j] * ratio[i * 8 + j]; } }
        c = wave_sum(c, lane); bb = wave_sum(bb, lane);
        if (lane == 0) { cs[n] = c; bw[n] = bb; }
    }
}
__device__ __forceinline__ void colsum_in(const Params& p, int l) { float* csb = (float*)(p.ws + WS_CSB) + (size_t)l * CSB_L;
    colsum_pass((const bf16_t*)(p.ws + W_IN), NINP, l == 0 ? p.in[2] : p.in[21] + (size_t)(l - 1) * 2048, l == 0 ? p.in[3] : p.in[22] + (size_t)(l - 1) * 2048, csb + CSB_IN, csb + CSB_IN + NINP); }
__device__ __forceinline__ void colsum_up(const Params& p, int l) { float* csb = (float*)(p.ws + WS_CSB) + (size_t)l * CSB_L;
    colsum_pass((const bf16_t*)(p.ws + W_UP), DFF, p.in[17] + (size_t)l * 2048, p.in[18] + (size_t)l * 2048, csb + CSB_UP, csb + CSB_UP + DFF); }
__device__ __forceinline__ void make_tables(const Params& p) {
    const int* pos = (const int*)p.in[1]; float* cosT = (float*)(p.ws + WS_COS); float* sinT = (float*)(p.ws + WS_SIN); float* sp = (float*)(p.ws + WS_SP);
    const int tid = otid();
    for (size_t i = (size_t)blockIdx.x * 512 + tid; i < (size_t)M_ * 32; i += (size_t)gridDim.x * 512) {
        const int row = (int)(i >> 5), k = (int)(i & 31); const float inv = powf(10000.0f, -(float)(2 * k) / 64.0f); const float ang = (float)pos[row] * inv;
        cosT[i] = cosf(ang); sinT[i] = sinf(ang); }
    for (int i = blockIdx.x * 512 + tid; i < DEPTH * 2 * 1024; i += gridDim.x * 512) { const float x = -p.in[15][i];
        sp[i] = fmaxf(x, 0.f) + log1pf(expf(-fabsf(x))); }
}
__device__ __forceinline__ void conv_phase(const Params& p, int l) {
    const bf16_t* xl = (const bf16_t*)(p.ws + WS_XL); bf16_t* xc = (bf16_t*)(p.ws + WS_XC);
    const float* cw = p.in[9] + (size_t)l * 4 * 1024; const float* cb = p.in[10] + (size_t)l * 1024;
    const int tid = otid();
    for (size_t i = (size_t)blockIdx.x * 512 + tid; i < (size_t)M_ * 128; i += (size_t)gridDim.x * 512) {
        const int row = (int)(i >> 7), c0 = (int)(i & 127) * 8, t = row & (SEQ - 1);
        float acc[8];
        { const f32x4 b0 = *(const f32x4*)(cb + c0), b1 = *(const f32x4*)(cb + c0 + 4); acc[0] = b0[0]; acc[1] = b0[1]; acc[2] = b0[2]; acc[3] = b0[3]; acc[4] = b1[0]; acc[5] = b1[1]; acc[6] = b1[2]; acc[7] = b1[3]; }
#pragma unroll
        for (int k = 0; k < 4; ++k) { const int tt = t - 2 + k; if (tt < 0 || tt >= SEQ) continue;
            const u32x4 xw = *(const u32x4*)(xl + (size_t)(row - 2 + k) * 1024 + c0);
            const f32x4 w0 = *(const f32x4*)(cw + k * 1024 + c0), w1 = *(const f32x4*)(cw + k * 1024 + c0 + 4);
            acc[0] += w0[0] * bf_lo(xw.x); acc[1] += w0[1] * bf_hi(xw.x); acc[2] += w0[2] * bf_lo(xw.y); acc[3] += w0[3] * bf_hi(xw.y);
            acc[4] += w1[0] * bf_lo(xw.z); acc[5] += w1[1] * bf_hi(xw.z); acc[6] += w1[2] * bf_lo(xw.w); acc[7] += w1[3] * bf_hi(xw.w); }
        u32x4 o; o.x = cvt_pk_bf16(acc[0], acc[1]); o.y = cvt_pk_bf16(acc[2], acc[3]); o.z = cvt_pk_bf16(acc[4], acc[5]); o.w = cvt_pk_bf16(acc[6], acc[7]);
        *(u32x4*)(xc + (size_t)row * 1024 + c0) = o;
    }
}
__device__ __forceinline__ void scan_local(const Params& p) {
    const unsigned* au = (const unsigned*)(p.ws + WS_AU); f32x4* ph = (f32x4*)(p.ws + WS_PH); const int tid = otid();
    for (int it = blockIdx.x; it < 2 * 8 * 64; it += gridDim.x) {
        const int c = it & 63, b = (it >> 6) & 7, d = it >> 9;
        const u32x2* src = (const u32x2*)(au + (size_t)d * M_ * 1024 + (size_t)(b * SEQ + c * 64) * 1024) + tid;
        float h0 = 0.f, h1 = 0.f, P0 = 1.f, P1 = 1.f;
#pragma unroll 16
        for (int s = 0; s < 64; ++s) { const int t = d ? 63 - s : s; const u32x2 w = src[(size_t)t * 512];
            const float a0 = 1.0f - bf_lo(w.x), a1 = 1.0f - bf_lo(w.y); h0 = a0 * h0 + bf_hi(w.x); h1 = a1 * h1 + bf_hi(w.y); P0 *= a0; P1 *= a1; }
        ph[(size_t)((d * 8 + b) * 64 + c) * 512 + tid] = (f32x4){P0, h0, P1, h1};
    }
}
__device__ __forceinline__ void scan_apply(const Params& p) {
    const unsigned* au = (const unsigned*)(p.ws + WS_AU); const f32x4* ph = (const f32x4*)(p.ws + WS_PH);
    const bf16_t* gg = (const bf16_t*)(p.ws + WS_GG); bf16_t* ycat = (bf16_t*)(p.ws + WS_YCAT); const int tid = otid();
    for (int it = blockIdx.x; it < 8 * 64; it += gridDim.x) {
        const int c = it & 63, b = it >> 6;
        float Hf0 = 0.f, Hf1 = 0.f, Hb0 = 0.f, Hb1 = 0.f;
        { const f32x4* pf = ph + (size_t)((0 * 8 + b) * 64) * 512 + tid;
          for (int c0 = 0; c0 < c; c0 += 8) { f32x4 e[8];
#pragma unroll
              for (int j = 0; j < 8; ++j) e[j] = (c0 + j < c) ? pf[(size_t)(c0 + j) * 512] : (f32x4){1.f, 0.f, 1.f, 0.f};
#pragma unroll
              for (int j = 0; j < 8; ++j) { Hf0 = e[j][0] * Hf0 + e[j][1]; Hf1 = e[j][2] * Hf1 + e[j][3]; } }
          const f32x4* pb = ph + (size_t)((1 * 8 + b) * 64) * 512 + tid;
          for (int c0 = 63; c0 > c; c0 -= 8) { f32x4 e[8];
#pragma unroll
              for (int j = 0; j < 8; ++j) e[j] = (c0 - j > c) ? pb[(size_t)(c0 - j) * 512] : (f32x4){1.f, 0.f, 1.f, 0.f};
#pragma unroll
              for (int j = 0; j < 8; ++j) { Hb0 = e[j][0] * Hb0 + e[j][1]; Hb1 = e[j][2] * Hb1 + e[j][3]; } } }
        const size_t r0 = (size_t)(b * SEQ + c * 64);
        const u32x2* __restrict__ s0 = (const u32x2*)(au + r0 * 1024) + tid; const u32x2* __restrict__ s1 = (const u32x2*)(au + (size_t)M_ * 1024 + r0 * 1024) + tid;
        const unsigned* __restrict__ gp = (const unsigned*)(gg + r0 * 1024) + tid; unsigned* __restrict__ yp = (unsigned*)(ycat + r0 * 2048 + 1024) + tid;
        float hf0[64], hf1[64];
        { u32x2 wa[8], wb[8];
#pragma unroll
          for (int j = 0; j < 8; ++j) wa[j] = s0[(size_t)j * 512];
#pragma unroll
          for (int bt = 0; bt < 8; bt += 2) {
#pragma unroll
              for (int j = 0; j < 8; ++j) wb[j] = s0[(size_t)((bt + 1) * 8 + j) * 512];
#pragma unroll
              for (int j = 0; j < 8; ++j) { const int t = bt * 8 + j; Hf0 = (1.0f - bf_lo(wa[j].x)) * Hf0 + bf_hi(wa[j].x); Hf1 = (1.0f - bf_lo(wa[j].y)) * Hf1 + bf_hi(wa[j].y); hf0[t] = Hf0; hf1[t] = Hf1; }
              if (bt + 2 < 8) {
#pragma unroll
                  for (int j = 0; j < 8; ++j) wa[j] = s0[(size_t)((bt + 2) * 8 + j) * 512]; }
#pragma unroll
              for (int j = 0; j < 8; ++j) { const int t = (bt + 1) * 8 + j; Hf0 = (1.0f - bf_lo(wb[j].x)) * Hf0 + bf_hi(wb[j].x); Hf1 = (1.0f - bf_lo(wb[j].y)) * Hf1 + bf_hi(wb[j].y); hf0[t] = Hf0; hf1[t] = Hf1; }
          } }
        { u32x2 wa[8], wb[8]; unsigned ga[8], gb[8];
#pragma unroll
          for (int j = 0; j < 8; ++j) { wa[j] = s1[(size_t)(63 - j) * 512]; ga[j] = gp[(size_t)(63 - j) * 512]; }
#pragma unroll
          for (int bt = 0; bt < 8; bt += 2) {
#pragma unroll
              for (int j = 0; j < 8; ++j) { const int t = 63 - ((bt + 1) * 8 + j); wb[j] = s1[(size_t)t * 512]; gb[j] = gp[(size_t)t * 512]; }
#pragma unroll
              for (int j = 0; j < 8; ++j) { const int t = 63 - (bt * 8 + j); Hb0 = (1.0f - bf_lo(wa[j].x)) * Hb0 + bf_hi(wa[j].x); Hb1 = (1.0f - bf_lo(wa[j].y)) * Hb1 + bf_hi(wa[j].y);
                  yp[(size_t)t * 1024] = cvt_pk_bf16(bf_lo(ga[j]) * (hf0[t] + Hb0), bf_hi(ga[j]) * (hf1[t] + Hb1)); }
              if (bt + 2 < 8) {
#pragma unroll
                  for (int j = 0; j < 8; ++j) { const int t = 63 - ((bt + 2) * 8 + j); wa[j] = s1[(size_t)t * 512]; ga[j] = gp[(size_t)t * 512]; } }
#pragma unroll
              for (int j = 0; j < 8; ++j) { const int t = 63 - ((bt + 1) * 8 + j); Hb0 = (1.0f - bf_lo(wb[j].x)) * Hb0 + bf_hi(wb[j].x); Hb1 = (1.0f - bf_lo(wb[j].y)) * Hb1 + bf_hi(wb[j].y);
                  yp[(size_t)t * 1024] = cvt_pk_bf16(bf_lo(gb[j]) * (hf0[t] + Hb0), bf_hi(gb[j]) * (hf1[t] + Hb1)); }
          } }
    }
}

__device__ __forceinline__ void grid_bar(unsigned* ctr, unsigned epoch) {
    asm volatile("s_waitcnt vmcnt(0) lgkmcnt(0)" ::: "memory");
    __syncthreads();
    if (otid() == 0) {
        __builtin_amdgcn_fence(__ATOMIC_RELEASE, "agent");
        asm volatile("s_waitcnt vmcnt(0)" ::: "memory");
        __hip_atomic_fetch_add(ctr, 1u, __ATOMIC_RELAXED, __HIP_MEMORY_SCOPE_AGENT);
        const unsigned target = (epoch + 1u) * gridDim.x;
        while (__hip_atomic_load(ctr, __ATOMIC_RELAXED, __HIP_MEMORY_SCOPE_AGENT) < target) __builtin_amdgcn_s_sleep(1);
        __builtin_amdgcn_fence(__ATOMIC_ACQUIRE, "agent");
        asm volatile("s_waitcnt vmcnt(0)" ::: "memory");
    }
    __syncthreads();
}
__global__ void __launch_bounds__(512, 2) mega_fwd(Params p) {
    extern __shared__ __attribute__((aligned(16))) unsigned char lds[];
    cg::grid_group grid = cg::this_grid();
    unsigned char* ws = p.ws;
    LAS unsigned char* ldsl = (LAS unsigned char*)lds;
    bf16_t* hb = (bf16_t*)(ws + WS_HB);
    const float* cosT = (const float*)(ws + WS_COS); const float* sinT = (const float*)(ws + WS_SIN);

    unsigned* bar_ctr = (unsigned*)(ws + WS_BAR);
    fix_t* stats0 = (fix_t*)(ws + WS_ST);
#define stats stats0
    { const int tid = otid();
      for (size_t i = (size_t)blockIdx.x * 512 + tid; i < (size_t)8 * 2 * M_; i += (size_t)gridDim.x * 512) stats[(size_t)2 * M_ + i] = 0ull;
    }
    make_tables(p);
    x_pass(p.in[0], hb, stats);
    grid.sync();
    convert_weights(p, 0, 0, CT6, (float*)lds);
    grid_bar(bar_ctr, 0u);
    colsum_in(p, 0); colsum_up(p, 0);
    grid_bar(bar_ctr, 1u);

#pragma unroll 1
    for (int l = 0; l < DEPTH; ++l) {
        const float* csb = (const float*)(ws + WS_CSB) + (size_t)l * CSB_L;
        fix_t* st0 = (fix_t*)(ws + WS_ST) + (size_t)(2 * l) * 2 * M_; fix_t* st1 = st0 + 2 * M_; fix_t* st2 = st1 + 2 * M_;
        if (l > 0) { colsum_up(p, l); convert_weights(p, l, CT5, CT6, (float*)lds); }
        { pg8::Order S = pg8::make_order(hb, 2048, ws + W_IN, 2048, M_, NINP, 2048);
          EpiIn E{(bf16_t*)(ws + WS_CQ), (bf16_t*)(ws + WS_CKV), (bf16_t*)(ws + WS_XL), (bf16_t*)(ws + WS_GG), (bf16_t*)(ws + WS_KPE), (float*)(ws + WS_SSQ), cosT, sinT, st0, csb + CSB_IN, csb + CSB_IN + NINP};
          pg8::gemm_phase(ldsl, S, E); }
        grid_bar(bar_ctr, 2u + 8u * (unsigned)l + 0u);
        conv_phase(p, l);
        { pg8::Order S = pg8::make_order(ws + WS_CQ, 512, ws + W_UQ, 512, M_, 1536, 512);
          EpiQ E{(bf16_t*)(ws + WS_Q), (const float*)(ws + WS_SSQ), cosT, sinT};
          pg8::gemm_phase(ldsl, S, E); }
        { pg8::Order S = pg8::make_order(ws + WS_CKV, 512, ws + W_UKV, 512, M_, 2048, 512);
          EpiKV E{(bf16_t*)(ws + WS_KV), (const float*)(ws + WS_SSQ)};
          pg8::gemm_phase(ldsl, S, E); }
        grid_bar(bar_ctr, 2u + 8u * (unsigned)l + 1u);
        {
            const bf16_t* Q = (const bf16_t*)(ws + WS_Q); const bf16_t* KV = (const bf16_t*)(ws + WS_KV); const bf16_t* KPE = (const bf16_t*)(ws + WS_KPE); bf16_t* ycat = (bf16_t*)(ws + WS_YCAT);
            const int G = gridDim.x, bx = blockIdx.x;
            for (int L = bx; L < 1024; L += G) {
                int pair, qb;
                if (G == 256) { const int i = L >> 8, c = L & 255, xcd = c & 7, j = c >> 3; pair = i * 16 + xcd * 2 + (j >> 4); qb = j & 15; } else { pair = L >> 4; qb = L & 15; }
                const int b = pair >> 3, h = pair & 7; const size_t row0 = (size_t)b * SEQ + (size_t)qb * 256;
                __syncthreads();
                att::attn_unit(Q + row0 * 1536 + h * 128, Q + row0 * 1536 + 1024 + h * 64, KV + (size_t)b * SEQ * 2048 + h * 256, KPE + (size_t)b * SEQ * 64, ycat + row0 * 2048 + h * 128, SEQ, (char*)lds);
            }
            __syncthreads();
        }
        { pg8::Order S = pg8::make_order(ws + WS_XC, 1024, ws + W_G, 128, M_, 512, 128);
          S.nZ = 8; S.a_z = 128 * 2; S.b_z = (size_t)512 * 128 * 2;
          EpiGate E{(unsigned*)(ws + WS_AU), (const bf16_t*)(ws + WS_XC), p.in[12] + (size_t)l * 2048, p.in[14] + (size_t)l * 2048, (const float*)(ws + WS_SP) + (size_t)l * 2048};
          pg8::gemm_phase(ldsl, S, E); }
        grid_bar(bar_ctr, 2u + 8u * (unsigned)l + 2u);
        scan_local(p);
        if (l + 1 < DEPTH) { __syncthreads(); convert_weights(p, l + 1, 0, CT3, (float*)lds); }
        grid_bar(bar_ctr, 2u + 8u * (unsigned)l + 3u);
        if (l + 1 < DEPTH) colsum_in(p, l + 1);
        scan_apply(p);
        grid_bar(bar_ctr, 2u + 8u * (unsigned)l + 4u);
        { pg8::Order S = pg8::make_order(ws + WS_YCAT, 2048, ws + W_OUT, 2048, M_, 2048, 2048);
          EpiRes E{l == 0 ? p.in[0] : p.out, p.out, hb, st0, l == 0 ? p.in[2] : p.in[21] + (size_t)(l - 1) * 2048, l == 0 ? p.in[3] : p.in[22] + (size_t)(l - 1) * 2048, st1};
          pg8::gemm_phase(ldsl, S, E); }
        grid_bar(bar_ctr, 2u + 8u * (unsigned)l + 5u);
        if (l + 1 < DEPTH) { convert_weights(p, l + 1, CT3, CT4, (float*)lds); }
        { pg8::Order S = pg8::make_order(hb, 2048, ws + W_UP, 2048, M_, DFF, 2048);
          EpiUp E{(bf16_t*)(ws + WS_F), st1, csb + CSB_UP, csb + CSB_UP + DFF}; pg8::gemm_phase(ldsl, S, E); }
        grid_bar(bar_ctr, 2u + 8u * (unsigned)l + 6u);
        if (l + 1 < DEPTH) { convert_weights(p, l + 1, CT4, CT5, (float*)lds); }
        { pg8::Order S = pg8::make_order(ws + WS_F, 8192, ws + W_DN, 8192, M_, 2048, 8192);
          EpiRes E{p.out, p.out, hb, st1, p.in[17] + (size_t)l * 2048, p.in[18] + (size_t)l * 2048, st2};
          pg8::gemm_phase(ldsl, S, E); }
        grid_bar(bar_ctr, 2u + 8u * (unsigned)l + 7u);
    }
    ln_final(p.out, (const fix_t*)(p.ws + WS_ST) + (size_t)(2 * DEPTH) * 2 * M_, p.in[21] + (size_t)(DEPTH - 1) * 2048, p.in[22] + (size_t)(DEPTH - 1) * 2048);
}

extern "C" void kernel_launch(void* const* d_in, const int* in_sizes, int n_in, void* d_out, int out_size, void* d_ws, size_t ws_size, hipStream_t stream) {
    constexpr int LDS_BYTES = pg8::STAGE_BYTES;
    static int grid_blocks = 0;
    if (grid_blocks == 0) {
        if (n_in != 23 || in_sizes[0] != M_ * DM || out_size != M_ * DM || ws_size < WS_END) {
            fprintf(stderr, "kernel_launch: shape mismatch (n_in %d, in0 %d, out %d, ws %zu, need %zu)\n", n_in, n_in > 0 ? in_sizes[0] : -1, out_size, ws_size, (size_t)WS_END); grid_blocks = -1; return; }
        int dev = 0, cus = 0, per_cu = 0;
        hipGetDevice(&dev); hipDeviceGetAttribute(&cus, hipDeviceAttributeMultiprocessorCount, dev);
        if (hipFuncSetAttribute((const void*)mega_fwd, hipFuncAttributeMaxDynamicSharedMemorySize, LDS_BYTES) != hipSuccess) { fprintf(stderr, "kernel_launch: hipFuncSetAttribute failed\n"); grid_blocks = -1; return; }
        if (hipOccupancyMaxActiveBlocksPerMultiprocessor(&per_cu, (const void*)mega_fwd, 512, LDS_BYTES) != hipSuccess || per_cu < 1) { fprintf(stderr, "kernel_launch: occupancy query says %d\n", per_cu); per_cu = 1; }
        (void)hipGetLastError();
        grid_blocks = cus * 1;
    }
    if (grid_blocks < 0) return;
    Params p{};
    for (int i = 0; i < 23; ++i) p.in[i] = (const float*)d_in[i];
    p.out = (float*)d_out; p.ws = (unsigned char*)d_ws;
    (void)hipMemsetAsync((char*)d_ws + WS_BAR, 0, 256, stream);
    void* args[] = {&p};
    hipError_t e = hipLaunchCooperativeKernel((const void*)mega_fwd, dim3(grid_blocks), dim3(512), args, LDS_BYTES, stream);
    if (e != hipSuccess) fprintf(stderr, "kernel_launch: cooperative launch failed: %s (grid %d)\n", hipGetErrorString(e), grid_blocks);
}
```

```cpp
#include <hip/hip_runtime.h>
#include <hip/hip_cooperative_groups.h>
#include <cstdio>
#include <cstdint>
namespace cg = cooperative_groups;

#define LAS __attribute__((address_space(3)))
typedef unsigned short bf16_t;
typedef short bf16x8 __attribute__((ext_vector_type(8)));
typedef short s16x4 __attribute__((ext_vector_type(4)));
typedef float f32x4 __attribute__((ext_vector_type(4)));
typedef float f32x2 __attribute__((ext_vector_type(2)));
typedef float f32x16 __attribute__((ext_vector_type(16)));
typedef unsigned u32x4 __attribute__((ext_vector_type(4)));
typedef unsigned u32x2 __attribute__((ext_vector_type(2)));

constexpr int M_ = 32768, DM = 2048, SEQ = 4096, NBATCH = 8, DEPTH = 4;
constexpr int NIN = 3136, NINP = 3328, DFF = 8192;
constexpr float ALPHA = 1.6817928305074290f;
constexpr float LN_EPS = 1e-5f, RMS_EPS = 1e-6f;
constexpr size_t MiB = 1ull << 20;
constexpr size_t WS_HB = 0;
constexpr size_t WS_W = 128 * MiB;
constexpr size_t W_IN = WS_W, W_UQ = W_IN + (size_t)NINP * 2048 * 2, W_UKV = W_UQ + 1536ull * 512 * 2, W_G = W_UKV + 2048ull * 512 * 2,
                 W_OUT = W_G + 8ull * 512 * 128 * 2, W_UP = W_OUT + 2048ull * 2048 * 2, W_DN = W_UP + 8192ull * 2048 * 2, W_END = W_DN + 8192ull * 2048 * 2;
static_assert(W_END <= 218 * MiB, "weights region");
constexpr size_t WS_COS = 218 * MiB, WS_SIN = 222 * MiB, WS_SP = 226 * MiB;
constexpr size_t WS_CSB = 226 * MiB + 65536;
constexpr int CSB_L = 2 * 3328 + 2 * 8192, CSB_IN = 0, CSB_UP = 2 * 3328;
constexpr size_t WS_BAR = 226 * MiB + 49152;
constexpr size_t WS_ST = 227 * MiB;
constexpr size_t WS_BIG = 232 * MiB;
constexpr size_t WS_F = WS_BIG;
constexpr size_t WS_GG = WS_BIG, WS_XC = WS_BIG + 64 * MiB, WS_YCAT = WS_BIG + 128 * MiB, WS_SSQ = WS_BIG + 256 * MiB, WS_KPE = WS_BIG + 258 * MiB,
                 WS_CQ = WS_BIG + 262 * MiB, WS_CKV = WS_BIG + 294 * MiB, WS_XL = WS_BIG + 326 * MiB, WS_AU = WS_BIG + 262 * MiB  ,
                 WS_Q = WS_BIG + 518 * MiB, WS_KV = WS_BIG + 614 * MiB, WS_PH = WS_BIG + 742 * MiB, WS_END = WS_BIG + 750 * MiB;
static_assert(WS_END <= 1024 * MiB, "workspace");

struct Params { const float* in[23]; float* out; unsigned char* ws; };

__device__ __forceinline__ int otid() { int t = threadIdx.x; asm volatile("" : "+v"(t)); return t; }
__device__ __forceinline__ unsigned cvt_pk_bf16(float lo, float hi) { unsigned r; asm volatile("v_cvt_pk_bf16_f32 %0, %1, %2" : "=v"(r) : "v"(lo), "v"(hi)); return r; }
__device__ __forceinline__ float sum_fq(float x) {
    auto a = __builtin_amdgcn_permlane16_swap(__float_as_uint(x), __float_as_uint(x), false, false); x = __uint_as_float(a[0]) + __uint_as_float(a[1]);
    auto b = __builtin_amdgcn_permlane32_swap(__float_as_uint(x), __float_as_uint(x), false, false); return __uint_as_float(b[0]) + __uint_as_float(b[1]); }
__device__ __forceinline__ float wave_sum(float x, int lane) {
#pragma unroll
    for (int o = 32; o >= 1; o >>= 1) x += __int_as_float(__builtin_amdgcn_ds_bpermute((lane ^ o) << 2, __float_as_int(x)));
    return x; }
__device__ __forceinline__ float bf_lo(unsigned w) { return __uint_as_float(w << 16); }
__device__ __forceinline__ float bf_hi(unsigned w) { return __uint_as_float(w & 0xffff0000u); }
__device__ __forceinline__ float sigmoidf_(float x) { return __builtin_amdgcn_rcpf(1.0f + __builtin_amdgcn_exp2f(-1.4426950408889634f * x)); }
__device__ __forceinline__ float gelu_tanh(float x) { const float z = 0.7978845608028654f * (x + 0.044715f * x * x * x); return x * sigmoidf_(2.0f * z); }
__device__ __forceinline__ u32x4 pack8(const f32x4 a, const f32x4 b) { u32x4 w; w.x = cvt_pk_bf16(a[0], a[1]); w.y = cvt_pk_bf16(a[2], a[3]); w.z = cvt_pk_bf16(b[0], b[1]); w.w = cvt_pk_bf16(b[2], b[3]); return w; }

namespace pg8 {
constexpr int BM = 256, BK = 64, HALF = 128, HTB = HALF * BK * 2, STAGE_BYTES = 8 * HTB, NXCD = 8, WGM = 8;
__host__ __device__ __forceinline__ int lds_byte(int r, int c) { const int st = (r >> 4) * 2 + (c >> 5), rr = r & 15, cc = c & 31, ob = rr * 64 + cc * 2; return st * 1024 + (ob ^ (((ob >> 9) & 1) << 5)); }
__host__ __device__ __forceinline__ void stage_rc(int b, int& R, int& C) { const int st = b / 1024, sb = b % 1024, swz = sb ^ (((sb >> 9) & 1) << 5); R = (st >> 1) * 16 + swz / 64; C = (st & 1) * 32 + (swz % 64) / 2; }
__host__ __device__ __forceinline__ int perm32(int rho) { const int n = rho >> 4, i = rho & 15; return 8 * (i >> 2) + 4 * n + (i & 3); }

struct Unit { int pm, pn, z; };
struct Order {
    int nM, nN, nZ, per, G, c;
    const char* A; const char* B; size_t a_pm, a_z, b_pn, b_z; int lda, ldb, K;
    __device__ __forceinline__ bool next(int i, Unit& u) const {
        const long L = (long)i * G + c; if (L >= (long)per * nZ) return false;
        u.z = (int)(L / per); int wgid = (int)(L % per);
        { const int q = per / NXCD, r = per % NXCD, xcd = wgid % NXCD, off = wgid / NXCD; wgid = (xcd < r ? xcd * (q + 1) : r * (q + 1) + (xcd - r) * q) + off; }
        const int nig = WGM * nN, gid = wgid / nig, fm = gid * WGM, gsz = (nM - fm) < WGM ? (nM - fm) : WGM;
        u.pm = fm + ((wgid % nig) % gsz); u.pn = (wgid % nig) / gsz; return true;
    }
    __device__ __forceinline__ const char* aptr(const Unit& u) const { return A + (size_t)u.pm * a_pm + (size_t)u.z * a_z; }
    __device__ __forceinline__ const char* bptr(const Unit& u) const { return B + (size_t)u.pn * b_pn + (size_t)u.z * b_z; }
};
__device__ __forceinline__ Order make_order(const void* A, int lda, const void* Bt, int ldb, int Mrows, int N, int K) {
    Order o; o.nM = Mrows / BM; o.nN = N / BM; o.nZ = 1; o.per = o.nM * o.nN; o.G = gridDim.x; o.c = blockIdx.x;
    o.A = (const char*)A; o.B = (const char*)Bt; o.a_pm = (size_t)BM * lda * 2; o.a_z = 0; o.b_pn = (size_t)BM * ldb * 2; o.b_z = 0; o.lda = lda; o.ldb = ldb; o.K = K; return o;
}

template <class Epi>
__device__ __forceinline__ void gemm_phase(LAS unsigned char* lds, const Order& S, const Epi& E) {
    const int tid = otid(), wid = __builtin_amdgcn_readfirstlane(tid >> 6), lane = tid & 63, wr = wid >> 2, wc = wid & 3, fr = lane & 15, fq = lane >> 4;
    const int nt = S.K / BK;
    unsigned voffA[2], voffB[2];
#pragma unroll
    for (int i = 0; i < 2; ++i) { int R, C; stage_rc(tid * 16 + i * 8192, R, C); const int Rb = Epi::PERM ? ((R & ~31) + perm32(R & 31)) : R;
        voffA[i] = (unsigned)(R * S.lda + C) * 2u; voffB[i] = (unsigned)(Rb * S.ldb + C) * 2u; }
    const size_t kstep = (size_t)(BK * 2);
    const size_t hstepA = (size_t)HALF * S.lda * 2, hstepB = (size_t)HALF * S.ldb * 2;
    const unsigned ldsw = (unsigned)wid * 1024u;
    const int aoff = lds_byte(wr * 64 + fr, fq * 8), boff = lds_byte(wc * 32 + fr, fq * 8);
#define PG8_SA(b, h) (((b) * 2 + (h)) * HTB)
#define PG8_SB(b, h) ((4 + (b) * 2 + (h)) * HTB)
#define PG8_STAGE(bufoff, gbase, voff) do { _Pragma("unroll") for (int _i = 0; _i < 2; ++_i) \
        __builtin_amdgcn_global_load_lds((const unsigned*)((const char*)(gbase) + (voff)[_i]), (LAS unsigned*)(lds + (bufoff) + ldsw + _i * 8192), 16, 0, 0); } while (0)
#define PG8_LDA(dst, b, h) do { _Pragma("unroll") for (int m = 0; m < 4; ++m) _Pragma("unroll") for (int k = 0; k < 2; ++k) dst[m][k] = *(const LAS bf16x8*)(lds + PG8_SA(b, h) + aoff + m * 2048 + k * 1024); } while (0)
#define PG8_LDB(dst, b, h) do { _Pragma("unroll") for (int n = 0; n < 2; ++n) _Pragma("unroll") for (int k = 0; k < 2; ++k) dst[n][k] = *(const LAS bf16x8*)(lds + PG8_SB(b, h) + boff + n * 2048 + k * 1024); } while (0)
#define PG8_MMA(ai, bj, At, Bt) do { __builtin_amdgcn_s_setprio(1); _Pragma("unroll") for (int m = 0; m < 4; ++m) _Pragma("unroll") for (int n = 0; n < 2; ++n) _Pragma("unroll") for (int k = 0; k < 2; ++k) \
        acc[ai][bj][m][n] = __builtin_amdgcn_mfma_f32_16x16x32_bf16(Bt[n][k], At[m][k], acc[ai][bj][m][n], 0, 0, 0); __builtin_amdgcn_s_setprio(0); } while (0)
#define PG8_WAIT_V(n) asm volatile("s_waitcnt vmcnt(" #n ")" ::: "memory")
#define PG8_WAIT_L(n) asm volatile("s_waitcnt lgkmcnt(" #n ")" ::: "memory")
#define PG8_BAR __builtin_amdgcn_s_barrier()
#define PG8_SCHED __builtin_amdgcn_sched_barrier(0)
    Unit cur, nxt; int ui = 0;
    if (!S.next(0, cur)) return;
    f32x4 acc[2][2][4][2];
#pragma unroll
    for (int a = 0; a < 2; ++a)
#pragma unroll
        for (int b = 0; b < 2; ++b)
#pragma unroll
            for (int m = 0; m < 4; ++m)
#pragma unroll
                for (int n = 0; n < 2; ++n) acc[a][b][m][n] = (f32x4){0.f, 0.f, 0.f, 0.f};
    bf16x8 At[4][2], B0[2][2], B1[2][2];
    const char* cA = S.aptr(cur); const char* cB = S.bptr(cur);
    PG8_STAGE(PG8_SB(0, 0), cB, voffB); PG8_STAGE(PG8_SA(0, 0), cA, voffA); PG8_STAGE(PG8_SB(0, 1), cB + hstepB, voffB); PG8_STAGE(PG8_SA(0, 1), cA + hstepA, voffA);
    if (wr == 1) PG8_BAR;
    PG8_WAIT_V(4); PG8_BAR;
    PG8_STAGE(PG8_SB(1, 0), cB + kstep, voffB); PG8_STAGE(PG8_SA(1, 0), cA + kstep, voffA); PG8_STAGE(PG8_SB(1, 1), cB + hstepB + kstep, voffB);
    PG8_WAIT_V(6); PG8_BAR;
    for (;;) {
        const bool has_next = S.next(ui + 1, nxt);
        const char* nA = has_next ? S.aptr(nxt) : cA; const char* nB = has_next ? S.bptr(nxt) : cB;
        for (int t = 0; t < nt; t += 2) {
            const bool last = (t == nt - 2);
            const char* a1 = cA + (size_t)(t + 1) * kstep;
            const char* a2 = last ? nA : cA + (size_t)(t + 2) * kstep; const char* b2 = last ? nB : cB + (size_t)(t + 2) * kstep;
            const char* a3 = a2 + kstep; const char* b3 = b2 + kstep;
            PG8_LDB(B0, 0, 0); PG8_SCHED; PG8_LDA(At, 0, 0); PG8_STAGE(PG8_SA(1, 1), a1 + hstepA, voffA);
            PG8_WAIT_L(8); PG8_BAR; PG8_WAIT_L(0); PG8_MMA(0, 0, At, B0); PG8_BAR; PG8_SCHED;
            PG8_LDB(B1, 0, 1); PG8_STAGE(PG8_SB(0, 0), b2, voffB);
            PG8_BAR; PG8_WAIT_L(0); PG8_MMA(0, 1, At, B1); PG8_BAR;
            PG8_LDA(At, 0, 1); PG8_STAGE(PG8_SA(0, 0), a2, voffA);
            PG8_BAR; PG8_WAIT_L(0); PG8_MMA(1, 0, At, B0); PG8_BAR; PG8_SCHED;
            PG8_STAGE(PG8_SB(0, 1), b2 + hstepB, voffB);
            PG8_WAIT_V(6); PG8_BAR; PG8_MMA(1, 1, At, B1); PG8_BAR;
            PG8_LDB(B0, 1, 0); PG8_SCHED; PG8_LDA(At, 1, 0); PG8_STAGE(PG8_SA(0, 1), a2 + hstepA, voffA);
            PG8_WAIT_L(8); PG8_BAR; PG8_WAIT_L(0); PG8_MMA(0, 0, At, B0); PG8_BAR; PG8_SCHED;
            PG8_LDB(B1, 1, 1); PG8_STAGE(PG8_SB(1, 0), b3, voffB);
            PG8_BAR; PG8_WAIT_L(0); PG8_MMA(0, 1, At, B1); PG8_BAR;
            PG8_LDA(At, 1, 1); PG8_STAGE(PG8_SA(1, 0), a3, voffA);
            PG8_BAR; PG8_WAIT_L(0); PG8_MMA(1, 0, At, B0); PG8_BAR; PG8_SCHED;
            PG8_STAGE(PG8_SB(1, 1), b3 + hstepB, voffB);
            PG8_WAIT_V(6); PG8_BAR; PG8_MMA(1, 1, At, B1); PG8_BAR;
        }
        E(acc, cur, wr, wc, fr, fq);
        if (!has_next) break;
#pragma unroll
        for (int a = 0; a < 2; ++a)
#pragma unroll
            for (int b = 0; b < 2; ++b)
#pragma unroll
                for (int m = 0; m < 4; ++m)
#pragma unroll
                    for (int n = 0; n < 2; ++n) acc[a][b][m][n] = (f32x4){0.f, 0.f, 0.f, 0.f};
        cur = nxt; cA = nA; cB = nB; ++ui;
    }
    PG8_WAIT_V(0);
    if (wr == 0) PG8_BAR;
    PG8_BAR;
#undef PG8_SA
#undef PG8_SB
#undef PG8_STAGE
#undef PG8_LDA
#undef PG8_LDB
#undef PG8_MMA
#undef PG8_WAIT_V
#undef PG8_WAIT_L
#undef PG8_BAR
#undef PG8_SCHED
}
}
using pg8::Unit;
typedef f32x4 Acc[2][2][4][2];

typedef unsigned long long fix_t;
__device__ __forceinline__ fix_t to_fix(float v) { return (fix_t)(long long)(v * 4294967296.0f); }
__device__ __forceinline__ float from_fix(fix_t v) { return fmaf((float)(unsigned)v, 2.3283064365386963e-10f, (float)(int)(v >> 32)); }
__device__ __forceinline__ void fix_add(fix_t* p, float v) { __hip_atomic_fetch_add(p, to_fix(v), __ATOMIC_RELAXED, __HIP_MEMORY_SCOPE_AGENT); }
__device__ __forceinline__ f32x4 ld_fix4(const fix_t* p) { typedef unsigned long long u64x2 __attribute__((ext_vector_type(2))); const u64x2 a = *(const u64x2*)p, b = *(const u64x2*)(p + 2);
    return (f32x4){from_fix(a.x), from_fix(a.y), from_fix(b.x), from_fix(b.y)}; }
__device__ __forceinline__ void row_ln(const fix_t* st, int row, float& mu, float& rs) { const float s1 = from_fix(st[row]), s2 = from_fix(st[M_ + row]); mu = s1 * (1.0f / 2048.0f); rs = __builtin_amdgcn_rsqf(s2 * (1.0f / 2048.0f) - mu * mu + LN_EPS); }
template <bool PERM>
__device__ __forceinline__ void ln_correct(f32x4 (&acc)[2][2][4][2], const fix_t* st, const float* cs, const float* bw, int row0, int colbase) {
    f32x4 c4[2][2], b4[2][2];
#pragma unroll
    for (int bj = 0; bj < 2; ++bj)
#pragma unroll
        for (int n = 0; n < 2; ++n) { const int col = colbase + bj * 128 + (PERM ? 4 * n : 16 * n); c4[bj][n] = *(const f32x4*)(cs + col); b4[bj][n] = *(const f32x4*)(bw + col); }
#pragma unroll
    for (int ai = 0; ai < 2; ++ai) { fix_t r1[4], r2[4];
#pragma unroll
        for (int m = 0; m < 4; ++m) { const int row = row0 + ai * 128 + m * 16; r1[m] = st[row]; r2[m] = st[M_ + row]; }
#pragma unroll
        for (int m = 0; m < 4; ++m) { const float mu = from_fix(r1[m]) * (1.0f / 2048.0f), rs = __builtin_amdgcn_rsqf(from_fix(r2[m]) * (1.0f / 2048.0f) - mu * mu + LN_EPS);
#pragma unroll
            for (int bj = 0; bj < 2; ++bj)
#pragma unroll
                for (int n = 0; n < 2; ++n) acc[ai][bj][m][n] = (acc[ai][bj][m][n] - c4[bj][n] * mu) * rs + b4[bj][n]; } }
}

struct EpiIn {
    static constexpr bool PERM = true;
    bf16_t *cq, *ckv, *xl, *gg, *kpe; float* ssq; const float *cosT, *sinT; const fix_t* st; const float *cs, *bw;
    __device__ __forceinline__ void operator()(Acc& acc, const Unit& u, int wr, int wc, int fr, int fq) const {
        const int row0 = u.pm * 256 + wr * 64 + fr, pn = u.pn;
        ln_correct<true>(acc, st, cs, bw, row0, pn * 256 + wc * 32 + 8 * fq);
        if (pn < 4) {
            bf16_t* base = (pn < 2 ? cq : ckv); const int col0 = (pn & 1) * 256 + wc * 32 + 8 * fq;
#pragma unroll
            for (int ai = 0; ai < 2; ++ai)
#pragma unroll
                for (int m = 0; m < 4; ++m) { const int row = row0 + ai * 128 + m * 16; float s = 0.f;
#pragma unroll
                    for (int bj = 0; bj < 2; ++bj) { const f32x4 v0 = acc[ai][bj][m][0], v1 = acc[ai][bj][m][1];
                        s += (v0[0] * v0[0] + v0[1] * v0[1]) + (v0[2] * v0[2] + v0[3] * v0[3]) + (v1[0] * v1[0] + v1[1] * v1[1]) + (v1[2] * v1[2] + v1[3] * v1[3]);
                        *(u32x4*)(base + (size_t)row * 512 + col0 + bj * 128) = pack8(v0, v1); }
                    s = sum_fq(s);
                    if (fq == 0) ssq[(size_t)row * 16 + pn * 4 + wc] = s; }
        } else if (pn < 8) {
            const int col0 = (pn - 4) * 256 + wc * 32 + 8 * fq;
#pragma unroll
            for (int ai = 0; ai < 2; ++ai)
#pragma unroll
                for (int m = 0; m < 4; ++m) { const int row = row0 + ai * 128 + m * 16;
#pragma unroll
                    for (int bj = 0; bj < 2; ++bj) *(u32x4*)(xl + (size_t)row * 1024 + col0 + bj * 128) = pack8(acc[ai][bj][m][0], acc[ai][bj][m][1]); }
        } else if (pn < 12) {
            const int col0 = (pn - 8) * 256 + wc * 32 + 8 * fq;
#pragma unroll
            for (int ai = 0; ai < 2; ++ai)
#pragma unroll
                for (int m = 0; m < 4; ++m) { const int row = row0 + ai * 128 + m * 16;
#pragma unroll
                    for (int bj = 0; bj < 2; ++bj) { f32x4 v0 = acc[ai][bj][m][0], v1 = acc[ai][bj][m][1];
#pragma unroll
                        for (int j = 0; j < 4; ++j) { v0[j] = gelu_tanh(v0[j]); v1[j] = gelu_tanh(v1[j]); }
                        *(u32x4*)(gg + (size_t)row * 1024 + col0 + bj * 128) = pack8(v0, v1); } }
        } else if (wc == 0) {
#pragma unroll
            for (int ai = 0; ai < 2; ++ai) { f32x4 c0[4], c1[4], s0[4], s1[4];
#pragma unroll
                for (int m = 0; m < 4; ++m) { const size_t t = (size_t)(row0 + ai * 128 + m * 16) * 32 + 8 * fq;
                    c0[m] = *(const f32x4*)(cosT + t); c1[m] = *(const f32x4*)(cosT + t + 4); s0[m] = *(const f32x4*)(sinT + t); s1[m] = *(const f32x4*)(sinT + t + 4); }
#pragma unroll
                for (int m = 0; m < 4; ++m) { const int row = row0 + ai * 128 + m * 16;
                    const f32x4 a0 = acc[ai][0][m][0], a1 = acc[ai][0][m][1], b0 = acc[ai][1][m][0], b1 = acc[ai][1][m][1];
                    *(u32x4*)(kpe + (size_t)row * 64 + 8 * fq) = pack8(a0 * c0[m] - b0 * s0[m], a1 * c1[m] - b1 * s1[m]);
                    *(u32x4*)(kpe + (size_t)row * 64 + 32 + 8 * fq) = pack8(b0 * c0[m] + a0 * s0[m], b1 * c1[m] + a1 * s1[m]); } }
        }
    }
};
__device__ __forceinline__ void rows_rstd(const float* ssq8, int row0, float (&rs)[8]) {
#pragma unroll
    for (int h = 0; h < 2; ++h) { f32x4 a[4], b[4];
#pragma unroll
        for (int k = 0; k < 4; ++k) { const float* p = ssq8 + (size_t)(row0 + h * 128 + k * 16) * 16; a[k] = *(const f32x4*)p; b[k] = *(const f32x4*)(p + 4); }
#pragma unroll
        for (int k = 0; k < 4; ++k) { const float s = ((a[k][0] + a[k][1]) + (a[k][2] + a[k][3])) + ((b[k][0] + b[k][1]) + (b[k][2] + b[k][3])); rs[h * 4 + k] = __builtin_amdgcn_rsqf(s * (1.0f / 512.0f) + RMS_EPS); } }
}
struct EpiQ {
    static constexpr bool PERM = true;
    bf16_t* q; const float* ssq; const float *cosT, *sinT;
    __device__ __forceinline__ void operator()(Acc& acc, const Unit& u, int wr, int wc, int fr, int fq) const {
        const int row0 = u.pm * 256 + wr * 64 + fr, pn = u.pn;
        float rs[8]; rows_rstd(ssq, row0, rs);
        if (pn < 4) {
            const int col0 = pn * 256 + wc * 32 + 8 * fq;
#pragma unroll
            for (int ai = 0; ai < 2; ++ai)
#pragma unroll
                for (int m = 0; m < 4; ++m) { const int row = row0 + ai * 128 + m * 16; const float r = rs[ai * 4 + m];
#pragma unroll
                    for (int bj = 0; bj < 2; ++bj) *(u32x4*)(q + (size_t)row * 1536 + col0 + bj * 128) = pack8(acc[ai][bj][m][0] * r, acc[ai][bj][m][1] * r); }
        } else {
            const int head = 4 * (pn - 4) + wc;
#pragma unroll
            for (int kb = 0; kb < 4; ++kb) { f32x4 c0[2], c1[2], s0[2], s1[2];
#pragma unroll
                for (int j = 0; j < 2; ++j) { const int k = kb * 2 + j; const size_t t = (size_t)(row0 + (k >> 2) * 128 + (k & 3) * 16) * 32 + 8 * fq;
                    c0[j] = *(const f32x4*)(cosT + t); c1[j] = *(const f32x4*)(cosT + t + 4); s0[j] = *(const f32x4*)(sinT + t); s1[j] = *(const f32x4*)(sinT + t + 4); }
#pragma unroll
                for (int j = 0; j < 2; ++j) { const int k = kb * 2 + j, ai = k >> 2, m = k & 3; const int row = row0 + ai * 128 + m * 16; const float r = rs[k];
                    const f32x4 a0 = acc[ai][0][m][0] * r, a1 = acc[ai][0][m][1] * r, b0 = acc[ai][1][m][0] * r, b1 = acc[ai][1][m][1] * r;
                    *(u32x4*)(q + (size_t)row * 1536 + 1024 + head * 64 + 8 * fq) = pack8(a0 * c0[j] - b0 * s0[j], a1 * c1[j] - b1 * s1[j]);
                    *(u32x4*)(q + (size_t)row * 1536 + 1024 + head * 64 + 32 + 8 * fq) = pack8(b0 * c0[j] + a0 * s0[j], b1 * c1[j] + a1 * s1[j]); } }
        }
    }
};
struct EpiKV {
    static constexpr bool PERM = true;
    bf16_t* kv; const float* ssq;
    __device__ __forceinline__ void operator()(Acc& acc, const Unit& u, int wr, int wc, int fr, int fq) const {
        const int row0 = u.pm * 256 + wr * 64 + fr, col0 = u.pn * 256 + wc * 32 + 8 * fq;
        float rs[8]; rows_rstd(ssq + 8, row0, rs);
#pragma unroll
        for (int ai = 0; ai < 2; ++ai)
#pragma unroll
            for (int m = 0; m < 4; ++m) { const int row = row0 + ai * 128 + m * 16; const float r = rs[ai * 4 + m];
#pragma unroll
                for (int bj = 0; bj < 2; ++bj) *(u32x4*)(kv + (size_t)row * 2048 + col0 + bj * 128) = pack8(acc[ai][bj][m][0] * r, acc[ai][bj][m][1] * r); }
    }
};
struct EpiGate {
    static constexpr bool PERM = true;
    unsigned* au; const bf16_t* xc; const float *ba, *bi, *sp;
    __device__ __forceinline__ void operator()(Acc& acc, const Unit& u, int wr, int wc, int fr, int fq) const {
        const int row0 = u.pm * 256 + wr * 64 + fr, d = u.pn, ch0 = u.z * 128 + wc * 32 + 8 * fq;
        unsigned* aud = au + (size_t)d * M_ * 1024;
#pragma unroll
        for (int n = 0; n < 2; ++n) {
            const int ch = ch0 + 4 * n;
            const f32x4 bav = *(const f32x4*)(ba + d * 1024 + ch), biv = *(const f32x4*)(bi + d * 1024 + ch), spv = *(const f32x4*)(sp + d * 1024 + ch) * (-8.0f * 1.4426950408889634f);
            u32x2 xws[8];
#pragma unroll
            for (int k = 0; k < 8; ++k) xws[k] = *(const u32x2*)(xc + (size_t)(row0 + (k >> 2) * 128 + (k & 3) * 16) * 1024 + ch);
#pragma unroll
            for (int ai = 0; ai < 2; ++ai)
#pragma unroll
                for (int m = 0; m < 4; ++m) { const int row = row0 + ai * 128 + m * 16;
                    const u32x2 xw = xws[ai * 4 + m];
                    const float xv[4] = {bf_lo(xw.x), bf_hi(xw.x), bf_lo(xw.y), bf_hi(xw.y)};
                    u32x4 o;
#pragma unroll
                    for (int j = 0; j < 4; ++j) {
                        const float r = sigmoidf_(acc[ai][0][m][n][j] + bav[j]);
                        const float ig = sigmoidf_(acc[ai][1][m][n][j] + biv[j]);
                        const float a = __builtin_amdgcn_exp2f(r * spv[j]);
                        const float oma = 1.0f - a;
                        const float uu = __builtin_amdgcn_sqrtf(oma * (1.0f + a)) * ig * xv[j];
                        o[j] = cvt_pk_bf16(oma, uu); }
                    *(u32x4*)(aud + (size_t)row * 1024 + ch) = o; }
        }
    }
};
#ifndef RES_PF
#define RES_PF 1
#endif
struct EpiRes {
    static constexpr bool PERM = false;
    const float* src; float* out; bf16_t* hb; const fix_t* st_old; const float *g, *b; fix_t* st_new;
    __device__ __forceinline__ void operator()(Acc& acc, const Unit& u, int wr, int wc, int fr, int fq) const {
        const int row0 = u.pm * 256 + wr * 64 + fr, col0 = u.pn * 256 + wc * 32 + 4 * fq;
        f32x4 gv[4], bv[4], P[RES_PF + 1][4]; float mus[8], rss[8];
#pragma unroll
        for (int h = 0; h < 2; ++h) { fix_t r1[4], r2[4];
#pragma unroll
            for (int k = 0; k < 4; ++k) { const int row = row0 + h * 128 + k * 16; r1[k] = st_old[row]; r2[k] = st_old[M_ + row]; }
#pragma unroll
            for (int k = 0; k < 4; ++k) { mus[h * 4 + k] = from_fix(r1[k]) * (1.0f / 2048.0f); rss[h * 4 + k] = __builtin_amdgcn_rsqf(from_fix(r2[k]) * (1.0f / 2048.0f) - mus[h * 4 + k] * mus[h * 4 + k] + LN_EPS); } }
#pragma unroll
        for (int c = 0; c < 4; ++c) { gv[c] = *(const f32x4*)(g + col0 + (c >> 1) * 128 + (c & 1) * 16); bv[c] = *(const f32x4*)(b + col0 + (c >> 1) * 128 + (c & 1) * 16); }
#define RES_LOAD(k) do { const size_t off_ = (size_t)(row0 + ((k) >> 2) * 128 + ((k) & 3) * 16) * 2048 + col0; _Pragma("unroll") for (int c = 0; c < 4; ++c) P[(k) % (RES_PF + 1)][c] = *(const f32x4*)(src + off_ + (c >> 1) * 128 + (c & 1) * 16); } while (0)
#pragma unroll
        for (int k = 0; k < RES_PF; ++k) RES_LOAD(k);
#pragma unroll
        for (int k = 0; k < 8; ++k) {
            if (k + RES_PF < 8) RES_LOAD(k + RES_PF);
            const int ai = k >> 2, m = k & 3; const size_t off = (size_t)(row0 + ai * 128 + m * 16) * 2048 + col0;
            const float mu = mus[k], rs = rss[k];
            float a1 = 0.f, a2 = 0.f;
#pragma unroll
            for (int c = 0; c < 4; ++c) { const int cc = (c >> 1) * 128 + (c & 1) * 16;
                const f32x4 v = ((P[k % (RES_PF + 1)][c] - mu) * rs * gv[c] + bv[c]) * ALPHA + acc[ai][c >> 1][m][c & 1];
                *(f32x4*)(out + off + cc) = v; u32x2 w; w.x = cvt_pk_bf16(v[0], v[1]); w.y = cvt_pk_bf16(v[2], v[3]); *(u32x2*)(hb + off + cc) = w;
                a1 += (v[0] + v[1]) + (v[2] + v[3]); a2 += (v[0] * v[0] + v[1] * v[1]) + (v[2] * v[2] + v[3] * v[3]); }
            a1 = sum_fq(a1); a2 = sum_fq(a2);
            { const int row = row0 + ai * 128 + m * 16; if (fq == 0) fix_add(st_new + row, a1); else if (fq == 1) fix_add(st_new + M_ + row, a2); }
        }
#undef RES_LOAD
    }
};
struct EpiUp {
    static constexpr bool PERM = true;
    bf16_t* f; const fix_t* st; const float *cs, *bw;
    __device__ __forceinline__ void operator()(Acc& acc, const Unit& u, int wr, int wc, int fr, int fq) const {
        const int row0 = u.pm * 256 + wr * 64 + fr, col0 = u.pn * 256 + wc * 32 + 8 * fq;
        ln_correct<true>(acc, st, cs, bw, row0, col0);
#pragma unroll
        for (int ai = 0; ai < 2; ++ai)
#pragma unroll
            for (int m = 0; m < 4; ++m) { const int row = row0 + ai * 128 + m * 16;
#pragma unroll
                for (int bj = 0; bj < 2; ++bj) { f32x4 v0 = acc[ai][bj][m][0], v1 = acc[ai][bj][m][1];
#pragma unroll
                    for (int j = 0; j < 4; ++j) { const float a = fmaxf(v0[j], 0.f), b = fmaxf(v1[j], 0.f); v0[j] = a * a; v1[j] = b * b; }
                    *(u32x4*)(f + (size_t)row * 8192 + col0 + bj * 128) = pack8(v0, v1); } }
    }
};

namespace att {
constexpr int NW = 8, QBLK = 32, KVBLK = 64;
constexpr float SCALE = 0.07216878364870323f;
constexpr float THR = 8.f;
#ifndef ATT_SDEPTH
#define ATT_SDEPTH 1
#endif
constexpr int SDEPTH = ATT_SDEPTH;
constexpr int SHM_V = KVBLK * 128 * 2, SHM_K = KVBLK * 128 * 2, SHM_R = KVBLK * 64 * 2;
constexpr int OFF_V = 0, OFF_K = 2 * SHM_V, OFF_R = OFF_K + 2 * SHM_K, OFF_WS = OFF_R + 2 * SHM_R, OFF_QR = OFF_WS + NW * 64 * 4, SHM_ATTN = OFF_QR + 256 * 128;
#define KSWZ(row, colB) ((row) * 256 + ((colB) ^ (((row) & 7) << 4)))
#define RSWZ(row, colB) ((row) * 128 + ((colB) ^ (((row) & 7) << 4)))
#define SBAR() __builtin_amdgcn_sched_barrier(0)
__device__ __forceinline__ int crow(int r, int hi) { return (r & 3) + 8 * (r >> 2) + 4 * hi; }
__device__ __forceinline__ void partialSM(f32x16& p0, f32x16& p1, float& m_reg, float& mn, float& alpha) {
    constexpr float C = SCALE * 1.4426950408889634f;
    float pmax = p0[0];
#pragma unroll
    for (int r = 1; r < 16; ++r) pmax = fmaxf(pmax, p0[r]);
#pragma unroll
    for (int r = 0; r < 16; ++r) pmax = fmaxf(pmax, p1[r]);
    { auto rr = __builtin_amdgcn_permlane32_swap(__float_as_uint(pmax), __float_as_uint(pmax), false, false);
      pmax = fmaxf(__uint_as_float(rr[0]), __uint_as_float(rr[1])); }
    if (__builtin_expect(__all(pmax - m_reg <= THR / SCALE), 1)) { mn = m_reg; alpha = 1.f; }
    else { mn = fmaxf(m_reg, pmax); alpha = __builtin_amdgcn_exp2f((m_reg - mn) * C); m_reg = mn; }
    const float mnC = -mn * C;
#pragma unroll
    for (int r = 0; r < 16; ++r) p0[r] = fmaf(p0[r], C, mnC);
#pragma unroll
    for (int r = 0; r < 16; ++r) p1[r] = fmaf(p1[r], C, mnC);
#pragma unroll
    for (int r = 0; r < 16; ++r) p0[r] = __builtin_amdgcn_exp2f(p0[r]);
}
__device__ __forceinline__ void finishSM(f32x16& p0, f32x16& p1, float alpha, float& l_reg, bf16x8& pa0, bf16x8& pa1, bf16x8& pa2, bf16x8& pa3) {
#pragma unroll
    for (int r = 0; r < 16; ++r) p1[r] = __builtin_amdgcn_exp2f(p1[r]);
    float ps = 0;
#pragma unroll
    for (int r = 0; r < 16; ++r) ps += p0[r];
#pragma unroll
    for (int r = 0; r < 16; ++r) ps += p1[r];
    { auto rr = __builtin_amdgcn_permlane32_swap(__float_as_uint(ps), __float_as_uint(ps), false, false);
      ps = __uint_as_float(rr[0]) + __uint_as_float(rr[1]); }
    l_reg = l_reg * alpha + ps;
#define PK4(P, BASE, OUT) do { unsigned a0 = cvt_pk_bf16(P[BASE + 0], P[BASE + 1]), a1 = cvt_pk_bf16(P[BASE + 2], P[BASE + 3]);   \
    unsigned b0 = cvt_pk_bf16(P[BASE + 4], P[BASE + 5]), b1 = cvt_pk_bf16(P[BASE + 6], P[BASE + 7]);                              \
    auto r0 = __builtin_amdgcn_permlane32_swap(a0, b0, false, false); auto r1 = __builtin_amdgcn_permlane32_swap(a1, b1, false, false); \
    u32x4 w = {r0[0], r1[0], r0[1], r1[1]}; OUT = *reinterpret_cast<bf16x8*>(&w); } while (0)
    PK4(p0, 0, pa0); PK4(p0, 8, pa1); PK4(p1, 0, pa2); PK4(p1, 8, pa3);
#undef PK4
}
__device__ __forceinline__ void qkt(f32x16& p0, f32x16& p1, const char* Ks, const char* Rs, const bf16x8* qr, const char* Qrl, int r32, int hi) {
    p0 = f32x16{}; p1 = f32x16{};
#pragma unroll
    for (int d0 = 0; d0 < 8; ++d0) { const int cb = (d0 * 16 + hi * 8) * 2;
        const bf16x8 b0 = *reinterpret_cast<const bf16x8*>(Ks + KSWZ(r32, cb));
        const bf16x8 b1 = *reinterpret_cast<const bf16x8*>(Ks + KSWZ(32 + r32, cb));
        p0 = __builtin_amdgcn_mfma_f32_32x32x16_bf16(b0, qr[d0], p0, 0, 0, 0);
        p1 = __builtin_amdgcn_mfma_f32_32x32x16_bf16(b1, qr[d0], p1, 0, 0, 0); }
#pragma unroll
    for (int d0 = 0; d0 < 4; ++d0) { const int cb = (d0 * 16 + hi * 8) * 2;
        const bf16x8 b0 = *reinterpret_cast<const bf16x8*>(Rs + RSWZ(r32, cb));
        const bf16x8 b1 = *reinterpret_cast<const bf16x8*>(Rs + RSWZ(32 + r32, cb));
        const bf16x8 qv = *reinterpret_cast<const bf16x8*>(Qrl + (cb ^ ((r32 & 7) << 4)));
        p0 = __builtin_amdgcn_mfma_f32_32x32x16_bf16(b0, qv, p0, 0, 0, 0);
        p1 = __builtin_amdgcn_mfma_f32_32x32x16_bf16(b1, qv, p1, 0, 0, 0); }
}
__device__ __forceinline__ int v_st(int k, int c) { const int kk = (k & ~0xC) | ((k & 4) << 1) | ((k & 8) >> 1); return ((kk >> 3) * 4 + (c >> 5)) * 512 + ((kk & 7) * 32 + (c & 31)) * 2; }
__device__ __forceinline__ int v_rd_base(int lane) { return ((lane & 3) << 3) | (((lane >> 2) & 3) << 6) | (((lane >> 4) & 1) << 5) | (((lane >> 5) & 1) << 8); }
constexpr int v_rd_off(int d0, int ks, int half) { return d0 * 512 + ks * 4096 + half * 2048; }
template <int OFF> __device__ __forceinline__ s16x4 tr_read(int vb) {
    s16x4 r; asm volatile("ds_read_b64_tr_b16 %0, %1 offset:%2" : "=&v"(r) : "v"(vb), "i"(OFF) : "memory"); return r;
}
template <int D0> __device__ __forceinline__ void pv_one(f32x16& od, int vb, bf16x8 pa0, bf16x8 pa1, bf16x8 pa2, bf16x8 pa3) {
    const s16x4 l0 = tr_read<v_rd_off(D0, 0, 0)>(vb), h0 = tr_read<v_rd_off(D0, 0, 1)>(vb), l1 = tr_read<v_rd_off(D0, 1, 0)>(vb), h1 = tr_read<v_rd_off(D0, 1, 1)>(vb);
    const s16x4 l2 = tr_read<v_rd_off(D0, 2, 0)>(vb), h2 = tr_read<v_rd_off(D0, 2, 1)>(vb), l3 = tr_read<v_rd_off(D0, 3, 0)>(vb), h3 = tr_read<v_rd_off(D0, 3, 1)>(vb);
    asm volatile("s_waitcnt lgkmcnt(0)" ::: "memory"); SBAR();
#define PK(L, H) (bf16x8){L[0], L[1], L[2], L[3], H[0], H[1], H[2], H[3]}
    od = __builtin_amdgcn_mfma_f32_32x32x16_bf16(pa0, PK(l0, h0), od, 0, 0, 0);
    od = __builtin_amdgcn_mfma_f32_32x32x16_bf16(pa1, PK(l1, h1), od, 0, 0, 0);
    od = __builtin_amdgcn_mfma_f32_32x32x16_bf16(pa2, PK(l2, h2), od, 0, 0, 0);
    od = __builtin_amdgcn_mfma_f32_32x32x16_bf16(pa3, PK(l3, h3), od, 0, 0, 0);
#undef PK
}
__device__ __forceinline__ void pv_d0(f32x16* o, int vb, bf16x8 pa0, bf16x8 pa1, bf16x8 pa2, bf16x8 pa3) {
    pv_one<0>(o[0], vb, pa0, pa1, pa2, pa3); pv_one<1>(o[1], vb, pa0, pa1, pa2, pa3); pv_one<2>(o[2], vb, pa0, pa1, pa2, pa3); pv_one<3>(o[3], vb, pa0, pa1, pa2, pa3);
}
__device__ __forceinline__ void attn_unit(const bf16_t* __restrict__ Qn, const bf16_t* __restrict__ Qr, const bf16_t* __restrict__ Kh, const bf16_t* __restrict__ Rh,
                                          bf16_t* __restrict__ Ob, int seq, char* lds) {
    const int tid = otid(), wid = tid >> 6, lane = tid & 63, r32 = lane & 31, hi = lane >> 5;
    char* V_lds = lds + OFF_V; char* K_lds = lds + OFF_K; char* R_lds = lds + OFF_R;
    float* ws = (float*)(lds + OFF_WS) + wid * 64; float* li_l = ws; float* al_l = ws + 32;
    float m_reg = -1e30f, l_reg = 0; f32x16 o[4] = {}; bf16x8 qr[8];
    char* Qrl = lds + OFF_QR + (wid * QBLK + r32) * 128;
    {
        const bf16_t* Qw = Qn + (size_t)(wid * QBLK + r32) * 1536 + hi * 8;
#pragma unroll
        for (int d0 = 0; d0 < 8; ++d0) qr[d0] = *reinterpret_cast<const bf16x8*>(Qw + d0 * 16);
        const bf16_t* Qw2 = Qr + (size_t)(wid * QBLK + r32) * 1536 + hi * 8;
#pragma unroll
        for (int d0 = 0; d0 < 4; ++d0) { const bf16x8 t = *reinterpret_cast<const bf16x8*>(Qw2 + d0 * 16); *reinterpret_cast<bf16x8*>(Qrl + (((d0 * 16 + hi * 8) * 2) ^ ((r32 & 7) << 4))) = t; }
    }
    const int sr = tid >> 4, sc = (tid & 15) * 8, vst0 = v_st(sr, sc), vst1 = v_st(32 + sr, sc);
    const int rr_ = tid >> 3, rc = (tid & 7) * 8;
    const int vb0 = (int)(uintptr_t)V_lds + v_rd_base(lane);
    struct { bf16x8 vs0, vs1, ks0, ks1, rs; } sr_[SDEPTH];
#define SLOAD(i, k0) do { sr_[i].vs0 = *(const bf16x8*)(&Kh[(size_t)((k0) + sr) * 2048 + 128 + sc]); sr_[i].vs1 = *(const bf16x8*)(&Kh[(size_t)((k0) + 32 + sr) * 2048 + 128 + sc]); \
    sr_[i].ks0 = *(const bf16x8*)(&Kh[(size_t)((k0) + sr) * 2048 + sc]); sr_[i].ks1 = *(const bf16x8*)(&Kh[(size_t)((k0) + 32 + sr) * 2048 + sc]); \
    sr_[i].rs = *(const bf16x8*)(&Rh[(size_t)((k0) + rr_) * 64 + rc]); } while (0)
#define SWRITE(b, i) do { *(bf16x8*)(V_lds + (b) * SHM_V + vst0) = sr_[i].vs0;          \
    *(bf16x8*)(V_lds + (b) * SHM_V + vst1) = sr_[i].vs1; const int kc = sc * 2;               \
    *(bf16x8*)(K_lds + (b) * SHM_K + KSWZ(sr, kc)) = sr_[i].ks0;                       \
    *(bf16x8*)(K_lds + (b) * SHM_K + KSWZ(32 + sr, kc)) = sr_[i].ks1;                  \
    *(bf16x8*)(R_lds + (b) * SHM_R + RSWZ(rr_, rc * 2)) = sr_[i].rs; } while (0)
#define SWAIT() do { if constexpr (SDEPTH == 2) asm volatile("s_waitcnt vmcnt(5)" ::: "memory"); else asm volatile("s_waitcnt vmcnt(0)" ::: "memory"); } while (0)
#define RESC(a) do { if (__any((a) < 1.f)) { if (hi == 0) al_l[r32] = (a); asm volatile("s_waitcnt lgkmcnt(0)" ::: "memory"); \
    _Pragma("unroll") for (int d = 0; d < 4; ++d) _Pragma("unroll") for (int r = 0; r < 16; ++r) o[d][r] *= al_l[crow(r, hi)]; } } while (0)
    f32x16 pA0, pA1, pB0, pB1; float mnA, mnB, alA, alB; bf16x8 pa0, pa1, pa2, pa3; const int NT = seq / KVBLK;
    constexpr int SE = 0, SO = SDEPTH - 1;
    SLOAD(SE, 0); asm volatile("s_waitcnt vmcnt(0)" ::: "memory"); SWRITE(0, SE); __syncthreads();
    qkt(pA0, pA1, K_lds, R_lds, qr, Qrl, r32, hi); partialSM(pA0, pA1, m_reg, mnA, alA);
    SLOAD(SO, KVBLK); if constexpr (SDEPTH == 2) { if (2 < NT) SLOAD(SE, 2 * KVBLK); }
    SWAIT(); SWRITE(1, SO); __syncthreads();
    for (int j = 1; j + 1 < NT; j += 2) {
        SBAR(); qkt(pB0, pB1, K_lds + SHM_K, R_lds + SHM_R, qr, Qrl, r32, hi);
        finishSM(pA0, pA1, alA, l_reg, pa0, pa1, pa2, pa3); SBAR();
        SLOAD(SO, (j + SDEPTH) * KVBLK); SBAR();
        pv_d0(o, vb0, pa0, pa1, pa2, pa3); partialSM(pB0, pB1, m_reg, mnB, alB);
        __syncthreads(); SWAIT(); SWRITE(0, SE);
        RESC(alB); __syncthreads();
        SBAR(); qkt(pA0, pA1, K_lds, R_lds, qr, Qrl, r32, hi);
        finishSM(pB0, pB1, alB, l_reg, pa0, pa1, pa2, pa3); SBAR();
        if (SDEPTH == 1 || j + 3 < NT) SLOAD(SE, (j + 1 + SDEPTH) * KVBLK); SBAR();
        pv_d0(o, vb0 + (int)SHM_V, pa0, pa1, pa2, pa3); partialSM(pA0, pA1, m_reg, mnA, alA);
        __syncthreads(); SWAIT(); SWRITE(1, SO);
        RESC(alA); __syncthreads();
    }
    SBAR(); qkt(pB0, pB1, K_lds + SHM_K, R_lds + SHM_R, qr, Qrl, r32, hi);
    finishSM(pA0, pA1, alA, l_reg, pa0, pa1, pa2, pa3); SBAR();
    pv_d0(o, vb0, pa0, pa1, pa2, pa3); partialSM(pB0, pB1, m_reg, mnB, alB);
    __syncthreads(); RESC(alB);
    finishSM(pB0, pB1, alB, l_reg, pa0, pa1, pa2, pa3); SBAR();
    pv_d0(o, vb0 + (int)SHM_V, pa0, pa1, pa2, pa3);
    if (hi == 0) li_l[r32] = l_reg; asm volatile("s_waitcnt lgkmcnt(0)" ::: "memory");
    float rli[16];
#pragma unroll
    for (int r = 0; r < 16; ++r) rli[r] = __builtin_amdgcn_rcpf(li_l[crow(r, hi)]);
    bf16_t* Ow = Ob + (size_t)(wid * QBLK) * 2048;
#pragma unroll
    for (int r = 0; r < 16; ++r) { const int orow = crow(r, hi);
#pragma unroll
        for (int d0 = 0; d0 < 4; ++d0) Ow[(size_t)orow * 2048 + d0 * 32 + r32] = (bf16_t)(cvt_pk_bf16(o[d0][r] * rli[r], 0.f) & 0xffffu); }
#undef SLOAD
#undef SWRITE
#undef SWAIT
#undef RESC
}
}

__device__ __forceinline__ void x_pass(const float* src, bf16_t* dstb, fix_t* st) {
    const int tid_ = otid(), lane = tid_ & 63, wave = tid_ >> 6;
    for (int row = blockIdx.x * 8 + wave; row < M_; row += gridDim.x * 8) {
        const float* s = src + (size_t)row * 2048; f32x4 v[8]; float s1 = 0.f, s2 = 0.f;
#pragma unroll
        for (int i = 0; i < 8; ++i) { v[i] = *(const f32x4*)(s + i * 256 + lane * 4); s1 += (v[i][0] + v[i][1]) + (v[i][2] + v[i][3]); s2 += (v[i][0] * v[i][0] + v[i][1] * v[i][1]) + (v[i][2] * v[i][2] + v[i][3] * v[i][3]); }
        s1 = wave_sum(s1, lane); s2 = wave_sum(s2, lane);
        if (lane == 0) { st[row] = to_fix(s1); st[M_ + row] = to_fix(s2); }
#pragma unroll
        for (int i = 0; i < 8; ++i) { u32x2 w; w.x = cvt_pk_bf16(v[i][0], v[i][1]); w.y = cvt_pk_bf16(v[i][2], v[i][3]); *(u32x2*)(dstb + (size_t)row * 2048 + i * 256 + lane * 4) = w; }
    }
}
__device__ __forceinline__ void ln_final(float* out, const fix_t* st, const float* g, const float* b) {
    const int tid = otid();
    for (size_t i = (size_t)blockIdx.x * 512 + tid; i < (size_t)M_ * 512; i += (size_t)gridDim.x * 512) {
        const int row = (int)(i >> 9), c = (int)(i & 511) * 4; float mu, rs; row_ln(st, row, mu, rs);
        const f32x4 P = *(const f32x4*)(out + i * 4), g4 = *(const f32x4*)(g + c), b4 = *(const f32x4*)(b + c);
        *(f32x4*)(out + i * 4) = (P - mu) * rs * g4 + b4;
    }
}
__device__ __forceinline__ int colmap(int mode, int n) {
    if (mode == 0) { if (n < 1024) return n; if (n < 2048) return 1088 + (n - 1024); if (n < 3072) return 2112 + (n - 2048);
        const int t = n - 3072, bj = t >> 7, r = t & 127; return r < 32 ? 1024 + bj * 32 + r : -1; }
    if (mode == 1) { if (n < 1024) return (n >> 7) * 192 + (n & 127);
        const int t = n - 1024, tile = t >> 8, bj = (t >> 7) & 1, wc = (t >> 5) & 3, i = t & 31; return (4 * tile + wc) * 192 + 128 + bj * 32 + i; }
    return n;
}
__device__ __forceinline__ void cvt_tile(const float* W, int ldw, bf16_t* Bt, int ldb, int n0, int k0, int mode, const float* kscale, float* T) {
    const int tid = otid(), n4 = (tid & 31) * 4, kq = tid >> 5, src = colmap(mode, n0 + n4);
    f32x4 v[8];
#pragma unroll
    for (int i = 0; i < 8; ++i) { const int kk = kq + 16 * i; v[i] = *(const f32x4*)(W + (size_t)(k0 + kk) * ldw + (src >= 0 ? src : 0)); }
    float ksc[8];
#pragma unroll
    for (int i = 0; i < 8; ++i) ksc[i] = kscale ? kscale[k0 + kq + 16 * i] : 1.0f;
#pragma unroll
    for (int i = 0; i < 8; ++i) v[i] = v[i] * (src >= 0 ? ksc[i] : 0.0f);
#pragma unroll
    for (int i = 0; i < 8; ++i)
#pragma unroll
        for (int j = 0; j < 4; ++j) T[(n4 + j) * 129 + kq + 16 * i] = v[i][j];
    __syncthreads();
    { const int n2 = tid >> 2, ks = (tid & 3) * 32; const float* t = T + n2 * 129 + ks; bf16_t* dst = Bt + (size_t)(n0 + n2) * ldb + k0 + ks;
#pragma unroll
      for (int i = 0; i < 4; ++i) { u32x4 w; w.x = cvt_pk_bf16(t[i * 8 + 0], t[i * 8 + 1]); w.y = cvt_pk_bf16(t[i * 8 + 2], t[i * 8 + 3]); w.z = cvt_pk_bf16(t[i * 8 + 4], t[i * 8 + 5]); w.w = cvt_pk_bf16(t[i * 8 + 6], t[i * 8 + 7]);
          *(u32x4*)(dst + i * 8) = w; } }
    __syncthreads();
}
constexpr int CT0 = 26 * 16, CT1 = CT0 + 12 * 4, CT2 = CT1 + 16 * 4, CT3 = CT2 + 32, CT4 = CT3 + 16 * 16, CT5 = CT4 + 64 * 16, CT6 = CT5 + 16 * 64;
__device__ __forceinline__ void convert_weights(const Params& p, int l, int t0, int t1, float* T) {
    unsigned char* ws = p.ws;
    const float* ing = l == 0 ? p.in[2] : p.in[21] + (size_t)(l - 1) * 2048;
    for (int t = t0 + blockIdx.x; t < t1; t += gridDim.x) {
        if (t < CT0) { const int nt = t % 26, kt = t / 26; cvt_tile(p.in[4] + (size_t)l * 2048 * NIN, NIN, (bf16_t*)(ws + W_IN), 2048, nt * 128, kt * 128, 0, ing, T); }
        else if (t < CT1) { const int u = t - CT0, nt = u % 12, kt = u / 12; cvt_tile(p.in[7] + (size_t)l * 512 * 1536, 1536, (bf16_t*)(ws + W_UQ), 512, nt * 128, kt * 128, 1, p.in[5] + l * 512, T); }
        else if (t < CT2) { const int u = t - CT1, nt = u % 16, kt = u / 16; cvt_tile(p.in[8] + (size_t)l * 512 * 2048, 2048, (bf16_t*)(ws + W_UKV), 512, nt * 128, kt * 128, 2, p.in[6] + l * 512, T); }
        else if (t < CT3) { const int mat = t - CT2, gate = mat & 1, h = (mat >> 1) & 7, d = mat >> 4;
            cvt_tile((gate ? p.in[13] : p.in[11]) + ((size_t)((l * 2 + d) * 8 + h)) * 128 * 128, 128, (bf16_t*)(ws + W_G) + (size_t)(h * 512 + d * 256 + gate * 128) * 128, 128, 0, 0, 2, nullptr, T); }
        else if (t < CT4) { const int u = t - CT3, nt = u % 16, kt = u / 16; cvt_tile(p.in[16] + (size_t)l * 2048 * 2048, 2048, (bf16_t*)(ws + W_OUT), 2048, nt * 128, kt * 128, 2, nullptr, T); }
        else if (t < CT5) { const int u = t - CT4, nt = u % 64, kt = u / 64; cvt_tile(p.in[19] + (size_t)l * 2048 * 8192, 8192, (bf16_t*)(ws + W_UP), 2048, nt * 128, kt * 128, 2, p.in[17] + (size_t)l * 2048, T); }
        else { const int u = t - CT5, nt = u % 16, kt = u / 16; cvt_tile(p.in[20] + (size_t)l * 8192 * 2048, 2048, (bf16_t*)(ws + W_DN), 8192, nt * 128, kt * 128, 2, nullptr, T); }
    }
}
__device__ __forceinline__ void colsum_pass(const bf16_t* Bt, int N, const float* lg, const float* lb, float* cs, float* bw) {
    const int tid = otid(), lane = tid & 63, wave = tid >> 6;
    float ratio[32];
#pragma unroll
    for (int i = 0; i < 4; ++i)
#pragma unroll
        for (int j = 0; j < 8; ++j) { const int k = i * 512 + lane * 8 + j; ratio[i * 8 + j] = lb[k] * __builtin_amdgcn_rcpf(lg[k]); }
    for (int n = blockIdx.x * 8 + wave; n < N; n += gridDim.x * 8) {
        u32x4 w[4];
#pragma unroll
        for (int i = 0; i < 4; ++i) w[i] = *(const u32x4*)(Bt + (size_t)n * 2048 + i * 512 + lane * 8);
        float c = 0.f, bb = 0.f;
#pragma unroll
        for (int i = 0; i < 4; ++i) { const float v[8] = {bf_lo(w[i].x), bf_hi(w[i].x), bf_lo(w[i].y), bf_hi(w[i].y), bf_lo(w[i].z), bf_hi(w[i].z), bf_lo(w[i].w), bf_hi(w[i].w)};
#pragma unroll
            for (int j = 0; j < 8; ++j) { c += v[j]; bb += v[j] * ratio[i * 8 + j]; } }
        c = wave_sum(c, lane); bb = wave_sum(bb, lane);
        if (lane == 0) { cs[n] = c; bw[n] = bb; }
    }
}
__device__ __forceinline__ void colsum_in(const Params& p, int l) { float* csb = (float*)(p.ws + WS_CSB) + (size_t)l * CSB_L;
    colsum_pass((const bf16_t*)(p.ws + W_IN), NINP, l == 0 ? p.in[2] : p.in[21] + (size_t)(l - 1) * 2048, l == 0 ? p.in[3] : p.in[22] + (size_t)(l - 1) * 2048, csb + CSB_IN, csb + CSB_IN + NINP); }
__device__ __forceinline__ void colsum_up(const Params& p, int l) { float* csb = (float*)(p.ws + WS_CSB) + (size_t)l * CSB_L;
    colsum_pass((const bf16_t*)(p.ws + W_UP), DFF, p.in[17] + (size_t)l * 2048, p.in[18] + (size_t)l * 2048, csb + CSB_UP, csb + CSB_UP + DFF); }
__device__ __forceinline__ void make_tables(const Params& p) {
    const int* pos = (const int*)p.in[1]; float* cosT = (float*)(p.ws + WS_COS); float* sinT = (float*)(p.ws + WS_SIN); float* sp = (float*)(p.ws + WS_SP);
    const int tid = otid();
    for (size_t i = (size_t)blockIdx.x * 512 + tid; i < (size_t)M_ * 32; i += (size_t)gridDim.x * 512) {
        const int row = (int)(i >> 5), k = (int)(i & 31); const float inv = powf(10000.0f, -(float)(2 * k) / 64.0f); const float ang = (float)pos[row] * inv;
        cosT[i] = cosf(ang); sinT[i] = sinf(ang); }
    for (int i = blockIdx.x * 512 + tid; i < DEPTH * 2 * 1024; i += gridDim.x * 512) { const float x = -p.in[15][i];
        sp[i] = fmaxf(x, 0.f) + log1pf(expf(-fabsf(x))); }
}
__device__ __forceinline__ void conv_phase(const Params& p, int l) {
    const bf16_t* xl = (const bf16_t*)(p.ws + WS_XL); bf16_t* xc = (bf16_t*)(p.ws + WS_XC);
    const float* cw = p.in[9] + (size_t)l * 4 * 1024; const float* cb = p.in[10] + (size_t)l * 1024;
    const int tid = otid();
    for (size_t i = (size_t)blockIdx.x * 512 + tid; i < (size_t)M_ * 128; i += (size_t)gridDim.x * 512) {
        const int row = (int)(i >> 7), c0 = (int)(i & 127) * 8, t = row & (SEQ - 1);
        float acc[8];
        { const f32x4 b0 = *(const f32x4*)(cb + c0), b1 = *(const f32x4*)(cb + c0 + 4); acc[0] = b0[0]; acc[1] = b0[1]; acc[2] = b0[2]; acc[3] = b0[3]; acc[4] = b1[0]; acc[5] = b1[1]; acc[6] = b1[2]; acc[7] = b1[3]; }
#pragma unroll
        for (int k = 0; k < 4; ++k) { const int tt = t - 2 + k; if (tt < 0 || tt >= SEQ) continue;
            const u32x4 xw = *(const u32x4*)(xl + (size_t)(row - 2 + k) * 1024 + c0);
            const f32x4 w0 = *(const f32x4*)(cw + k * 1024 + c0), w1 = *(const f32x4*)(cw + k * 1024 + c0 + 4);
            acc[0] += w0[0] * bf_lo(xw.x); acc[1] += w0[1] * bf_hi(xw.x); acc[2] += w0[2] * bf_lo(xw.y); acc[3] += w0[3] * bf_hi(xw.y);
            acc[4] += w1[0] * bf_lo(xw.z); acc[5] += w1[1] * bf_hi(xw.z); acc[6] += w1[2] * bf_lo(xw.w); acc[7] += w1[3] * bf_hi(xw.w); }
        u32x4 o; o.x = cvt_pk_bf16(acc[0], acc[1]); o.y = cvt_pk_bf16(acc[2], acc[3]); o.z = cvt_pk_bf16(acc[4], acc[5]); o.w = cvt_pk_bf16(acc[6], acc[7]);
        *(u32x4*)(xc + (size_t)row * 1024 + c0) = o;
    }
}
__device__ __forceinline__ void scan_local(const Params& p) {
    const unsigned* au = (const unsigned*)(p.ws + WS_AU); f32x4* ph = (f32x4*)(p.ws + WS_PH); const int tid = otid();
    for (int it = blockIdx.x; it < 2 * 8 * 64; it += gridDim.x) {
        const int c = it & 63, b = (it >> 6) & 7, d = it >> 9;
        const u32x2* __restrict__ src = (const u32x2*)(au + (size_t)d * M_ * 1024 + (size_t)(b * SEQ + c * 64) * 1024) + tid;
        float h0 = 0.f, h1 = 0.f, P0 = 1.f, P1 = 1.f;
        const long step = d ? -512 : 512; const u32x2* q = src + (d ? (size_t)63 * 512 : 0);
        u32x2 wa[16], wb[16];
#pragma unroll
        for (int j = 0; j < 16; ++j) wa[j] = q[(long)j * step];
#pragma unroll
        for (int bt = 0; bt < 4; bt += 2) {
#pragma unroll
            for (int j = 0; j < 16; ++j) wb[j] = q[(long)((bt + 1) * 16 + j) * step];
#pragma unroll
            for (int j = 0; j < 16; ++j) { const float a0 = 1.0f - bf_lo(wa[j].x), a1 = 1.0f - bf_lo(wa[j].y); h0 = a0 * h0 + bf_hi(wa[j].x); h1 = a1 * h1 + bf_hi(wa[j].y); P0 *= a0; P1 *= a1; }
            if (bt + 2 < 4) {
#pragma unroll
                for (int j = 0; j < 16; ++j) wa[j] = q[(long)((bt + 2) * 16 + j) * step]; }
#pragma unroll
            for (int j = 0; j < 16; ++j) { const float a0 = 1.0f - bf_lo(wb[j].x), a1 = 1.0f - bf_lo(wb[j].y); h0 = a0 * h0 + bf_hi(wb[j].x); h1 = a1 * h1 + bf_hi(wb[j].y); P0 *= a0; P1 *= a1; }
        }
        ph[(size_t)((d * 8 + b) * 64 + c) * 512 + tid] = (f32x4){P0, h0, P1, h1};
    }
}
__device__ __forceinline__ void scan_apply(const Params& p) {
    const unsigned* au = (const unsigned*)(p.ws + WS_AU); const f32x4* ph = (const f32x4*)(p.ws + WS_PH);
    const bf16_t* gg = (const bf16_t*)(p.ws + WS_GG); bf16_t* ycat = (bf16_t*)(p.ws + WS_YCAT); const int tid = otid();
    for (int it = blockIdx.x; it < 8 * 64; it += gridDim.x) {
        const int c = it & 63, b = it >> 6;
        float Hf0 = 0.f, Hf1 = 0.f, Hb0 = 0.f, Hb1 = 0.f;
        { const f32x4* pf = ph + (size_t)((0 * 8 + b) * 64) * 512 + tid;
          for (int c0 = 0; c0 < c; c0 += 8) { f32x4 e[8];
#pragma unroll
              for (int j = 0; j < 8; ++j) e[j] = pf[(size_t)min(c0 + j, c - 1) * 512];
#pragma unroll
              for (int j = 0; j < 8; ++j) if (c0 + j >= c) e[j] = (f32x4){1.f, 0.f, 1.f, 0.f};
#pragma unroll
              for (int j = 0; j < 8; ++j) { Hf0 = e[j][0] * Hf0 + e[j][1]; Hf1 = e[j][2] * Hf1 + e[j][3]; } }
          const f32x4* pb = ph + (size_t)((1 * 8 + b) * 64) * 512 + tid;
          for (int c0 = 63; c0 > c; c0 -= 8) { f32x4 e[8];
#pragma unroll
              for (int j = 0; j < 8; ++j) e[j] = pb[(size_t)max(c0 - j, c + 1) * 512];
#pragma unroll
              for (int j = 0; j < 8; ++j) if (c0 - j <= c) e[j] = (f32x4){1.f, 0.f, 1.f, 0.f};
#pragma unroll
              for (int j = 0; j < 8; ++j) { Hb0 = e[j][0] * Hb0 + e[j][1]; Hb1 = e[j][2] * Hb1 + e[j][3]; } } }
        const size_t r0 = (size_t)(b * SEQ + c * 64);
        const u32x2* __restrict__ s0 = (const u32x2*)(au + r0 * 1024) + tid; const u32x2* __restrict__ s1 = (const u32x2*)(au + (size_t)M_ * 1024 + r0 * 1024) + tid;
        const unsigned* __restrict__ gp = (const unsigned*)(gg + r0 * 1024) + tid; unsigned* __restrict__ yp = (unsigned*)(ycat + r0 * 2048 + 1024) + tid;
        float hf0[64], hf1[64];
        { u32x2 wa[8], wb[8];
#pragma unroll
          for (int j = 0; j < 8; ++j) wa[j] = s0[(size_t)j * 512];
#pragma unroll
          for (int bt = 0; bt < 8; bt += 2) {
#pragma unroll
              for (int j = 0; j < 8; ++j) wb[j] = s0[(size_t)((bt + 1) * 8 + j) * 512];
#pragma unroll
              for (int j = 0; j < 8; ++j) { const int t = bt * 8 + j; Hf0 = (1.0f - bf_lo(wa[j].x)) * Hf0 + bf_hi(wa[j].x); Hf1 = (1.0f - bf_lo(wa[j].y)) * Hf1 + bf_hi(wa[j].y); hf0[t] = Hf0; hf1[t] = Hf1; }
              if (bt + 2 < 8) {
#pragma unroll
                  for (int j = 0; j < 8; ++j) wa[j] = s0[(size_t)((bt + 2) * 8 + j) * 512]; }
#pragma unroll
              for (int j = 0; j < 8; ++j) { const int t = (bt + 1) * 8 + j; Hf0 = (1.0f - bf_lo(wb[j].x)) * Hf0 + bf_hi(wb[j].x); Hf1 = (1.0f - bf_lo(wb[j].y)) * Hf1 + bf_hi(wb[j].y); hf0[t] = Hf0; hf1[t] = Hf1; }
          } }
        { u32x2 wa[8], wb[8]; unsigned ga[8], gb[8];
#pragma unroll
          for (int j = 0; j < 8; ++j) { wa[j] = s1[(size_t)(63 - j) * 512]; ga[j] = gp[(size_t)(63 - j) * 512]; }
#pragma unroll
          for (int bt = 0; bt < 8; bt += 2) {
#pragma unroll
              for (int j = 0; j < 8; ++j) { const int t = 63 - ((bt + 1) * 8 + j); wb[j] = s1[(size_t)t * 512]; gb[j] = gp[(size_t)t * 512]; }
#pragma unroll
              for (int j = 0; j < 8; ++j) { const int t = 63 - (bt * 8 + j); Hb0 = (1.0f - bf_lo(wa[j].x)) * Hb0 + bf_hi(wa[j].x); Hb1 = (1.0f - bf_lo(wa[j].y)) * Hb1 + bf_hi(wa[j].y);
                  yp[(size_t)t * 1024] = cvt_pk_bf16(bf_lo(ga[j]) * (hf0[t] + Hb0), bf_hi(ga[j]) * (hf1[t] + Hb1)); }
              if (bt + 2 < 8) {
#pragma unroll
                  for (int j = 0; j < 8; ++j) { const int t = 63 - ((bt + 2) * 8 + j); wa[j] = s1[(size_t)t * 512]; ga[j] = gp[(size_t)t * 512]; } }
#pragma unroll
              for (int j = 0; j < 8; ++j) { const int t = 63 - ((bt + 1) * 8 + j); Hb0 = (1.0f - bf_lo(wb[j].x)) * Hb0 + bf_hi(wb[j].x); Hb1 = (1.0f - bf_lo(wb[j].y)) * Hb1 + bf_hi(wb[j].y);
                  yp[(size_t)t * 1024] = cvt_pk_bf16(bf_lo(gb[j]) * (hf0[t] + Hb0), bf_hi(gb[j]) * (hf1[t] + Hb1)); }
          } }
    }
}

__device__ __forceinline__ void grid_bar(unsigned* ctr, unsigned epoch) {
    asm volatile("s_waitcnt vmcnt(0) lgkmcnt(0)" ::: "memory");
    __syncthreads();
    if (otid() == 0) {
        __builtin_amdgcn_fence(__ATOMIC_RELEASE, "agent");
        asm volatile("s_waitcnt vmcnt(0)" ::: "memory");
        __hip_atomic_fetch_add(ctr, 1u, __ATOMIC_RELAXED, __HIP_MEMORY_SCOPE_AGENT);
        const unsigned target = (epoch + 1u) * gridDim.x;
        while (__hip_atomic_load(ctr, __ATOMIC_RELAXED, __HIP_MEMORY_SCOPE_AGENT) < target) __builtin_amdgcn_s_sleep(1);
        __builtin_amdgcn_fence(__ATOMIC_ACQUIRE, "agent");
        asm volatile("s_waitcnt vmcnt(0)" ::: "memory");
    }
    __syncthreads();
}
__global__ void __launch_bounds__(512, 2) mega_fwd(Params p) {
    extern __shared__ __attribute__((aligned(16))) unsigned char lds[];
    cg::grid_group grid = cg::this_grid();
    unsigned char* ws = p.ws;
    LAS unsigned char* ldsl = (LAS unsigned char*)lds;
    bf16_t* hb = (bf16_t*)(ws + WS_HB);
    const float* cosT = (const float*)(ws + WS_COS); const float* sinT = (const float*)(ws + WS_SIN);

    unsigned* bar_ctr = (unsigned*)(ws + WS_BAR);
    fix_t* stats0 = (fix_t*)(ws + WS_ST);
#define stats stats0
    { const int tid = otid();
      for (size_t i = (size_t)blockIdx.x * 512 + tid; i < (size_t)8 * 2 * M_; i += (size_t)gridDim.x * 512) stats[(size_t)2 * M_ + i] = 0ull;
    }
    make_tables(p);
    x_pass(p.in[0], hb, stats);
    grid.sync();
    convert_weights(p, 0, 0, CT6, (float*)lds);
    grid_bar(bar_ctr, 0u);
    colsum_in(p, 0); colsum_up(p, 0);
    grid_bar(bar_ctr, 1u);

#pragma unroll 1
    for (int l = 0; l < DEPTH; ++l) {
        const float* csb = (const float*)(ws + WS_CSB) + (size_t)l * CSB_L;
        fix_t* st0 = (fix_t*)(ws + WS_ST) + (size_t)(2 * l) * 2 * M_; fix_t* st1 = st0 + 2 * M_; fix_t* st2 = st1 + 2 * M_;
        if (l > 0) { colsum_up(p, l); convert_weights(p, l, CT5, CT6, (float*)lds); }
        { pg8::Order S = pg8::make_order(hb, 2048, ws + W_IN, 2048, M_, NINP, 2048);
          EpiIn E{(bf16_t*)(ws + WS_CQ), (bf16_t*)(ws + WS_CKV), (bf16_t*)(ws + WS_XL), (bf16_t*)(ws + WS_GG), (bf16_t*)(ws + WS_KPE), (float*)(ws + WS_SSQ), cosT, sinT, st0, csb + CSB_IN, csb + CSB_IN + NINP};
          pg8::gemm_phase(ldsl, S, E); }
        grid_bar(bar_ctr, 2u + 8u * (unsigned)l + 0u);
        conv_phase(p, l);
        { pg8::Order S = pg8::make_order(ws + WS_CQ, 512, ws + W_UQ, 512, M_, 1536, 512);
          EpiQ E{(bf16_t*)(ws + WS_Q), (const float*)(ws + WS_SSQ), cosT, sinT};
          pg8::gemm_phase(ldsl, S, E); }
        { pg8::Order S = pg8::make_order(ws + WS_CKV, 512, ws + W_UKV, 512, M_, 2048, 512);
          EpiKV E{(bf16_t*)(ws + WS_KV), (const float*)(ws + WS_SSQ)};
          pg8::gemm_phase(ldsl, S, E); }
        grid_bar(bar_ctr, 2u + 8u * (unsigned)l + 1u);
        {
            const bf16_t* Q = (const bf16_t*)(ws + WS_Q); const bf16_t* KV = (const bf16_t*)(ws + WS_KV); const bf16_t* KPE = (const bf16_t*)(ws + WS_KPE); bf16_t* ycat = (bf16_t*)(ws + WS_YCAT);
            const int G = gridDim.x, bx = blockIdx.x;
            for (int L = bx; L < 1024; L += G) {
                int pair, qb;
                if (G == 256) { const int i = L >> 8, c = L & 255, xcd = c & 7, j = c >> 3; pair = i * 16 + xcd * 2 + (j >> 4); qb = j & 15; } else { pair = L >> 4; qb = L & 15; }
                const int b = pair >> 3, h = pair & 7; const size_t row0 = (size_t)b * SEQ + (size_t)qb * 256;
                __syncthreads();
                att::attn_unit(Q + row0 * 1536 + h * 128, Q + row0 * 1536 + 1024 + h * 64, KV + (size_t)b * SEQ * 2048 + h * 256, KPE + (size_t)b * SEQ * 64, ycat + row0 * 2048 + h * 128, SEQ, (char*)lds);
            }
            __syncthreads();
        }
        { pg8::Order S = pg8::make_order(ws + WS_XC, 1024, ws + W_G, 128, M_, 512, 128);
          S.nZ = 8; S.a_z = 128 * 2; S.b_z = (size_t)512 * 128 * 2;
          EpiGate E{(unsigned*)(ws + WS_AU), (const bf16_t*)(ws + WS_XC), p.in[12] + (size_t)l * 2048, p.in[14] + (size_t)l * 2048, (const float*)(ws + WS_SP) + (size_t)l * 2048};
          pg8::gemm_phase(ldsl, S, E); }
        grid_bar(bar_ctr, 2u + 8u * (unsigned)l + 2u);
        scan_local(p);
        if (l + 1 < DEPTH) { __syncthreads(); convert_weights(p, l + 1, 0, CT3, (float*)lds); }
        grid_bar(bar_ctr, 2u + 8u * (unsigned)l + 3u);
        if (l + 1 < DEPTH) colsum_in(p, l + 1);
        scan_apply(p);
        grid_bar(bar_ctr, 2u + 8u * (unsigned)l + 4u);
        { pg8::Order S = pg8::make_order(ws + WS_YCAT, 2048, ws + W_OUT, 2048, M_, 2048, 2048);
          EpiRes E{l == 0 ? p.in[0] : p.out, p.out, hb, st0, l == 0 ? p.in[2] : p.in[21] + (size_t)(l - 1) * 2048, l == 0 ? p.in[3] : p.in[22] + (size_t)(l - 1) * 2048, st1};
          pg8::gemm_phase(ldsl, S, E); }
        grid_bar(bar_ctr, 2u + 8u * (unsigned)l + 5u);
        if (l + 1 < DEPTH) { convert_weights(p, l + 1, CT3, CT4, (float*)lds); }
        { pg8::Order S = pg8::make_order(hb, 2048, ws + W_UP, 2048, M_, DFF, 2048);
          EpiUp E{(bf16_t*)(ws + WS_F), st1, csb + CSB_UP, csb + CSB_UP + DFF}; pg8::gemm_phase(ldsl, S, E); }
        grid_bar(bar_ctr, 2u + 8u * (unsigned)l + 6u);
        if (l + 1 < DEPTH) { convert_weights(p, l + 1, CT4, CT5, (float*)lds); }
        { pg8::Order S = pg8::make_order(ws + WS_F, 8192, ws + W_DN, 8192, M_, 2048, 8192);
          EpiRes E{p.out, p.out, hb, st1, p.in[17] + (size_t)l * 2048, p.in[18] + (size_t)l * 2048, st2};
          pg8::gemm_phase(ldsl, S, E); }
        grid_bar(bar_ctr, 2u + 8u * (unsigned)l + 7u);
    }
    ln_final(p.out, (const fix_t*)(p.ws + WS_ST) + (size_t)(2 * DEPTH) * 2 * M_, p.in[21] + (size_t)(DEPTH - 1) * 2048, p.in[22] + (size_t)(DEPTH - 1) * 2048);
}

extern "C" void kernel_launch(void* const* d_in, const int* in_sizes, int n_in, void* d_out, int out_size, void* d_ws, size_t ws_size, hipStream_t stream) {
    constexpr int LDS_BYTES = pg8::STAGE_BYTES;
    static int grid_blocks = 0;
    if (grid_blocks == 0) {
        if (n_in != 23 || in_sizes[0] != M_ * DM || out_size != M_ * DM || ws_size < WS_END) {
            fprintf(stderr, "kernel_launch: shape mismatch (n_in %d, in0 %d, out %d, ws %zu, need %zu)\n", n_in, n_in > 0 ? in_sizes[0] : -1, out_size, ws_size, (size_t)WS_END); grid_blocks = -1; return; }
        int dev = 0, cus = 0, per_cu = 0;
        hipGetDevice(&dev); hipDeviceGetAttribute(&cus, hipDeviceAttributeMultiprocessorCount, dev);
        if (hipFuncSetAttribute((const void*)mega_fwd, hipFuncAttributeMaxDynamicSharedMemorySize, LDS_BYTES) != hipSuccess) { fprintf(stderr, "kernel_launch: hipFuncSetAttribute failed\n"); grid_blocks = -1; return; }
        if (hipOccupancyMaxActiveBlocksPerMultiprocessor(&per_cu, (const void*)mega_fwd, 512, LDS_BYTES) != hipSuccess || per_cu < 1) { fprintf(stderr, "kernel_launch: occupancy query says %d\n", per_cu); per_cu = 1; }
        (void)hipGetLastError();
        grid_blocks = cus * 1;
    }
    if (grid_blocks < 0) return;
    Params p{};
    for (int i = 0; i < 23; ++i) p.in[i] = (const float*)d_in[i];
    p.out = (float*)d_out; p.ws = (unsigned char*)d_ws;
    (void)hipMemsetAsync((char*)d_ws + WS_BAR, 0, 256, stream);
    void* args[] = {&p};
    hipError_t e = hipLaunchCooperativeKernel((const void*)mega_fwd, dim3(grid_blocks), dim3(512), args, LDS_BYTES, stream);
    if (e != hipSuccess) fprintf(stderr, "kernel_launch: cooperative launch failed: %s (grid %d)\n", hipGetErrorString(e), grid_blocks);
}
```

```cpp
#include <hip/hip_runtime.h>
#include <hip/hip_cooperative_groups.h>
#include <cstdio>
#include <cstdint>
namespace cg = cooperative_groups;

#define LAS __attribute__((address_space(3)))
typedef unsigned short bf16_t;
typedef short bf16x8 __attribute__((ext_vector_type(8)));
typedef short s16x4 __attribute__((ext_vector_type(4)));
typedef float f32x4 __attribute__((ext_vector_type(4)));
typedef float f32x2 __attribute__((ext_vector_type(2)));
typedef float f32x16 __attribute__((ext_vector_type(16)));
typedef unsigned u32x4 __attribute__((ext_vector_type(4)));
typedef unsigned u32x2 __attribute__((ext_vector_type(2)));

constexpr int M_ = 32768, DM = 2048, SEQ = 4096, NBATCH = 8, DEPTH = 4;
constexpr int NIN = 3136, NINP = 3328, DFF = 8192;
constexpr float ALPHA = 1.6817928305074290f;
constexpr float LN_EPS = 1e-5f, RMS_EPS = 1e-6f;
constexpr size_t MiB = 1ull << 20;
constexpr size_t WS_HB = 0;
constexpr size_t WS_W = 128 * MiB;
constexpr size_t W_IN = WS_W, W_UQ = W_IN + (size_t)NINP * 2048 * 2, W_UKV = W_UQ + 1536ull * 512 * 2, W_G = W_UKV + 2048ull * 512 * 2,
                 W_OUT = W_G + 8ull * 512 * 128 * 2, W_UP = W_OUT + 2048ull * 2048 * 2, W_DN = W_UP + 8192ull * 2048 * 2, W_END = W_DN + 8192ull * 2048 * 2;
static_assert(W_END <= 218 * MiB, "weights region");
constexpr size_t WS_COS = 218 * MiB, WS_SIN = 222 * MiB, WS_SP = 226 * MiB;
constexpr size_t WS_CSB = 226 * MiB + 65536;
constexpr int CSB_L = 2 * 3328 + 2 * 8192, CSB_IN = 0, CSB_UP = 2 * 3328;
constexpr size_t WS_BAR = 226 * MiB + 49152;
constexpr size_t WS_ST = 227 * MiB;
constexpr size_t WS_BIG = 232 * MiB;
constexpr size_t WS_F = WS_BIG;
constexpr size_t WS_GG = WS_BIG, WS_XC = WS_BIG + 64 * MiB, WS_YCAT = WS_BIG + 128 * MiB, WS_SSQ = WS_BIG + 256 * MiB, WS_KPE = WS_BIG + 258 * MiB,
                 WS_CQ = WS_BIG + 262 * MiB, WS_CKV = WS_BIG + 294 * MiB, WS_XL = WS_BIG + 326 * MiB, WS_AU = WS_BIG + 262 * MiB  ,
                 WS_Q = WS_BIG + 518 * MiB, WS_KV = WS_BIG + 614 * MiB, WS_PH = WS_BIG + 742 * MiB, WS_END = WS_BIG + 750 * MiB;
static_assert(WS_END <= 1024 * MiB, "workspace");

struct Params { const float* in[23]; float* out; unsigned char* ws; };

__device__ __forceinline__ int otid() { int t = threadIdx.x; asm volatile("" : "+v"(t)); return t; }
__device__ __forceinline__ unsigned cvt_pk_bf16(float lo, float hi) { unsigned r; asm volatile("v_cvt_pk_bf16_f32 %0, %1, %2" : "=v"(r) : "v"(lo), "v"(hi)); return r; }
__device__ __forceinline__ float sum_fq(float x) {
    auto a = __builtin_amdgcn_permlane16_swap(__float_as_uint(x), __float_as_uint(x), false, false); x = __uint_as_float(a[0]) + __uint_as_float(a[1]);
    auto b = __builtin_amdgcn_permlane32_swap(__float_as_uint(x), __float_as_uint(x), false, false); return __uint_as_float(b[0]) + __uint_as_float(b[1]); }
__device__ __forceinline__ float wave_sum(float x, int lane) {
#pragma unroll
    for (int o = 32; o >= 1; o >>= 1) x += __int_as_float(__builtin_amdgcn_ds_bpermute((lane ^ o) << 2, __float_as_int(x)));
    return x; }
__device__ __forceinline__ float bf_lo(unsigned w) { return __uint_as_float(w << 16); }
__device__ __forceinline__ float bf_hi(unsigned w) { return __uint_as_float(w & 0xffff0000u); }
__device__ __forceinline__ float sigmoidf_(float x) { return __builtin_amdgcn_rcpf(1.0f + __builtin_amdgcn_exp2f(-1.4426950408889634f * x)); }
__device__ __forceinline__ float gelu_tanh(float x) { const float z = 0.7978845608028654f * (x + 0.044715f * x * x * x); return x * sigmoidf_(2.0f * z); }
__device__ __forceinline__ u32x4 pack8(const f32x4 a, const f32x4 b) { u32x4 w; w.x = cvt_pk_bf16(a[0], a[1]); w.y = cvt_pk_bf16(a[2], a[3]); w.z = cvt_pk_bf16(b[0], b[1]); w.w = cvt_pk_bf16(b[2], b[3]); return w; }

namespace pg8 {
constexpr int BM = 256, BK = 64, HALF = 128, HTB = HALF * BK * 2, STAGE_BYTES = 8 * HTB, NXCD = 8, WGM = 8;
__host__ __device__ __forceinline__ int lds_byte(int r, int c) { const int st = (r >> 4) * 2 + (c >> 5), rr = r & 15, cc = c & 31, ob = rr * 64 + cc * 2; return st * 1024 + (ob ^ (((ob >> 9) & 1) << 5)); }
__host__ __device__ __forceinline__ void stage_rc(int b, int& R, int& C) { const int st = b / 1024, sb = b % 1024, swz = sb ^ (((sb >> 9) & 1) << 5); R = (st >> 1) * 16 + swz / 64; C = (st & 1) * 32 + (swz % 64) / 2; }
__host__ __device__ __forceinline__ int perm32(int rho) { const int n = rho >> 4, i = rho & 15; return 8 * (i >> 2) + 4 * n + (i & 3); }

struct Unit { int pm, pn, z; };
struct Order {
    int nM, nN, nZ, per, G, c;
    const char* A; const char* B; size_t a_pm, a_z, b_pn, b_z; int lda, ldb, K;
    __device__ __forceinline__ bool next(int i, Unit& u) const {
        const long L = (long)i * G + c; if (L >= (long)per * nZ) return false;
        u.z = (int)(L / per); int wgid = (int)(L % per);
        { const int q = per / NXCD, r = per % NXCD, xcd = wgid % NXCD, off = wgid / NXCD; wgid = (xcd < r ? xcd * (q + 1) : r * (q + 1) + (xcd - r) * q) + off; }
        const int nig = WGM * nN, gid = wgid / nig, fm = gid * WGM, gsz = (nM - fm) < WGM ? (nM - fm) : WGM;
        u.pm = fm + ((wgid % nig) % gsz); u.pn = (wgid % nig) / gsz; return true;
    }
    __device__ __forceinline__ const char* aptr(const Unit& u) const { return A + (size_t)u.pm * a_pm + (size_t)u.z * a_z; }
    __device__ __forceinline__ const char* bptr(const Unit& u) const { return B + (size_t)u.pn * b_pn + (size_t)u.z * b_z; }
};
__device__ __forceinline__ Order make_order(const void* A, int lda, const void* Bt, int ldb, int Mrows, int N, int K) {
    Order o; o.nM = Mrows / BM; o.nN = N / BM; o.nZ = 1; o.per = o.nM * o.nN; o.G = gridDim.x; o.c = blockIdx.x;
    o.A = (const char*)A; o.B = (const char*)Bt; o.a_pm = (size_t)BM * lda * 2; o.a_z = 0; o.b_pn = (size_t)BM * ldb * 2; o.b_z = 0; o.lda = lda; o.ldb = ldb; o.K = K; return o;
}

template <class Epi>
__device__ __forceinline__ void gemm_phase(LAS unsigned char* lds, const Order& S, const Epi& E) {
    const int tid = otid(), wid = __builtin_amdgcn_readfirstlane(tid >> 6), lane = tid & 63, wr = wid >> 2, wc = wid & 3, fr = lane & 15, fq = lane >> 4;
    const int nt = S.K / BK;
    unsigned voffA[2], voffB[2];
#pragma unroll
    for (int i = 0; i < 2; ++i) { int R, C; stage_rc(tid * 16 + i * 8192, R, C); const int Rb = Epi::PERM ? ((R & ~31) + perm32(R & 31)) : R;
        voffA[i] = (unsigned)(R * S.lda + C) * 2u; voffB[i] = (unsigned)(Rb * S.ldb + C) * 2u; }
    const size_t kstep = (size_t)(BK * 2);
    const size_t hstepA = (size_t)HALF * S.lda * 2, hstepB = (size_t)HALF * S.ldb * 2;
    const unsigned ldsw = (unsigned)wid * 1024u;
    const int aoff = lds_byte(wr * 64 + fr, fq * 8), boff = lds_byte(wc * 32 + fr, fq * 8);
#define PG8_SA(b, h) (((b) * 2 + (h)) * HTB)
#define PG8_SB(b, h) ((4 + (b) * 2 + (h)) * HTB)
#define PG8_STAGE(bufoff, gbase, voff) do { _Pragma("unroll") for (int _i = 0; _i < 2; ++_i) \
        __builtin_amdgcn_global_load_lds((const unsigned*)((const char*)(gbase) + (voff)[_i]), (LAS unsigned*)(lds + (bufoff) + ldsw + _i * 8192), 16, 0, 0); } while (0)
#define PG8_LDA(dst, b, h) do { _Pragma("unroll") for (int m = 0; m < 4; ++m) _Pragma("unroll") for (int k = 0; k < 2; ++k) dst[m][k] = *(const LAS bf16x8*)(lds + PG8_SA(b, h) + aoff + m * 2048 + k * 1024); } while (0)
#define PG8_LDB(dst, b, h) do { _Pragma("unroll") for (int n = 0; n < 2; ++n) _Pragma("unroll") for (int k = 0; k < 2; ++k) dst[n][k] = *(const LAS bf16x8*)(lds + PG8_SB(b, h) + boff + n * 2048 + k * 1024); } while (0)
#define PG8_MMA(ai, bj, At, Bt) do { __builtin_amdgcn_s_setprio(1); _Pragma("unroll") for (int m = 0; m < 4; ++m) _Pragma("unroll") for (int n = 0; n < 2; ++n) _Pragma("unroll") for (int k = 0; k < 2; ++k) \
        acc[ai][bj][m][n] = __builtin_amdgcn_mfma_f32_16x16x32_bf16(Bt[n][k], At[m][k], acc[ai][bj][m][n], 0, 0, 0); __builtin_amdgcn_s_setprio(0); } while (0)
#define PG8_WAIT_V(n) asm volatile("s_waitcnt vmcnt(" #n ")" ::: "memory")
#define PG8_WAIT_L(n) asm volatile("s_waitcnt lgkmcnt(" #n ")" ::: "memory")
#define PG8_BAR __builtin_amdgcn_s_barrier()
#define PG8_SCHED __builtin_amdgcn_sched_barrier(0)
    Unit cur, nxt; int ui = 0;
    if (!S.next(0, cur)) return;
    f32x4 acc[2][2][4][2];
#pragma unroll
    for (int a = 0; a < 2; ++a)
#pragma unroll
        for (int b = 0; b < 2; ++b)
#pragma unroll
            for (int m = 0; m < 4; ++m)
#pragma unroll
                for (int n = 0; n < 2; ++n) acc[a][b][m][n] = (f32x4){0.f, 0.f, 0.f, 0.f};
    bf16x8 At[4][2], B0[2][2], B1[2][2];
    const char* cA = S.aptr(cur); const char* cB = S.bptr(cur);
    PG8_STAGE(PG8_SB(0, 0), cB, voffB); PG8_STAGE(PG8_SA(0, 0), cA, voffA); PG8_STAGE(PG8_SB(0, 1), cB + hstepB, voffB); PG8_STAGE(PG8_SA(0, 1), cA + hstepA, voffA);
    if (wr == 1) PG8_BAR;
    PG8_WAIT_V(4); PG8_BAR;
    PG8_STAGE(PG8_SB(1, 0), cB + kstep, voffB); PG8_STAGE(PG8_SA(1, 0), cA + kstep, voffA); PG8_STAGE(PG8_SB(1, 1), cB + hstepB + kstep, voffB);
    PG8_WAIT_V(6); PG8_BAR;
    for (;;) {
        const bool has_next = S.next(ui + 1, nxt);
        const char* nA = has_next ? S.aptr(nxt) : cA; const char* nB = has_next ? S.bptr(nxt) : cB;
        for (int t = 0; t < nt; t += 2) {
            const bool last = (t == nt - 2);
            const char* a1 = cA + (size_t)(t + 1) * kstep;
            const char* a2 = last ? nA : cA + (size_t)(t + 2) * kstep; const char* b2 = last ? nB : cB + (size_t)(t + 2) * kstep;
            const char* a3 = a2 + kstep; const char* b3 = b2 + kstep;
            PG8_LDB(B0, 0, 0); PG8_SCHED; PG8_LDA(At, 0, 0); PG8_STAGE(PG8_SA(1, 1), a1 + hstepA, voffA);
            PG8_WAIT_L(8); PG8_BAR; PG8_WAIT_L(0); PG8_MMA(0, 0, At, B0); PG8_BAR; PG8_SCHED;
            PG8_LDB(B1, 0, 1); PG8_STAGE(PG8_SB(0, 0), b2, voffB);
            PG8_BAR; PG8_WAIT_L(0); PG8_MMA(0, 1, At, B1); PG8_BAR;
            PG8_LDA(At, 0, 1); PG8_STAGE(PG8_SA(0, 0), a2, voffA);
            PG8_BAR; PG8_WAIT_L(0); PG8_MMA(1, 0, At, B0); PG8_BAR; PG8_SCHED;
            PG8_STAGE(PG8_SB(0, 1), b2 + hstepB, voffB);
            PG8_WAIT_V(6); PG8_BAR; PG8_MMA(1, 1, At, B1); PG8_BAR;
            PG8_LDB(B0, 1, 0); PG8_SCHED; PG8_LDA(At, 1, 0); PG8_STAGE(PG8_SA(0, 1), a2 + hstepA, voffA);
            PG8_WAIT_L(8); PG8_BAR; PG8_WAIT_L(0); PG8_MMA(0, 0, At, B0); PG8_BAR; PG8_SCHED;
            PG8_LDB(B1, 1, 1); PG8_STAGE(PG8_SB(1, 0), b3, voffB);
            PG8_BAR; PG8_WAIT_L(0); PG8_MMA(0, 1, At, B1); PG8_BAR;
            PG8_LDA(At, 1, 1); PG8_STAGE(PG8_SA(1, 0), a3, voffA);
            PG8_BAR; PG8_WAIT_L(0); PG8_MMA(1, 0, At, B0); PG8_BAR; PG8_SCHED;
            PG8_STAGE(PG8_SB(1, 1), b3 + hstepB, voffB);
            PG8_WAIT_V(6); PG8_BAR; PG8_MMA(1, 1, At, B1); PG8_BAR;
        }
        E(acc, cur, wr, wc, fr, fq);
        if (!has_next) break;
#pragma unroll
        for (int a = 0; a < 2; ++a)
#pragma unroll
            for (int b = 0; b < 2; ++b)
#pragma unroll
                for (int m = 0; m < 4; ++m)
#pragma unroll
                    for (int n = 0; n < 2; ++n) acc[a][b][m][n] = (f32x4){0.f, 0.f, 0.f, 0.f};
        cur = nxt; cA = nA; cB = nB; ++ui;
    }
    PG8_WAIT_V(0);
    if (wr == 0) PG8_BAR;
    PG8_BAR;
#undef PG8_SA
#undef PG8_SB
#undef PG8_STAGE
#undef PG8_LDA
#undef PG8_LDB
#undef PG8_MMA
#undef PG8_WAIT_V
#undef PG8_WAIT_L
#undef PG8_BAR
#undef PG8_SCHED
}
}
using pg8::Unit;
typedef f32x4 Acc[2][2][4][2];

typedef unsigned long long fix_t;
__device__ __forceinline__ fix_t to_fix(float v) { return (fix_t)(long long)(v * 4294967296.0f); }
__device__ __forceinline__ float from_fix(fix_t v) { return fmaf((float)(unsigned)v, 2.3283064365386963e-10f, (float)(int)(v >> 32)); }
__device__ __forceinline__ void fix_add(fix_t* p, float v) { __hip_atomic_fetch_add(p, to_fix(v), __ATOMIC_RELAXED, __HIP_MEMORY_SCOPE_AGENT); }
__device__ __forceinline__ f32x4 ld_fix4(const fix_t* p) { typedef unsigned long long u64x2 __attribute__((ext_vector_type(2))); const u64x2 a = *(const u64x2*)p, b = *(const u64x2*)(p + 2);
    return (f32x4){from_fix(a.x), from_fix(a.y), from_fix(b.x), from_fix(b.y)}; }
__device__ __forceinline__ void row_ln(const fix_t* st, int row, float& mu, float& rs) { const float s1 = from_fix(st[row]), s2 = from_fix(st[M_ + row]); mu = s1 * (1.0f / 2048.0f); rs = __builtin_amdgcn_rsqf(s2 * (1.0f / 2048.0f) - mu * mu + LN_EPS); }
template <bool PERM>
__device__ __forceinline__ void ln_correct(f32x4 (&acc)[2][2][4][2], const fix_t* st, const float* cs, const float* bw, int row0, int colbase) {
    f32x4 c4[2][2], b4[2][2];
#pragma unroll
    for (int bj = 0; bj < 2; ++bj)
#pragma unroll
        for (int n = 0; n < 2; ++n) { const int col = colbase + bj * 128 + (PERM ? 4 * n : 16 * n); c4[bj][n] = *(const f32x4*)(cs + col); b4[bj][n] = *(const f32x4*)(bw + col); }
#pragma unroll
    for (int ai = 0; ai < 2; ++ai) { fix_t r1[4], r2[4];
#pragma unroll
        for (int m = 0; m < 4; ++m) { const int row = row0 + ai * 128 + m * 16; r1[m] = st[row]; r2[m] = st[M_ + row]; }
#pragma unroll
        for (int m = 0; m < 4; ++m) { const float mu = from_fix(r1[m]) * (1.0f / 2048.0f), rs = __builtin_amdgcn_rsqf(from_fix(r2[m]) * (1.0f / 2048.0f) - mu * mu + LN_EPS);
#pragma unroll
            for (int bj = 0; bj < 2; ++bj)
#pragma unroll
                for (int n = 0; n < 2; ++n) acc[ai][bj][m][n] = (acc[ai][bj][m][n] - c4[bj][n] * mu) * rs + b4[bj][n]; } }
}

struct EpiIn {
    static constexpr bool PERM = true;
    bf16_t *cq, *ckv, *xl, *gg, *kpe; float* ssq; const float *cosT, *sinT; const fix_t* st; const float *cs, *bw;
    __device__ __forceinline__ void operator()(Acc& acc, const Unit& u, int wr, int wc, int fr, int fq) const {
        const int row0 = u.pm * 256 + wr * 64 + fr, pn = u.pn;
        ln_correct<true>(acc, st, cs, bw, row0, pn * 256 + wc * 32 + 8 * fq);
        if (pn < 4) {
            bf16_t* base = (pn < 2 ? cq : ckv); const int col0 = (pn & 1) * 256 + wc * 32 + 8 * fq;
#pragma unroll
            for (int ai = 0; ai < 2; ++ai)
#pragma unroll
                for (int m = 0; m < 4; ++m) { const int row = row0 + ai * 128 + m * 16; float s = 0.f;
#pragma unroll
                    for (int bj = 0; bj < 2; ++bj) { const f32x4 v0 = acc[ai][bj][m][0], v1 = acc[ai][bj][m][1];
                        s += (v0[0] * v0[0] + v0[1] * v0[1]) + (v0[2] * v0[2] + v0[3] * v0[3]) + (v1[0] * v1[0] + v1[1] * v1[1]) + (v1[2] * v1[2] + v1[3] * v1[3]);
                        *(u32x4*)(base + (size_t)row * 512 + col0 + bj * 128) = pack8(v0, v1); }
                    s = sum_fq(s);
                    if (fq == 0) ssq[(size_t)row * 16 + pn * 4 + wc] = s; }
        } else if (pn < 8) {
            const int col0 = (pn - 4) * 256 + wc * 32 + 8 * fq;
#pragma unroll
            for (int ai = 0; ai < 2; ++ai)
#pragma unroll
                for (int m = 0; m < 4; ++m) { const int row = row0 + ai * 128 + m * 16;
#pragma unroll
                    for (int bj = 0; bj < 2; ++bj) *(u32x4*)(xl + (size_t)row * 1024 + col0 + bj * 128) = pack8(acc[ai][bj][m][0], acc[ai][bj][m][1]); }
        } else if (pn < 12) {
            const int col0 = (pn - 8) * 256 + wc * 32 + 8 * fq;
#pragma unroll
            for (int ai = 0; ai < 2; ++ai)
#pragma unroll
                for (int m = 0; m < 4; ++m) { const int row = row0 + ai * 128 + m * 16;
#pragma unroll
                    for (int bj = 0; bj < 2; ++bj) { f32x4 v0 = acc[ai][bj][m][0], v1 = acc[ai][bj][m][1];
#pragma unroll
                        for (int j = 0; j < 4; ++j) { v0[j] = gelu_tanh(v0[j]); v1[j] = gelu_tanh(v1[j]); }
                        *(u32x4*)(gg + (size_t)row * 1024 + col0 + bj * 128) = pack8(v0, v1); } }
        } else if (wc == 0) {
#pragma unroll
            for (int ai = 0; ai < 2; ++ai) { f32x4 c0[4], c1[4], s0[4], s1[4];
#pragma unroll
                for (int m = 0; m < 4; ++m) { const size_t t = (size_t)(row0 + ai * 128 + m * 16) * 32 + 8 * fq;
                    c0[m] = *(const f32x4*)(cosT + t); c1[m] = *(const f32x4*)(cosT + t + 4); s0[m] = *(const f32x4*)(sinT + t); s1[m] = *(const f32x4*)(sinT + t + 4); }
#pragma unroll
                for (int m = 0; m < 4; ++m) { const int row = row0 + ai * 128 + m * 16;
                    const f32x4 a0 = acc[ai][0][m][0], a1 = acc[ai][0][m][1], b0 = acc[ai][1][m][0], b1 = acc[ai][1][m][1];
                    *(u32x4*)(kpe + (size_t)row * 64 + 8 * fq) = pack8(a0 * c0[m] - b0 * s0[m], a1 * c1[m] - b1 * s1[m]);
                    *(u32x4*)(kpe + (size_t)row * 64 + 32 + 8 * fq) = pack8(b0 * c0[m] + a0 * s0[m], b1 * c1[m] + a1 * s1[m]); } }
        }
    }
};
__device__ __forceinline__ void rows_rstd(const float* ssq8, int row0, float (&rs)[8]) {
#pragma unroll
    for (int h = 0; h < 2; ++h) { f32x4 a[4], b[4];
#pragma unroll
        for (int k = 0; k < 4; ++k) { const float* p = ssq8 + (size_t)(row0 + h * 128 + k * 16) * 16; a[k] = *(const f32x4*)p; b[k] = *(const f32x4*)(p + 4); }
#pragma unroll
        for (int k = 0; k < 4; ++k) { const float s = ((a[k][0] + a[k][1]) + (a[k][2] + a[k][3])) + ((b[k][0] + b[k][1]) + (b[k][2] + b[k][3])); rs[h * 4 + k] = __builtin_amdgcn_rsqf(s * (1.0f / 512.0f) + RMS_EPS); } }
}
struct EpiQ {
    static constexpr bool PERM = true;
    bf16_t* q; const float* ssq; const float *cosT, *sinT;
    __device__ __forceinline__ void operator()(Acc& acc, const Unit& u, int wr, int wc, int fr, int fq) const {
        const int row0 = u.pm * 256 + wr * 64 + fr, pn = u.pn;
        float rs[8]; rows_rstd(ssq, row0, rs);
        if (pn < 4) {
            const int col0 = pn * 256 + wc * 32 + 8 * fq;
#pragma unroll
            for (int ai = 0; ai < 2; ++ai)
#pragma unroll
                for (int m = 0; m < 4; ++m) { const int row = row0 + ai * 128 + m * 16; const float r = rs[ai * 4 + m];
#pragma unroll
                    for (int bj = 0; bj < 2; ++bj) *(u32x4*)(q + (size_t)row * 1536 + col0 + bj * 128) = pack8(acc[ai][bj][m][0] * r, acc[ai][bj][m][1] * r); }
        } else {
            const int head = 4 * (pn - 4) + wc;
#pragma unroll
            for (int kb = 0; kb < 4; ++kb) { f32x4 c0[2], c1[2], s0[2], s1[2];
#pragma unroll
                for (int j = 0; j < 2; ++j) { const int k = kb * 2 + j; const size_t t = (size_t)(row0 + (k >> 2) * 128 + (k & 3) * 16) * 32 + 8 * fq;
                    c0[j] = *(const f32x4*)(cosT + t); c1[j] = *(const f32x4*)(cosT + t + 4); s0[j] = *(const f32x4*)(sinT + t); s1[j] = *(const f32x4*)(sinT + t + 4); }
#pragma unroll
                for (int j = 0; j < 2; ++j) { const int k = kb * 2 + j, ai = k >> 2, m = k & 3; const int row = row0 + ai * 128 + m * 16; const float r = rs[k];
                    const f32x4 a0 = acc[ai][0][m][0] * r, a1 = acc[ai][0][m][1] * r, b0 = acc[ai][1][m][0] * r, b1 = acc[ai][1][m][1] * r;
                    *(u32x4*)(q + (size_t)row * 1536 + 1024 + head * 64 + 8 * fq) = pack8(a0 * c0[j] - b0 * s0[j], a1 * c1[j] - b1 * s1[j]);
                    *(u32x4*)(q + (size_t)row * 1536 + 1024 + head * 64 + 32 + 8 * fq) = pack8(b0 * c0[j] + a0 * s0[j], b1 * c1[j] + a1 * s1[j]); } }
        }
    }
};
struct EpiKV {
    static constexpr bool PERM = true;
    bf16_t* kv; const float* ssq;
    __device__ __forceinline__ void operator()(Acc& acc, const Unit& u, int wr, int wc, int fr, int fq) const {
        const int row0 = u.pm * 256 + wr * 64 + fr, col0 = u.pn * 256 + wc * 32 + 8 * fq;
        float rs[8]; rows_rstd(ssq + 8, row0, rs);
#pragma unroll
        for (int ai = 0; ai < 2; ++ai)
#pragma unroll
            for (int m = 0; m < 4; ++m) { const int row = row0 + ai * 128 + m * 16; const float r = rs[ai * 4 + m];
#pragma unroll
                for (int bj = 0; bj < 2; ++bj) *(u32x4*)(kv + (size_t)row * 2048 + col0 + bj * 128) = pack8(acc[ai][bj][m][0] * r, acc[ai][bj][m][1] * r); }
    }
};
struct EpiGate {
    static constexpr bool PERM = true;
    unsigned* au; const bf16_t* xc; const float *ba, *bi, *sp;
    __device__ __forceinline__ void operator()(Acc& acc, const Unit& u, int wr, int wc, int fr, int fq) const {
        const int row0 = u.pm * 256 + wr * 64 + fr, d = u.pn, ch0 = u.z * 128 + wc * 32 + 8 * fq;
        unsigned* aud = au + (size_t)d * M_ * 1024;
#pragma unroll
        for (int n = 0; n < 2; ++n) {
            const int ch = ch0 + 4 * n;
            const f32x4 bav = *(const f32x4*)(ba + d * 1024 + ch), biv = *(const f32x4*)(bi + d * 1024 + ch), spv = *(const f32x4*)(sp + d * 1024 + ch) * (-8.0f * 1.4426950408889634f);
            u32x2 xws[8];
#pragma unroll
            for (int k = 0; k < 8; ++k) xws[k] = *(const u32x2*)(xc + (size_t)(row0 + (k >> 2) * 128 + (k & 3) * 16) * 1024 + ch);
#pragma unroll
            for (int ai = 0; ai < 2; ++ai)
#pragma unroll
                for (int m = 0; m < 4; ++m) { const int row = row0 + ai * 128 + m * 16;
                    const u32x2 xw = xws[ai * 4 + m];
                    const float xv[4] = {bf_lo(xw.x), bf_hi(xw.x), bf_lo(xw.y), bf_hi(xw.y)};
                    u32x4 o;
#pragma unroll
                    for (int j = 0; j < 4; ++j) {
                        const float r = sigmoidf_(acc[ai][0][m][n][j] + bav[j]);
                        const float ig = sigmoidf_(acc[ai][1][m][n][j] + biv[j]);
                        const float a = __builtin_amdgcn_exp2f(r * spv[j]);
                        const float oma = 1.0f - a;
                        const float uu = __builtin_amdgcn_sqrtf(oma * (1.0f + a)) * ig * xv[j];
                        o[j] = cvt_pk_bf16(oma, uu); }
                    *(u32x4*)(aud + (size_t)row * 1024 + ch) = o; }
        }
    }
};
#ifndef RES_PF
#define RES_PF 2
#endif
struct EpiRes {
    static constexpr bool PERM = false;
    bf16_t* hb; const fix_t* st_old; const float *g, *b; fix_t* st_new;
    __device__ __forceinline__ void operator()(Acc& acc, const Unit& u, int wr, int wc, int fr, int fq) const {
        const int row0 = u.pm * 256 + wr * 64 + fr, col0 = u.pn * 256 + wc * 32 + 4 * fq;
        f32x4 gv[4], bv[4]; u32x2 P[RES_PF + 1][4]; float mus[8], rss[8];
#define RES_LOAD(k) do { const size_t off_ = (size_t)(row0 + ((k) >> 2) * 128 + ((k) & 3) * 16) * 2048 + col0; _Pragma("unroll") for (int c = 0; c < 4; ++c) P[(k) % (RES_PF + 1)][c] = *(const u32x2*)(hb + off_ + (c >> 1) * 128 + (c & 1) * 16); } while (0)
#pragma unroll
        for (int k = 0; k < RES_PF; ++k) RES_LOAD(k);
#pragma unroll
        for (int c = 0; c < 4; ++c) { gv[c] = *(const f32x4*)(g + col0 + (c >> 1) * 128 + (c & 1) * 16); bv[c] = *(const f32x4*)(b + col0 + (c >> 1) * 128 + (c & 1) * 16); }
#pragma unroll
        for (int h = 0; h < 2; ++h) { fix_t r1[4], r2[4];
#pragma unroll
            for (int k = 0; k < 4; ++k) { const int row = row0 + h * 128 + k * 16; r1[k] = st_old[row]; r2[k] = st_old[M_ + row]; }
#pragma unroll
            for (int k = 0; k < 4; ++k) { mus[h * 4 + k] = from_fix(r1[k]) * (1.0f / 2048.0f); rss[h * 4 + k] = __builtin_amdgcn_rsqf(from_fix(r2[k]) * (1.0f / 2048.0f) - mus[h * 4 + k] * mus[h * 4 + k] + LN_EPS); } }
#pragma unroll
        for (int k = 0; k < 8; ++k) {
            if (k + RES_PF < 8) RES_LOAD(k + RES_PF);
            const int ai = k >> 2, m = k & 3; const size_t off = (size_t)(row0 + ai * 128 + m * 16) * 2048 + col0;
            const float mu = mus[k], rs = rss[k];
            float a1 = 0.f, a2 = 0.f;
#pragma unroll
            for (int c = 0; c < 4; ++c) { const int cc = (c >> 1) * 128 + (c & 1) * 16; const u32x2 pw = P[k % (RES_PF + 1)][c];
                const f32x4 Pf = {bf_lo(pw.x), bf_hi(pw.x), bf_lo(pw.y), bf_hi(pw.y)};
                const f32x4 v = ((Pf - mu) * rs * gv[c] + bv[c]) * ALPHA + acc[ai][c >> 1][m][c & 1];
                u32x2 w; w.x = cvt_pk_bf16(v[0], v[1]); w.y = cvt_pk_bf16(v[2], v[3]); *(u32x2*)(hb + off + cc) = w;
                a1 += (v[0] + v[1]) + (v[2] + v[3]); a2 += (v[0] * v[0] + v[1] * v[1]) + (v[2] * v[2] + v[3] * v[3]); }
            a1 = sum_fq(a1); a2 = sum_fq(a2);
            { const int row = row0 + ai * 128 + m * 16; if (fq == 0) fix_add(st_new + row, a1); else if (fq == 1) fix_add(st_new + M_ + row, a2); }
        }
#undef RES_LOAD
    }
};
struct EpiUp {
    static constexpr bool PERM = true;
    bf16_t* f; const fix_t* st; const float *cs, *bw;
    __device__ __forceinline__ void operator()(Acc& acc, const Unit& u, int wr, int wc, int fr, int fq) const {
        const int row0 = u.pm * 256 + wr * 64 + fr, col0 = u.pn * 256 + wc * 32 + 8 * fq;
        ln_correct<true>(acc, st, cs, bw, row0, col0);
#pragma unroll
        for (int ai = 0; ai < 2; ++ai)
#pragma unroll
            for (int m = 0; m < 4; ++m) { const int row = row0 + ai * 128 + m * 16;
#pragma unroll
                for (int bj = 0; bj < 2; ++bj) { f32x4 v0 = acc[ai][bj][m][0], v1 = acc[ai][bj][m][1];
#pragma unroll
                    for (int j = 0; j < 4; ++j) { const float a = fmaxf(v0[j], 0.f), b = fmaxf(v1[j], 0.f); v0[j] = a * a; v1[j] = b * b; }
                    *(u32x4*)(f + (size_t)row * 8192 + col0 + bj * 128) = pack8(v0, v1); } }
    }
};

namespace att {
constexpr int NW = 8, QBLK = 32, KVBLK = 64;
constexpr float SCALE = 0.07216878364870323f;
constexpr float THR = 8.f;
#ifndef ATT_SDEPTH
#define ATT_SDEPTH 1
#endif
constexpr int SDEPTH = ATT_SDEPTH;
constexpr int SHM_V = KVBLK * 128 * 2, SHM_K = KVBLK * 128 * 2, SHM_R = KVBLK * 64 * 2;
constexpr int OFF_V = 0, OFF_K = 2 * SHM_V, OFF_R = OFF_K + 2 * SHM_K, OFF_WS = OFF_R + 2 * SHM_R, OFF_QR = OFF_WS + NW * 64 * 4, SHM_ATTN = OFF_QR + 256 * 128;
#define KSWZ(row, colB) ((row) * 256 + ((colB) ^ (((row) & 7) << 4)))
#define RSWZ(row, colB) ((row) * 128 + ((colB) ^ (((row) & 7) << 4)))
#define SBAR() __builtin_amdgcn_sched_barrier(0)
__device__ __forceinline__ int crow(int r, int hi) { return (r & 3) + 8 * (r >> 2) + 4 * hi; }
__device__ __forceinline__ void partialSM(f32x16& p0, f32x16& p1, float& m_reg, float& mn, float& alpha) {
    constexpr float C = SCALE * 1.4426950408889634f;
    float pmax = p0[0];
#pragma unroll
    for (int r = 1; r < 16; ++r) pmax = fmaxf(pmax, p0[r]);
#pragma unroll
    for (int r = 0; r < 16; ++r) pmax = fmaxf(pmax, p1[r]);
    { auto rr = __builtin_amdgcn_permlane32_swap(__float_as_uint(pmax), __float_as_uint(pmax), false, false);
      pmax = fmaxf(__uint_as_float(rr[0]), __uint_as_float(rr[1])); }
    if (__builtin_expect(__all(pmax - m_reg <= THR / SCALE), 1)) { mn = m_reg; alpha = 1.f; }
    else { mn = fmaxf(m_reg, pmax); alpha = __builtin_amdgcn_exp2f((m_reg - mn) * C); m_reg = mn; }
    const float mnC = -mn * C;
#pragma unroll
    for (int r = 0; r < 16; ++r) p0[r] = fmaf(p0[r], C, mnC);
#pragma unroll
    for (int r = 0; r < 16; ++r) p1[r] = fmaf(p1[r], C, mnC);
#pragma unroll
    for (int r = 0; r < 16; ++r) p0[r] = __builtin_amdgcn_exp2f(p0[r]);
}
__device__ __forceinline__ void finishSM(f32x16& p0, f32x16& p1, float alpha, float& l_reg, bf16x8& pa0, bf16x8& pa1, bf16x8& pa2, bf16x8& pa3) {
#pragma unroll
    for (int r = 0; r < 16; ++r) p1[r] = __builtin_amdgcn_exp2f(p1[r]);
    float ps = 0;
#pragma unroll
    for (int r = 0; r < 16; ++r) ps += p0[r];
#pragma unroll
    for (int r = 0; r < 16; ++r) ps += p1[r];
    { auto rr = __builtin_amdgcn_permlane32_swap(__float_as_uint(ps), __float_as_uint(ps), false, false);
      ps = __uint_as_float(rr[0]) + __uint_as_float(rr[1]); }
    l_reg = l_reg * alpha + ps;
#define PK4(P, BASE, OUT) do { unsigned a0 = cvt_pk_bf16(P[BASE + 0], P[BASE + 1]), a1 = cvt_pk_bf16(P[BASE + 2], P[BASE + 3]);   \
    unsigned b0 = cvt_pk_bf16(P[BASE + 4], P[BASE + 5]), b1 = cvt_pk_bf16(P[BASE + 6], P[BASE + 7]);                              \
    auto r0 = __builtin_amdgcn_permlane32_swap(a0, b0, false, false); auto r1 = __builtin_amdgcn_permlane32_swap(a1, b1, false, false); \
    u32x4 w = {r0[0], r1[0], r0[1], r1[1]}; OUT = *reinterpret_cast<bf16x8*>(&w); } while (0)
    PK4(p0, 0, pa0); PK4(p0, 8, pa1); PK4(p1, 0, pa2); PK4(p1, 8, pa3);
#undef PK4
}
__device__ __forceinline__ void qkt(f32x16& p0, f32x16& p1, const char* Ks, const char* Rs, const bf16x8* qr, const char* Qrl, int r32, int hi) {
    p0 = f32x16{}; p1 = f32x16{};
#pragma unroll
    for (int d0 = 0; d0 < 8; ++d0) { const int cb = (d0 * 16 + hi * 8) * 2;
        const bf16x8 b0 = *reinterpret_cast<const bf16x8*>(Ks + KSWZ(r32, cb));
        const bf16x8 b1 = *reinterpret_cast<const bf16x8*>(Ks + KSWZ(32 + r32, cb));
        p0 = __builtin_amdgcn_mfma_f32_32x32x16_bf16(b0, qr[d0], p0, 0, 0, 0);
        p1 = __builtin_amdgcn_mfma_f32_32x32x16_bf16(b1, qr[d0], p1, 0, 0, 0); }
#pragma unroll
    for (int d0 = 0; d0 < 4; ++d0) { const int cb = (d0 * 16 + hi * 8) * 2;
        const bf16x8 b0 = *reinterpret_cast<const bf16x8*>(Rs + RSWZ(r32, cb));
        const bf16x8 b1 = *reinterpret_cast<const bf16x8*>(Rs + RSWZ(32 + r32, cb));
        const bf16x8 qv = *reinterpret_cast<const bf16x8*>(Qrl + (cb ^ ((r32 & 7) << 4)));
        p0 = __builtin_amdgcn_mfma_f32_32x32x16_bf16(b0, qv, p0, 0, 0, 0);
        p1 = __builtin_amdgcn_mfma_f32_32x32x16_bf16(b1, qv, p1, 0, 0, 0); }
}
__device__ __forceinline__ int v_st(int k, int c) { const int kk = (k & ~0xC) | ((k & 4) << 1) | ((k & 8) >> 1); return ((kk >> 3) * 4 + (c >> 5)) * 512 + ((kk & 7) * 32 + (c & 31)) * 2; }
__device__ __forceinline__ int v_rd_base(int lane) { return ((lane & 3) << 3) | (((lane >> 2) & 3) << 6) | (((lane >> 4) & 1) << 5) | (((lane >> 5) & 1) << 8); }
constexpr int v_rd_off(int d0, int ks, int half) { return d0 * 512 + ks * 4096 + half * 2048; }
template <int OFF> __device__ __forceinline__ s16x4 tr_read(int vb) {
    s16x4 r; asm volatile("ds_read_b64_tr_b16 %0, %1 offset:%2" : "=&v"(r) : "v"(vb), "i"(OFF) : "memory"); return r;
}
template <int D0> __device__ __forceinline__ void pv_one(f32x16& od, int vb, bf16x8 pa0, bf16x8 pa1, bf16x8 pa2, bf16x8 pa3) {
    const s16x4 l0 = tr_read<v_rd_off(D0, 0, 0)>(vb), h0 = tr_read<v_rd_off(D0, 0, 1)>(vb), l1 = tr_read<v_rd_off(D0, 1, 0)>(vb), h1 = tr_read<v_rd_off(D0, 1, 1)>(vb);
    const s16x4 l2 = tr_read<v_rd_off(D0, 2, 0)>(vb), h2 = tr_read<v_rd_off(D0, 2, 1)>(vb), l3 = tr_read<v_rd_off(D0, 3, 0)>(vb), h3 = tr_read<v_rd_off(D0, 3, 1)>(vb);
    asm volatile("s_waitcnt lgkmcnt(0)" ::: "memory"); SBAR();
#define PK(L, H) (bf16x8){L[0], L[1], L[2], L[3], H[0], H[1], H[2], H[3]}
    od = __builtin_amdgcn_mfma_f32_32x32x16_bf16(pa0, PK(l0, h0), od, 0, 0, 0);
    od = __builtin_amdgcn_mfma_f32_32x32x16_bf16(pa1, PK(l1, h1), od, 0, 0, 0);
    od = __builtin_amdgcn_mfma_f32_32x32x16_bf16(pa2, PK(l2, h2), od, 0, 0, 0);
    od = __builtin_amdgcn_mfma_f32_32x32x16_bf16(pa3, PK(l3, h3), od, 0, 0, 0);
#undef PK
}
__device__ __forceinline__ void pv_d0(f32x16* o, int vb, bf16x8 pa0, bf16x8 pa1, bf16x8 pa2, bf16x8 pa3) {
    pv_one<0>(o[0], vb, pa0, pa1, pa2, pa3); pv_one<1>(o[1], vb, pa0, pa1, pa2, pa3); pv_one<2>(o[2], vb, pa0, pa1, pa2, pa3); pv_one<3>(o[3], vb, pa0, pa1, pa2, pa3);
}
__device__ __forceinline__ void attn_unit(const bf16_t* __restrict__ Qn, const bf16_t* __restrict__ Qr, const bf16_t* __restrict__ Kh, const bf16_t* __restrict__ Rh,
                                          bf16_t* __restrict__ Ob, int seq, char* lds) {
    const int tid = otid(), wid = tid >> 6, lane = tid & 63, r32 = lane & 31, hi = lane >> 5;
    char* V_lds = lds + OFF_V; char* K_lds = lds + OFF_K; char* R_lds = lds + OFF_R;
    float* ws = (float*)(lds + OFF_WS) + wid * 64; float* li_l = ws; float* al_l = ws + 32;
    float m_reg = -1e30f, l_reg = 0; f32x16 o[4] = {}; bf16x8 qr[8];
    char* Qrl = lds + OFF_QR + (wid * QBLK + r32) * 128;
    {
        const bf16_t* Qw = Qn + (size_t)(wid * QBLK + r32) * 1536 + hi * 8;
#pragma unroll
        for (int d0 = 0; d0 < 8; ++d0) qr[d0] = *reinterpret_cast<const bf16x8*>(Qw + d0 * 16);
        const bf16_t* Qw2 = Qr + (size_t)(wid * QBLK + r32) * 1536 + hi * 8;
#pragma unroll
        for (int d0 = 0; d0 < 4; ++d0) { const bf16x8 t = *reinterpret_cast<const bf16x8*>(Qw2 + d0 * 16); *reinterpret_cast<bf16x8*>(Qrl + (((d0 * 16 + hi * 8) * 2) ^ ((r32 & 7) << 4))) = t; }
    }
    const int sr = tid >> 4, sc = (tid & 15) * 8, vst0 = v_st(sr, sc), vst1 = v_st(32 + sr, sc);
    const int rr_ = tid >> 3, rc = (tid & 7) * 8;
    const int vb0 = (int)(uintptr_t)V_lds + v_rd_base(lane);
    struct { bf16x8 vs0, vs1, ks0, ks1, rs; } sr_[SDEPTH];
#define SLOAD(i, k0) do { sr_[i].vs0 = *(const bf16x8*)(&Kh[(size_t)((k0) + sr) * 2048 + 128 + sc]); sr_[i].vs1 = *(const bf16x8*)(&Kh[(size_t)((k0) + 32 + sr) * 2048 + 128 + sc]); \
    sr_[i].ks0 = *(const bf16x8*)(&Kh[(size_t)((k0) + sr) * 2048 + sc]); sr_[i].ks1 = *(const bf16x8*)(&Kh[(size_t)((k0) + 32 + sr) * 2048 + sc]); \
    sr_[i].rs = *(const bf16x8*)(&Rh[(size_t)((k0) + rr_) * 64 + rc]); } while (0)
#define SWRITE(b, i) do { *(bf16x8*)(V_lds + (b) * SHM_V + vst0) = sr_[i].vs0;          \
    *(bf16x8*)(V_lds + (b) * SHM_V + vst1) = sr_[i].vs1; const int kc = sc * 2;               \
    *(bf16x8*)(K_lds + (b) * SHM_K + KSWZ(sr, kc)) = sr_[i].ks0;                       \
    *(bf16x8*)(K_lds + (b) * SHM_K + KSWZ(32 + sr, kc)) = sr_[i].ks1;                  \
    *(bf16x8*)(R_lds + (b) * SHM_R + RSWZ(rr_, rc * 2)) = sr_[i].rs; } while (0)
#define SWAIT() do { if constexpr (SDEPTH == 2) asm volatile("s_waitcnt vmcnt(5)" ::: "memory"); else asm volatile("s_waitcnt vmcnt(0)" ::: "memory"); } while (0)
#define RESC(a) do { if (__any((a) < 1.f)) { if (hi == 0) al_l[r32] = (a); asm volatile("s_waitcnt lgkmcnt(0)" ::: "memory"); \
    _Pragma("unroll") for (int d = 0; d < 4; ++d) _Pragma("unroll") for (int r = 0; r < 16; ++r) o[d][r] *= al_l[crow(r, hi)]; } } while (0)
    f32x16 pA0, pA1, pB0, pB1; float mnA, mnB, alA, alB; bf16x8 pa0, pa1, pa2, pa3; const int NT = seq / KVBLK;
    constexpr int SE = 0, SO = SDEPTH - 1;
    SLOAD(SE, 0); asm volatile("s_waitcnt vmcnt(0)" ::: "memory"); SWRITE(0, SE); __syncthreads();
    qkt(pA0, pA1, K_lds, R_lds, qr, Qrl, r32, hi); partialSM(pA0, pA1, m_reg, mnA, alA);
    SLOAD(SO, KVBLK); if constexpr (SDEPTH == 2) { if (2 < NT) SLOAD(SE, 2 * KVBLK); }
    SWAIT(); SWRITE(1, SO); __syncthreads();
    for (int j = 1; j + 1 < NT; j += 2) {
        SBAR(); qkt(pB0, pB1, K_lds + SHM_K, R_lds + SHM_R, qr, Qrl, r32, hi);
        finishSM(pA0, pA1, alA, l_reg, pa0, pa1, pa2, pa3); SBAR();
        SLOAD(SO, (j + SDEPTH) * KVBLK); SBAR();
        pv_d0(o, vb0, pa0, pa1, pa2, pa3); partialSM(pB0, pB1, m_reg, mnB, alB);
        __syncthreads(); SWAIT(); SWRITE(0, SE);
        RESC(alB); __syncthreads();
        SBAR(); qkt(pA0, pA1, K_lds, R_lds, qr, Qrl, r32, hi);
        finishSM(pB0, pB1, alB, l_reg, pa0, pa1, pa2, pa3); SBAR();
        if (SDEPTH == 1 || j + 3 < NT) SLOAD(SE, (j + 1 + SDEPTH) * KVBLK); SBAR();
        pv_d0(o, vb0 + (int)SHM_V, pa0, pa1, pa2, pa3); partialSM(pA0, pA1, m_reg, mnA, alA);
        __syncthreads(); SWAIT(); SWRITE(1, SO);
        RESC(alA); __syncthreads();
    }
    SBAR(); qkt(pB0, pB1, K_lds + SHM_K, R_lds + SHM_R, qr, Qrl, r32, hi);
    finishSM(pA0, pA1, alA, l_reg, pa0, pa1, pa2, pa3); SBAR();
    pv_d0(o, vb0, pa0, pa1, pa2, pa3); partialSM(pB0, pB1, m_reg, mnB, alB);
    __syncthreads(); RESC(alB);
    finishSM(pB0, pB1, alB, l_reg, pa0, pa1, pa2, pa3); SBAR();
    pv_d0(o, vb0 + (int)SHM_V, pa0, pa1, pa2, pa3);
    if (hi == 0) li_l[r32] = l_reg; asm volatile("s_waitcnt lgkmcnt(0)" ::: "memory");
    float rli[16];
#pragma unroll
    for (int r = 0; r < 16; ++r) rli[r] = __builtin_amdgcn_rcpf(li_l[crow(r, hi)]);
    bf16_t* Ow = Ob + (size_t)(wid * QBLK) * 2048;
#pragma unroll
    for (int r = 0; r < 16; ++r) { const int orow = crow(r, hi);
#pragma unroll
        for (int d0 = 0; d0 < 4; ++d0) Ow[(size_t)orow * 2048 + d0 * 32 + r32] = (bf16_t)(cvt_pk_bf16(o[d0][r] * rli[r], 0.f) & 0xffffu); }
#undef SLOAD
#undef SWRITE
#undef SWAIT
#undef RESC
}
}

__device__ __forceinline__ void x_pass(const float* src, bf16_t* dstb, fix_t* st) {
    const int tid_ = otid(), lane = tid_ & 63, wave = tid_ >> 6;
    for (int row = blockIdx.x * 8 + wave; row < M_; row += gridDim.x * 8) {
        const float* s = src + (size_t)row * 2048; f32x4 v[8]; float s1 = 0.f, s2 = 0.f;
#pragma unroll
        for (int i = 0; i < 8; ++i) { v[i] = *(const f32x4*)(s + i * 256 + lane * 4); s1 += (v[i][0] + v[i][1]) + (v[i][2] + v[i][3]); s2 += (v[i][0] * v[i][0] + v[i][1] * v[i][1]) + (v[i][2] * v[i][2] + v[i][3] * v[i][3]); }
        s1 = wave_sum(s1, lane); s2 = wave_sum(s2, lane);
        if (lane == 0) { st[row] = to_fix(s1); st[M_ + row] = to_fix(s2); }
#pragma unroll
        for (int i = 0; i < 8; ++i) { u32x2 w; w.x = cvt_pk_bf16(v[i][0], v[i][1]); w.y = cvt_pk_bf16(v[i][2], v[i][3]); *(u32x2*)(dstb + (size_t)row * 2048 + i * 256 + lane * 4) = w; }
    }
}
__device__ __forceinline__ void ln_final(float* out, const bf16_t* hb, const fix_t* st, const float* g, const float* b) {
    const int tid = otid();
    for (size_t i = (size_t)blockIdx.x * 512 + tid; i < (size_t)M_ * 512; i += (size_t)gridDim.x * 512) {
        const int row = (int)(i >> 9), c = (int)(i & 511) * 4; float mu, rs; row_ln(st, row, mu, rs);
        const u32x2 pw = *(const u32x2*)(hb + i * 4); const f32x4 P = {bf_lo(pw.x), bf_hi(pw.x), bf_lo(pw.y), bf_hi(pw.y)}, g4 = *(const f32x4*)(g + c), b4 = *(const f32x4*)(b + c);
        *(f32x4*)(out + i * 4) = (P - mu) * rs * g4 + b4;
    }
}
__device__ __forceinline__ int colmap(int mode, int n) {
    if (mode == 0) { if (n < 1024) return n; if (n < 2048) return 1088 + (n - 1024); if (n < 3072) return 2112 + (n - 2048);
        const int t = n - 3072, bj = t >> 7, r = t & 127; return r < 32 ? 1024 + bj * 32 + r : -1; }
    if (mode == 1) { if (n < 1024) return (n >> 7) * 192 + (n & 127);
        const int t = n - 1024, tile = t >> 8, bj = (t >> 7) & 1, wc = (t >> 5) & 3, i = t & 31; return (4 * tile + wc) * 192 + 128 + bj * 32 + i; }
    return n;
}
__device__ __forceinline__ void cvt_tile(const float* W, int ldw, bf16_t* Bt, int ldb, int n0, int k0, int mode, const float* kscale, float* T) {
    const int tid = otid(), n4 = (tid & 31) * 4, kq = tid >> 5, src = colmap(mode, n0 + n4);
    f32x4 v[8];
#pragma unroll
    for (int i = 0; i < 8; ++i) { const int kk = kq + 16 * i; v[i] = *(const f32x4*)(W + (size_t)(k0 + kk) * ldw + (src >= 0 ? src : 0)); }
    float ksc[8];
#pragma unroll
    for (int i = 0; i < 8; ++i) ksc[i] = kscale ? kscale[k0 + kq + 16 * i] : 1.0f;
#pragma unroll
    for (int i = 0; i < 8; ++i) v[i] = v[i] * (src >= 0 ? ksc[i] : 0.0f);
#pragma unroll
    for (int i = 0; i < 8; ++i)
#pragma unroll
        for (int j = 0; j < 4; ++j) T[(n4 + j) * 129 + kq + 16 * i] = v[i][j];
    __syncthreads();
    { const int n2 = tid >> 2, ks = (tid & 3) * 32; const float* t = T + n2 * 129 + ks; bf16_t* dst = Bt + (size_t)(n0 + n2) * ldb + k0 + ks;
#pragma unroll
      for (int i = 0; i < 4; ++i) { u32x4 w; w.x = cvt_pk_bf16(t[i * 8 + 0], t[i * 8 + 1]); w.y = cvt_pk_bf16(t[i * 8 + 2], t[i * 8 + 3]); w.z = cvt_pk_bf16(t[i * 8 + 4], t[i * 8 + 5]); w.w = cvt_pk_bf16(t[i * 8 + 6], t[i * 8 + 7]);
          *(u32x4*)(dst + i * 8) = w; } }
    __syncthreads();
}
constexpr int CT0 = 26 * 16, CT1 = CT0 + 12 * 4, CT2 = CT1 + 16 * 4, CT3 = CT2 + 32, CT4 = CT3 + 16 * 16, CT5 = CT4 + 64 * 16, CT6 = CT5 + 16 * 64;
__device__ __forceinline__ void convert_weights(const Params& p, int l, int t0, int t1, float* T) {
    unsigned char* ws = p.ws;
    const float* ing = l == 0 ? p.in[2] : p.in[21] + (size_t)(l - 1) * 2048;
    for (int t = t0 + blockIdx.x; t < t1; t += gridDim.x) {
        if (t < CT0) { const int nt = t % 26, kt = t / 26; cvt_tile(p.in[4] + (size_t)l * 2048 * NIN, NIN, (bf16_t*)(ws + W_IN), 2048, nt * 128, kt * 128, 0, ing, T); }
        else if (t < CT1) { const int u = t - CT0, nt = u % 12, kt = u / 12; cvt_tile(p.in[7] + (size_t)l * 512 * 1536, 1536, (bf16_t*)(ws + W_UQ), 512, nt * 128, kt * 128, 1, p.in[5] + l * 512, T); }
        else if (t < CT2) { const int u = t - CT1, nt = u % 16, kt = u / 16; cvt_tile(p.in[8] + (size_t)l * 512 * 2048, 2048, (bf16_t*)(ws + W_UKV), 512, nt * 128, kt * 128, 2, p.in[6] + l * 512, T); }
        else if (t < CT3) { const int mat = t - CT2, gate = mat & 1, h = (mat >> 1) & 7, d = mat >> 4;
            cvt_tile((gate ? p.in[13] : p.in[11]) + ((size_t)((l * 2 + d) * 8 + h)) * 128 * 128, 128, (bf16_t*)(ws + W_G) + (size_t)(h * 512 + d * 256 + gate * 128) * 128, 128, 0, 0, 2, nullptr, T); }
        else if (t < CT4) { const int u = t - CT3, nt = u % 16, kt = u / 16; cvt_tile(p.in[16] + (size_t)l * 2048 * 2048, 2048, (bf16_t*)(ws + W_OUT), 2048, nt * 128, kt * 128, 2, nullptr, T); }
        else if (t < CT5) { const int u = t - CT4, nt = u % 64, kt = u / 64; cvt_tile(p.in[19] + (size_t)l * 2048 * 8192, 8192, (bf16_t*)(ws + W_UP), 2048, nt * 128, kt * 128, 2, p.in[17] + (size_t)l * 2048, T); }
        else { const int u = t - CT5, nt = u % 16, kt = u / 16; cvt_tile(p.in[20] + (size_t)l * 8192 * 2048, 2048, (bf16_t*)(ws + W_DN), 8192, nt * 128, kt * 128, 2, nullptr, T); }
    }
}
__device__ __forceinline__ void colsum_pass(const bf16_t* Bt, int N, const float* lg, const float* lb, float* cs, float* bw) {
    const int tid = otid(), lane = tid & 63, wave = tid >> 6;
    float ratio[32];
#pragma unroll
    for (int i = 0; i < 4; ++i)
#pragma unroll
        for (int j = 0; j < 8; ++j) { const int k = i * 512 + lane * 8 + j; ratio[i * 8 + j] = lb[k] * __builtin_amdgcn_rcpf(lg[k]); }
    for (int n = blockIdx.x * 8 + wave; n < N; n += gridDim.x * 8) {
        u32x4 w[4];
#pragma unroll
        for (int i = 0; i < 4; ++i) w[i] = *(const u32x4*)(Bt + (size_t)n * 2048 + i * 512 + lane * 8);
        float c = 0.f, bb = 0.f;
#pragma unroll
        for (int i = 0; i < 4; ++i) { const float v[8] = {bf_lo(w[i].x), bf_hi(w[i].x), bf_lo(w[i].y), bf_hi(w[i].y), bf_lo(w[i].z), bf_hi(w[i].z), bf_lo(w[i].w), bf_hi(w[i].w)};
#pragma unroll
            for (int j = 0; j < 8; ++j) { c += v[j]; bb += v[j] * ratio[i * 8 + j]; } }
        c = wave_sum(c, lane); bb = wave_sum(bb, lane);
        if (lane == 0) { cs[n] = c; bw[n] = bb; }
    }
}
__device__ __forceinline__ void colsum_in(const Params& p, int l) { float* csb = (float*)(p.ws + WS_CSB) + (size_t)l * CSB_L;
    colsum_pass((const bf16_t*)(p.ws + W_IN), NINP, l == 0 ? p.in[2] : p.in[21] + (size_t)(l - 1) * 2048, l == 0 ? p.in[3] : p.in[22] + (size_t)(l - 1) * 2048, csb + CSB_IN, csb + CSB_IN + NINP); }
__device__ __forceinline__ void colsum_up(const Params& p, int l) { float* csb = (float*)(p.ws + WS_CSB) + (size_t)l * CSB_L;
    colsum_pass((const bf16_t*)(p.ws + W_UP), DFF, p.in[17] + (size_t)l * 2048, p.in[18] + (size_t)l * 2048, csb + CSB_UP, csb + CSB_UP + DFF); }
__device__ __forceinline__ void make_tables(const Params& p) {
    const int* pos = (const int*)p.in[1]; float* cosT = (float*)(p.ws + WS_COS); float* sinT = (float*)(p.ws + WS_SIN); float* sp = (float*)(p.ws + WS_SP);
    const int tid = otid();
    for (size_t i = (size_t)blockIdx.x * 512 + tid; i < (size_t)M_ * 32; i += (size_t)gridDim.x * 512) {
        const int row = (int)(i >> 5), k = (int)(i & 31); const float inv = powf(10000.0f, -(float)(2 * k) / 64.0f); const float ang = (float)pos[row] * inv;
        cosT[i] = cosf(ang); sinT[i] = sinf(ang); }
    for (int i = blockIdx.x * 512 + tid; i < DEPTH * 2 * 1024; i += gridDim.x * 512) { const float x = -p.in[15][i];
        sp[i] = fmaxf(x, 0.f) + log1pf(expf(-fabsf(x))); }
}
__device__ __forceinline__ void conv_phase(const Params& p, int l) {
    const bf16_t* __restrict__ xl = (const bf16_t*)(p.ws + WS_XL); bf16_t* __restrict__ xc = (bf16_t*)(p.ws + WS_XC);
    const float* cw = p.in[9] + (size_t)l * 4 * 1024; const float* cb = p.in[10] + (size_t)l * 1024;
    const int tid = otid();
    for (size_t i = (size_t)blockIdx.x * 512 + tid; i < (size_t)M_ * 128; i += (size_t)gridDim.x * 512) {
        const int row = (int)(i >> 7), c0 = (int)(i & 127) * 8, t = row & (SEQ - 1);
        u32x4 xw[4]; f32x4 w0[4], w1[4];
#pragma unroll
        for (int k = 0; k < 4; ++k) { const int tt = t - 2 + k; const bool ok = (tt >= 0) && (tt < SEQ); const int rr = ok ? row - 2 + k : row;
            xw[k] = *(const u32x4*)(xl + (size_t)rr * 1024 + c0);
            w0[k] = *(const f32x4*)(cw + k * 1024 + c0); w1[k] = *(const f32x4*)(cw + k * 1024 + c0 + 4);
            if (!ok) { w0[k] = (f32x4){0.f, 0.f, 0.f, 0.f}; w1[k] = (f32x4){0.f, 0.f, 0.f, 0.f}; } }
        const f32x4 b0 = *(const f32x4*)(cb + c0), b1 = *(const f32x4*)(cb + c0 + 4);
        float acc[8] = {b0[0], b0[1], b0[2], b0[3], b1[0], b1[1], b1[2], b1[3]};
#pragma unroll
        for (int k = 0; k < 4; ++k) {
            acc[0] += w0[k][0] * bf_lo(xw[k].x); acc[1] += w0[k][1] * bf_hi(xw[k].x); acc[2] += w0[k][2] * bf_lo(xw[k].y); acc[3] += w0[k][3] * bf_hi(xw[k].y);
            acc[4] += w1[k][0] * bf_lo(xw[k].z); acc[5] += w1[k][1] * bf_hi(xw[k].z); acc[6] += w1[k][2] * bf_lo(xw[k].w); acc[7] += w1[k][3] * bf_hi(xw[k].w); }
        u32x4 o; o.x = cvt_pk_bf16(acc[0], acc[1]); o.y = cvt_pk_bf16(acc[2], acc[3]); o.z = cvt_pk_bf16(acc[4], acc[5]); o.w = cvt_pk_bf16(acc[6], acc[7]);
        *(u32x4*)(xc + (size_t)row * 1024 + c0) = o;
    }
}
__device__ __forceinline__ void scan_local(const Params& p) {
    const unsigned* au = (const unsigned*)(p.ws + WS_AU); f32x4* ph = (f32x4*)(p.ws + WS_PH); const int tid = otid();
    for (int it = blockIdx.x; it < 2 * 8 * 64; it += gridDim.x) {
        const int c = it & 63, b = (it >> 6) & 7, d = it >> 9;
        const u32x2* __restrict__ src = (const u32x2*)(au + (size_t)d * M_ * 1024 + (size_t)(b * SEQ + c * 64) * 1024) + tid;
        float h0 = 0.f, h1 = 0.f, P0 = 1.f, P1 = 1.f;
        const long step = d ? -512 : 512; const u32x2* q = src + (d ? (size_t)63 * 512 : 0);
        u32x2 wa[16], wb[16];
#pragma unroll
        for (int j = 0; j < 16; ++j) wa[j] = q[(long)j * step];
#pragma unroll
        for (int bt = 0; bt < 4; bt += 2) {
#pragma unroll
            for (int j = 0; j < 16; ++j) wb[j] = q[(long)((bt + 1) * 16 + j) * step];
#pragma unroll
            for (int j = 0; j < 16; ++j) { const float a0 = 1.0f - bf_lo(wa[j].x), a1 = 1.0f - bf_lo(wa[j].y); h0 = a0 * h0 + bf_hi(wa[j].x); h1 = a1 * h1 + bf_hi(wa[j].y); P0 *= a0; P1 *= a1; }
            if (bt + 2 < 4) {
#pragma unroll
                for (int j = 0; j < 16; ++j) wa[j] = q[(long)((bt + 2) * 16 + j) * step]; }
#pragma unroll
            for (int j = 0; j < 16; ++j) { const float a0 = 1.0f - bf_lo(wb[j].x), a1 = 1.0f - bf_lo(wb[j].y); h0 = a0 * h0 + bf_hi(wb[j].x); h1 = a1 * h1 + bf_hi(wb[j].y); P0 *= a0; P1 *= a1; }
        }
        ph[(size_t)((d * 8 + b) * 64 + c) * 512 + tid] = (f32x4){P0, h0, P1, h1};
    }
}
__device__ __forceinline__ void scan_apply(const Params& p) {
    const unsigned* au = (const unsigned*)(p.ws + WS_AU); const f32x4* ph = (const f32x4*)(p.ws + WS_PH);
    const bf16_t* gg = (const bf16_t*)(p.ws + WS_GG); bf16_t* ycat = (bf16_t*)(p.ws + WS_YCAT); const int tid = otid();
    for (int it = blockIdx.x; it < 8 * 64; it += gridDim.x) {
        const int c = it & 63, b = it >> 6;
        float Hf0 = 0.f, Hf1 = 0.f, Hb0 = 0.f, Hb1 = 0.f;
        { const f32x4* pf = ph + (size_t)((0 * 8 + b) * 64) * 512 + tid;
          for (int c0 = 0; c0 < c; c0 += 8) { f32x4 e[8];
#pragma unroll
              for (int j = 0; j < 8; ++j) e[j] = pf[(size_t)min(c0 + j, c - 1) * 512];
#pragma unroll
              for (int j = 0; j < 8; ++j) if (c0 + j >= c) e[j] = (f32x4){1.f, 0.f, 1.f, 0.f};
#pragma unroll
              for (int j = 0; j < 8; ++j) { Hf0 = e[j][0] * Hf0 + e[j][1]; Hf1 = e[j][2] * Hf1 + e[j][3]; } }
          const f32x4* pb = ph + (size_t)((1 * 8 + b) * 64) * 512 + tid;
          for (int c0 = 63; c0 > c; c0 -= 8) { f32x4 e[8];
#pragma unroll
              for (int j = 0; j < 8; ++j) e[j] = pb[(size_t)max(c0 - j, c + 1) * 512];
#pragma unroll
              for (int j = 0; j < 8; ++j) if (c0 - j <= c) e[j] = (f32x4){1.f, 0.f, 1.f, 0.f};
#pragma unroll
              for (int j = 0; j < 8; ++j) { Hb0 = e[j][0] * Hb0 + e[j][1]; Hb1 = e[j][2] * Hb1 + e[j][3]; } } }
        const size_t r0 = (size_t)(b * SEQ + c * 64);
        const u32x2* __restrict__ s0 = (const u32x2*)(au + r0 * 1024) + tid; const u32x2* __restrict__ s1 = (const u32x2*)(au + (size_t)M_ * 1024 + r0 * 1024) + tid;
        const unsigned* __restrict__ gp = (const unsigned*)(gg + r0 * 1024) + tid; unsigned* __restrict__ yp = (unsigned*)(ycat + r0 * 2048 + 1024) + tid;
        float hf0[64], hf1[64];
        { u32x2 wa[8], wb[8];
#pragma unroll
          for (int j = 0; j < 8; ++j) wa[j] = s0[(size_t)j * 512];
#pragma unroll
          for (int bt = 0; bt < 8; bt += 2) {
#pragma unroll
              for (int j = 0; j < 8; ++j) wb[j] = s0[(size_t)((bt + 1) * 8 + j) * 512];
#pragma unroll
              for (int j = 0; j < 8; ++j) { const int t = bt * 8 + j; Hf0 = (1.0f - bf_lo(wa[j].x)) * Hf0 + bf_hi(wa[j].x); Hf1 = (1.0f - bf_lo(wa[j].y)) * Hf1 + bf_hi(wa[j].y); hf0[t] = Hf0; hf1[t] = Hf1; }
              if (bt + 2 < 8) {
#pragma unroll
                  for (int j = 0; j < 8; ++j) wa[j] = s0[(size_t)((bt + 2) * 8 + j) * 512]; }
#pragma unroll
              for (int j = 0; j < 8; ++j) { const int t = (bt + 1) * 8 + j; Hf0 = (1.0f - bf_lo(wb[j].x)) * Hf0 + bf_hi(wb[j].x); Hf1 = (1.0f - bf_lo(wb[j].y)) * Hf1 + bf_hi(wb[j].y); hf0[t] = Hf0; hf1[t] = Hf1; }
          } }
        { u32x2 wa[8], wb[8]; unsigned ga[8], gb[8];
#pragma unroll
          for (int j = 0; j < 8; ++j) { wa[j] = s1[(size_t)(63 - j) * 512]; ga[j] = gp[(size_t)(63 - j) * 512]; }
#pragma unroll
          for (int bt = 0; bt < 8; bt += 2) {
#pragma unroll
              for (int j = 0; j < 8; ++j) { const int t = 63 - ((bt + 1) * 8 + j); wb[j] = s1[(size_t)t * 512]; gb[j] = gp[(size_t)t * 512]; }
#pragma unroll
              for (int j = 0; j < 8; ++j) { const int t = 63 - (bt * 8 + j); Hb0 = (1.0f - bf_lo(wa[j].x)) * Hb0 + bf_hi(wa[j].x); Hb1 = (1.0f - bf_lo(wa[j].y)) * Hb1 + bf_hi(wa[j].y);
                  yp[(size_t)t * 1024] = cvt_pk_bf16(bf_lo(ga[j]) * (hf0[t] + Hb0), bf_hi(ga[j]) * (hf1[t] + Hb1)); }
              if (bt + 2 < 8) {
#pragma unroll
                  for (int j = 0; j < 8; ++j) { const int t = 63 - ((bt + 2) * 8 + j); wa[j] = s1[(size_t)t * 512]; ga[j] = gp[(size_t)t * 512]; } }
#pragma unroll
              for (int j = 0; j < 8; ++j) { const int t = 63 - ((bt + 1) * 8 + j); Hb0 = (1.0f - bf_lo(wb[j].x)) * Hb0 + bf_hi(wb[j].x); Hb1 = (1.0f - bf_lo(wb[j].y)) * Hb1 + bf_hi(wb[j].y);
                  yp[(size_t)t * 1024] = cvt_pk_bf16(bf_lo(gb[j]) * (hf0[t] + Hb0), bf_hi(gb[j]) * (hf1[t] + Hb1)); }
          } }
    }
}

__device__ __forceinline__ void grid_bar(unsigned* ctr, unsigned epoch) {
    asm volatile("s_waitcnt vmcnt(0) lgkmcnt(0)" ::: "memory");
    __syncthreads();
    if (otid() == 0) {
        __builtin_amdgcn_fence(__ATOMIC_RELEASE, "agent");
        asm volatile("s_waitcnt vmcnt(0)" ::: "memory");
        __hip_atomic_fetch_add(ctr, 1u, __ATOMIC_RELAXED, __HIP_MEMORY_SCOPE_AGENT);
        const unsigned target = (epoch + 1u) * gridDim.x;
        while (__hip_atomic_load(ctr, __ATOMIC_RELAXED, __HIP_MEMORY_SCOPE_AGENT) < target) __builtin_amdgcn_s_sleep(1);
        __builtin_amdgcn_fence(__ATOMIC_ACQUIRE, "agent");
        asm volatile("s_waitcnt vmcnt(0)" ::: "memory");
    }
    __syncthreads();
}
__global__ void __launch_bounds__(512, 2) mega_fwd(Params p) {
    extern __shared__ __attribute__((aligned(16))) unsigned char lds[];
    cg::grid_group grid = cg::this_grid();
    unsigned char* ws = p.ws;
    LAS unsigned char* ldsl = (LAS unsigned char*)lds;
    bf16_t* hb = (bf16_t*)(ws + WS_HB);
    const float* cosT = (const float*)(ws + WS_COS); const float* sinT = (const float*)(ws + WS_SIN);

    unsigned* bar_ctr = (unsigned*)(ws + WS_BAR);
    fix_t* stats0 = (fix_t*)(ws + WS_ST);
#define stats stats0
    { const int tid = otid();
      for (size_t i = (size_t)blockIdx.x * 512 + tid; i < (size_t)8 * 2 * M_; i += (size_t)gridDim.x * 512) stats[(size_t)2 * M_ + i] = 0ull;
    }
    make_tables(p);
    x_pass(p.in[0], hb, stats);
    grid.sync();
    convert_weights(p, 0, 0, CT6, (float*)lds);
    grid_bar(bar_ctr, 0u);
    colsum_in(p, 0); colsum_up(p, 0);
    grid_bar(bar_ctr, 1u);

#pragma unroll 1
    for (int l = 0; l < DEPTH; ++l) {
        { typedef __attribute__((address_space(1))) unsigned char gu8; uintptr_t w_ = (uintptr_t)p.ws; asm volatile("" : "+s"(w_)); ws = (unsigned char*)(gu8*)w_; }
        const float* csb = (const float*)(ws + WS_CSB) + (size_t)l * CSB_L;
        fix_t* st0 = (fix_t*)(ws + WS_ST) + (size_t)(2 * l) * 2 * M_; fix_t* st1 = st0 + 2 * M_; fix_t* st2 = st1 + 2 * M_;
        if (l > 0) { colsum_up(p, l); convert_weights(p, l, CT5, CT6, (float*)lds); }
        { pg8::Order S = pg8::make_order(hb, 2048, ws + W_IN, 2048, M_, NINP, 2048);
          EpiIn E{(bf16_t*)(ws + WS_CQ), (bf16_t*)(ws + WS_CKV), (bf16_t*)(ws + WS_XL), (bf16_t*)(ws + WS_GG), (bf16_t*)(ws + WS_KPE), (float*)(ws + WS_SSQ), cosT, sinT, st0, csb + CSB_IN, csb + CSB_IN + NINP};
          pg8::gemm_phase(ldsl, S, E); }
        grid_bar(bar_ctr, 2u + 8u * (unsigned)l + 0u);
        conv_phase(p, l);
        { pg8::Order S = pg8::make_order(ws + WS_CQ, 512, ws + W_UQ, 512, M_, 1536, 512);
          EpiQ E{(bf16_t*)(ws + WS_Q), (const float*)(ws + WS_SSQ), cosT, sinT};
          pg8::gemm_phase(ldsl, S, E); }
        { pg8::Order S = pg8::make_order(ws + WS_CKV, 512, ws + W_UKV, 512, M_, 2048, 512);
          EpiKV E{(bf16_t*)(ws + WS_KV), (const float*)(ws + WS_SSQ)};
          pg8::gemm_phase(ldsl, S, E); }
        grid_bar(bar_ctr, 2u + 8u * (unsigned)l + 1u);
        {
            const bf16_t* Q = (const bf16_t*)(ws + WS_Q); const bf16_t* KV = (const bf16_t*)(ws + WS_KV); const bf16_t* KPE = (const bf16_t*)(ws + WS_KPE); bf16_t* ycat = (bf16_t*)(ws + WS_YCAT);
            const int G = gridDim.x, bx = blockIdx.x;
            for (int L = bx; L < 1024; L += G) {
                int pair, qb;
                if (G == 256) { const int i = L >> 8, c = L & 255, xcd = c & 7, j = c >> 3; pair = i * 16 + xcd * 2 + (j >> 4); qb = j & 15; } else { pair = L >> 4; qb = L & 15; }
                const int b = pair >> 3, h = pair & 7; const size_t row0 = (size_t)b * SEQ + (size_t)qb * 256;
                __syncthreads();
                att::attn_unit(Q + row0 * 1536 + h * 128, Q + row0 * 1536 + 1024 + h * 64, KV + (size_t)b * SEQ * 2048 + h * 256, KPE + (size_t)b * SEQ * 64, ycat + row0 * 2048 + h * 128, SEQ, (char*)lds);
            }
            __syncthreads();
        }
        { pg8::Order S = pg8::make_order(ws + WS_XC, 1024, ws + W_G, 128, M_, 512, 128);
          S.nZ = 8; S.a_z = 128 * 2; S.b_z = (size_t)512 * 128 * 2;
          EpiGate E{(unsigned*)(ws + WS_AU), (const bf16_t*)(ws + WS_XC), p.in[12] + (size_t)l * 2048, p.in[14] + (size_t)l * 2048, (const float*)(ws + WS_SP) + (size_t)l * 2048};
          pg8::gemm_phase(ldsl, S, E); }
        grid_bar(bar_ctr, 2u + 8u * (unsigned)l + 2u);
        scan_local(p);
        if (l + 1 < DEPTH) { __syncthreads(); convert_weights(p, l + 1, 0, CT3, (float*)lds); }
        grid_bar(bar_ctr, 2u + 8u * (unsigned)l + 3u);
        if (l + 1 < DEPTH) colsum_in(p, l + 1);
        scan_apply(p);
        grid_bar(bar_ctr, 2u + 8u * (unsigned)l + 4u);
        { pg8::Order S = pg8::make_order(ws + WS_YCAT, 2048, ws + W_OUT, 2048, M_, 2048, 2048);
          EpiRes E{hb, st0, l == 0 ? p.in[2] : p.in[21] + (size_t)(l - 1) * 2048, l == 0 ? p.in[3] : p.in[22] + (size_t)(l - 1) * 2048, st1};
          pg8::gemm_phase(ldsl, S, E); }
        grid_bar(bar_ctr, 2u + 8u * (unsigned)l + 5u);
        if (l + 1 < DEPTH) { convert_weights(p, l + 1, CT3, CT4, (float*)lds); }
        { pg8::Order S = pg8::make_order(hb, 2048, ws + W_UP, 2048, M_, DFF, 2048);
          EpiUp E{(bf16_t*)(ws + WS_F), st1, csb + CSB_UP, csb + CSB_UP + DFF}; pg8::gemm_phase(ldsl, S, E); }
        grid_bar(bar_ctr, 2u + 8u * (unsigned)l + 6u);
        if (l + 1 < DEPTH) { convert_weights(p, l + 1, CT4, CT5, (float*)lds); }
        { pg8::Order S = pg8::make_order(ws + WS_F, 8192, ws + W_DN, 8192, M_, 2048, 8192);
          EpiRes E{hb, st1, p.in[17] + (size_t)l * 2048, p.in[18] + (size_t)l * 2048, st2};
          pg8::gemm_phase(ldsl, S, E); }
        grid_bar(bar_ctr, 2u + 8u * (unsigned)l + 7u);
    }
    ln_final(p.out, (const bf16_t*)(p.ws + WS_HB), (const fix_t*)(p.ws + WS_ST) + (size_t)(2 * DEPTH) * 2 * M_, p.in[21] + (size_t)(DEPTH - 1) * 2048, p.in[22] + (size_t)(DEPTH - 1) * 2048);
}

extern "C" void kernel_launch(void* const* d_in, const int* in_sizes, int n_in, void* d_out, int out_size, void* d_ws, size_t ws_size, hipStream_t stream) {
    constexpr int LDS_BYTES = pg8::STAGE_BYTES;
    static int grid_blocks = 0;
    if (grid_blocks == 0) {
        if (n_in != 23 || in_sizes[0] != M_ * DM || out_size != M_ * DM || ws_size < WS_END) {
            fprintf(stderr, "kernel_launch: shape mismatch (n_in %d, in0 %d, out %d, ws %zu, need %zu)\n", n_in, n_in > 0 ? in_sizes[0] : -1, out_size, ws_size, (size_t)WS_END); grid_blocks = -1; return; }
        int dev = 0, cus = 0, per_cu = 0;
        hipGetDevice(&dev); hipDeviceGetAttribute(&cus, hipDeviceAttributeMultiprocessorCount, dev);
        if (hipFuncSetAttribute((const void*)mega_fwd, hipFuncAttributeMaxDynamicSharedMemorySize, LDS_BYTES) != hipSuccess) { fprintf(stderr, "kernel_launch: hipFuncSetAttribute failed\n"); grid_blocks = -1; return; }
        if (hipOccupancyMaxActiveBlocksPerMultiprocessor(&per_cu, (const void*)mega_fwd, 512, LDS_BYTES) != hipSuccess || per_cu < 1) { fprintf(stderr, "kernel_launch: occupancy query says %d\n", per_cu); per_cu = 1; }
        (void)hipGetLastError();
        grid_blocks = cus * 1;
    }
    if (grid_blocks < 0) return;
    Params p{};
    for (int i = 0; i < 23; ++i) p.in[i] = (const float*)d_in[i];
    p.out = (float*)d_out; p.ws = (unsigned char*)d_ws;
    (void)hipMemsetAsync((char*)d_ws + WS_BAR, 0, 256, stream);
    void* args[] = {&p};
    hipError_t e = hipLaunchCooperativeKernel((const void*)mega_fwd, dim3(grid_blocks), dim3(512), args, LDS_BYTES, stream);
    if (e != hipSuccess) fprintf(stderr, "kernel_launch: cooperative launch failed: %s (grid %d)\n", hipGetErrorString(e), grid_blocks);
}
```

```cpp
#include <hip/hip_runtime.h>
#include <hip/hip_cooperative_groups.h>
#include <cstdio>
#include <cstdint>
namespace cg = cooperative_groups;

#define LAS __attribute__((address_space(3)))
typedef unsigned short bf16_t;
typedef short bf16x8 __attribute__((ext_vector_type(8)));
typedef short s16x4 __attribute__((ext_vector_type(4)));
typedef float f32x4 __attribute__((ext_vector_type(4)));
typedef float f32x2 __attribute__((ext_vector_type(2)));
typedef float f32x16 __attribute__((ext_vector_type(16)));
typedef unsigned u32x4 __attribute__((ext_vector_type(4)));
typedef unsigned u32x2 __attribute__((ext_vector_type(2)));

constexpr int M_ = 32768, DM = 2048, SEQ = 4096, NBATCH = 8, DEPTH = 4;
constexpr int NIN = 3136, NINP = 3328, DFF = 8192;
constexpr float ALPHA = 1.6817928305074290f;
constexpr float LN_EPS = 1e-5f, RMS_EPS = 1e-6f;
constexpr size_t MiB = 1ull << 20;
constexpr size_t WS_HB = 0;
constexpr size_t WS_W = 128 * MiB;
constexpr size_t W_IN = WS_W, W_UQ = W_IN + (size_t)NINP * 2048 * 2, W_UKV = W_UQ + 1536ull * 512 * 2, W_G = W_UKV + 2048ull * 512 * 2,
                 W_OUT = W_G + 8ull * 512 * 128 * 2, W_UP = W_OUT + 2048ull * 2048 * 2, W_DN = W_UP + 8192ull * 2048 * 2, W_END = W_DN + 8192ull * 2048 * 2;
static_assert(W_END <= 218 * MiB, "weights region");
constexpr size_t WS_COS = 218 * MiB, WS_SIN = 222 * MiB, WS_SP = 226 * MiB;
constexpr size_t WS_CSB = 226 * MiB + 65536;
constexpr int CSB_L = 2 * 3328 + 2 * 8192, CSB_IN = 0, CSB_UP = 2 * 3328;
constexpr size_t WS_BAR = 226 * MiB + 49152;
constexpr size_t WS_ST = 227 * MiB;
constexpr size_t WS_BIG = 232 * MiB;
constexpr size_t WS_F = WS_BIG;
constexpr size_t WS_GG = WS_BIG, WS_XC = WS_BIG + 64 * MiB, WS_YCAT = WS_BIG + 128 * MiB, WS_SSQ = WS_BIG + 256 * MiB, WS_KPE = WS_BIG + 258 * MiB,
                 WS_CQ = WS_BIG + 262 * MiB, WS_CKV = WS_BIG + 294 * MiB, WS_XL = WS_BIG + 326 * MiB, WS_AU = WS_BIG + 262 * MiB  ,
                 WS_Q = WS_BIG + 518 * MiB, WS_KV = WS_BIG + 614 * MiB, WS_PH = WS_BIG + 742 * MiB, WS_END = WS_BIG + 750 * MiB;
static_assert(WS_END <= 1024 * MiB, "workspace");

struct Params { const float* in[23]; float* out; unsigned char* ws; };

__device__ __forceinline__ int otid() { int t = threadIdx.x; asm volatile("" : "+v"(t)); return t; }
__device__ __forceinline__ unsigned cvt_pk_bf16(float lo, float hi) { unsigned r; asm volatile("v_cvt_pk_bf16_f32 %0, %1, %2" : "=v"(r) : "v"(lo), "v"(hi)); return r; }
__device__ __forceinline__ float sum_fq(float x) {
    auto a = __builtin_amdgcn_permlane16_swap(__float_as_uint(x), __float_as_uint(x), false, false); x = __uint_as_float(a[0]) + __uint_as_float(a[1]);
    auto b = __builtin_amdgcn_permlane32_swap(__float_as_uint(x), __float_as_uint(x), false, false); return __uint_as_float(b[0]) + __uint_as_float(b[1]); }
__device__ __forceinline__ float wave_sum(float x, int lane) {
#pragma unroll
    for (int o = 32; o >= 1; o >>= 1) x += __int_as_float(__builtin_amdgcn_ds_bpermute((lane ^ o) << 2, __float_as_int(x)));
    return x; }
__device__ __forceinline__ float bf_lo(unsigned w) { return __uint_as_float(w << 16); }
__device__ __forceinline__ float bf_hi(unsigned w) { return __uint_as_float(w & 0xffff0000u); }
__device__ __forceinline__ float sigmoidf_(float x) { return __builtin_amdgcn_rcpf(1.0f + __builtin_amdgcn_exp2f(-1.4426950408889634f * x)); }
__device__ __forceinline__ float gelu_tanh(float x) { const float z = 0.7978845608028654f * (x + 0.044715f * x * x * x); return x * sigmoidf_(2.0f * z); }
__device__ __forceinline__ u32x4 pack8(const f32x4 a, const f32x4 b) { u32x4 w; w.x = cvt_pk_bf16(a[0], a[1]); w.y = cvt_pk_bf16(a[2], a[3]); w.z = cvt_pk_bf16(b[0], b[1]); w.w = cvt_pk_bf16(b[2], b[3]); return w; }

namespace pg8 {
constexpr int BM = 256, BK = 64, HALF = 128, HTB = HALF * BK * 2, STAGE_BYTES = 8 * HTB, NXCD = 8, WGM = 8;
__host__ __device__ __forceinline__ int lds_byte(int r, int c) { const int st = (r >> 4) * 2 + (c >> 5), rr = r & 15, cc = c & 31, ob = rr * 64 + cc * 2; return st * 1024 + (ob ^ (((ob >> 9) & 1) << 5)); }
__host__ __device__ __forceinline__ void stage_rc(int b, int& R, int& C) { const int st = b / 1024, sb = b % 1024, swz = sb ^ (((sb >> 9) & 1) << 5); R = (st >> 1) * 16 + swz / 64; C = (st & 1) * 32 + (swz % 64) / 2; }
__host__ __device__ __forceinline__ int perm32(int rho) { const int n = rho >> 4, i = rho & 15; return 8 * (i >> 2) + 4 * n + (i & 3); }

struct Unit { int pm, pn, z; };
struct Order {
    int nM, nN, nZ, per, G, c, wgm;
    const char* A; const char* B; size_t a_pm, a_z, b_pn, b_z; int lda, ldb, K;
    __device__ __forceinline__ bool next(int i, Unit& u) const {
        const long L = (long)i * G + c; if (L >= (long)per * nZ) return false;
        u.z = (int)(L / per); int wgid = (int)(L % per);
        { const int q = per / NXCD, r = per % NXCD, xcd = wgid % NXCD, off = wgid / NXCD; wgid = (xcd < r ? xcd * (q + 1) : r * (q + 1) + (xcd - r) * q) + off; }
        const int nig = wgm * nN, gid = wgid / nig, fm = gid * wgm, gsz = (nM - fm) < wgm ? (nM - fm) : wgm;
        u.pm = fm + ((wgid % nig) % gsz); u.pn = (wgid % nig) / gsz; return true;
    }
    __device__ __forceinline__ const char* aptr(const Unit& u) const { return A + (size_t)u.pm * a_pm + (size_t)u.z * a_z; }
    __device__ __forceinline__ const char* bptr(const Unit& u) const { return B + (size_t)u.pn * b_pn + (size_t)u.z * b_z; }
};
__device__ __forceinline__ Order make_order(const void* A, int lda, const void* Bt, int ldb, int Mrows, int N, int K) {
    Order o; o.nM = Mrows / BM; o.nN = N / BM; o.nZ = 1; o.per = o.nM * o.nN; o.G = gridDim.x; o.c = blockIdx.x; o.wgm = WGM;
    o.A = (const char*)A; o.B = (const char*)Bt; o.a_pm = (size_t)BM * lda * 2; o.a_z = 0; o.b_pn = (size_t)BM * ldb * 2; o.b_z = 0; o.lda = lda; o.ldb = ldb; o.K = K; return o;
}

template <class Epi>
__device__ __forceinline__ void gemm_phase(LAS unsigned char* lds, const Order& S, const Epi& E) {
    const int tid = otid(), wid = __builtin_amdgcn_readfirstlane(tid >> 6), lane = tid & 63, wr = wid >> 2, wc = wid & 3, fr = lane & 15, fq = lane >> 4;
    const int nt = S.K / BK;
    unsigned voffA[2], voffB[2];
#pragma unroll
    for (int i = 0; i < 2; ++i) { int R, C; stage_rc(tid * 16 + i * 8192, R, C); const int Rb = Epi::PERM ? ((R & ~31) + perm32(R & 31)) : R;
        voffA[i] = (unsigned)(R * S.lda + C) * 2u; voffB[i] = (unsigned)(Rb * S.ldb + C) * 2u; }
    const size_t kstep = (size_t)(BK * 2);
    const size_t hstepA = (size_t)HALF * S.lda * 2, hstepB = (size_t)HALF * S.ldb * 2;
    const unsigned ldsw = (unsigned)wid * 1024u;
    const int aoff = lds_byte(wr * 64 + fr, fq * 8), boff = lds_byte(wc * 32 + fr, fq * 8);
#define PG8_SA(b, h) (((b) * 2 + (h)) * HTB)
#define PG8_SB(b, h) ((4 + (b) * 2 + (h)) * HTB)
#define PG8_STAGE(bufoff, gbase, voff) do { _Pragma("unroll") for (int _i = 0; _i < 2; ++_i) \
        __builtin_amdgcn_global_load_lds((const unsigned*)((const char*)(gbase) + (voff)[_i]), (LAS unsigned*)(lds + (bufoff) + ldsw + _i * 8192), 16, 0, 0); } while (0)
#define PG8_LDA(dst, b, h) do { _Pragma("unroll") for (int m = 0; m < 4; ++m) _Pragma("unroll") for (int k = 0; k < 2; ++k) dst[m][k] = *(const LAS bf16x8*)(lds + PG8_SA(b, h) + aoff + m * 2048 + k * 1024); } while (0)
#define PG8_LDB(dst, b, h) do { _Pragma("unroll") for (int n = 0; n < 2; ++n) _Pragma("unroll") for (int k = 0; k < 2; ++k) dst[n][k] = *(const LAS bf16x8*)(lds + PG8_SB(b, h) + boff + n * 2048 + k * 1024); } while (0)
#define PG8_MMA(ai, bj, At, Bt) do { __builtin_amdgcn_s_setprio(1); _Pragma("unroll") for (int m = 0; m < 4; ++m) _Pragma("unroll") for (int n = 0; n < 2; ++n) _Pragma("unroll") for (int k = 0; k < 2; ++k) \
        acc[ai][bj][m][n] = __builtin_amdgcn_mfma_f32_16x16x32_bf16(Bt[n][k], At[m][k], acc[ai][bj][m][n], 0, 0, 0); __builtin_amdgcn_s_setprio(0); } while (0)
#define PG8_WAIT_V(n) asm volatile("s_waitcnt vmcnt(" #n ")" ::: "memory")
#define PG8_WAIT_L(n) asm volatile("s_waitcnt lgkmcnt(" #n ")" ::: "memory")
#define PG8_BAR __builtin_amdgcn_s_barrier()
#define PG8_SCHED __builtin_amdgcn_sched_barrier(0)
    Unit cur, nxt; int ui = 0;
    if (!S.next(0, cur)) return;
    f32x4 acc[2][2][4][2];
#pragma unroll
    for (int a = 0; a < 2; ++a)
#pragma unroll
        for (int b = 0; b < 2; ++b)
#pragma unroll
            for (int m = 0; m < 4; ++m)
#pragma unroll
                for (int n = 0; n < 2; ++n) acc[a][b][m][n] = (f32x4){0.f, 0.f, 0.f, 0.f};
    bf16x8 At[4][2], B0[2][2], B1[2][2];
    const char* cA = S.aptr(cur); const char* cB = S.bptr(cur);
    PG8_STAGE(PG8_SB(0, 0), cB, voffB); PG8_STAGE(PG8_SA(0, 0), cA, voffA); PG8_STAGE(PG8_SB(0, 1), cB + hstepB, voffB); PG8_STAGE(PG8_SA(0, 1), cA + hstepA, voffA);
    if (wr == 1) PG8_BAR;
    PG8_WAIT_V(4); PG8_BAR;
    PG8_STAGE(PG8_SB(1, 0), cB + kstep, voffB); PG8_STAGE(PG8_SA(1, 0), cA + kstep, voffA); PG8_STAGE(PG8_SB(1, 1), cB + hstepB + kstep, voffB);
    PG8_WAIT_V(6); PG8_BAR;
    for (;;) {
        const bool has_next = S.next(ui + 1, nxt);
        const char* nA = has_next ? S.aptr(nxt) : cA; const char* nB = has_next ? S.bptr(nxt) : cB;
        for (int t = 0; t < nt; t += 2) {
            const bool last = (t == nt - 2);
            const char* a1 = cA + (size_t)(t + 1) * kstep;
            const char* a2 = last ? nA : cA + (size_t)(t + 2) * kstep; const char* b2 = last ? nB : cB + (size_t)(t + 2) * kstep;
            const char* a3 = a2 + kstep; const char* b3 = b2 + kstep;
            PG8_LDB(B0, 0, 0); PG8_SCHED; PG8_LDA(At, 0, 0); PG8_STAGE(PG8_SA(1, 1), a1 + hstepA, voffA);
            PG8_WAIT_L(8); PG8_BAR; PG8_WAIT_L(0); PG8_MMA(0, 0, At, B0); PG8_BAR; PG8_SCHED;
            PG8_LDB(B1, 0, 1); PG8_STAGE(PG8_SB(0, 0), b2, voffB);
            PG8_BAR; PG8_WAIT_L(0); PG8_MMA(0, 1, At, B1); PG8_BAR;
            PG8_LDA(At, 0, 1); PG8_STAGE(PG8_SA(0, 0), a2, voffA);
            PG8_BAR; PG8_WAIT_L(0); PG8_MMA(1, 0, At, B0); PG8_BAR; PG8_SCHED;
            PG8_STAGE(PG8_SB(0, 1), b2 + hstepB, voffB);
            PG8_WAIT_V(6); PG8_BAR; PG8_MMA(1, 1, At, B1); PG8_BAR;
            PG8_LDB(B0, 1, 0); PG8_SCHED; PG8_LDA(At, 1, 0); PG8_STAGE(PG8_SA(0, 1), a2 + hstepA, voffA);
            PG8_WAIT_L(8); PG8_BAR; PG8_WAIT_L(0); PG8_MMA(0, 0, At, B0); PG8_BAR; PG8_SCHED;
            PG8_LDB(B1, 1, 1); PG8_STAGE(PG8_SB(1, 0), b3, voffB);
            PG8_BAR; PG8_WAIT_L(0); PG8_MMA(0, 1, At, B1); PG8_BAR;
            PG8_LDA(At, 1, 1); PG8_STAGE(PG8_SA(1, 0), a3, voffA);
            PG8_BAR; PG8_WAIT_L(0); PG8_MMA(1, 0, At, B0); PG8_BAR; PG8_SCHED;
            PG8_STAGE(PG8_SB(1, 1), b3 + hstepB, voffB);
            PG8_WAIT_V(6); PG8_BAR; PG8_MMA(1, 1, At, B1); PG8_BAR;
        }
        E(acc, cur, wr, wc, fr, fq);
        if (!has_next) break;
#pragma unroll
        for (int a = 0; a < 2; ++a)
#pragma unroll
            for (int b = 0; b < 2; ++b)
#pragma unroll
                for (int m = 0; m < 4; ++m)
#pragma unroll
                    for (int n = 0; n < 2; ++n) acc[a][b][m][n] = (f32x4){0.f, 0.f, 0.f, 0.f};
        cur = nxt; cA = nA; cB = nB; ++ui;
    }
    PG8_WAIT_V(0);
    if (wr == 0) PG8_BAR;
    PG8_BAR;
#undef PG8_SA
#undef PG8_SB
#undef PG8_STAGE
#undef PG8_LDA
#undef PG8_LDB
#undef PG8_MMA
#undef PG8_WAIT_V
#undef PG8_WAIT_L
#undef PG8_BAR
#undef PG8_SCHED
}
}
using pg8::Unit;
typedef f32x4 Acc[2][2][4][2];

typedef unsigned long long fix_t;
__device__ __forceinline__ fix_t to_fix(float v) { return (fix_t)(long long)(v * 4294967296.0f); }
__device__ __forceinline__ float from_fix(fix_t v) { return fmaf((float)(unsigned)v, 2.3283064365386963e-10f, (float)(int)(v >> 32)); }
__device__ __forceinline__ void fix_add(fix_t* p, float v) { __hip_atomic_fetch_add(p, to_fix(v), __ATOMIC_RELAXED, __HIP_MEMORY_SCOPE_AGENT); }
__device__ __forceinline__ f32x4 ld_fix4(const fix_t* p) { typedef unsigned long long u64x2 __attribute__((ext_vector_type(2))); const u64x2 a = *(const u64x2*)p, b = *(const u64x2*)(p + 2);
    return (f32x4){from_fix(a.x), from_fix(a.y), from_fix(b.x), from_fix(b.y)}; }
__device__ __forceinline__ void row_ln(const fix_t* st, int row, float& mu, float& rs) { const float s1 = from_fix(st[row]), s2 = from_fix(st[M_ + row]); mu = s1 * (1.0f / 2048.0f); rs = __builtin_amdgcn_rsqf(s2 * (1.0f / 2048.0f) - mu * mu + LN_EPS); }
template <bool PERM>
__device__ __forceinline__ void ln_correct(f32x4 (&acc)[2][2][4][2], const fix_t* st, const float* cs, const float* bw, int row0, int colbase) {
    f32x4 c4[2][2], b4[2][2];
#pragma unroll
    for (int bj = 0; bj < 2; ++bj)
#pragma unroll
        for (int n = 0; n < 2; ++n) { const int col = colbase + bj * 128 + (PERM ? 4 * n : 16 * n); c4[bj][n] = *(const f32x4*)(cs + col); b4[bj][n] = *(const f32x4*)(bw + col); }
#pragma unroll
    for (int ai = 0; ai < 2; ++ai) { fix_t r1[4], r2[4];
#pragma unroll
        for (int m = 0; m < 4; ++m) { const int row = row0 + ai * 128 + m * 16; r1[m] = st[row]; r2[m] = st[M_ + row]; }
#pragma unroll
        for (int m = 0; m < 4; ++m) { const float mu = from_fix(r1[m]) * (1.0f / 2048.0f), rs = __builtin_amdgcn_rsqf(from_fix(r2[m]) * (1.0f / 2048.0f) - mu * mu + LN_EPS);
#pragma unroll
            for (int bj = 0; bj < 2; ++bj)
#pragma unroll
                for (int n = 0; n < 2; ++n) acc[ai][bj][m][n] = (acc[ai][bj][m][n] - c4[bj][n] * mu) * rs + b4[bj][n]; } }
}

struct EpiIn {
    static constexpr bool PERM = true;
    bf16_t *cq, *ckv, *xl, *gg, *kpe; float* ssq; const float *cosT, *sinT; const fix_t* st; const float *cs, *bw;
    __device__ __forceinline__ void operator()(Acc& acc, const Unit& u, int wr, int wc, int fr, int fq) const {
        const int row0 = u.pm * 256 + wr * 64 + fr, pn = u.pn;
        ln_correct<true>(acc, st, cs, bw, row0, pn * 256 + wc * 32 + 8 * fq);
        if (pn < 4) {
            bf16_t* base = (pn < 2 ? cq : ckv); const int col0 = (pn & 1) * 256 + wc * 32 + 8 * fq;
#pragma unroll
            for (int ai = 0; ai < 2; ++ai)
#pragma unroll
                for (int m = 0; m < 4; ++m) { const int row = row0 + ai * 128 + m * 16; float s = 0.f;
#pragma unroll
                    for (int bj = 0; bj < 2; ++bj) { const f32x4 v0 = acc[ai][bj][m][0], v1 = acc[ai][bj][m][1];
                        s += (v0[0] * v0[0] + v0[1] * v0[1]) + (v0[2] * v0[2] + v0[3] * v0[3]) + (v1[0] * v1[0] + v1[1] * v1[1]) + (v1[2] * v1[2] + v1[3] * v1[3]);
                        *(u32x4*)(base + (size_t)row * 512 + col0 + bj * 128) = pack8(v0, v1); }
                    s = sum_fq(s);
                    if (fq == 0) ssq[(size_t)row * 16 + pn * 4 + wc] = s; }
        } else if (pn < 8) {
            const int col0 = (pn - 4) * 256 + wc * 32 + 8 * fq;
#pragma unroll
            for (int ai = 0; ai < 2; ++ai)
#pragma unroll
                for (int m = 0; m < 4; ++m) { const int row = row0 + ai * 128 + m * 16;
#pragma unroll
                    for (int bj = 0; bj < 2; ++bj) *(u32x4*)(xl + (size_t)row * 1024 + col0 + bj * 128) = pack8(acc[ai][bj][m][0], acc[ai][bj][m][1]); }
        } else if (pn < 12) {
            const int col0 = (pn - 8) * 256 + wc * 32 + 8 * fq;
#pragma unroll
            for (int ai = 0; ai < 2; ++ai)
#pragma unroll
                for (int m = 0; m < 4; ++m) { const int row = row0 + ai * 128 + m * 16;
#pragma unroll
                    for (int bj = 0; bj < 2; ++bj) { f32x4 v0 = acc[ai][bj][m][0], v1 = acc[ai][bj][m][1];
#pragma unroll
                        for (int j = 0; j < 4; ++j) { v0[j] = gelu_tanh(v0[j]); v1[j] = gelu_tanh(v1[j]); }
                        *(u32x4*)(gg + (size_t)row * 1024 + col0 + bj * 128) = pack8(v0, v1); } }
        } else if (wc == 0) {
#pragma unroll
            for (int ai = 0; ai < 2; ++ai) { f32x4 c0[4], c1[4], s0[4], s1[4];
#pragma unroll
                for (int m = 0; m < 4; ++m) { const size_t t = (size_t)(row0 + ai * 128 + m * 16) * 32 + 8 * fq;
                    c0[m] = *(const f32x4*)(cosT + t); c1[m] = *(const f32x4*)(cosT + t + 4); s0[m] = *(const f32x4*)(sinT + t); s1[m] = *(const f32x4*)(sinT + t + 4); }
#pragma unroll
                for (int m = 0; m < 4; ++m) { const int row = row0 + ai * 128 + m * 16;
                    const f32x4 a0 = acc[ai][0][m][0], a1 = acc[ai][0][m][1], b0 = acc[ai][1][m][0], b1 = acc[ai][1][m][1];
                    *(u32x4*)(kpe + (size_t)row * 64 + 8 * fq) = pack8(a0 * c0[m] - b0 * s0[m], a1 * c1[m] - b1 * s1[m]);
                    *(u32x4*)(kpe + (size_t)row * 64 + 32 + 8 * fq) = pack8(b0 * c0[m] + a0 * s0[m], b1 * c1[m] + a1 * s1[m]); } }
        }
    }
};
__device__ __forceinline__ void rows_rstd(const float* ssq8, int row0, float (&rs)[8]) {
#pragma unroll
    for (int h = 0; h < 2; ++h) { f32x4 a[4], b[4];
#pragma unroll
        for (int k = 0; k < 4; ++k) { const float* p = ssq8 + (size_t)(row0 + h * 128 + k * 16) * 16; a[k] = *(const f32x4*)p; b[k] = *(const f32x4*)(p + 4); }
#pragma unroll
        for (int k = 0; k < 4; ++k) { const float s = ((a[k][0] + a[k][1]) + (a[k][2] + a[k][3])) + ((b[k][0] + b[k][1]) + (b[k][2] + b[k][3])); rs[h * 4 + k] = __builtin_amdgcn_rsqf(s * (1.0f / 512.0f) + RMS_EPS); } }
}
struct EpiQ {
    static constexpr bool PERM = true;
    bf16_t* q; const float* ssq; const float *cosT, *sinT;
    __device__ __forceinline__ void operator()(Acc& acc, const Unit& u, int wr, int wc, int fr, int fq) const {
        const int row0 = u.pm * 256 + wr * 64 + fr, pn = u.pn;
        float rs[8]; rows_rstd(ssq, row0, rs);
        if (pn < 4) {
            const int col0 = pn * 256 + wc * 32 + 8 * fq;
#pragma unroll
            for (int ai = 0; ai < 2; ++ai)
#pragma unroll
                for (int m = 0; m < 4; ++m) { const int row = row0 + ai * 128 + m * 16; const float r = rs[ai * 4 + m];
#pragma unroll
                    for (int bj = 0; bj < 2; ++bj) *(u32x4*)(q + (size_t)row * 1536 + col0 + bj * 128) = pack8(acc[ai][bj][m][0] * r, acc[ai][bj][m][1] * r); }
        } else {
            const int head = 4 * (pn - 4) + wc;
#pragma unroll
            for (int kb = 0; kb < 4; ++kb) { f32x4 c0[2], c1[2], s0[2], s1[2];
#pragma unroll
                for (int j = 0; j < 2; ++j) { const int k = kb * 2 + j; const size_t t = (size_t)(row0 + (k >> 2) * 128 + (k & 3) * 16) * 32 + 8 * fq;
                    c0[j] = *(const f32x4*)(cosT + t); c1[j] = *(const f32x4*)(cosT + t + 4); s0[j] = *(const f32x4*)(sinT + t); s1[j] = *(const f32x4*)(sinT + t + 4); }
#pragma unroll
                for (int j = 0; j < 2; ++j) { const int k = kb * 2 + j, ai = k >> 2, m = k & 3; const int row = row0 + ai * 128 + m * 16; const float r = rs[k];
                    const f32x4 a0 = acc[ai][0][m][0] * r, a1 = acc[ai][0][m][1] * r, b0 = acc[ai][1][m][0] * r, b1 = acc[ai][1][m][1] * r;
                    *(u32x4*)(q + (size_t)row * 1536 + 1024 + head * 64 + 8 * fq) = pack8(a0 * c0[j] - b0 * s0[j], a1 * c1[j] - b1 * s1[j]);
                    *(u32x4*)(q + (size_t)row * 1536 + 1024 + head * 64 + 32 + 8 * fq) = pack8(b0 * c0[j] + a0 * s0[j], b1 * c1[j] + a1 * s1[j]); } }
        }
    }
};
struct EpiKV {
    static constexpr bool PERM = true;
    bf16_t* kv; const float* ssq;
    __device__ __forceinline__ void operator()(Acc& acc, const Unit& u, int wr, int wc, int fr, int fq) const {
        const int row0 = u.pm * 256 + wr * 64 + fr, col0 = u.pn * 256 + wc * 32 + 8 * fq;
        float rs[8]; rows_rstd(ssq + 8, row0, rs);
#pragma unroll
        for (int ai = 0; ai < 2; ++ai)
#pragma unroll
            for (int m = 0; m < 4; ++m) { const int row = row0 + ai * 128 + m * 16; const float r = rs[ai * 4 + m];
#pragma unroll
                for (int bj = 0; bj < 2; ++bj) *(u32x4*)(kv + (size_t)row * 2048 + col0 + bj * 128) = pack8(acc[ai][bj][m][0] * r, acc[ai][bj][m][1] * r); }
    }
};
struct EpiGate {
    static constexpr bool PERM = true;
    unsigned* au; const bf16_t* xc; const float *ba, *bi, *sp;
    __device__ __forceinline__ void operator()(Acc& acc, const Unit& u, int wr, int wc, int fr, int fq) const {
        const int row0 = u.pm * 256 + wr * 64 + fr, d = u.pn, ch0 = u.z * 128 + wc * 32 + 8 * fq;
        unsigned* aud = au + (size_t)d * M_ * 1024;
#pragma unroll
        for (int n = 0; n < 2; ++n) {
            const int ch = ch0 + 4 * n;
            const f32x4 bav = *(const f32x4*)(ba + d * 1024 + ch), biv = *(const f32x4*)(bi + d * 1024 + ch), spv = *(const f32x4*)(sp + d * 1024 + ch) * (-8.0f * 1.4426950408889634f);
            u32x2 xws[8];
#pragma unroll
            for (int k = 0; k < 8; ++k) xws[k] = *(const u32x2*)(xc + (size_t)(row0 + (k >> 2) * 128 + (k & 3) * 16) * 1024 + ch);
#pragma unroll
            for (int ai = 0; ai < 2; ++ai)
#pragma unroll
                for (int m = 0; m < 4; ++m) { const int row = row0 + ai * 128 + m * 16;
                    const u32x2 xw = xws[ai * 4 + m];
                    const float xv[4] = {bf_lo(xw.x), bf_hi(xw.x), bf_lo(xw.y), bf_hi(xw.y)};
                    u32x4 o;
#pragma unroll
                    for (int j = 0; j < 4; ++j) {
                        const float r = sigmoidf_(acc[ai][0][m][n][j] + bav[j]);
                        const float ig = sigmoidf_(acc[ai][1][m][n][j] + biv[j]);
                        const float a = __builtin_amdgcn_exp2f(r * spv[j]);
                        const float oma = 1.0f - a;
                        const float uu = __builtin_amdgcn_sqrtf(oma * (1.0f + a)) * ig * xv[j];
                        o[j] = cvt_pk_bf16(oma, uu); }
                    *(u32x4*)(aud + (size_t)row * 1024 + ch) = o; }
        }
    }
};
#ifndef RES_PF
#define RES_PF 2
#endif
struct EpiRes {
    static constexpr bool PERM = false;
    bf16_t* hb; const fix_t* st_old; const float *g, *b; fix_t* st_new;
    __device__ __forceinline__ void operator()(Acc& acc, const Unit& u, int wr, int wc, int fr, int fq) const {
        const int row0 = u.pm * 256 + wr * 64 + fr, col0 = u.pn * 256 + wc * 32 + 4 * fq;
        f32x4 gv[4], bv[4]; u32x2 P[RES_PF + 1][4]; float mus[8], rss[8];
#define RES_LOAD(k) do { const size_t off_ = (size_t)(row0 + ((k) >> 2) * 128 + ((k) & 3) * 16) * 2048 + col0; _Pragma("unroll") for (int c = 0; c < 4; ++c) P[(k) % (RES_PF + 1)][c] = *(const u32x2*)(hb + off_ + (c >> 1) * 128 + (c & 1) * 16); } while (0)
#pragma unroll
        for (int k = 0; k < RES_PF; ++k) RES_LOAD(k);
#pragma unroll
        for (int c = 0; c < 4; ++c) { gv[c] = *(const f32x4*)(g + col0 + (c >> 1) * 128 + (c & 1) * 16); bv[c] = *(const f32x4*)(b + col0 + (c >> 1) * 128 + (c & 1) * 16); }
#pragma unroll
        for (int h = 0; h < 2; ++h) { fix_t r1[4], r2[4];
#pragma unroll
            for (int k = 0; k < 4; ++k) { const int row = row0 + h * 128 + k * 16; r1[k] = st_old[row]; r2[k] = st_old[M_ + row]; }
#pragma unroll
            for (int k = 0; k < 4; ++k) { mus[h * 4 + k] = from_fix(r1[k]) * (1.0f / 2048.0f); rss[h * 4 + k] = __builtin_amdgcn_rsqf(from_fix(r2[k]) * (1.0f / 2048.0f) - mus[h * 4 + k] * mus[h * 4 + k] + LN_EPS); } }
#pragma unroll
        for (int k = 0; k < 8; ++k) {
            if (k + RES_PF < 8) RES_LOAD(k + RES_PF);
            const int ai = k >> 2, m = k & 3; const size_t off = (size_t)(row0 + ai * 128 + m * 16) * 2048 + col0;
            const float mu = mus[k], rs = rss[k];
            float a1 = 0.f, a2 = 0.f;
#pragma unroll
            for (int c = 0; c < 4; ++c) { const int cc = (c >> 1) * 128 + (c & 1) * 16; const u32x2 pw = P[k % (RES_PF + 1)][c];
                const f32x4 Pf = {bf_lo(pw.x), bf_hi(pw.x), bf_lo(pw.y), bf_hi(pw.y)};
                const f32x4 v = ((Pf - mu) * rs * gv[c] + bv[c]) * ALPHA + acc[ai][c >> 1][m][c & 1];
                u32x2 w; w.x = cvt_pk_bf16(v[0], v[1]); w.y = cvt_pk_bf16(v[2], v[3]); *(u32x2*)(hb + off + cc) = w;
                a1 += (v[0] + v[1]) + (v[2] + v[3]); a2 += (v[0] * v[0] + v[1] * v[1]) + (v[2] * v[2] + v[3] * v[3]); }
            a1 = sum_fq(a1); a2 = sum_fq(a2);
            { const int row = row0 + ai * 128 + m * 16; if (fq == 0) fix_add(st_new + row, a1); else if (fq == 1) fix_add(st_new + M_ + row, a2); }
        }
#undef RES_LOAD
    }
};
struct EpiUp {
    static constexpr bool PERM = true;
    bf16_t* f; const fix_t* st; const float *cs, *bw;
    __device__ __forceinline__ void operator()(Acc& acc, const Unit& u, int wr, int wc, int fr, int fq) const {
        const int row0 = u.pm * 256 + wr * 64 + fr, col0 = u.pn * 256 + wc * 32 + 8 * fq;
        ln_correct<true>(acc, st, cs, bw, row0, col0);
#pragma unroll
        for (int ai = 0; ai < 2; ++ai)
#pragma unroll
            for (int m = 0; m < 4; ++m) { const int row = row0 + ai * 128 + m * 16;
#pragma unroll
                for (int bj = 0; bj < 2; ++bj) { f32x4 v0 = acc[ai][bj][m][0], v1 = acc[ai][bj][m][1];
#pragma unroll
                    for (int j = 0; j < 4; ++j) { const float a = fmaxf(v0[j], 0.f), b = fmaxf(v1[j], 0.f); v0[j] = a * a; v1[j] = b * b; }
                    __builtin_nontemporal_store(pack8(v0, v1), (u32x4*)(f + (size_t)row * 8192 + col0 + bj * 128)); } }
    }
};

namespace att {
constexpr int NW = 8, QBLK = 32, KVBLK = 64;
constexpr float SCALE = 0.07216878364870323f;
constexpr float THR = 8.f;
#ifndef ATT_SDEPTH
#define ATT_SDEPTH 1
#endif
constexpr int SDEPTH = ATT_SDEPTH;
constexpr int SHM_V = KVBLK * 128 * 2, SHM_K = KVBLK * 128 * 2, SHM_R = KVBLK * 64 * 2;
constexpr int OFF_V = 0, OFF_K = 2 * SHM_V, OFF_R = OFF_K + 2 * SHM_K, OFF_WS = OFF_R + 2 * SHM_R, OFF_QR = OFF_WS + NW * 64 * 4, SHM_ATTN = OFF_QR + 256 * 128;
#define KSWZ(row, colB) ((row) * 256 + ((colB) ^ (((row) & 7) << 4)))
#define RSWZ(row, colB) ((row) * 128 + ((colB) ^ (((row) & 7) << 4)))
#define SBAR() __builtin_amdgcn_sched_barrier(0)
__device__ __forceinline__ int crow(int r, int hi) { return (r & 3) + 8 * (r >> 2) + 4 * hi; }
__device__ __forceinline__ void partialSM(f32x16& p0, f32x16& p1, float& m_reg, float& mn, float& alpha) {
    constexpr float C = SCALE * 1.4426950408889634f;
    float pmax = p0[0];
#pragma unroll
    for (int r = 1; r < 16; ++r) pmax = fmaxf(pmax, p0[r]);
#pragma unroll
    for (int r = 0; r < 16; ++r) pmax = fmaxf(pmax, p1[r]);
    { auto rr = __builtin_amdgcn_permlane32_swap(__float_as_uint(pmax), __float_as_uint(pmax), false, false);
      pmax = fmaxf(__uint_as_float(rr[0]), __uint_as_float(rr[1])); }
    if (__builtin_expect(__all(pmax - m_reg <= THR / SCALE), 1)) { mn = m_reg; alpha = 1.f; }
    else { mn = fmaxf(m_reg, pmax); alpha = __builtin_amdgcn_exp2f((m_reg - mn) * C); m_reg = mn; }
    const float mnC = -mn * C;
#pragma unroll
    for (int r = 0; r < 16; ++r) p0[r] = fmaf(p0[r], C, mnC);
#pragma unroll
    for (int r = 0; r < 16; ++r) p1[r] = fmaf(p1[r], C, mnC);
#pragma unroll
    for (int r = 0; r < 16; ++r) p0[r] = __builtin_amdgcn_exp2f(p0[r]);
}
__device__ __forceinline__ void finishSM(f32x16& p0, f32x16& p1, float alpha, float& l_reg, bf16x8& pa0, bf16x8& pa1, bf16x8& pa2, bf16x8& pa3) {
#pragma unroll
    for (int r = 0; r < 16; ++r) p1[r] = __builtin_amdgcn_exp2f(p1[r]);
    float ps = 0;
#pragma unroll
    for (int r = 0; r < 16; ++r) ps += p0[r];
#pragma unroll
    for (int r = 0; r < 16; ++r) ps += p1[r];
    { auto rr = __builtin_amdgcn_permlane32_swap(__float_as_uint(ps), __float_as_uint(ps), false, false);
      ps = __uint_as_float(rr[0]) + __uint_as_float(rr[1]); }
    l_reg = l_reg * alpha + ps;
#define PK4(P, BASE, OUT) do { unsigned a0 = cvt_pk_bf16(P[BASE + 0], P[BASE + 1]), a1 = cvt_pk_bf16(P[BASE + 2], P[BASE + 3]);   \
    unsigned b0 = cvt_pk_bf16(P[BASE + 4], P[BASE + 5]), b1 = cvt_pk_bf16(P[BASE + 6], P[BASE + 7]);                              \
    auto r0 = __builtin_amdgcn_permlane32_swap(a0, b0, false, false); auto r1 = __builtin_amdgcn_permlane32_swap(a1, b1, false, false); \
    u32x4 w = {r0[0], r1[0], r0[1], r1[1]}; OUT = *reinterpret_cast<bf16x8*>(&w); } while (0)
    PK4(p0, 0, pa0); PK4(p0, 8, pa1); PK4(p1, 0, pa2); PK4(p1, 8, pa3);
#undef PK4
}
__device__ __forceinline__ void qkt(f32x16& p0, f32x16& p1, const char* Ks, const char* Rs, const bf16x8* qr, const char* Qrl, int r32, int hi) {
    p0 = f32x16{}; p1 = f32x16{};
#pragma unroll
    for (int d0 = 0; d0 < 8; ++d0) { const int cb = (d0 * 16 + hi * 8) * 2;
        const bf16x8 b0 = *reinterpret_cast<const bf16x8*>(Ks + KSWZ(r32, cb));
        const bf16x8 b1 = *reinterpret_cast<const bf16x8*>(Ks + KSWZ(32 + r32, cb));
        p0 = __builtin_amdgcn_mfma_f32_32x32x16_bf16(b0, qr[d0], p0, 0, 0, 0);
        p1 = __builtin_amdgcn_mfma_f32_32x32x16_bf16(b1, qr[d0], p1, 0, 0, 0); }
#pragma unroll
    for (int d0 = 0; d0 < 4; ++d0) { const int cb = (d0 * 16 + hi * 8) * 2;
        const bf16x8 b0 = *reinterpret_cast<const bf16x8*>(Rs + RSWZ(r32, cb));
        const bf16x8 b1 = *reinterpret_cast<const bf16x8*>(Rs + RSWZ(32 + r32, cb));
        const bf16x8 qv = *reinterpret_cast<const bf16x8*>(Qrl + (cb ^ ((r32 & 7) << 4)));
        p0 = __builtin_amdgcn_mfma_f32_32x32x16_bf16(b0, qv, p0, 0, 0, 0);
        p1 = __builtin_amdgcn_mfma_f32_32x32x16_bf16(b1, qv, p1, 0, 0, 0); }
}
__device__ __forceinline__ int v_st(int k, int c) { const int kk = (k & ~0xC) | ((k & 4) << 1) | ((k & 8) >> 1); return ((kk >> 3) * 4 + (c >> 5)) * 512 + ((kk & 7) * 32 + (c & 31)) * 2; }
__device__ __forceinline__ int v_rd_base(int lane) { return ((lane & 3) << 3) | (((lane >> 2) & 3) << 6) | (((lane >> 4) & 1) << 5) | (((lane >> 5) & 1) << 8); }
constexpr int v_rd_off(int d0, int ks, int half) { return d0 * 512 + ks * 4096 + half * 2048; }
template <int OFF> __device__ __forceinline__ s16x4 tr_read(int vb) {
    s16x4 r; asm volatile("ds_read_b64_tr_b16 %0, %1 offset:%2" : "=&v"(r) : "v"(vb), "i"(OFF) : "memory"); return r;
}
template <int D0> __device__ __forceinline__ void pv_one(f32x16& od, int vb, bf16x8 pa0, bf16x8 pa1, bf16x8 pa2, bf16x8 pa3) {
    const s16x4 l0 = tr_read<v_rd_off(D0, 0, 0)>(vb), h0 = tr_read<v_rd_off(D0, 0, 1)>(vb), l1 = tr_read<v_rd_off(D0, 1, 0)>(vb), h1 = tr_read<v_rd_off(D0, 1, 1)>(vb);
    const s16x4 l2 = tr_read<v_rd_off(D0, 2, 0)>(vb), h2 = tr_read<v_rd_off(D0, 2, 1)>(vb), l3 = tr_read<v_rd_off(D0, 3, 0)>(vb), h3 = tr_read<v_rd_off(D0, 3, 1)>(vb);
    asm volatile("s_waitcnt lgkmcnt(0)" ::: "memory"); SBAR();
#define PK(L, H) (bf16x8){L[0], L[1], L[2], L[3], H[0], H[1], H[2], H[3]}
    od = __builtin_amdgcn_mfma_f32_32x32x16_bf16(pa0, PK(l0, h0), od, 0, 0, 0);
    od = __builtin_amdgcn_mfma_f32_32x32x16_bf16(pa1, PK(l1, h1), od, 0, 0, 0);
    od = __builtin_amdgcn_mfma_f32_32x32x16_bf16(pa2, PK(l2, h2), od, 0, 0, 0);
    od = __builtin_amdgcn_mfma_f32_32x32x16_bf16(pa3, PK(l3, h3), od, 0, 0, 0);
#undef PK
}
__device__ __forceinline__ void pv_d0(f32x16* o, int vb, bf16x8 pa0, bf16x8 pa1, bf16x8 pa2, bf16x8 pa3) {
    pv_one<0>(o[0], vb, pa0, pa1, pa2, pa3); pv_one<1>(o[1], vb, pa0, pa1, pa2, pa3); pv_one<2>(o[2], vb, pa0, pa1, pa2, pa3); pv_one<3>(o[3], vb, pa0, pa1, pa2, pa3);
}
__device__ __forceinline__ void attn_unit(const bf16_t* __restrict__ Qn, const bf16_t* __restrict__ Qr, const bf16_t* __restrict__ Kh, const bf16_t* __restrict__ Rh,
                                          bf16_t* __restrict__ Ob, int seq, char* lds) {
    const int tid = otid(), wid = tid >> 6, lane = tid & 63, r32 = lane & 31, hi = lane >> 5;
    char* V_lds = lds + OFF_V; char* K_lds = lds + OFF_K; char* R_lds = lds + OFF_R;
    float* ws = (float*)(lds + OFF_WS) + wid * 64; float* li_l = ws; float* al_l = ws + 32;
    float m_reg = -1e30f, l_reg = 0; f32x16 o[4] = {}; bf16x8 qr[8];
    char* Qrl = lds + OFF_QR + (wid * QBLK + r32) * 128;
    {
        const bf16_t* Qw = Qn + (size_t)(wid * QBLK + r32) * 1536 + hi * 8;
#pragma unroll
        for (int d0 = 0; d0 < 8; ++d0) qr[d0] = *reinterpret_cast<const bf16x8*>(Qw + d0 * 16);
        const bf16_t* Qw2 = Qr + (size_t)(wid * QBLK + r32) * 1536 + hi * 8;
#pragma unroll
        for (int d0 = 0; d0 < 4; ++d0) { const bf16x8 t = *reinterpret_cast<const bf16x8*>(Qw2 + d0 * 16); *reinterpret_cast<bf16x8*>(Qrl + (((d0 * 16 + hi * 8) * 2) ^ ((r32 & 7) << 4))) = t; }
    }
    const int sr = tid >> 4, sc = (tid & 15) * 8, vst0 = v_st(sr, sc), vst1 = v_st(32 + sr, sc);
    const int rr_ = tid >> 3, rc = (tid & 7) * 8;
    const int vb0 = (int)(uintptr_t)V_lds + v_rd_base(lane);
    struct { bf16x8 vs0, vs1, ks0, ks1, rs; } sr_[SDEPTH];
#define SLOAD(i, k0) do { sr_[i].vs0 = *(const bf16x8*)(&Kh[(size_t)((k0) + sr) * 2048 + 128 + sc]); sr_[i].vs1 = *(const bf16x8*)(&Kh[(size_t)((k0) + 32 + sr) * 2048 + 128 + sc]); \
    sr_[i].ks0 = *(const bf16x8*)(&Kh[(size_t)((k0) + sr) * 2048 + sc]); sr_[i].ks1 = *(const bf16x8*)(&Kh[(size_t)((k0) + 32 + sr) * 2048 + sc]); \
    sr_[i].rs = *(const bf16x8*)(&Rh[(size_t)((k0) + rr_) * 64 + rc]); } while (0)
#define SWRITE(b, i) do { *(bf16x8*)(V_lds + (b) * SHM_V + vst0) = sr_[i].vs0;          \
    *(bf16x8*)(V_lds + (b) * SHM_V + vst1) = sr_[i].vs1; const int kc = sc * 2;               \
    *(bf16x8*)(K_lds + (b) * SHM_K + KSWZ(sr, kc)) = sr_[i].ks0;                       \
    *(bf16x8*)(K_lds + (b) * SHM_K + KSWZ(32 + sr, kc)) = sr_[i].ks1;                  \
    *(bf16x8*)(R_lds + (b) * SHM_R + RSWZ(rr_, rc * 2)) = sr_[i].rs; } while (0)
#define SWAIT() do { if constexpr (SDEPTH == 2) asm volatile("s_waitcnt vmcnt(5)" ::: "memory"); else asm volatile("s_waitcnt vmcnt(0)" ::: "memory"); } while (0)
#define RESC(a) do { if (__any((a) < 1.f)) { if (hi == 0) al_l[r32] = (a); asm volatile("s_waitcnt lgkmcnt(0)" ::: "memory"); \
    _Pragma("unroll") for (int d = 0; d < 4; ++d) _Pragma("unroll") for (int r = 0; r < 16; ++r) o[d][r] *= al_l[crow(r, hi)]; } } while (0)
    f32x16 pA0, pA1, pB0, pB1; float mnA, mnB, alA, alB; bf16x8 pa0, pa1, pa2, pa3; const int NT = seq / KVBLK;
    constexpr int SE = 0, SO = SDEPTH - 1;
    SLOAD(SE, 0); asm volatile("s_waitcnt vmcnt(0)" ::: "memory"); SWRITE(0, SE); __syncthreads();
    qkt(pA0, pA1, K_lds, R_lds, qr, Qrl, r32, hi); partialSM(pA0, pA1, m_reg, mnA, alA);
    SLOAD(SO, KVBLK); if constexpr (SDEPTH == 2) { if (2 < NT) SLOAD(SE, 2 * KVBLK); }
    SWAIT(); SWRITE(1, SO); __syncthreads();
    for (int j = 1; j + 1 < NT; j += 2) {
        SBAR(); qkt(pB0, pB1, K_lds + SHM_K, R_lds + SHM_R, qr, Qrl, r32, hi);
        finishSM(pA0, pA1, alA, l_reg, pa0, pa1, pa2, pa3); SBAR();
        SLOAD(SO, (j + SDEPTH) * KVBLK); SBAR();
        pv_d0(o, vb0, pa0, pa1, pa2, pa3); partialSM(pB0, pB1, m_reg, mnB, alB);
        __syncthreads(); SWAIT(); SWRITE(0, SE);
        RESC(alB); __syncthreads();
        SBAR(); qkt(pA0, pA1, K_lds, R_lds, qr, Qrl, r32, hi);
        finishSM(pB0, pB1, alB, l_reg, pa0, pa1, pa2, pa3); SBAR();
        if (SDEPTH == 1 || j + 3 < NT) SLOAD(SE, (j + 1 + SDEPTH) * KVBLK); SBAR();
        pv_d0(o, vb0 + (int)SHM_V, pa0, pa1, pa2, pa3); partialSM(pA0, pA1, m_reg, mnA, alA);
        __syncthreads(); SWAIT(); SWRITE(1, SO);
        RESC(alA); __syncthreads();
    }
    SBAR(); qkt(pB0, pB1, K_lds + SHM_K, R_lds + SHM_R, qr, Qrl, r32, hi);
    finishSM(pA0, pA1, alA, l_reg, pa0, pa1, pa2, pa3); SBAR();
    pv_d0(o, vb0, pa0, pa1, pa2, pa3); partialSM(pB0, pB1, m_reg, mnB, alB);
    __syncthreads(); RESC(alB);
    finishSM(pB0, pB1, alB, l_reg, pa0, pa1, pa2, pa3); SBAR();
    pv_d0(o, vb0 + (int)SHM_V, pa0, pa1, pa2, pa3);
    if (hi == 0) li_l[r32] = l_reg; asm volatile("s_waitcnt lgkmcnt(0)" ::: "memory");
    float rli[16];
#pragma unroll
    for (int r = 0; r < 16; ++r) rli[r] = __builtin_amdgcn_rcpf(li_l[crow(r, hi)]);
    bf16_t* Ow = Ob + (size_t)(wid * QBLK) * 2048;
#pragma unroll
    for (int r = 0; r < 16; ++r) { const int orow = crow(r, hi);
#pragma unroll
        for (int d0 = 0; d0 < 4; ++d0) Ow[(size_t)orow * 2048 + d0 * 32 + r32] = (bf16_t)(cvt_pk_bf16(o[d0][r] * rli[r], 0.f) & 0xffffu); }
#undef SLOAD
#undef SWRITE
#undef SWAIT
#undef RESC
}
}

__device__ __forceinline__ void x_pass(const float* src, bf16_t* dstb, fix_t* st) {
    const int tid_ = otid(), lane = tid_ & 63, wave = tid_ >> 6;
    for (int row = blockIdx.x * 8 + wave; row < M_; row += gridDim.x * 8) {
        const float* s = src + (size_t)row * 2048; f32x4 v[8]; float s1 = 0.f, s2 = 0.f;
#pragma unroll
        for (int i = 0; i < 8; ++i) { v[i] = *(const f32x4*)(s + i * 256 + lane * 4); s1 += (v[i][0] + v[i][1]) + (v[i][2] + v[i][3]); s2 += (v[i][0] * v[i][0] + v[i][1] * v[i][1]) + (v[i][2] * v[i][2] + v[i][3] * v[i][3]); }
        s1 = wave_sum(s1, lane); s2 = wave_sum(s2, lane);
        if (lane == 0) { st[row] = to_fix(s1); st[M_ + row] = to_fix(s2); }
#pragma unroll
        for (int i = 0; i < 8; ++i) { u32x2 w; w.x = cvt_pk_bf16(v[i][0], v[i][1]); w.y = cvt_pk_bf16(v[i][2], v[i][3]); *(u32x2*)(dstb + (size_t)row * 2048 + i * 256 + lane * 4) = w; }
    }
}
__device__ __forceinline__ void ln_final(float* out, const bf16_t* hb, const fix_t* st, const float* g, const float* b) {
    const int tid = otid();
    for (size_t i = (size_t)blockIdx.x * 512 + tid; i < (size_t)M_ * 512; i += (size_t)gridDim.x * 512) {
        const int row = (int)(i >> 9), c = (int)(i & 511) * 4; float mu, rs; row_ln(st, row, mu, rs);
        const u32x2 pw = *(const u32x2*)(hb + i * 4); const f32x4 P = {bf_lo(pw.x), bf_hi(pw.x), bf_lo(pw.y), bf_hi(pw.y)}, g4 = *(const f32x4*)(g + c), b4 = *(const f32x4*)(b + c);
        *(f32x4*)(out + i * 4) = (P - mu) * rs * g4 + b4;
    }
}
__device__ __forceinline__ int colmap(int mode, int n) {
    if (mode == 0) { if (n < 1024) return n; if (n < 2048) return 1088 + (n - 1024); if (n < 3072) return 2112 + (n - 2048);
        const int t = n - 3072, bj = t >> 7, r = t & 127; return r < 32 ? 1024 + bj * 32 + r : -1; }
    if (mode == 1) { if (n < 1024) return (n >> 7) * 192 + (n & 127);
        const int t = n - 1024, tile = t >> 8, bj = (t >> 7) & 1, wc = (t >> 5) & 3, i = t & 31; return (4 * tile + wc) * 192 + 128 + bj * 32 + i; }
    return n;
}
__device__ __forceinline__ void cvt_tile(const float* W, int ldw, bf16_t* Bt, int ldb, int n0, int k0, int mode, const float* kscale, float* T) {
    const int tid = otid(), n4 = (tid & 31) * 4, kq = tid >> 5, src = colmap(mode, n0 + n4);
    f32x4 v[8];
#pragma unroll
    for (int i = 0; i < 8; ++i) { const int kk = kq + 16 * i; v[i] = *(const f32x4*)(W + (size_t)(k0 + kk) * ldw + (src >= 0 ? src : 0)); }
    float ksc[8];
#pragma unroll
    for (int i = 0; i < 8; ++i) ksc[i] = kscale ? kscale[k0 + kq + 16 * i] : 1.0f;
#pragma unroll
    for (int i = 0; i < 8; ++i) v[i] = v[i] * (src >= 0 ? ksc[i] : 0.0f);
#pragma unroll
    for (int i = 0; i < 8; ++i)
#pragma unroll
        for (int j = 0; j < 4; ++j) T[(n4 + j) * 129 + kq + 16 * i] = v[i][j];
    __syncthreads();
    { const int n2 = tid >> 2, ks = (tid & 3) * 32; const float* t = T + n2 * 129 + ks; bf16_t* dst = Bt + (size_t)(n0 + n2) * ldb + k0 + ks;
#pragma unroll
      for (int i = 0; i < 4; ++i) { u32x4 w; w.x = cvt_pk_bf16(t[i * 8 + 0], t[i * 8 + 1]); w.y = cvt_pk_bf16(t[i * 8 + 2], t[i * 8 + 3]); w.z = cvt_pk_bf16(t[i * 8 + 4], t[i * 8 + 5]); w.w = cvt_pk_bf16(t[i * 8 + 6], t[i * 8 + 7]);
          *(u32x4*)(dst + i * 8) = w; } }
    __syncthreads();
}
constexpr int CT0 = 26 * 16, CT1 = CT0 + 12 * 4, CT2 = CT1 + 16 * 4, CT3 = CT2 + 32, CT4 = CT3 + 16 * 16, CT5 = CT4 + 64 * 16, CT6 = CT5 + 16 * 64;
__device__ __forceinline__ void convert_weights(const Params& p, int l, int t0, int t1, float* T) {
    unsigned char* ws = p.ws;
    const float* ing = l == 0 ? p.in[2] : p.in[21] + (size_t)(l - 1) * 2048;
    for (int t = t0 + blockIdx.x; t < t1; t += gridDim.x) {
        if (t < CT0) { const int nt = t % 26, kt = t / 26; cvt_tile(p.in[4] + (size_t)l * 2048 * NIN, NIN, (bf16_t*)(ws + W_IN), 2048, nt * 128, kt * 128, 0, ing, T); }
        else if (t < CT1) { const int u = t - CT0, nt = u % 12, kt = u / 12; cvt_tile(p.in[7] + (size_t)l * 512 * 1536, 1536, (bf16_t*)(ws + W_UQ), 512, nt * 128, kt * 128, 1, p.in[5] + l * 512, T); }
        else if (t < CT2) { const int u = t - CT1, nt = u % 16, kt = u / 16; cvt_tile(p.in[8] + (size_t)l * 512 * 2048, 2048, (bf16_t*)(ws + W_UKV), 512, nt * 128, kt * 128, 2, p.in[6] + l * 512, T); }
        else if (t < CT3) { const int mat = t - CT2, gate = mat & 1, h = (mat >> 1) & 7, d = mat >> 4;
            cvt_tile((gate ? p.in[13] : p.in[11]) + ((size_t)((l * 2 + d) * 8 + h)) * 128 * 128, 128, (bf16_t*)(ws + W_G) + (size_t)(h * 512 + d * 256 + gate * 128) * 128, 128, 0, 0, 2, nullptr, T); }
        else if (t < CT4) { const int u = t - CT3, nt = u % 16, kt = u / 16; cvt_tile(p.in[16] + (size_t)l * 2048 * 2048, 2048, (bf16_t*)(ws + W_OUT), 2048, nt * 128, kt * 128, 2, nullptr, T); }
        else if (t < CT5) { const int u = t - CT4, nt = u % 64, kt = u / 64; cvt_tile(p.in[19] + (size_t)l * 2048 * 8192, 8192, (bf16_t*)(ws + W_UP), 2048, nt * 128, kt * 128, 2, p.in[17] + (size_t)l * 2048, T); }
        else { const int u = t - CT5, nt = u % 16, kt = u / 16; cvt_tile(p.in[20] + (size_t)l * 8192 * 2048, 2048, (bf16_t*)(ws + W_DN), 8192, nt * 128, kt * 128, 2, nullptr, T); }
    }
}
__device__ __forceinline__ void colsum_pass(const bf16_t* Bt, int N, const float* lg, const float* lb, float* cs, float* bw) {
    const int tid = otid(), lane = tid & 63, wave = tid >> 6;
    float ratio[32];
#pragma unroll
    for (int i = 0; i < 4; ++i)
#pragma unroll
        for (int j = 0; j < 8; ++j) { const int k = i * 512 + lane * 8 + j; ratio[i * 8 + j] = lb[k] * __builtin_amdgcn_rcpf(lg[k]); }
    for (int n = blockIdx.x * 8 + wave; n < N; n += gridDim.x * 8) {
        u32x4 w[4];
#pragma unroll
        for (int i = 0; i < 4; ++i) w[i] = *(const u32x4*)(Bt + (size_t)n * 2048 + i * 512 + lane * 8);
        float c = 0.f, bb = 0.f;
#pragma unroll
        for (int i = 0; i < 4; ++i) { const float v[8] = {bf_lo(w[i].x), bf_hi(w[i].x), bf_lo(w[i].y), bf_hi(w[i].y), bf_lo(w[i].z), bf_hi(w[i].z), bf_lo(w[i].w), bf_hi(w[i].w)};
#pragma unroll
            for (int j = 0; j < 8; ++j) { c += v[j]; bb += v[j] * ratio[i * 8 + j]; } }
        c = wave_sum(c, lane); bb = wave_sum(bb, lane);
        if (lane == 0) { cs[n] = c; bw[n] = bb; }
    }
}
__device__ __forceinline__ void colsum_in(const Params& p, int l) { float* csb = (float*)(p.ws + WS_CSB) + (size_t)l * CSB_L;
    colsum_pass((const bf16_t*)(p.ws + W_IN), NINP, l == 0 ? p.in[2] : p.in[21] + (size_t)(l - 1) * 2048, l == 0 ? p.in[3] : p.in[22] + (size_t)(l - 1) * 2048, csb + CSB_IN, csb + CSB_IN + NINP); }
__device__ __forceinline__ void colsum_up(const Params& p, int l) { float* csb = (float*)(p.ws + WS_CSB) + (size_t)l * CSB_L;
    colsum_pass((const bf16_t*)(p.ws + W_UP), DFF, p.in[17] + (size_t)l * 2048, p.in[18] + (size_t)l * 2048, csb + CSB_UP, csb + CSB_UP + DFF); }
__device__ __forceinline__ void make_tables(const Params& p) {
    const int* pos = (const int*)p.in[1]; float* cosT = (float*)(p.ws + WS_COS); float* sinT = (float*)(p.ws + WS_SIN); float* sp = (float*)(p.ws + WS_SP);
    const int tid = otid();
    for (size_t i = (size_t)blockIdx.x * 512 + tid; i < (size_t)M_ * 32; i += (size_t)gridDim.x * 512) {
        const int row = (int)(i >> 5), k = (int)(i & 31); const float inv = powf(10000.0f, -(float)(2 * k) / 64.0f); const float ang = (float)pos[row] * inv;
        cosT[i] = cosf(ang); sinT[i] = sinf(ang); }
    for (int i = blockIdx.x * 512 + tid; i < DEPTH * 2 * 1024; i += gridDim.x * 512) { const float x = -p.in[15][i];
        sp[i] = fmaxf(x, 0.f) + log1pf(expf(-fabsf(x))); }
}
__device__ __forceinline__ void conv_phase(const Params& p, int l) {
    const bf16_t* __restrict__ xl = (const bf16_t*)(p.ws + WS_XL); bf16_t* __restrict__ xc = (bf16_t*)(p.ws + WS_XC);
    const float* cw = p.in[9] + (size_t)l * 4 * 1024; const float* cb = p.in[10] + (size_t)l * 1024;
    const int tid = otid();
    for (size_t i = (size_t)blockIdx.x * 512 + tid; i < (size_t)M_ * 128; i += (size_t)gridDim.x * 512) {
        const int row = (int)(i >> 7), c0 = (int)(i & 127) * 8, t = row & (SEQ - 1);
        u32x4 xw[4]; f32x4 w0[4], w1[4];
#pragma unroll
        for (int k = 0; k < 4; ++k) { const int tt = t - 2 + k; const bool ok = (tt >= 0) && (tt < SEQ); const int rr = ok ? row - 2 + k : row;
            xw[k] = *(const u32x4*)(xl + (size_t)rr * 1024 + c0);
            w0[k] = *(const f32x4*)(cw + k * 1024 + c0); w1[k] = *(const f32x4*)(cw + k * 1024 + c0 + 4);
            if (!ok) { w0[k] = (f32x4){0.f, 0.f, 0.f, 0.f}; w1[k] = (f32x4){0.f, 0.f, 0.f, 0.f}; } }
        const f32x4 b0 = *(const f32x4*)(cb + c0), b1 = *(const f32x4*)(cb + c0 + 4);
        float acc[8] = {b0[0], b0[1], b0[2], b0[3], b1[0], b1[1], b1[2], b1[3]};
#pragma unroll
        for (int k = 0; k < 4; ++k) {
            acc[0] += w0[k][0] * bf_lo(xw[k].x); acc[1] += w0[k][1] * bf_hi(xw[k].x); acc[2] += w0[k][2] * bf_lo(xw[k].y); acc[3] += w0[k][3] * bf_hi(xw[k].y);
            acc[4] += w1[k][0] * bf_lo(xw[k].z); acc[5] += w1[k][1] * bf_hi(xw[k].z); acc[6] += w1[k][2] * bf_lo(xw[k].w); acc[7] += w1[k][3] * bf_hi(xw[k].w); }
        u32x4 o; o.x = cvt_pk_bf16(acc[0], acc[1]); o.y = cvt_pk_bf16(acc[2], acc[3]); o.z = cvt_pk_bf16(acc[4], acc[5]); o.w = cvt_pk_bf16(acc[6], acc[7]);
        *(u32x4*)(xc + (size_t)row * 1024 + c0) = o;
    }
}
__device__ __forceinline__ void scan_local(const Params& p) {
    const unsigned* au = (const unsigned*)(p.ws + WS_AU); f32x4* ph = (f32x4*)(p.ws + WS_PH); const int tid = otid();
    for (int it = blockIdx.x; it < 2 * 8 * 64; it += gridDim.x) {
        const int c = it & 63, b = (it >> 6) & 7, d = it >> 9;
        const u32x2* __restrict__ src = (const u32x2*)(au + (size_t)d * M_ * 1024 + (size_t)(b * SEQ + c * 64) * 1024) + tid;
        float h0 = 0.f, h1 = 0.f, P0 = 1.f, P1 = 1.f;
        const long step = d ? -512 : 512; const u32x2* q = src + (d ? (size_t)63 * 512 : 0);
        u32x2 wa[16], wb[16];
#pragma unroll
        for (int j = 0; j < 16; ++j) wa[j] = q[(long)j * step];
#pragma unroll
        for (int bt = 0; bt < 4; bt += 2) {
#pragma unroll
            for (int j = 0; j < 16; ++j) wb[j] = q[(long)((bt + 1) * 16 + j) * step];
#pragma unroll
            for (int j = 0; j < 16; ++j) { const float a0 = 1.0f - bf_lo(wa[j].x), a1 = 1.0f - bf_lo(wa[j].y); h0 = a0 * h0 + bf_hi(wa[j].x); h1 = a1 * h1 + bf_hi(wa[j].y); P0 *= a0; P1 *= a1; }
            if (bt + 2 < 4) {
#pragma unroll
                for (int j = 0; j < 16; ++j) wa[j] = q[(long)((bt + 2) * 16 + j) * step]; }
#pragma unroll
            for (int j = 0; j < 16; ++j) { const float a0 = 1.0f - bf_lo(wb[j].x), a1 = 1.0f - bf_lo(wb[j].y); h0 = a0 * h0 + bf_hi(wb[j].x); h1 = a1 * h1 + bf_hi(wb[j].y); P0 *= a0; P1 *= a1; }
        }
        ph[(size_t)((d * 8 + b) * 64 + c) * 512 + tid] = (f32x4){P0, h0, P1, h1};
    }
}
__device__ __forceinline__ void scan_apply(const Params& p) {
    const unsigned* au = (const unsigned*)(p.ws + WS_AU); const f32x4* ph = (const f32x4*)(p.ws + WS_PH);
    const bf16_t* gg = (const bf16_t*)(p.ws + WS_GG); bf16_t* ycat = (bf16_t*)(p.ws + WS_YCAT); const int tid = otid();
    for (int it = blockIdx.x; it < 8 * 64; it += gridDim.x) {
        const int c = it & 63, b = it >> 6;
        float Hf0 = 0.f, Hf1 = 0.f, Hb0 = 0.f, Hb1 = 0.f;
        { const f32x4* pf = ph + (size_t)((0 * 8 + b) * 64) * 512 + tid;
          for (int c0 = 0; c0 < c; c0 += 8) { f32x4 e[8];
#pragma unroll
              for (int j = 0; j < 8; ++j) e[j] = pf[(size_t)min(c0 + j, c - 1) * 512];
#pragma unroll
              for (int j = 0; j < 8; ++j) if (c0 + j >= c) e[j] = (f32x4){1.f, 0.f, 1.f, 0.f};
#pragma unroll
              for (int j = 0; j < 8; ++j) { Hf0 = e[j][0] * Hf0 + e[j][1]; Hf1 = e[j][2] * Hf1 + e[j][3]; } }
          const f32x4* pb = ph + (size_t)((1 * 8 + b) * 64) * 512 + tid;
          for (int c0 = 63; c0 > c; c0 -= 8) { f32x4 e[8];
#pragma unroll
              for (int j = 0; j < 8; ++j) e[j] = pb[(size_t)max(c0 - j, c + 1) * 512];
#pragma unroll
              for (int j = 0; j < 8; ++j) if (c0 - j <= c) e[j] = (f32x4){1.f, 0.f, 1.f, 0.f};
#pragma unroll
              for (int j = 0; j < 8; ++j) { Hb0 = e[j][0] * Hb0 + e[j][1]; Hb1 = e[j][2] * Hb1 + e[j][3]; } } }
        const size_t r0 = (size_t)(b * SEQ + c * 64);
        const u32x2* __restrict__ s0 = (const u32x2*)(au + r0 * 1024) + tid; const u32x2* __restrict__ s1 = (const u32x2*)(au + (size_t)M_ * 1024 + r0 * 1024) + tid;
        const unsigned* __restrict__ gp = (const unsigned*)(gg + r0 * 1024) + tid; unsigned* __restrict__ yp = (unsigned*)(ycat + r0 * 2048 + 1024) + tid;
        float hf0[64], hf1[64];
        { u32x2 wa[8], wb[8];
#pragma unroll
          for (int j = 0; j < 8; ++j) wa[j] = s0[(size_t)j * 512];
#pragma unroll
          for (int bt = 0; bt < 8; bt += 2) {
#pragma unroll
              for (int j = 0; j < 8; ++j) wb[j] = s0[(size_t)((bt + 1) * 8 + j) * 512];
#pragma unroll
              for (int j = 0; j < 8; ++j) { const int t = bt * 8 + j; Hf0 = (1.0f - bf_lo(wa[j].x)) * Hf0 + bf_hi(wa[j].x); Hf1 = (1.0f - bf_lo(wa[j].y)) * Hf1 + bf_hi(wa[j].y); hf0[t] = Hf0; hf1[t] = Hf1; }
              if (bt + 2 < 8) {
#pragma unroll
                  for (int j = 0; j < 8; ++j) wa[j] = s0[(size_t)((bt + 2) * 8 + j) * 512]; }
#pragma unroll
              for (int j = 0; j < 8; ++j) { const int t = (bt + 1) * 8 + j; Hf0 = (1.0f - bf_lo(wb[j].x)) * Hf0 + bf_hi(wb[j].x); Hf1 = (1.0f - bf_lo(wb[j].y)) * Hf1 + bf_hi(wb[j].y); hf0[t] = Hf0; hf1[t] = Hf1; }
          } }
        { u32x2 wa[8], wb[8]; unsigned ga[8], gb[8];
#pragma unroll
          for (int j = 0; j < 8; ++j) { wa[j] = s1[(size_t)(63 - j) * 512]; ga[j] = gp[(size_t)(63 - j) * 512]; }
#pragma unroll
          for (int bt = 0; bt < 8; bt += 2) {
#pragma unroll
              for (int j = 0; j < 8; ++j) { const int t = 63 - ((bt + 1) * 8 + j); wb[j] = s1[(size_t)t * 512]; gb[j] = gp[(size_t)t * 512]; }
#pragma unroll
              for (int j = 0; j < 8; ++j) { const int t = 63 - (bt * 8 + j); Hb0 = (1.0f - bf_lo(wa[j].x)) * Hb0 + bf_hi(wa[j].x); Hb1 = (1.0f - bf_lo(wa[j].y)) * Hb1 + bf_hi(wa[j].y);
                  yp[(size_t)t * 1024] = cvt_pk_bf16(bf_lo(ga[j]) * (hf0[t] + Hb0), bf_hi(ga[j]) * (hf1[t] + Hb1)); }
              if (bt + 2 < 8) {
#pragma unroll
                  for (int j = 0; j < 8; ++j) { const int t = 63 - ((bt + 2) * 8 + j); wa[j] = s1[(size_t)t * 512]; ga[j] = gp[(size_t)t * 512]; } }
#pragma unroll
              for (int j = 0; j < 8; ++j) { const int t = 63 - ((bt + 1) * 8 + j); Hb0 = (1.0f - bf_lo(wb[j].x)) * Hb0 + bf_hi(wb[j].x); Hb1 = (1.0f - bf_lo(wb[j].y)) * Hb1 + bf_hi(wb[j].y);
                  yp[(size_t)t * 1024] = cvt_pk_bf16(bf_lo(gb[j]) * (hf0[t] + Hb0), bf_hi(gb[j]) * (hf1[t] + Hb1)); }
          } }
    }
}

__device__ __forceinline__ void grid_bar(unsigned* ctr, unsigned epoch) {
    asm volatile("s_waitcnt vmcnt(0) lgkmcnt(0)" ::: "memory");
    __syncthreads();
    if (otid() == 0) {
        __builtin_amdgcn_fence(__ATOMIC_RELEASE, "agent");
        asm volatile("s_waitcnt vmcnt(0)" ::: "memory");
        __hip_atomic_fetch_add(ctr, 1u, __ATOMIC_RELAXED, __HIP_MEMORY_SCOPE_AGENT);
        const unsigned target = (epoch + 1u) * gridDim.x;
        while (__hip_atomic_load(ctr, __ATOMIC_RELAXED, __HIP_MEMORY_SCOPE_AGENT) < target) __builtin_amdgcn_s_sleep(1);
        __builtin_amdgcn_fence(__ATOMIC_ACQUIRE, "agent");
        asm volatile("s_waitcnt vmcnt(0)" ::: "memory");
    }
    __syncthreads();
}
__global__ void __launch_bounds__(512, 2) mega_fwd(Params p) {
    extern __shared__ __attribute__((aligned(16))) unsigned char lds[];
    cg::grid_group grid = cg::this_grid();
    unsigned char* ws = p.ws;
    LAS unsigned char* ldsl = (LAS unsigned char*)lds;
    bf16_t* hb = (bf16_t*)(ws + WS_HB);
    const float* cosT = (const float*)(ws + WS_COS); const float* sinT = (const float*)(ws + WS_SIN);

    unsigned* bar_ctr = (unsigned*)(ws + WS_BAR);
    fix_t* stats0 = (fix_t*)(ws + WS_ST);
#define stats stats0
    { const int tid = otid();
      for (size_t i = (size_t)blockIdx.x * 512 + tid; i < (size_t)8 * 2 * M_; i += (size_t)gridDim.x * 512) stats[(size_t)2 * M_ + i] = 0ull;
    }
    make_tables(p);
    x_pass(p.in[0], hb, stats);
    grid.sync();
    convert_weights(p, 0, 0, CT6, (float*)lds);
    grid_bar(bar_ctr, 0u);
    colsum_in(p, 0); colsum_up(p, 0);
    grid_bar(bar_ctr, 1u);

#pragma unroll 1
    for (int l = 0; l < DEPTH; ++l) {
        { typedef __attribute__((address_space(1))) unsigned char gu8; uintptr_t w_ = (uintptr_t)p.ws; asm volatile("" : "+s"(w_)); ws = (unsigned char*)(gu8*)w_; }
        const float* csb = (const float*)(ws + WS_CSB) + (size_t)l * CSB_L;
        fix_t* st0 = (fix_t*)(ws + WS_ST) + (size_t)(2 * l) * 2 * M_; fix_t* st1 = st0 + 2 * M_; fix_t* st2 = st1 + 2 * M_;
        if (l > 0) { colsum_up(p, l); convert_weights(p, l, CT5, CT6, (float*)lds); }
        { pg8::Order S = pg8::make_order(hb, 2048, ws + W_IN, 2048, M_, NINP, 2048);
          EpiIn E{(bf16_t*)(ws + WS_CQ), (bf16_t*)(ws + WS_CKV), (bf16_t*)(ws + WS_XL), (bf16_t*)(ws + WS_GG), (bf16_t*)(ws + WS_KPE), (float*)(ws + WS_SSQ), cosT, sinT, st0, csb + CSB_IN, csb + CSB_IN + NINP};
          pg8::gemm_phase(ldsl, S, E); }
        grid_bar(bar_ctr, 2u + 8u * (unsigned)l + 0u);
        conv_phase(p, l);
        { pg8::Order S = pg8::make_order(ws + WS_CQ, 512, ws + W_UQ, 512, M_, 1536, 512);
          EpiQ E{(bf16_t*)(ws + WS_Q), (const float*)(ws + WS_SSQ), cosT, sinT};
          pg8::gemm_phase(ldsl, S, E); }
        { pg8::Order S = pg8::make_order(ws + WS_CKV, 512, ws + W_UKV, 512, M_, 2048, 512);
          EpiKV E{(bf16_t*)(ws + WS_KV), (const float*)(ws + WS_SSQ)};
          pg8::gemm_phase(ldsl, S, E); }
        grid_bar(bar_ctr, 2u + 8u * (unsigned)l + 1u);
        {
            const bf16_t* Q = (const bf16_t*)(ws + WS_Q); const bf16_t* KV = (const bf16_t*)(ws + WS_KV); const bf16_t* KPE = (const bf16_t*)(ws + WS_KPE); bf16_t* ycat = (bf16_t*)(ws + WS_YCAT);
            const int G = gridDim.x, bx = blockIdx.x;
            for (int L = bx; L < 1024; L += G) {
                int pair, qb;
                if (G == 256) { const int i = L >> 8, c = L & 255, xcd = c & 7, j = c >> 3; pair = i * 16 + xcd * 2 + (j >> 4); qb = j & 15; } else { pair = L >> 4; qb = L & 15; }
                const int b = pair >> 3, h = pair & 7; const size_t row0 = (size_t)b * SEQ + (size_t)qb * 256;
                __syncthreads();
                att::attn_unit(Q + row0 * 1536 + h * 128, Q + row0 * 1536 + 1024 + h * 64, KV + (size_t)b * SEQ * 2048 + h * 256, KPE + (size_t)b * SEQ * 64, ycat + row0 * 2048 + h * 128, SEQ, (char*)lds);
            }
            __syncthreads();
        }
        { pg8::Order S = pg8::make_order(ws + WS_XC, 1024, ws + W_G, 128, M_, 512, 128);
          S.nZ = 8; S.a_z = 128 * 2; S.b_z = (size_t)512 * 128 * 2;
          EpiGate E{(unsigned*)(ws + WS_AU), (const bf16_t*)(ws + WS_XC), p.in[12] + (size_t)l * 2048, p.in[14] + (size_t)l * 2048, (const float*)(ws + WS_SP) + (size_t)l * 2048};
          pg8::gemm_phase(ldsl, S, E); }
        grid_bar(bar_ctr, 2u + 8u * (unsigned)l + 2u);
        scan_local(p);
        if (l + 1 < DEPTH) { __syncthreads(); convert_weights(p, l + 1, 0, CT3, (float*)lds); }
        grid_bar(bar_ctr, 2u + 8u * (unsigned)l + 3u);
        if (l + 1 < DEPTH) colsum_in(p, l + 1);
        scan_apply(p);
        grid_bar(bar_ctr, 2u + 8u * (unsigned)l + 4u);
        { pg8::Order S = pg8::make_order(ws + WS_YCAT, 2048, ws + W_OUT, 2048, M_, 2048, 2048); S.wgm = 4;
          EpiRes E{hb, st0, l == 0 ? p.in[2] : p.in[21] + (size_t)(l - 1) * 2048, l == 0 ? p.in[3] : p.in[22] + (size_t)(l - 1) * 2048, st1};
          pg8::gemm_phase(ldsl, S, E); }
        grid_bar(bar_ctr, 2u + 8u * (unsigned)l + 5u);
        if (l + 1 < DEPTH) { convert_weights(p, l + 1, CT3, CT4, (float*)lds); }
        { pg8::Order S = pg8::make_order(hb, 2048, ws + W_UP, 2048, M_, DFF, 2048);
          EpiUp E{(bf16_t*)(ws + WS_F), st1, csb + CSB_UP, csb + CSB_UP + DFF}; pg8::gemm_phase(ldsl, S, E); }
        grid_bar(bar_ctr, 2u + 8u * (unsigned)l + 6u);
        if (l + 1 < DEPTH) { convert_weights(p, l + 1, CT4, CT5, (float*)lds); }
        { pg8::Order S = pg8::make_order(ws + WS_F, 8192, ws + W_DN, 8192, M_, 2048, 8192); S.wgm = 4;
          EpiRes E{hb, st1, p.in[17] + (size_t)l * 2048, p.in[18] + (size_t)l * 2048, st2};
          pg8::gemm_phase(ldsl, S, E); }
        grid_bar(bar_ctr, 2u + 8u * (unsigned)l + 7u);
    }
    ln_final(p.out, (const bf16_t*)(p.ws + WS_HB), (const fix_t*)(p.ws + WS_ST) + (size_t)(2 * DEPTH) * 2 * M_, p.in[21] + (size_t)(DEPTH - 1) * 2048, p.in[22] + (size_t)(DEPTH - 1) * 2048);
}

extern "C" void kernel_launch(void* const* d_in, const int* in_sizes, int n_in, void* d_out, int out_size, void* d_ws, size_t ws_size, hipStream_t stream) {
    constexpr int LDS_BYTES = pg8::STAGE_BYTES;
    static int grid_blocks = 0;
    if (grid_blocks == 0) {
        if (n_in != 23 || in_sizes[0] != M_ * DM || out_size != M_ * DM || ws_size < WS_END) {
            fprintf(stderr, "kernel_launch: shape mismatch (n_in %d, in0 %d, out %d, ws %zu, need %zu)\n", n_in, n_in > 0 ? in_sizes[0] : -1, out_size, ws_size, (size_t)WS_END); grid_blocks = -1; return; }
        int dev = 0, cus = 0, per_cu = 0;
        hipGetDevice(&dev); hipDeviceGetAttribute(&cus, hipDeviceAttributeMultiprocessorCount, dev);
        if (hipFuncSetAttribute((const void*)mega_fwd, hipFuncAttributeMaxDynamicSharedMemorySize, LDS_BYTES) != hipSuccess) { fprintf(stderr, "kernel_launch: hipFuncSetAttribute failed\n"); grid_blocks = -1; return; }
        if (hipOccupancyMaxActiveBlocksPerMultiprocessor(&per_cu, (const void*)mega_fwd, 512, LDS_BYTES) != hipSuccess || per_cu < 1) { fprintf(stderr, "kernel_launch: occupancy query says %d\n", per_cu); per_cu = 1; }
        (void)hipGetLastError();
        grid_blocks = cus * 1;
    }
    if (grid_blocks < 0) return;
    Params p{};
    for (int i = 0; i < 23; ++i) p.in[i] = (const float*)d_in[i];
    p.out = (float*)d_out; p.ws = (unsigned char*)d_ws;
    (void)hipMemsetAsync((char*)d_ws + WS_BAR, 0, 256, stream);
    void* args[] = {&p};
    hipError_t e = hipLaunchCooperativeKernel((const void*)mega_fwd, dim3(grid_blocks), dim3(512), args, LDS_BYTES, stream);
    if (e != hipSuccess) fprintf(stderr, "kernel_launch: cooperative launch failed: %s (grid %d)\n", hipGetErrorString(e), grid_blocks);
}
```

```cpp
#include <hip/hip_runtime.h>
#include <hip/hip_cooperative_groups.h>
#include <cstdio>
#include <cstdint>
namespace cg = cooperative_groups;

#define LAS __attribute__((address_space(3)))
typedef unsigned short bf16_t;
typedef short bf16x8 __attribute__((ext_vector_type(8)));
typedef short s16x4 __attribute__((ext_vector_type(4)));
typedef float f32x4 __attribute__((ext_vector_type(4)));
typedef float f32x2 __attribute__((ext_vector_type(2)));
typedef float f32x16 __attribute__((ext_vector_type(16)));
typedef unsigned u32x4 __attribute__((ext_vector_type(4)));
typedef unsigned u32x2 __attribute__((ext_vector_type(2)));

constexpr int M_ = 32768, DM = 2048, SEQ = 4096, NBATCH = 8, DEPTH = 4;
constexpr int NIN = 3136, NINP = 3328, DFF = 8192;
constexpr float ALPHA = 1.6817928305074290f;
constexpr float LN_EPS = 1e-5f, RMS_EPS = 1e-6f;
constexpr size_t MiB = 1ull << 20;
constexpr size_t WS_HB = 0;
constexpr size_t WS_W = 128 * MiB;
constexpr size_t W_IN = WS_W, W_UQ = W_IN + (size_t)NINP * 2048 * 2, W_UKV = W_UQ + 1536ull * 512 * 2, W_G = W_UKV + 2048ull * 512 * 2,
                 W_OUT = W_G + 8ull * 512 * 128 * 2, W_UP = W_OUT + 2048ull * 2048 * 2, W_DN = W_UP + 8192ull * 2048 * 2, W_END = W_DN + 8192ull * 2048 * 2;
static_assert(W_END <= 218 * MiB, "weights region");
constexpr size_t WS_COS = 218 * MiB, WS_SIN = 222 * MiB, WS_SP = 226 * MiB;
constexpr size_t WS_CSB = 226 * MiB + 65536;
constexpr int CSB_L = 2 * 3328 + 2 * 8192, CSB_IN = 0, CSB_UP = 2 * 3328;
constexpr size_t WS_BAR = 226 * MiB + 49152;
constexpr size_t WS_ST = 227 * MiB;
constexpr size_t WS_BIG = 232 * MiB;
constexpr size_t WS_F = WS_BIG;
constexpr size_t WS_GG = WS_BIG, WS_XC = WS_BIG + 64 * MiB, WS_YCAT = WS_BIG + 128 * MiB, WS_SSQ = WS_BIG + 256 * MiB, WS_KPE = WS_BIG + 258 * MiB,
                 WS_CQ = WS_BIG + 262 * MiB, WS_CKV = WS_BIG + 294 * MiB, WS_XL = WS_BIG + 326 * MiB, WS_AU = WS_BIG + 262 * MiB  ,
                 WS_Q = WS_BIG + 518 * MiB, WS_KV = WS_BIG + 614 * MiB, WS_PH = WS_BIG + 742 * MiB, WS_END = WS_BIG + 750 * MiB;
static_assert(WS_END <= 1024 * MiB, "workspace");

struct Params { const float* in[23]; float* out; unsigned char* ws; };

__device__ __forceinline__ int otid(int wv) { int t; asm volatile("v_mbcnt_lo_u32_b32 %0, -1, 0\n\tv_mbcnt_hi_u32_b32 %0, -1, %0" : "=v"(t)); return (wv << 6) | t; }
__device__ __forceinline__ unsigned cvt_pk_bf16(float lo, float hi) { unsigned r; asm volatile("v_cvt_pk_bf16_f32 %0, %1, %2" : "=v"(r) : "v"(lo), "v"(hi)); return r; }
__device__ __forceinline__ float sum_fq(float x) {
    auto a = __builtin_amdgcn_permlane16_swap(__float_as_uint(x), __float_as_uint(x), false, false); x = __uint_as_float(a[0]) + __uint_as_float(a[1]);
    auto b = __builtin_amdgcn_permlane32_swap(__float_as_uint(x), __float_as_uint(x), false, false); return __uint_as_float(b[0]) + __uint_as_float(b[1]); }
__device__ __forceinline__ float wave_sum(float x, int lane) {
#pragma unroll
    for (int o = 32; o >= 1; o >>= 1) x += __int_as_float(__builtin_amdgcn_ds_bpermute((lane ^ o) << 2, __float_as_int(x)));
    return x; }
__device__ __forceinline__ float bf_lo(unsigned w) { return __uint_as_float(w << 16); }
__device__ __forceinline__ float bf_hi(unsigned w) { return __uint_as_float(w & 0xffff0000u); }
__device__ __forceinline__ float sigmoidf_(float x) { return __builtin_amdgcn_rcpf(1.0f + __builtin_amdgcn_exp2f(-1.4426950408889634f * x)); }
__device__ __forceinline__ float gelu_tanh(float x) { const float z = 0.7978845608028654f * (x + 0.044715f * x * x * x); return x * sigmoidf_(2.0f * z); }
__device__ __forceinline__ u32x4 pack8(const f32x4 a, const f32x4 b) { u32x4 w; w.x = cvt_pk_bf16(a[0], a[1]); w.y = cvt_pk_bf16(a[2], a[3]); w.z = cvt_pk_bf16(b[0], b[1]); w.w = cvt_pk_bf16(b[2], b[3]); return w; }

namespace pg8 {
constexpr int BM = 256, BK = 64, HALF = 128, HTB = HALF * BK * 2, STAGE_BYTES = 8 * HTB, NXCD = 8, WGM = 8;
__host__ __device__ __forceinline__ int lds_byte(int r, int c) { const int st = (r >> 4) * 2 + (c >> 5), rr = r & 15, cc = c & 31, ob = rr * 64 + cc * 2; return st * 1024 + (ob ^ (((ob >> 9) & 1) << 5)); }
__host__ __device__ __forceinline__ void stage_rc(int b, int& R, int& C) { const int st = b / 1024, sb = b % 1024, swz = sb ^ (((sb >> 9) & 1) << 5); R = (st >> 1) * 16 + swz / 64; C = (st & 1) * 32 + (swz % 64) / 2; }
__host__ __device__ __forceinline__ int perm32(int rho) { const int n = rho >> 4, i = rho & 15; return 8 * (i >> 2) + 4 * n + (i & 3); }

struct Unit { int pm, pn, z; };
struct Order {
    int nM, nN, nZ, per, G, c, wgm;
    const char* A; const char* B; size_t a_pm, a_z, b_pn, b_z; int lda, ldb, K;
    __device__ __forceinline__ bool next(int i, Unit& u) const {
        const long L = (long)i * G + c; if (L >= (long)per * nZ) return false;
        u.z = (int)(L / per); int wgid = (int)(L % per);
        { const int q = per / NXCD, r = per % NXCD, xcd = wgid % NXCD, off = wgid / NXCD; wgid = (xcd < r ? xcd * (q + 1) : r * (q + 1) + (xcd - r) * q) + off; }
        const int nig = wgm * nN, gid = wgid / nig, fm = gid * wgm, gsz = (nM - fm) < wgm ? (nM - fm) : wgm;
        u.pm = fm + ((wgid % nig) % gsz); u.pn = (wgid % nig) / gsz; return true;
    }
    __device__ __forceinline__ const char* aptr(const Unit& u) const { return A + (size_t)u.pm * a_pm + (size_t)u.z * a_z; }
    __device__ __forceinline__ const char* bptr(const Unit& u) const { return B + (size_t)u.pn * b_pn + (size_t)u.z * b_z; }
};
__device__ __forceinline__ Order make_order(const void* A, int lda, const void* Bt, int ldb, int Mrows, int N, int K) {
    Order o; o.nM = Mrows / BM; o.nN = N / BM; o.nZ = 1; o.per = o.nM * o.nN; o.G = gridDim.x; o.c = blockIdx.x; o.wgm = WGM;
    o.A = (const char*)A; o.B = (const char*)Bt; o.a_pm = (size_t)BM * lda * 2; o.a_z = 0; o.b_pn = (size_t)BM * ldb * 2; o.b_z = 0; o.lda = lda; o.ldb = ldb; o.K = K; return o;
}

template <class Epi>
__device__ __forceinline__ void gemm_phase(LAS unsigned char* lds, const Order& S, const Epi& E, int wv) {
    const int tid = otid(wv), wid = __builtin_amdgcn_readfirstlane(tid >> 6), lane = tid & 63, wr = wid >> 2, wc = wid & 3, fr = lane & 15, fq = lane >> 4;
    const int nt = S.K / BK;
    unsigned voffA[2], voffB[2];
#pragma unroll
    for (int i = 0; i < 2; ++i) { int R, C; stage_rc(tid * 16 + i * 8192, R, C); const int Rb = Epi::PERM ? ((R & ~31) + perm32(R & 31)) : R;
        voffA[i] = (unsigned)(R * S.lda + C) * 2u; voffB[i] = (unsigned)(Rb * S.ldb + C) * 2u; }
    const size_t kstep = (size_t)(BK * 2);
    const size_t hstepA = (size_t)HALF * S.lda * 2, hstepB = (size_t)HALF * S.ldb * 2;
    const unsigned ldsw = (unsigned)wid * 1024u;
    const int aoff = lds_byte(wr * 64 + fr, fq * 8), boff = lds_byte(wc * 32 + fr, fq * 8);
#define PG8_SA(b, h) (((b) * 2 + (h)) * HTB)
#define PG8_SB(b, h) ((4 + (b) * 2 + (h)) * HTB)
#define PG8_STAGE(bufoff, gbase, voff) do { _Pragma("unroll") for (int _i = 0; _i < 2; ++_i) \
        __builtin_amdgcn_global_load_lds((const unsigned*)((const char*)(gbase) + (voff)[_i]), (LAS unsigned*)(lds + (bufoff) + ldsw + _i * 8192), 16, 0, 0); } while (0)
#define PG8_LDA(dst, b, h) do { _Pragma("unroll") for (int m = 0; m < 4; ++m) _Pragma("unroll") for (int k = 0; k < 2; ++k) dst[m][k] = *(const LAS bf16x8*)(lds + PG8_SA(b, h) + aoff + m * 2048 + k * 1024); } while (0)
#define PG8_LDB(dst, b, h) do { _Pragma("unroll") for (int n = 0; n < 2; ++n) _Pragma("unroll") for (int k = 0; k < 2; ++k) dst[n][k] = *(const LAS bf16x8*)(lds + PG8_SB(b, h) + boff + n * 2048 + k * 1024); } while (0)
#define PG8_MMA(ai, bj, At, Bt) do { __builtin_amdgcn_s_setprio(1); _Pragma("unroll") for (int m = 0; m < 4; ++m) _Pragma("unroll") for (int n = 0; n < 2; ++n) _Pragma("unroll") for (int k = 0; k < 2; ++k) \
        acc[ai][bj][m][n] = __builtin_amdgcn_mfma_f32_16x16x32_bf16(Bt[n][k], At[m][k], acc[ai][bj][m][n], 0, 0, 0); __builtin_amdgcn_s_setprio(0); } while (0)
#define PG8_WAIT_V(n) asm volatile("s_waitcnt vmcnt(" #n ")" ::: "memory")
#define PG8_WAIT_L(n) asm volatile("s_waitcnt lgkmcnt(" #n ")" ::: "memory")
#define PG8_BAR __builtin_amdgcn_s_barrier()
#define PG8_SCHED __builtin_amdgcn_sched_barrier(0)
    Unit cur, nxt; int ui = 0;
    if (!S.next(0, cur)) return;
    f32x4 acc[2][2][4][2];
#pragma unroll
    for (int a = 0; a < 2; ++a)
#pragma unroll
        for (int b = 0; b < 2; ++b)
#pragma unroll
            for (int m = 0; m < 4; ++m)
#pragma unroll
                for (int n = 0; n < 2; ++n) acc[a][b][m][n] = (f32x4){0.f, 0.f, 0.f, 0.f};
    bf16x8 At[4][2], B0[2][2], B1[2][2];
    const char* cA = S.aptr(cur); const char* cB = S.bptr(cur);
    PG8_STAGE(PG8_SB(0, 0), cB, voffB); PG8_STAGE(PG8_SA(0, 0), cA, voffA); PG8_STAGE(PG8_SB(0, 1), cB + hstepB, voffB); PG8_STAGE(PG8_SA(0, 1), cA + hstepA, voffA);
    if (wr == 1) PG8_BAR;
    PG8_WAIT_V(4); PG8_BAR;
    PG8_STAGE(PG8_SB(1, 0), cB + kstep, voffB); PG8_STAGE(PG8_SA(1, 0), cA + kstep, voffA); PG8_STAGE(PG8_SB(1, 1), cB + hstepB + kstep, voffB);
    PG8_WAIT_V(6); PG8_BAR;
    for (;;) {
        const bool has_next = S.next(ui + 1, nxt);
        const char* nA = has_next ? S.aptr(nxt) : cA; const char* nB = has_next ? S.bptr(nxt) : cB;
        for (int t = 0; t < nt; t += 2) {
            const bool last = (t == nt - 2);
            const char* a1 = cA + (size_t)(t + 1) * kstep;
            const char* a2 = last ? nA : cA + (size_t)(t + 2) * kstep; const char* b2 = last ? nB : cB + (size_t)(t + 2) * kstep;
            const char* a3 = a2 + kstep; const char* b3 = b2 + kstep;
            PG8_LDB(B0, 0, 0); PG8_SCHED; PG8_LDA(At, 0, 0); PG8_STAGE(PG8_SA(1, 1), a1 + hstepA, voffA);
            PG8_WAIT_L(8); PG8_BAR; PG8_WAIT_L(0); PG8_MMA(0, 0, At, B0); PG8_BAR; PG8_SCHED;
            PG8_LDB(B1, 0, 1); PG8_STAGE(PG8_SB(0, 0), b2, voffB);
            PG8_BAR; PG8_WAIT_L(0); PG8_MMA(0, 1, At, B1); PG8_BAR;
            PG8_LDA(At, 0, 1); PG8_STAGE(PG8_SA(0, 0), a2, voffA);
            PG8_BAR; PG8_WAIT_L(0); PG8_MMA(1, 0, At, B0); PG8_BAR; PG8_SCHED;
            PG8_STAGE(PG8_SB(0, 1), b2 + hstepB, voffB);
            PG8_WAIT_V(6); PG8_BAR; PG8_MMA(1, 1, At, B1); PG8_BAR;
            PG8_LDB(B0, 1, 0); PG8_SCHED; PG8_LDA(At, 1, 0); PG8_STAGE(PG8_SA(0, 1), a2 + hstepA, voffA);
            PG8_WAIT_L(8); PG8_BAR; PG8_WAIT_L(0); PG8_MMA(0, 0, At, B0); PG8_BAR; PG8_SCHED;
            PG8_LDB(B1, 1, 1); PG8_STAGE(PG8_SB(1, 0), b3, voffB);
            PG8_BAR; PG8_WAIT_L(0); PG8_MMA(0, 1, At, B1); PG8_BAR;
            PG8_LDA(At, 1, 1); PG8_STAGE(PG8_SA(1, 0), a3, voffA);
            PG8_BAR; PG8_WAIT_L(0); PG8_MMA(1, 0, At, B0); PG8_BAR; PG8_SCHED;
            PG8_STAGE(PG8_SB(1, 1), b3 + hstepB, voffB);
            PG8_WAIT_V(6); PG8_BAR; PG8_MMA(1, 1, At, B1); PG8_BAR;
        }
        E(acc, cur, wr, wc, fr, fq);
        if (!has_next) break;
#pragma unroll
        for (int a = 0; a < 2; ++a)
#pragma unroll
            for (int b = 0; b < 2; ++b)
#pragma unroll
                for (int m = 0; m < 4; ++m)
#pragma unroll
                    for (int n = 0; n < 2; ++n) acc[a][b][m][n] = (f32x4){0.f, 0.f, 0.f, 0.f};
        cur = nxt; cA = nA; cB = nB; ++ui;
    }
    PG8_WAIT_V(0);
    if (wr == 0) PG8_BAR;
    PG8_BAR;
#undef PG8_SA
#undef PG8_SB
#undef PG8_STAGE
#undef PG8_LDA
#undef PG8_LDB
#undef PG8_MMA
#undef PG8_WAIT_V
#undef PG8_WAIT_L
#undef PG8_BAR
#undef PG8_SCHED
}
}
using pg8::Unit;
typedef f32x4 Acc[2][2][4][2];

typedef unsigned long long fix_t;
__device__ __forceinline__ fix_t to_fix(float v) { return (fix_t)(long long)(v * 4294967296.0f); }
__device__ __forceinline__ float from_fix(fix_t v) { return fmaf((float)(unsigned)v, 2.3283064365386963e-10f, (float)(int)(v >> 32)); }
__device__ __forceinline__ void fix_add(fix_t* p, float v) { __hip_atomic_fetch_add(p, to_fix(v), __ATOMIC_RELAXED, __HIP_MEMORY_SCOPE_AGENT); }
__device__ __forceinline__ f32x4 ld_fix4(const fix_t* p) { typedef unsigned long long u64x2 __attribute__((ext_vector_type(2))); const u64x2 a = *(const u64x2*)p, b = *(const u64x2*)(p + 2);
    return (f32x4){from_fix(a.x), from_fix(a.y), from_fix(b.x), from_fix(b.y)}; }
__device__ __forceinline__ void row_ln(const fix_t* st, int row, float& mu, float& rs) { const float s1 = from_fix(st[row]), s2 = from_fix(st[M_ + row]); mu = s1 * (1.0f / 2048.0f); rs = __builtin_amdgcn_rsqf(s2 * (1.0f / 2048.0f) - mu * mu + LN_EPS); }
template <bool PERM>
__device__ __forceinline__ void ln_correct(f32x4 (&acc)[2][2][4][2], const fix_t* st, const float* cs, const float* bw, int row0, int colbase) {
    f32x4 c4[2][2], b4[2][2];
#pragma unroll
    for (int bj = 0; bj < 2; ++bj)
#pragma unroll
        for (int n = 0; n < 2; ++n) { const int col = colbase + bj * 128 + (PERM ? 4 * n : 16 * n); c4[bj][n] = *(const f32x4*)(cs + col); b4[bj][n] = *(const f32x4*)(bw + col); }
#pragma unroll
    for (int ai = 0; ai < 2; ++ai) { fix_t r1[4], r2[4];
#pragma unroll
        for (int m = 0; m < 4; ++m) { const int row = row0 + ai * 128 + m * 16; r1[m] = st[row]; r2[m] = st[M_ + row]; }
#pragma unroll
        for (int m = 0; m < 4; ++m) { const float mu = from_fix(r1[m]) * (1.0f / 2048.0f), rs = __builtin_amdgcn_rsqf(from_fix(r2[m]) * (1.0f / 2048.0f) - mu * mu + LN_EPS);
#pragma unroll
            for (int bj = 0; bj < 2; ++bj)
#pragma unroll
                for (int n = 0; n < 2; ++n) acc[ai][bj][m][n] = (acc[ai][bj][m][n] - c4[bj][n] * mu) * rs + b4[bj][n]; } }
}

struct EpiIn {
    static constexpr bool PERM = true;
    bf16_t *cq, *ckv, *xl, *gg, *kpe; float* ssq; const float *cosT, *sinT; const fix_t* st; const float *cs, *bw;
    __device__ __forceinline__ void operator()(Acc& acc, const Unit& u, int wr, int wc, int fr, int fq) const {
        const int row0 = u.pm * 256 + wr * 64 + fr, pn = u.pn;
        ln_correct<true>(acc, st, cs, bw, row0, pn * 256 + wc * 32 + 8 * fq);
        if (pn < 4) {
            bf16_t* base = (pn < 2 ? cq : ckv); const int col0 = (pn & 1) * 256 + wc * 32 + 8 * fq;
#pragma unroll
            for (int ai = 0; ai < 2; ++ai)
#pragma unroll
                for (int m = 0; m < 4; ++m) { const int row = row0 + ai * 128 + m * 16; float s = 0.f;
#pragma unroll
                    for (int bj = 0; bj < 2; ++bj) { const f32x4 v0 = acc[ai][bj][m][0], v1 = acc[ai][bj][m][1];
                        s += (v0[0] * v0[0] + v0[1] * v0[1]) + (v0[2] * v0[2] + v0[3] * v0[3]) + (v1[0] * v1[0] + v1[1] * v1[1]) + (v1[2] * v1[2] + v1[3] * v1[3]);
                        *(u32x4*)(base + (size_t)row * 512 + col0 + bj * 128) = pack8(v0, v1); }
                    s = sum_fq(s);
                    if (fq == 0) ssq[(size_t)row * 16 + pn * 4 + wc] = s; }
        } else if (pn < 8) {
            const int col0 = (pn - 4) * 256 + wc * 32 + 8 * fq;
#pragma unroll
            for (int ai = 0; ai < 2; ++ai)
#pragma unroll
                for (int m = 0; m < 4; ++m) { const int row = row0 + ai * 128 + m * 16;
#pragma unroll
                    for (int bj = 0; bj < 2; ++bj) *(u32x4*)(xl + (size_t)row * 1024 + col0 + bj * 128) = pack8(acc[ai][bj][m][0], acc[ai][bj][m][1]); }
        } else if (pn < 12) {
            const int col0 = (pn - 8) * 256 + wc * 32 + 8 * fq;
#pragma unroll
            for (int ai = 0; ai < 2; ++ai)
#pragma unroll
                for (int m = 0; m < 4; ++m) { const int row = row0 + ai * 128 + m * 16;
#pragma unroll
                    for (int bj = 0; bj < 2; ++bj) { f32x4 v0 = acc[ai][bj][m][0], v1 = acc[ai][bj][m][1];
#pragma unroll
                        for (int j = 0; j < 4; ++j) { v0[j] = gelu_tanh(v0[j]); v1[j] = gelu_tanh(v1[j]); }
                        *(u32x4*)(gg + (size_t)row * 1024 + col0 + bj * 128) = pack8(v0, v1); } }
        } else if (wc == 0) {
#pragma unroll
            for (int ai = 0; ai < 2; ++ai) { f32x4 c0[4], c1[4], s0[4], s1[4];
#pragma unroll
                for (int m = 0; m < 4; ++m) { const size_t t = (size_t)(row0 + ai * 128 + m * 16) * 32 + 8 * fq;
                    c0[m] = *(const f32x4*)(cosT + t); c1[m] = *(const f32x4*)(cosT + t + 4); s0[m] = *(const f32x4*)(sinT + t); s1[m] = *(const f32x4*)(sinT + t + 4); }
#pragma unroll
                for (int m = 0; m < 4; ++m) { const int row = row0 + ai * 128 + m * 16;
                    const f32x4 a0 = acc[ai][0][m][0], a1 = acc[ai][0][m][1], b0 = acc[ai][1][m][0], b1 = acc[ai][1][m][1];
                    *(u32x4*)(kpe + (size_t)row * 64 + 8 * fq) = pack8(a0 * c0[m] - b0 * s0[m], a1 * c1[m] - b1 * s1[m]);
                    *(u32x4*)(kpe + (size_t)row * 64 + 32 + 8 * fq) = pack8(b0 * c0[m] + a0 * s0[m], b1 * c1[m] + a1 * s1[m]); } }
        }
    }
};
__device__ __forceinline__ void rows_rstd(const float* ssq8, int row0, float (&rs)[8]) {
#pragma unroll
    for (int h = 0; h < 2; ++h) { f32x4 a[4], b[4];
#pragma unroll
        for (int k = 0; k < 4; ++k) { const float* p = ssq8 + (size_t)(row0 + h * 128 + k * 16) * 16; a[k] = *(const f32x4*)p; b[k] = *(const f32x4*)(p + 4); }
#pragma unroll
        for (int k = 0; k < 4; ++k) { const float s = ((a[k][0] + a[k][1]) + (a[k][2] + a[k][3])) + ((b[k][0] + b[k][1]) + (b[k][2] + b[k][3])); rs[h * 4 + k] = __builtin_amdgcn_rsqf(s * (1.0f / 512.0f) + RMS_EPS); } }
}
struct EpiQ {
    static constexpr bool PERM = true;
    bf16_t* q; const float* ssq; const float *cosT, *sinT;
    __device__ __forceinline__ void operator()(Acc& acc, const Unit& u, int wr, int wc, int fr, int fq) const {
        const int row0 = u.pm * 256 + wr * 64 + fr, pn = u.pn;
        float rs[8]; rows_rstd(ssq, row0, rs);
        if (pn < 4) {
            const int col0 = pn * 256 + wc * 32 + 8 * fq;
#pragma unroll
            for (int ai = 0; ai < 2; ++ai)
#pragma unroll
                for (int m = 0; m < 4; ++m) { const int row = row0 + ai * 128 + m * 16; const float r = rs[ai * 4 + m];
#pragma unroll
                    for (int bj = 0; bj < 2; ++bj) *(u32x4*)(q + (size_t)row * 1536 + col0 + bj * 128) = pack8(acc[ai][bj][m][0] * r, acc[ai][bj][m][1] * r); }
        } else {
            const int head = 4 * (pn - 4) + wc;
#pragma unroll
            for (int kb = 0; kb < 4; ++kb) { f32x4 c0[2], c1[2], s0[2], s1[2];
#pragma unroll
                for (int j = 0; j < 2; ++j) { const int k = kb * 2 + j; const size_t t = (size_t)(row0 + (k >> 2) * 128 + (k & 3) * 16) * 32 + 8 * fq;
                    c0[j] = *(const f32x4*)(cosT + t); c1[j] = *(const f32x4*)(cosT + t + 4); s0[j] = *(const f32x4*)(sinT + t); s1[j] = *(const f32x4*)(sinT + t + 4); }
#pragma unroll
                for (int j = 0; j < 2; ++j) { const int k = kb * 2 + j, ai = k >> 2, m = k & 3; const int row = row0 + ai * 128 + m * 16; const float r = rs[k];
                    const f32x4 a0 = acc[ai][0][m][0] * r, a1 = acc[ai][0][m][1] * r, b0 = acc[ai][1][m][0] * r, b1 = acc[ai][1][m][1] * r;
                    *(u32x4*)(q + (size_t)row * 1536 + 1024 + head * 64 + 8 * fq) = pack8(a0 * c0[j] - b0 * s0[j], a1 * c1[j] - b1 * s1[j]);
                    *(u32x4*)(q + (size_t)row * 1536 + 1024 + head * 64 + 32 + 8 * fq) = pack8(b0 * c0[j] + a0 * s0[j], b1 * c1[j] + a1 * s1[j]); } }
        }
    }
};
struct EpiKV {
    static constexpr bool PERM = true;
    bf16_t* kv; const float* ssq;
    __device__ __forceinline__ void operator()(Acc& acc, const Unit& u, int wr, int wc, int fr, int fq) const {
        const int row0 = u.pm * 256 + wr * 64 + fr, col0 = u.pn * 256 + wc * 32 + 8 * fq;
        float rs[8]; rows_rstd(ssq + 8, row0, rs);
#pragma unroll
        for (int ai = 0; ai < 2; ++ai)
#pragma unroll
            for (int m = 0; m < 4; ++m) { const int row = row0 + ai * 128 + m * 16; const float r = rs[ai * 4 + m];
#pragma unroll
                for (int bj = 0; bj < 2; ++bj) *(u32x4*)(kv + (size_t)row * 2048 + col0 + bj * 128) = pack8(acc[ai][bj][m][0] * r, acc[ai][bj][m][1] * r); }
    }
};
struct EpiGate {
    static constexpr bool PERM = true;
    unsigned* au; const bf16_t* xc; const float *ba, *bi, *sp;
    __device__ __forceinline__ void operator()(Acc& acc, const Unit& u, int wr, int wc, int fr, int fq) const {
        const int row0 = u.pm * 256 + wr * 64 + fr, d = u.pn, ch0 = u.z * 128 + wc * 32 + 8 * fq;
        unsigned* aud = au + (size_t)d * M_ * 1024;
#pragma unroll
        for (int n = 0; n < 2; ++n) {
            const int ch = ch0 + 4 * n;
            const f32x4 bav = *(const f32x4*)(ba + d * 1024 + ch), biv = *(const f32x4*)(bi + d * 1024 + ch), spv = *(const f32x4*)(sp + d * 1024 + ch) * (-8.0f * 1.4426950408889634f);
            u32x2 xws[8];
#pragma unroll
            for (int k = 0; k < 8; ++k) xws[k] = *(const u32x2*)(xc + (size_t)(row0 + (k >> 2) * 128 + (k & 3) * 16) * 1024 + ch);
#pragma unroll
            for (int ai = 0; ai < 2; ++ai)
#pragma unroll
                for (int m = 0; m < 4; ++m) { const int row = row0 + ai * 128 + m * 16;
                    const u32x2 xw = xws[ai * 4 + m];
                    const float xv[4] = {bf_lo(xw.x), bf_hi(xw.x), bf_lo(xw.y), bf_hi(xw.y)};
                    u32x4 o;
#pragma unroll
                    for (int j = 0; j < 4; ++j) {
                        const float r = sigmoidf_(acc[ai][0][m][n][j] + bav[j]);
                        const float ig = sigmoidf_(acc[ai][1][m][n][j] + biv[j]);
                        const float a = __builtin_amdgcn_exp2f(r * spv[j]);
                        const float oma = 1.0f - a;
                        const float uu = __builtin_amdgcn_sqrtf(oma * (1.0f + a)) * ig * xv[j];
                        o[j] = cvt_pk_bf16(oma, uu); }
                    *(u32x4*)(aud + (size_t)row * 1024 + ch) = o; }
        }
    }
};
#ifndef RES_PF
#define RES_PF 2
#endif
struct EpiRes {
    static constexpr bool PERM = false;
    bf16_t* hb; const fix_t* st_old; const float *g, *b; fix_t* st_new;
    __device__ __forceinline__ void operator()(Acc& acc, const Unit& u, int wr, int wc, int fr, int fq) const {
        const int row0 = u.pm * 256 + wr * 64 + fr, col0 = u.pn * 256 + wc * 32 + 4 * fq;
        f32x4 gv[4], bv[4]; u32x2 P[RES_PF + 1][4]; float mus[8], rss[8];
#define RES_LOAD(k) do { const size_t off_ = (size_t)(row0 + ((k) >> 2) * 128 + ((k) & 3) * 16) * 2048 + col0; _Pragma("unroll") for (int c = 0; c < 4; ++c) P[(k) % (RES_PF + 1)][c] = *(const u32x2*)(hb + off_ + (c >> 1) * 128 + (c & 1) * 16); } while (0)
#pragma unroll
        for (int k = 0; k < RES_PF; ++k) RES_LOAD(k);
#pragma unroll
        for (int c = 0; c < 4; ++c) { gv[c] = *(const f32x4*)(g + col0 + (c >> 1) * 128 + (c & 1) * 16); bv[c] = *(const f32x4*)(b + col0 + (c >> 1) * 128 + (c & 1) * 16); }
#pragma unroll
        for (int h = 0; h < 2; ++h) { fix_t r1[4], r2[4];
#pragma unroll
            for (int k = 0; k < 4; ++k) { const int row = row0 + h * 128 + k * 16; r1[k] = st_old[row]; r2[k] = st_old[M_ + row]; }
#pragma unroll
            for (int k = 0; k < 4; ++k) { mus[h * 4 + k] = from_fix(r1[k]) * (1.0f / 2048.0f); rss[h * 4 + k] = __builtin_amdgcn_rsqf(from_fix(r2[k]) * (1.0f / 2048.0f) - mus[h * 4 + k] * mus[h * 4 + k] + LN_EPS); } }
#pragma unroll
        for (int k = 0; k < 8; ++k) {
            if (k + RES_PF < 8) RES_LOAD(k + RES_PF);
            const int ai = k >> 2, m = k & 3; const size_t off = (size_t)(row0 + ai * 128 + m * 16) * 2048 + col0;
            const float mu = mus[k], rs = rss[k];
            float a1 = 0.f, a2 = 0.f;
#pragma unroll
            for (int c = 0; c < 4; ++c) { const int cc = (c >> 1) * 128 + (c & 1) * 16; const u32x2 pw = P[k % (RES_PF + 1)][c];
                const f32x4 Pf = {bf_lo(pw.x), bf_hi(pw.x), bf_lo(pw.y), bf_hi(pw.y)};
                const f32x4 v = ((Pf - mu) * rs * gv[c] + bv[c]) * ALPHA + acc[ai][c >> 1][m][c & 1];
                u32x2 w; w.x = cvt_pk_bf16(v[0], v[1]); w.y = cvt_pk_bf16(v[2], v[3]); *(u32x2*)(hb + off + cc) = w;
                a1 += (v[0] + v[1]) + (v[2] + v[3]); a2 += (v[0] * v[0] + v[1] * v[1]) + (v[2] * v[2] + v[3] * v[3]); }
            a1 = sum_fq(a1); a2 = sum_fq(a2);
            { const int row = row0 + ai * 128 + m * 16; if (fq == 0) fix_add(st_new + row, a1); else if (fq == 1) fix_add(st_new + M_ + row, a2); }
        }
#undef RES_LOAD
    }
};
struct EpiUp {
    static constexpr bool PERM = true;
    bf16_t* f; const fix_t* st; const float *cs, *bw;
    __device__ __forceinline__ void operator()(Acc& acc, const Unit& u, int wr, int wc, int fr, int fq) const {
        const int row0 = u.pm * 256 + wr * 64 + fr, col0 = u.pn * 256 + wc * 32 + 8 * fq;
        ln_correct<true>(acc, st, cs, bw, row0, col0);
#pragma unroll
        for (int ai = 0; ai < 2; ++ai)
#pragma unroll
            for (int m = 0; m < 4; ++m) { const int row = row0 + ai * 128 + m * 16;
#pragma unroll
                for (int bj = 0; bj < 2; ++bj) { f32x4 v0 = acc[ai][bj][m][0], v1 = acc[ai][bj][m][1];
#pragma unroll
                    for (int j = 0; j < 4; ++j) { const float a = fmaxf(v0[j], 0.f), b = fmaxf(v1[j], 0.f); v0[j] = a * a; v1[j] = b * b; }
                    __builtin_nontemporal_store(pack8(v0, v1), (u32x4*)(f + (size_t)row * 8192 + col0 + bj * 128)); } }
    }
};

namespace att {
constexpr int NW = 8, QBLK = 32, KVBLK = 64;
constexpr float SCALE = 0.07216878364870323f;
constexpr float THR = 8.f;
#ifndef ATT_SDEPTH
#define ATT_SDEPTH 1
#endif
constexpr int SDEPTH = ATT_SDEPTH;
constexpr int SHM_V = KVBLK * 128 * 2, SHM_K = KVBLK * 128 * 2, SHM_R = KVBLK * 64 * 2;
constexpr int OFF_V = 0, OFF_K = 2 * SHM_V, OFF_R = OFF_K + 2 * SHM_K, OFF_WS = OFF_R + 2 * SHM_R, OFF_QR = OFF_WS + NW * 64 * 4, SHM_ATTN = OFF_QR + 256 * 128;
#define KSWZ(row, colB) ((row) * 256 + ((colB) ^ (((row) & 7) << 4)))
#define RSWZ(row, colB) ((row) * 128 + ((colB) ^ (((row) & 7) << 4)))
#define SBAR() __builtin_amdgcn_sched_barrier(0)
__device__ __forceinline__ int crow(int r, int hi) { return (r & 3) + 8 * (r >> 2) + 4 * hi; }
__device__ __forceinline__ void partialSM(f32x16& p0, f32x16& p1, float& m_reg, float& mn, float& alpha) {
    constexpr float C = SCALE * 1.4426950408889634f;
    float pmax = p0[0];
#pragma unroll
    for (int r = 1; r < 16; ++r) pmax = fmaxf(pmax, p0[r]);
#pragma unroll
    for (int r = 0; r < 16; ++r) pmax = fmaxf(pmax, p1[r]);
    { auto rr = __builtin_amdgcn_permlane32_swap(__float_as_uint(pmax), __float_as_uint(pmax), false, false);
      pmax = fmaxf(__uint_as_float(rr[0]), __uint_as_float(rr[1])); }
    if (__builtin_expect(__all(pmax - m_reg <= THR / SCALE), 1)) { mn = m_reg; alpha = 1.f; }
    else { mn = fmaxf(m_reg, pmax); alpha = __builtin_amdgcn_exp2f((m_reg - mn) * C); m_reg = mn; }
    const float mnC = -mn * C;
#pragma unroll
    for (int r = 0; r < 16; ++r) p0[r] = fmaf(p0[r], C, mnC);
#pragma unroll
    for (int r = 0; r < 16; ++r) p1[r] = fmaf(p1[r], C, mnC);
#pragma unroll
    for (int r = 0; r < 16; ++r) p0[r] = __builtin_amdgcn_exp2f(p0[r]);
}
__device__ __forceinline__ void finishSM(f32x16& p0, f32x16& p1, float alpha, float& l_reg, bf16x8& pa0, bf16x8& pa1, bf16x8& pa2, bf16x8& pa3) {
#pragma unroll
    for (int r = 0; r < 16; ++r) p1[r] = __builtin_amdgcn_exp2f(p1[r]);
    float ps = 0;
#pragma unroll
    for (int r = 0; r < 16; ++r) ps += p0[r];
#pragma unroll
    for (int r = 0; r < 16; ++r) ps += p1[r];
    { auto rr = __builtin_amdgcn_permlane32_swap(__float_as_uint(ps), __float_as_uint(ps), false, false);
      ps = __uint_as_float(rr[0]) + __uint_as_float(rr[1]); }
    l_reg = l_reg * alpha + ps;
#define PK4(P, BASE, OUT) do { unsigned a0 = cvt_pk_bf16(P[BASE + 0], P[BASE + 1]), a1 = cvt_pk_bf16(P[BASE + 2], P[BASE + 3]);   \
    unsigned b0 = cvt_pk_bf16(P[BASE + 4], P[BASE + 5]), b1 = cvt_pk_bf16(P[BASE + 6], P[BASE + 7]);                              \
    auto r0 = __builtin_amdgcn_permlane32_swap(a0, b0, false, false); auto r1 = __builtin_amdgcn_permlane32_swap(a1, b1, false, false); \
    u32x4 w = {r0[0], r1[0], r0[1], r1[1]}; OUT = *reinterpret_cast<bf16x8*>(&w); } while (0)
    PK4(p0, 0, pa0); PK4(p0, 8, pa1); PK4(p1, 0, pa2); PK4(p1, 8, pa3);
#undef PK4
}
__device__ __forceinline__ void qkt(f32x16& p0, f32x16& p1, const char* Ks, const char* Rs, const bf16x8* qr, const char* Qrl, int r32, int hi) {
    p0 = f32x16{}; p1 = f32x16{};
#pragma unroll
    for (int d0 = 0; d0 < 8; ++d0) { const int cb = (d0 * 16 + hi * 8) * 2;
        const bf16x8 b0 = *reinterpret_cast<const bf16x8*>(Ks + KSWZ(r32, cb));
        const bf16x8 b1 = *reinterpret_cast<const bf16x8*>(Ks + KSWZ(32 + r32, cb));
        p0 = __builtin_amdgcn_mfma_f32_32x32x16_bf16(b0, qr[d0], p0, 0, 0, 0);
        p1 = __builtin_amdgcn_mfma_f32_32x32x16_bf16(b1, qr[d0], p1, 0, 0, 0); }
#pragma unroll
    for (int d0 = 0; d0 < 4; ++d0) { const int cb = (d0 * 16 + hi * 8) * 2;
        const bf16x8 b0 = *reinterpret_cast<const bf16x8*>(Rs + RSWZ(r32, cb));
        const bf16x8 b1 = *reinterpret_cast<const bf16x8*>(Rs + RSWZ(32 + r32, cb));
        const bf16x8 qv = *reinterpret_cast<const bf16x8*>(Qrl + (cb ^ ((r32 & 7) << 4)));
        p0 = __builtin_amdgcn_mfma_f32_32x32x16_bf16(b0, qv, p0, 0, 0, 0);
        p1 = __builtin_amdgcn_mfma_f32_32x32x16_bf16(b1, qv, p1, 0, 0, 0); }
}
__device__ __forceinline__ int v_st(int k, int c) { const int kk = (k & ~0xC) | ((k & 4) << 1) | ((k & 8) >> 1); return ((kk >> 3) * 4 + (c >> 5)) * 512 + ((kk & 7) * 32 + (c & 31)) * 2; }
__device__ __forceinline__ int v_rd_base(int lane) { return ((lane & 3) << 3) | (((lane >> 2) & 3) << 6) | (((lane >> 4) & 1) << 5) | (((lane >> 5) & 1) << 8); }
constexpr int v_rd_off(int d0, int ks, int half) { return d0 * 512 + ks * 4096 + half * 2048; }
template <int OFF> __device__ __forceinline__ s16x4 tr_read(int vb) {
    s16x4 r; asm volatile("ds_read_b64_tr_b16 %0, %1 offset:%2" : "=&v"(r) : "v"(vb), "i"(OFF) : "memory"); return r;
}
template <int D0> __device__ __forceinline__ void pv_one(f32x16& od, int vb, bf16x8 pa0, bf16x8 pa1, bf16x8 pa2, bf16x8 pa3) {
    const s16x4 l0 = tr_read<v_rd_off(D0, 0, 0)>(vb), h0 = tr_read<v_rd_off(D0, 0, 1)>(vb), l1 = tr_read<v_rd_off(D0, 1, 0)>(vb), h1 = tr_read<v_rd_off(D0, 1, 1)>(vb);
    const s16x4 l2 = tr_read<v_rd_off(D0, 2, 0)>(vb), h2 = tr_read<v_rd_off(D0, 2, 1)>(vb), l3 = tr_read<v_rd_off(D0, 3, 0)>(vb), h3 = tr_read<v_rd_off(D0, 3, 1)>(vb);
    asm volatile("s_waitcnt lgkmcnt(0)" ::: "memory"); SBAR();
#define PK(L, H) (bf16x8){L[0], L[1], L[2], L[3], H[0], H[1], H[2], H[3]}
    od = __builtin_amdgcn_mfma_f32_32x32x16_bf16(pa0, PK(l0, h0), od, 0, 0, 0);
    od = __builtin_amdgcn_mfma_f32_32x32x16_bf16(pa1, PK(l1, h1), od, 0, 0, 0);
    od = __builtin_amdgcn_mfma_f32_32x32x16_bf16(pa2, PK(l2, h2), od, 0, 0, 0);
    od = __builtin_amdgcn_mfma_f32_32x32x16_bf16(pa3, PK(l3, h3), od, 0, 0, 0);
#undef PK
}
__device__ __forceinline__ void pv_d0(f32x16* o, int vb, bf16x8 pa0, bf16x8 pa1, bf16x8 pa2, bf16x8 pa3) {
    pv_one<0>(o[0], vb, pa0, pa1, pa2, pa3); pv_one<1>(o[1], vb, pa0, pa1, pa2, pa3); pv_one<2>(o[2], vb, pa0, pa1, pa2, pa3); pv_one<3>(o[3], vb, pa0, pa1, pa2, pa3);
}
__device__ __forceinline__ void attn_unit(const bf16_t* __restrict__ Qn, const bf16_t* __restrict__ Qr, const bf16_t* __restrict__ Kh, const bf16_t* __restrict__ Rh,
                                          bf16_t* __restrict__ Ob, int seq, char* lds, int wv) {
    const int tid = otid(wv), wid = tid >> 6, lane = tid & 63, r32 = lane & 31, hi = lane >> 5;
    char* V_lds = lds + OFF_V; char* K_lds = lds + OFF_K; char* R_lds = lds + OFF_R;
    float* ws = (float*)(lds + OFF_WS) + wid * 64; float* li_l = ws; float* al_l = ws + 32;
    float m_reg = -1e30f, l_reg = 0; f32x16 o[4] = {}; bf16x8 qr[8];
    char* Qrl = lds + OFF_QR + (wid * QBLK + r32) * 128;
    {
        const bf16_t* Qw = Qn + (size_t)(wid * QBLK + r32) * 1536 + hi * 8;
#pragma unroll
        for (int d0 = 0; d0 < 8; ++d0) qr[d0] = *reinterpret_cast<const bf16x8*>(Qw + d0 * 16);
        const bf16_t* Qw2 = Qr + (size_t)(wid * QBLK + r32) * 1536 + hi * 8;
#pragma unroll
        for (int d0 = 0; d0 < 4; ++d0) { const bf16x8 t = *reinterpret_cast<const bf16x8*>(Qw2 + d0 * 16); *reinterpret_cast<bf16x8*>(Qrl + (((d0 * 16 + hi * 8) * 2) ^ ((r32 & 7) << 4))) = t; }
    }
    const int sr = tid >> 4, sc = (tid & 15) * 8, vst0 = v_st(sr, sc), vst1 = v_st(32 + sr, sc);
    const int rr_ = tid >> 3, rc = (tid & 7) * 8;
    const int vb0 = (int)(uintptr_t)V_lds + v_rd_base(lane);
    struct { bf16x8 vs0, vs1, ks0, ks1, rs; } sr_[SDEPTH];
#define SLOAD(i, k0) do { sr_[i].vs0 = *(const bf16x8*)(&Kh[(size_t)((k0) + sr) * 2048 + 128 + sc]); sr_[i].vs1 = *(const bf16x8*)(&Kh[(size_t)((k0) + 32 + sr) * 2048 + 128 + sc]); \
    sr_[i].ks0 = *(const bf16x8*)(&Kh[(size_t)((k0) + sr) * 2048 + sc]); sr_[i].ks1 = *(const bf16x8*)(&Kh[(size_t)((k0) + 32 + sr) * 2048 + sc]); \
    sr_[i].rs = *(const bf16x8*)(&Rh[(size_t)((k0) + rr_) * 64 + rc]); } while (0)
#define SWRITE(b, i) do { *(bf16x8*)(V_lds + (b) * SHM_V + vst0) = sr_[i].vs0;          \
    *(bf16x8*)(V_lds + (b) * SHM_V + vst1) = sr_[i].vs1; const int kc = sc * 2;               \
    *(bf16x8*)(K_lds + (b) * SHM_K + KSWZ(sr, kc)) = sr_[i].ks0;                       \
    *(bf16x8*)(K_lds + (b) * SHM_K + KSWZ(32 + sr, kc)) = sr_[i].ks1;                  \
    *(bf16x8*)(R_lds + (b) * SHM_R + RSWZ(rr_, rc * 2)) = sr_[i].rs; } while (0)
#define SWAIT() do { if constexpr (SDEPTH == 2) asm volatile("s_waitcnt vmcnt(5)" ::: "memory"); else asm volatile("s_waitcnt vmcnt(0)" ::: "memory"); } while (0)
#define RESC(a) do { if (__any((a) < 1.f)) { if (hi == 0) al_l[r32] = (a); asm volatile("s_waitcnt lgkmcnt(0)" ::: "memory"); \
    _Pragma("unroll") for (int d = 0; d < 4; ++d) _Pragma("unroll") for (int r = 0; r < 16; ++r) o[d][r] *= al_l[crow(r, hi)]; } } while (0)
    f32x16 pA0, pA1, pB0, pB1; float mnA, mnB, alA, alB; bf16x8 pa0, pa1, pa2, pa3; const int NT = seq / KVBLK;
    constexpr int SE = 0, SO = SDEPTH - 1;
    SLOAD(SE, 0); asm volatile("s_waitcnt vmcnt(0)" ::: "memory"); SWRITE(0, SE); __syncthreads();
    qkt(pA0, pA1, K_lds, R_lds, qr, Qrl, r32, hi); partialSM(pA0, pA1, m_reg, mnA, alA);
    SLOAD(SO, KVBLK); if constexpr (SDEPTH == 2) { if (2 < NT) SLOAD(SE, 2 * KVBLK); }
    SWAIT(); SWRITE(1, SO); __syncthreads();
    for (int j = 1; j + 1 < NT; j += 2) {
        SBAR(); qkt(pB0, pB1, K_lds + SHM_K, R_lds + SHM_R, qr, Qrl, r32, hi);
        finishSM(pA0, pA1, alA, l_reg, pa0, pa1, pa2, pa3); SBAR();
        SLOAD(SO, (j + SDEPTH) * KVBLK); SBAR();
        pv_d0(o, vb0, pa0, pa1, pa2, pa3); partialSM(pB0, pB1, m_reg, mnB, alB);
        __syncthreads(); SWAIT(); SWRITE(0, SE);
        RESC(alB); __syncthreads();
        SBAR(); qkt(pA0, pA1, K_lds, R_lds, qr, Qrl, r32, hi);
        finishSM(pB0, pB1, alB, l_reg, pa0, pa1, pa2, pa3); SBAR();
        if (SDEPTH == 1 || j + 3 < NT) SLOAD(SE, (j + 1 + SDEPTH) * KVBLK); SBAR();
        pv_d0(o, vb0 + (int)SHM_V, pa0, pa1, pa2, pa3); partialSM(pA0, pA1, m_reg, mnA, alA);
        __syncthreads(); SWAIT(); SWRITE(1, SO);
        RESC(alA); __syncthreads();
    }
    SBAR(); qkt(pB0, pB1, K_lds + SHM_K, R_lds + SHM_R, qr, Qrl, r32, hi);
    finishSM(pA0, pA1, alA, l_reg, pa0, pa1, pa2, pa3); SBAR();
    pv_d0(o, vb0, pa0, pa1, pa2, pa3); partialSM(pB0, pB1, m_reg, mnB, alB);
    __syncthreads(); RESC(alB);
    finishSM(pB0, pB1, alB, l_reg, pa0, pa1, pa2, pa3); SBAR();
    pv_d0(o, vb0 + (int)SHM_V, pa0, pa1, pa2, pa3);
    if (hi == 0) li_l[r32] = l_reg; asm volatile("s_waitcnt lgkmcnt(0)" ::: "memory");
    float rli[16];
#pragma unroll
    for (int r = 0; r < 16; ++r) rli[r] = __builtin_amdgcn_rcpf(li_l[crow(r, hi)]);
    bf16_t* Ow = Ob + (size_t)(wid * QBLK) * 2048;
#pragma unroll
    for (int r = 0; r < 16; ++r) { const int orow = crow(r, hi);
#pragma unroll
        for (int d0 = 0; d0 < 4; ++d0) Ow[(size_t)orow * 2048 + d0 * 32 + r32] = (bf16_t)(cvt_pk_bf16(o[d0][r] * rli[r], 0.f) & 0xffffu); }
#undef SLOAD
#undef SWRITE
#undef SWAIT
#undef RESC
}
}

__device__ __forceinline__ void x_pass(const float* src, bf16_t* dstb, fix_t* st, int wv) {
    const int tid_ = otid(wv), lane = tid_ & 63, wave = tid_ >> 6;
    for (int row = blockIdx.x * 8 + wave; row < M_; row += gridDim.x * 8) {
        const float* s = src + (size_t)row * 2048; f32x4 v[8]; float s1 = 0.f, s2 = 0.f;
#pragma unroll
        for (int i = 0; i < 8; ++i) { v[i] = *(const f32x4*)(s + i * 256 + lane * 4); s1 += (v[i][0] + v[i][1]) + (v[i][2] + v[i][3]); s2 += (v[i][0] * v[i][0] + v[i][1] * v[i][1]) + (v[i][2] * v[i][2] + v[i][3] * v[i][3]); }
        s1 = wave_sum(s1, lane); s2 = wave_sum(s2, lane);
        if (lane == 0) { st[row] = to_fix(s1); st[M_ + row] = to_fix(s2); }
#pragma unroll
        for (int i = 0; i < 8; ++i) { u32x2 w; w.x = cvt_pk_bf16(v[i][0], v[i][1]); w.y = cvt_pk_bf16(v[i][2], v[i][3]); *(u32x2*)(dstb + (size_t)row * 2048 + i * 256 + lane * 4) = w; }
    }
}
__device__ __forceinline__ void ln_final(float* out, const bf16_t* hb, const fix_t* st, const float* g, const float* b, int wv) {
    const int tid = otid(wv);
    for (int i = blockIdx.x * 512 + tid; i < M_ * 512; i += gridDim.x * 512) {
        const int row = i >> 9, c = (i & 511) * 4; float mu, rs; row_ln(st, row, mu, rs);
        const u32x2 pw = *(const u32x2*)(hb + (size_t)i * 4); const f32x4 P = {bf_lo(pw.x), bf_hi(pw.x), bf_lo(pw.y), bf_hi(pw.y)}, g4 = *(const f32x4*)(g + c), b4 = *(const f32x4*)(b + c);
        *(f32x4*)(out + (size_t)i * 4) = (P - mu) * rs * g4 + b4;
    }
}
__device__ __forceinline__ int colmap(int mode, int n) {
    if (mode == 0) { if (n < 1024) return n; if (n < 2048) return 1088 + (n - 1024); if (n < 3072) return 2112 + (n - 2048);
        const int t = n - 3072, bj = t >> 7, r = t & 127; return r < 32 ? 1024 + bj * 32 + r : -1; }
    if (mode == 1) { if (n < 1024) return (n >> 7) * 192 + (n & 127);
        const int t = n - 1024, tile = t >> 8, bj = (t >> 7) & 1, wc = (t >> 5) & 3, i = t & 31; return (4 * tile + wc) * 192 + 128 + bj * 32 + i; }
    return n;
}
__device__ __forceinline__ void cvt_tile(const float* W, int ldw, bf16_t* Bt, int ldb, int n0, int k0, int mode, const float* kscale, float* T, int wv) {
    const int tid = otid(wv), n4 = (tid & 31) * 4, kq = tid >> 5, src = colmap(mode, n0 + n4);
    f32x4 v[8];
#pragma unroll
    for (int i = 0; i < 8; ++i) { const int kk = kq + 16 * i; v[i] = *(const f32x4*)(W + (size_t)(k0 + kk) * ldw + (src >= 0 ? src : 0)); }
    float ksc[8];
#pragma unroll
    for (int i = 0; i < 8; ++i) ksc[i] = kscale ? kscale[k0 + kq + 16 * i] : 1.0f;
#pragma unroll
    for (int i = 0; i < 8; ++i) v[i] = v[i] * (src >= 0 ? ksc[i] : 0.0f);
#pragma unroll
    for (int i = 0; i < 8; ++i)
#pragma unroll
        for (int j = 0; j < 4; ++j) T[(n4 + j) * 129 + kq + 16 * i] = v[i][j];
    __syncthreads();
    { const int n2 = tid >> 2, ks = (tid & 3) * 32; const float* t = T + n2 * 129 + ks; bf16_t* dst = Bt + (size_t)(n0 + n2) * ldb + k0 + ks;
#pragma unroll
      for (int i = 0; i < 4; ++i) { u32x4 w; w.x = cvt_pk_bf16(t[i * 8 + 0], t[i * 8 + 1]); w.y = cvt_pk_bf16(t[i * 8 + 2], t[i * 8 + 3]); w.z = cvt_pk_bf16(t[i * 8 + 4], t[i * 8 + 5]); w.w = cvt_pk_bf16(t[i * 8 + 6], t[i * 8 + 7]);
          *(u32x4*)(dst + i * 8) = w; } }
    __syncthreads();
}
constexpr int CT0 = 26 * 16, CT1 = CT0 + 12 * 4, CT2 = CT1 + 16 * 4, CT3 = CT2 + 32, CT4 = CT3 + 16 * 16, CT5 = CT4 + 64 * 16, CT6 = CT5 + 16 * 64;
__device__ __forceinline__ void convert_weights(const Params& p, int l, int t0, int t1, float* T, int wv) {
    unsigned char* ws = p.ws;
    const float* ing = l == 0 ? p.in[2] : p.in[21] + (size_t)(l - 1) * 2048;
    for (int t = t0 + blockIdx.x; t < t1; t += gridDim.x) {
        if (t < CT0) { const int nt = t % 26, kt = t / 26; cvt_tile(p.in[4] + (size_t)l * 2048 * NIN, NIN, (bf16_t*)(ws + W_IN), 2048, nt * 128, kt * 128, 0, ing, T, wv); }
        else if (t < CT1) { const int u = t - CT0, nt = u % 12, kt = u / 12; cvt_tile(p.in[7] + (size_t)l * 512 * 1536, 1536, (bf16_t*)(ws + W_UQ), 512, nt * 128, kt * 128, 1, p.in[5] + l * 512, T, wv); }
        else if (t < CT2) { const int u = t - CT1, nt = u % 16, kt = u / 16; cvt_tile(p.in[8] + (size_t)l * 512 * 2048, 2048, (bf16_t*)(ws + W_UKV), 512, nt * 128, kt * 128, 2, p.in[6] + l * 512, T, wv); }
        else if (t < CT3) { const int mat = t - CT2, gate = mat & 1, h = (mat >> 1) & 7, d = mat >> 4;
            cvt_tile((gate ? p.in[13] : p.in[11]) + ((size_t)((l * 2 + d) * 8 + h)) * 128 * 128, 128, (bf16_t*)(ws + W_G) + (size_t)(h * 512 + d * 256 + gate * 128) * 128, 128, 0, 0, 2, nullptr, T, wv); }
        else if (t < CT4) { const int u = t - CT3, nt = u % 16, kt = u / 16; cvt_tile(p.in[16] + (size_t)l * 2048 * 2048, 2048, (bf16_t*)(ws + W_OUT), 2048, nt * 128, kt * 128, 2, nullptr, T, wv); }
        else if (t < CT5) { const int u = t - CT4, nt = u % 64, kt = u / 64; cvt_tile(p.in[19] + (size_t)l * 2048 * 8192, 8192, (bf16_t*)(ws + W_UP), 2048, nt * 128, kt * 128, 2, p.in[17] + (size_t)l * 2048, T, wv); }
        else { const int u = t - CT5, nt = u % 16, kt = u / 16; cvt_tile(p.in[20] + (size_t)l * 8192 * 2048, 2048, (bf16_t*)(ws + W_DN), 8192, nt * 128, kt * 128, 2, nullptr, T, wv); }
    }
}
__device__ __forceinline__ void colsum_pass(const bf16_t* Bt, int N, const float* lg, const float* lb, float* cs, float* bw, int wv) {
    const int tid = otid(wv), lane = tid & 63, wave = tid >> 6;
    float ratio[32];
#pragma unroll
    for (int i = 0; i < 4; ++i)
#pragma unroll
        for (int j = 0; j < 8; ++j) { const int k = i * 512 + lane * 8 + j; ratio[i * 8 + j] = lb[k] * __builtin_amdgcn_rcpf(lg[k]); }
    for (int n = blockIdx.x * 8 + wave; n < N; n += gridDim.x * 8) {
        u32x4 w[4];
#pragma unroll
        for (int i = 0; i < 4; ++i) w[i] = *(const u32x4*)(Bt + (size_t)n * 2048 + i * 512 + lane * 8);
        float c = 0.f, bb = 0.f;
#pragma unroll
        for (int i = 0; i < 4; ++i) { const float v[8] = {bf_lo(w[i].x), bf_hi(w[i].x), bf_lo(w[i].y), bf_hi(w[i].y), bf_lo(w[i].z), bf_hi(w[i].z), bf_lo(w[i].w), bf_hi(w[i].w)};
#pragma unroll
            for (int j = 0; j < 8; ++j) { c += v[j]; bb += v[j] * ratio[i * 8 + j]; } }
        c = wave_sum(c, lane); bb = wave_sum(bb, lane);
        if (lane == 0) { cs[n] = c; bw[n] = bb; }
    }
}
__device__ __forceinline__ void colsum_in(const Params& p, int l, int wv) { float* csb = (float*)(p.ws + WS_CSB) + (size_t)l * CSB_L;
    colsum_pass((const bf16_t*)(p.ws + W_IN), NINP, l == 0 ? p.in[2] : p.in[21] + (size_t)(l - 1) * 2048, l == 0 ? p.in[3] : p.in[22] + (size_t)(l - 1) * 2048, csb + CSB_IN, csb + CSB_IN + NINP, wv); }
__device__ __forceinline__ void colsum_up(const Params& p, int l, int wv) { float* csb = (float*)(p.ws + WS_CSB) + (size_t)l * CSB_L;
    colsum_pass((const bf16_t*)(p.ws + W_UP), DFF, p.in[17] + (size_t)l * 2048, p.in[18] + (size_t)l * 2048, csb + CSB_UP, csb + CSB_UP + DFF, wv); }
__device__ __forceinline__ void make_tables(const Params& p, int wv) {
    const int* pos = (const int*)p.in[1]; float* cosT = (float*)(p.ws + WS_COS); float* sinT = (float*)(p.ws + WS_SIN); float* sp = (float*)(p.ws + WS_SP);
    const int tid = otid(wv);
    for (int i = blockIdx.x * 512 + tid; i < M_ * 32; i += gridDim.x * 512) {
        const int row = i >> 5, k = i & 31; const float inv = powf(10000.0f, -(float)(2 * k) / 64.0f); const float ang = (float)pos[row] * inv;
        cosT[i] = cosf(ang); sinT[i] = sinf(ang); }
    for (int i = blockIdx.x * 512 + tid; i < DEPTH * 2 * 1024; i += gridDim.x * 512) { const float x = -p.in[15][i];
        sp[i] = fmaxf(x, 0.f) + log1pf(expf(-fabsf(x))); }
}
__device__ __forceinline__ void conv_phase(const Params& p, int l, int wv) {
    const bf16_t* __restrict__ xl = (const bf16_t*)(p.ws + WS_XL); bf16_t* __restrict__ xc = (bf16_t*)(p.ws + WS_XC);
    const float* cw = p.in[9] + (size_t)l * 4 * 1024; const float* cb = p.in[10] + (size_t)l * 1024;
    const int tid = otid(wv);
    for (int i = blockIdx.x * 512 + tid; i < M_ * 128; i += gridDim.x * 512) {
        const int row = i >> 7, c0 = (i & 127) * 8, t = row & (SEQ - 1);
        u32x4 xw[4]; f32x4 w0[4], w1[4];
#pragma unroll
        for (int k = 0; k < 4; ++k) { const int tt = t - 2 + k; const bool ok = (tt >= 0) && (tt < SEQ); const int rr = ok ? row - 2 + k : row;
            xw[k] = *(const u32x4*)(xl + (size_t)rr * 1024 + c0);
            w0[k] = *(const f32x4*)(cw + k * 1024 + c0); w1[k] = *(const f32x4*)(cw + k * 1024 + c0 + 4);
            if (!ok) { w0[k] = (f32x4){0.f, 0.f, 0.f, 0.f}; w1[k] = (f32x4){0.f, 0.f, 0.f, 0.f}; } }
        const f32x4 b0 = *(const f32x4*)(cb + c0), b1 = *(const f32x4*)(cb + c0 + 4);
        float acc[8] = {b0[0], b0[1], b0[2], b0[3], b1[0], b1[1], b1[2], b1[3]};
#pragma unroll
        for (int k = 0; k < 4; ++k) {
            acc[0] += w0[k][0] * bf_lo(xw[k].x); acc[1] += w0[k][1] * bf_hi(xw[k].x); acc[2] += w0[k][2] * bf_lo(xw[k].y); acc[3] += w0[k][3] * bf_hi(xw[k].y);
            acc[4] += w1[k][0] * bf_lo(xw[k].z); acc[5] += w1[k][1] * bf_hi(xw[k].z); acc[6] += w1[k][2] * bf_lo(xw[k].w); acc[7] += w1[k][3] * bf_hi(xw[k].w); }
        u32x4 o; o.x = cvt_pk_bf16(acc[0], acc[1]); o.y = cvt_pk_bf16(acc[2], acc[3]); o.z = cvt_pk_bf16(acc[4], acc[5]); o.w = cvt_pk_bf16(acc[6], acc[7]);
        *(u32x4*)(xc + (size_t)row * 1024 + c0) = o;
    }
}
__device__ __forceinline__ void scan_local(const Params& p, int wv) {
    const unsigned* au = (const unsigned*)(p.ws + WS_AU); f32x4* ph = (f32x4*)(p.ws + WS_PH); const int tid = otid(wv);
    for (int it = blockIdx.x; it < 2 * 8 * 64; it += gridDim.x) {
        const int c = it & 63, b = (it >> 6) & 7, d = it >> 9;
        const u32x2* __restrict__ src = (const u32x2*)(au + (size_t)d * M_ * 1024 + (size_t)(b * SEQ + c * 64) * 1024) + tid;
        float h0 = 0.f, h1 = 0.f, P0 = 1.f, P1 = 1.f;
        const long step = d ? -512 : 512; const u32x2* q = src + (d ? (size_t)63 * 512 : 0);
        u32x2 wa[16], wb[16];
#pragma unroll
        for (int j = 0; j < 16; ++j) wa[j] = q[(long)j * step];
#pragma unroll
        for (int bt = 0; bt < 4; bt += 2) {
#pragma unroll
            for (int j = 0; j < 16; ++j) wb[j] = q[(long)((bt + 1) * 16 + j) * step];
#pragma unroll
            for (int j = 0; j < 16; ++j) { const float a0 = 1.0f - bf_lo(wa[j].x), a1 = 1.0f - bf_lo(wa[j].y); h0 = a0 * h0 + bf_hi(wa[j].x); h1 = a1 * h1 + bf_hi(wa[j].y); P0 *= a0; P1 *= a1; }
            if (bt + 2 < 4) {
#pragma unroll
                for (int j = 0; j < 16; ++j) wa[j] = q[(long)((bt + 2) * 16 + j) * step]; }
#pragma unroll
            for (int j = 0; j < 16; ++j) { const float a0 = 1.0f - bf_lo(wb[j].x), a1 = 1.0f - bf_lo(wb[j].y); h0 = a0 * h0 + bf_hi(wb[j].x); h1 = a1 * h1 + bf_hi(wb[j].y); P0 *= a0; P1 *= a1; }
        }
        ph[(size_t)((d * 8 + b) * 64 + c) * 512 + tid] = (f32x4){P0, h0, P1, h1};
    }
}
__device__ __forceinline__ void scan_apply(const Params& p, int wv) {
    const unsigned* au = (const unsigned*)(p.ws + WS_AU); const f32x4* ph = (const f32x4*)(p.ws + WS_PH);
    const bf16_t* gg = (const bf16_t*)(p.ws + WS_GG); bf16_t* ycat = (bf16_t*)(p.ws + WS_YCAT); const int tid = otid(wv);
    for (int it = blockIdx.x; it < 8 * 64; it += gridDim.x) {
        const int c = it & 63, b = it >> 6;
        float Hf0 = 0.f, Hf1 = 0.f, Hb0 = 0.f, Hb1 = 0.f;
        { const f32x4* pf = ph + (size_t)((0 * 8 + b) * 64) * 512 + tid;
          for (int c0 = 0; c0 < c; c0 += 8) { f32x4 e[8];
#pragma unroll
              for (int j = 0; j < 8; ++j) e[j] = pf[(size_t)min(c0 + j, c - 1) * 512];
#pragma unroll
              for (int j = 0; j < 8; ++j) if (c0 + j >= c) e[j] = (f32x4){1.f, 0.f, 1.f, 0.f};
#pragma unroll
              for (int j = 0; j < 8; ++j) { Hf0 = e[j][0] * Hf0 + e[j][1]; Hf1 = e[j][2] * Hf1 + e[j][3]; } }
          const f32x4* pb = ph + (size_t)((1 * 8 + b) * 64) * 512 + tid;
          for (int c0 = 63; c0 > c; c0 -= 8) { f32x4 e[8];
#pragma unroll
              for (int j = 0; j < 8; ++j) e[j] = pb[(size_t)max(c0 - j, c + 1) * 512];
#pragma unroll
              for (int j = 0; j < 8; ++j) if (c0 - j <= c) e[j] = (f32x4){1.f, 0.f, 1.f, 0.f};
#pragma unroll
              for (int j = 0; j < 8; ++j) { Hb0 = e[j][0] * Hb0 + e[j][1]; Hb1 = e[j][2] * Hb1 + e[j][3]; } } }
        const size_t r0 = (size_t)(b * SEQ + c * 64);
        const u32x2* __restrict__ s0 = (const u32x2*)(au + r0 * 1024) + tid; const u32x2* __restrict__ s1 = (const u32x2*)(au + (size_t)M_ * 1024 + r0 * 1024) + tid;
        const unsigned* __restrict__ gp = (const unsigned*)(gg + r0 * 1024) + tid; unsigned* __restrict__ yp = (unsigned*)(ycat + r0 * 2048 + 1024) + tid;
        float hf0[64], hf1[64];
        { u32x2 wa[8], wb[8];
#pragma unroll
          for (int j = 0; j < 8; ++j) wa[j] = s0[(size_t)j * 512];
#pragma unroll
          for (int bt = 0; bt < 8; bt += 2) {
#pragma unroll
              for (int j = 0; j < 8; ++j) wb[j] = s0[(size_t)((bt + 1) * 8 + j) * 512];
#pragma unroll
              for (int j = 0; j < 8; ++j) { const int t = bt * 8 + j; Hf0 = (1.0f - bf_lo(wa[j].x)) * Hf0 + bf_hi(wa[j].x); Hf1 = (1.0f - bf_lo(wa[j].y)) * Hf1 + bf_hi(wa[j].y); hf0[t] = Hf0; hf1[t] = Hf1; }
              if (bt + 2 < 8) {
#pragma unroll
                  for (int j = 0; j < 8; ++j) wa[j] = s0[(size_t)((bt + 2) * 8 + j) * 512]; }
#pragma unroll
              for (int j = 0; j < 8; ++j) { const int t = (bt + 1) * 8 + j; Hf0 = (1.0f - bf_lo(wb[j].x)) * Hf0 + bf_hi(wb[j].x); Hf1 = (1.0f - bf_lo(wb[j].y)) * Hf1 + bf_hi(wb[j].y); hf0[t] = Hf0; hf1[t] = Hf1; }
          } }
        { u32x2 wa[8], wb[8]; unsigned ga[8], gb[8];
#pragma unroll
          for (int j = 0; j < 8; ++j) { wa[j] = s1[(size_t)(63 - j) * 512]; ga[j] = gp[(size_t)(63 - j) * 512]; }
#pragma unroll
          for (int bt = 0; bt < 8; bt += 2) {
#pragma unroll
              for (int j = 0; j < 8; ++j) { const int t = 63 - ((bt + 1) * 8 + j); wb[j] = s1[(size_t)t * 512]; gb[j] = gp[(size_t)t * 512]; }
#pragma unroll
              for (int j = 0; j < 8; ++j) { const int t = 63 - (bt * 8 + j); Hb0 = (1.0f - bf_lo(wa[j].x)) * Hb0 + bf_hi(wa[j].x); Hb1 = (1.0f - bf_lo(wa[j].y)) * Hb1 + bf_hi(wa[j].y);
                  yp[(size_t)t * 1024] = cvt_pk_bf16(bf_lo(ga[j]) * (hf0[t] + Hb0), bf_hi(ga[j]) * (hf1[t] + Hb1)); }
              if (bt + 2 < 8) {
#pragma unroll
                  for (int j = 0; j < 8; ++j) { const int t = 63 - ((bt + 2) * 8 + j); wa[j] = s1[(size_t)t * 512]; ga[j] = gp[(size_t)t * 512]; } }
#pragma unroll
              for (int j = 0; j < 8; ++j) { const int t = 63 - ((bt + 1) * 8 + j); Hb0 = (1.0f - bf_lo(wb[j].x)) * Hb0 + bf_hi(wb[j].x); Hb1 = (1.0f - bf_lo(wb[j].y)) * Hb1 + bf_hi(wb[j].y);
                  yp[(size_t)t * 1024] = cvt_pk_bf16(bf_lo(gb[j]) * (hf0[t] + Hb0), bf_hi(gb[j]) * (hf1[t] + Hb1)); }
          } }
    }
}

#define XB_TMO      128
#define XB_XCNT(j)  (256  + 64 * (j))
#define XB_XSUB(j)  (1280 + 64 * (j))
#define XB_XGEN(j)  (2304 + 64 * (j))
#define XB_TOP      3328
#define XB_TOPGEN   3392
#define XCD_BAR_WORDS 3456
#define XB_SPIN_CAP (1u << 20)
__device__ __forceinline__ unsigned xb_ld(unsigned* p)              { return __hip_atomic_load(p, __ATOMIC_RELAXED, __HIP_MEMORY_SCOPE_AGENT); }
__device__ __forceinline__ unsigned xb_add(unsigned* p, unsigned v) { return __hip_atomic_fetch_add(p, v, __ATOMIC_RELAXED, __HIP_MEMORY_SCOPE_AGENT); }
__device__ __forceinline__ unsigned xb_xcc_id() { unsigned x; asm volatile("s_getreg_b32 %0, hwreg(20, 0, 4)" : "=s"(x)); return x & 0xFu; }
#define XB_SPIN(cond, bar) do { unsigned _sp = 0; while (cond) { __builtin_amdgcn_s_sleep(1); \
    if ((++_sp & 255u) == 0u) { if (xb_ld(&(bar)[XB_TMO])) break; if (_sp > XB_SPIN_CAP) { atomicAdd(&(bar)[XB_TMO], 1u); break; } } } } while (0)
struct XcdBarrier { unsigned* bar; unsigned x; volatile LAS unsigned* st; };
__device__ __forceinline__ XcdBarrier xcd_barrier_post(unsigned* bar, volatile LAS unsigned* st, int wv) {
    XcdBarrier b; b.bar = bar; b.x = (unsigned)__builtin_amdgcn_readfirstlane((int)xb_xcc_id()); b.st = st;
    if (otid(wv) == 0) (void)xb_add(&bar[XB_XCNT(b.x)], 1u);
    return b;
}
__device__ __forceinline__ void xcd_barrier_complete(unsigned* bar, unsigned x, unsigned& nloc, unsigned& nx) {
    const unsigned G = gridDim.x * gridDim.y * gridDim.z;
    unsigned sum, cnt, mine, sp = 0u;
    for (;;) {
        sum = 0u; cnt = 0u; mine = 0u;
#pragma unroll
        for (unsigned j = 0; j < 16; ++j) { const unsigned c = xb_ld(&bar[XB_XCNT(j)]); sum += c; cnt += (c > 0u) ? 1u : 0u; mine = (j == x) ? c : mine; }
        if (sum == G) break;
        __builtin_amdgcn_s_sleep(1);
        if ((++sp & 255u) == 0u) { if (xb_ld(&bar[XB_TMO])) break; if (sp > XB_SPIN_CAP) { atomicAdd(&bar[XB_TMO], 1u); break; } }
    }
    nloc = mine > 0u ? mine : 1u; nx = cnt > 0u ? cnt : 1u;
}
__device__ __forceinline__ void xcd_barrier(const XcdBarrier& b, unsigned* barp, int wv) {
    asm volatile("s_waitcnt vmcnt(0) lgkmcnt(0)" ::: "memory");
    __syncthreads();
    if (otid(wv) == 0) {
        const unsigned bx_ = xb_xcc_id();
        unsigned* bar = barp;
        __builtin_amdgcn_s_waitcnt(0);
        unsigned nloc = b.st[0], nx = b.st[1];
        if (nloc == 0u) { xcd_barrier_complete(bar, bx_, nloc, nx); b.st[0] = nloc; b.st[1] = nx; }
        const unsigned old = xb_add(&bar[XB_XSUB(bx_)], 1u);
        const unsigned gen = old / nloc;
        if (old + 1u == (gen + 1u) * nloc) {
            __builtin_amdgcn_fence(__ATOMIC_RELEASE, "agent");
            asm volatile("s_waitcnt vmcnt(0)" ::: "memory");
            const unsigned og = xb_add(&bar[XB_TOP], 1u);
            const unsigned tg = og / nx;
            if (og + 1u == (tg + 1u) * nx) xb_add(&bar[XB_TOPGEN], 1u);
            else XB_SPIN(xb_ld(&bar[XB_TOPGEN]) == tg, bar);
            __builtin_amdgcn_fence(__ATOMIC_ACQUIRE, "agent");
            xb_add(&bar[XB_XGEN(bx_)], 1u);
            asm volatile("s_waitcnt vmcnt(0)" ::: "memory");
        } else {
            XB_SPIN(xb_ld(&bar[XB_XGEN(bx_)]) == gen, bar);
            __builtin_amdgcn_fence(__ATOMIC_ACQUIRE, "agent");
            asm volatile("s_waitcnt vmcnt(0)" ::: "memory");
        }
    }
    __syncthreads();
}
__global__ void __launch_bounds__(512, 2) mega_fwd(Params p) {
    extern __shared__ __attribute__((aligned(16))) unsigned char lds[];
    cg::grid_group grid = cg::this_grid();
    const int wv = __builtin_amdgcn_readfirstlane((int)threadIdx.x >> 6);
    unsigned char* ws = p.ws;
    LAS unsigned char* ldsl = (LAS unsigned char*)lds;
    bf16_t* hb = (bf16_t*)(ws + WS_HB);
    const float* cosT = (const float*)(ws + WS_COS); const float* sinT = (const float*)(ws + WS_SIN);

    volatile LAS unsigned* xst = (volatile LAS unsigned*)(ldsl + pg8::STAGE_BYTES);
    { const int t_ = otid(wv); if (t_ < 4) xst[t_] = 0u; }
    __syncthreads();
    XcdBarrier xb = xcd_barrier_post((unsigned*)(ws + WS_BAR), xst, wv);
    fix_t* stats0 = (fix_t*)(ws + WS_ST);
#define stats stats0
    { const int tid = otid(wv);
      for (int i = blockIdx.x * 512 + tid; i < 8 * 2 * M_; i += gridDim.x * 512) stats[(size_t)2 * M_ + i] = 0ull;
    }
    make_tables(p, wv);
    x_pass(p.in[0], hb, stats, wv);
    grid.sync();
    convert_weights(p, 0, 0, CT6, (float*)lds, wv);
    xcd_barrier(xb, (unsigned*)(ws + WS_BAR), wv);
    colsum_in(p, 0, wv); colsum_up(p, 0, wv);
    xcd_barrier(xb, (unsigned*)(ws + WS_BAR), wv);

#pragma unroll 1
    for (int l = 0; l < DEPTH; ++l) {
        { typedef __attribute__((address_space(1))) unsigned char gu8; uintptr_t w_ = (uintptr_t)p.ws; asm volatile("" : "+s"(w_)); ws = (unsigned char*)(gu8*)w_; }
        const float* csb = (const float*)(ws + WS_CSB) + (size_t)l * CSB_L;
        fix_t* st0 = (fix_t*)(ws + WS_ST) + (size_t)(2 * l) * 2 * M_; fix_t* st1 = st0 + 2 * M_; fix_t* st2 = st1 + 2 * M_;
        if (l > 0) { colsum_up(p, l, wv); convert_weights(p, l, CT5, CT6, (float*)lds, wv); }
        { pg8::Order S = pg8::make_order(hb, 2048, ws + W_IN, 2048, M_, NINP, 2048);
          EpiIn E{(bf16_t*)(ws + WS_CQ), (bf16_t*)(ws + WS_CKV), (bf16_t*)(ws + WS_XL), (bf16_t*)(ws + WS_GG), (bf16_t*)(ws + WS_KPE), (float*)(ws + WS_SSQ), cosT, sinT, st0, csb + CSB_IN, csb + CSB_IN + NINP};
          pg8::gemm_phase(ldsl, S, E, wv); }
        xcd_barrier(xb, (unsigned*)(ws + WS_BAR), wv);
        conv_phase(p, l, wv);
        { pg8::Order S = pg8::make_order(ws + WS_CQ, 512, ws + W_UQ, 512, M_, 1536, 512);
          EpiQ E{(bf16_t*)(ws + WS_Q), (const float*)(ws + WS_SSQ), cosT, sinT};
          pg8::gemm_phase(ldsl, S, E, wv); }
        { pg8::Order S = pg8::make_order(ws + WS_CKV, 512, ws + W_UKV, 512, M_, 2048, 512);
          EpiKV E{(bf16_t*)(ws + WS_KV), (const float*)(ws + WS_SSQ)};
          pg8::gemm_phase(ldsl, S, E, wv); }
        xcd_barrier(xb, (unsigned*)(ws + WS_BAR), wv);
        {
            const bf16_t* Q = (const bf16_t*)(ws + WS_Q); const bf16_t* KV = (const bf16_t*)(ws + WS_KV); const bf16_t* KPE = (const bf16_t*)(ws + WS_KPE); bf16_t* ycat = (bf16_t*)(ws + WS_YCAT);
            const int G = gridDim.x, bx = blockIdx.x;
            for (int L = bx; L < 1024; L += G) {
                int pair, qb;
                if (G == 256) { const int i = L >> 8, c = L & 255, xcd = c & 7, j = c >> 3; pair = i * 16 + xcd * 2 + (j >> 4); qb = j & 15; } else { pair = L >> 4; qb = L & 15; }
                const int b = pair >> 3, h = pair & 7; const size_t row0 = (size_t)b * SEQ + (size_t)qb * 256;
                __syncthreads();
                att::attn_unit(Q + row0 * 1536 + h * 128, Q + row0 * 1536 + 1024 + h * 64, KV + (size_t)b * SEQ * 2048 + h * 256, KPE + (size_t)b * SEQ * 64, ycat + row0 * 2048 + h * 128, SEQ, (char*)lds, wv);
            }
            __syncthreads();
        }
        { pg8::Order S = pg8::make_order(ws + WS_XC, 1024, ws + W_G, 128, M_, 512, 128);
          S.nZ = 8; S.a_z = 128 * 2; S.b_z = (size_t)512 * 128 * 2;
          EpiGate E{(unsigned*)(ws + WS_AU), (const bf16_t*)(ws + WS_XC), p.in[12] + (size_t)l * 2048, p.in[14] + (size_t)l * 2048, (const float*)(ws + WS_SP) + (size_t)l * 2048};
          pg8::gemm_phase(ldsl, S, E, wv); }
        xcd_barrier(xb, (unsigned*)(ws + WS_BAR), wv);
        scan_local(p, wv);
        if (l + 1 < DEPTH) { __syncthreads(); convert_weights(p, l + 1, 0, CT3, (float*)lds, wv); }
        xcd_barrier(xb, (unsigned*)(ws + WS_BAR), wv);
        if (l + 1 < DEPTH) colsum_in(p, l + 1, wv);
        scan_apply(p, wv);
        xcd_barrier(xb, (unsigned*)(ws + WS_BAR), wv);
        { pg8::Order S = pg8::make_order(ws + WS_YCAT, 2048, ws + W_OUT, 2048, M_, 2048, 2048); S.wgm = 4;
          EpiRes E{hb, st0, l == 0 ? p.in[2] : p.in[21] + (size_t)(l - 1) * 2048, l == 0 ? p.in[3] : p.in[22] + (size_t)(l - 1) * 2048, st1};
          pg8::gemm_phase(ldsl, S, E, wv); }
        xcd_barrier(xb, (unsigned*)(ws + WS_BAR), wv);
        if (l + 1 < DEPTH) { convert_weights(p, l + 1, CT3, CT4, (float*)lds, wv); }
        { pg8::Order S = pg8::make_order(hb, 2048, ws + W_UP, 2048, M_, DFF, 2048);
          EpiUp E{(bf16_t*)(ws + WS_F), st1, csb + CSB_UP, csb + CSB_UP + DFF}; pg8::gemm_phase(ldsl, S, E, wv); }
        xcd_barrier(xb, (unsigned*)(ws + WS_BAR), wv);
        if (l + 1 < DEPTH) { convert_weights(p, l + 1, CT4, CT5, (float*)lds, wv); }
        { pg8::Order S = pg8::make_order(ws + WS_F, 8192, ws + W_DN, 8192, M_, 2048, 8192); S.wgm = 4;
          EpiRes E{hb, st1, p.in[17] + (size_t)l * 2048, p.in[18] + (size_t)l * 2048, st2};
          pg8::gemm_phase(ldsl, S, E, wv); }
        xcd_barrier(xb, (unsigned*)(ws + WS_BAR), wv);
    }
    ln_final(p.out, (const bf16_t*)(p.ws + WS_HB), (const fix_t*)(p.ws + WS_ST) + (size_t)(2 * DEPTH) * 2 * M_, p.in[21] + (size_t)(DEPTH - 1) * 2048, p.in[22] + (size_t)(DEPTH - 1) * 2048, wv);
}

extern "C" void kernel_launch(void* const* d_in, const int* in_sizes, int n_in, void* d_out, int out_size, void* d_ws, size_t ws_size, hipStream_t stream) {
    constexpr int LDS_BYTES = pg8::STAGE_BYTES + 16;
    static int grid_blocks = 0;
    if (grid_blocks == 0) {
        if (n_in != 23 || in_sizes[0] != M_ * DM || out_size != M_ * DM || ws_size < WS_END) {
            fprintf(stderr, "kernel_launch: shape mismatch (n_in %d, in0 %d, out %d, ws %zu, need %zu)\n", n_in, n_in > 0 ? in_sizes[0] : -1, out_size, ws_size, (size_t)WS_END); grid_blocks = -1; return; }
        int dev = 0, cus = 0, per_cu = 0;
        hipGetDevice(&dev); hipDeviceGetAttribute(&cus, hipDeviceAttributeMultiprocessorCount, dev);
        if (hipFuncSetAttribute((const void*)mega_fwd, hipFuncAttributeMaxDynamicSharedMemorySize, LDS_BYTES) != hipSuccess) { fprintf(stderr, "kernel_launch: hipFuncSetAttribute failed\n"); grid_blocks = -1; return; }
        if (hipOccupancyMaxActiveBlocksPerMultiprocessor(&per_cu, (const void*)mega_fwd, 512, LDS_BYTES) != hipSuccess || per_cu < 1) { fprintf(stderr, "kernel_launch: occupancy query says %d\n", per_cu); per_cu = 1; }
        (void)hipGetLastError();
        grid_blocks = cus * 1;
    }
    if (grid_blocks < 0) return;
    Params p{};
    for (int i = 0; i < 23; ++i) p.in[i] = (const float*)d_in[i];
    p.out = (float*)d_out; p.ws = (unsigned char*)d_ws;
    (void)hipMemsetAsync((char*)d_ws + WS_BAR, 0, XCD_BAR_WORDS * 4, stream);
    void* args[] = {&p};
    hipError_t e = hipLaunchCooperativeKernel((const void*)mega_fwd, dim3(grid_blocks), dim3(512), args, LDS_BYTES, stream);
    if (e != hipSuccess) fprintf(stderr, "kernel_launch: cooperative launch failed: %s (grid %d)\n", hipGetErrorString(e), grid_blocks);
}
```

```cpp
#include <hip/hip_runtime.h>
#include <hip/hip_cooperative_groups.h>
#include <cstdio>
#include <cstdint>
namespace cg = cooperative_groups;

#define LAS __attribute__((address_space(3)))
typedef unsigned short bf16_t;
typedef short bf16x8 __attribute__((ext_vector_type(8)));
typedef short s16x4 __attribute__((ext_vector_type(4)));
typedef float f32x4 __attribute__((ext_vector_type(4)));
typedef float f32x2 __attribute__((ext_vector_type(2)));
typedef float f32x16 __attribute__((ext_vector_type(16)));
typedef unsigned u32x4 __attribute__((ext_vector_type(4)));
typedef unsigned u32x2 __attribute__((ext_vector_type(2)));

constexpr int M_ = 32768, DM = 2048, SEQ = 4096, NBATCH = 8, DEPTH = 4;
constexpr int NIN = 3136, NINP = 3328, DFF = 8192;
constexpr float ALPHA = 1.6817928305074290f;
constexpr float LN_EPS = 1e-5f, RMS_EPS = 1e-6f;
constexpr size_t MiB = 1ull << 20;
constexpr size_t WS_HB = 0;
constexpr size_t WS_W = 128 * MiB;
constexpr size_t W_IN = WS_W, W_UQ = W_IN + (size_t)NINP * 2048 * 2, W_UKV = W_UQ + 1536ull * 512 * 2, W_G = W_UKV + 2048ull * 512 * 2,
                 W_OUT = W_G + 8ull * 512 * 128 * 2, W_UP = W_OUT + 2048ull * 2048 * 2, W_DN = W_UP + 8192ull * 2048 * 2, W_END = W_DN + 8192ull * 2048 * 2;
static_assert(W_END <= 218 * MiB, "weights region");
constexpr size_t WS_COS = 218 * MiB, WS_SIN = 222 * MiB, WS_SP = 226 * MiB;
constexpr size_t WS_CSB = 226 * MiB + 65536;
constexpr int CSB_L = 2 * 3328 + 2 * 8192, CSB_IN = 0, CSB_UP = 2 * 3328;
constexpr size_t WS_BAR = 226 * MiB + 49152;
constexpr size_t WS_ST = 227 * MiB;
constexpr size_t WS_BIG = 232 * MiB;
constexpr size_t WS_F = WS_BIG;
constexpr size_t WS_GG = WS_BIG, WS_XC = WS_BIG + 64 * MiB, WS_YCAT = WS_BIG + 128 * MiB, WS_SSQ = WS_BIG + 256 * MiB, WS_KPE = WS_BIG + 258 * MiB,
                 WS_CQ = WS_BIG + 262 * MiB, WS_CKV = WS_BIG + 294 * MiB, WS_XL = WS_BIG + 326 * MiB, WS_AU = WS_BIG + 262 * MiB  ,
                 WS_Q = WS_BIG + 518 * MiB, WS_KV = WS_BIG + 614 * MiB, WS_PH = WS_BIG + 742 * MiB, WS_END = WS_BIG + 750 * MiB;
static_assert(WS_END <= 1024 * MiB, "workspace");

struct Params { const float* in[23]; float* out; unsigned char* ws; };

__device__ __forceinline__ int otid(int wv) { int t; asm volatile("v_mbcnt_lo_u32_b32 %0, -1, 0\n\tv_mbcnt_hi_u32_b32 %0, -1, %0" : "=v"(t)); return (wv << 6) | t; }
__device__ __forceinline__ unsigned cvt_pk_bf16(float lo, float hi) { unsigned r; asm volatile("v_cvt_pk_bf16_f32 %0, %1, %2" : "=v"(r) : "v"(lo), "v"(hi)); return r; }
__device__ __forceinline__ float sum_fq(float x) {
    auto a = __builtin_amdgcn_permlane16_swap(__float_as_uint(x), __float_as_uint(x), false, false); x = __uint_as_float(a[0]) + __uint_as_float(a[1]);
    auto b = __builtin_amdgcn_permlane32_swap(__float_as_uint(x), __float_as_uint(x), false, false); return __uint_as_float(b[0]) + __uint_as_float(b[1]); }
__device__ __forceinline__ float wave_sum(float x, int lane) {
#pragma unroll
    for (int o = 32; o >= 1; o >>= 1) x += __int_as_float(__builtin_amdgcn_ds_bpermute((lane ^ o) << 2, __float_as_int(x)));
    return x; }
__device__ __forceinline__ float bf_lo(unsigned w) { return __uint_as_float(w << 16); }
__device__ __forceinline__ float bf_hi(unsigned w) { return __uint_as_float(w & 0xffff0000u); }
__device__ __forceinline__ float sigmoidf_(float x) { return __builtin_amdgcn_rcpf(1.0f + __builtin_amdgcn_exp2f(-1.4426950408889634f * x)); }
__device__ __forceinline__ float gelu_tanh(float x) { const float z = 0.7978845608028654f * (x + 0.044715f * x * x * x); return x * sigmoidf_(2.0f * z); }
__device__ __forceinline__ u32x4 pack8(const f32x4 a, const f32x4 b) { u32x4 w; w.x = cvt_pk_bf16(a[0], a[1]); w.y = cvt_pk_bf16(a[2], a[3]); w.z = cvt_pk_bf16(b[0], b[1]); w.w = cvt_pk_bf16(b[2], b[3]); return w; }

namespace pg8 {
constexpr int BM = 256, BK = 64, HALF = 128, HTB = HALF * BK * 2, STAGE_BYTES = 8 * HTB, NXCD = 8, WGM = 8;
__host__ __device__ __forceinline__ int lds_byte(int r, int c) { const int st = (r >> 4) * 2 + (c >> 5), rr = r & 15, cc = c & 31, ob = rr * 64 + cc * 2; return st * 1024 + (ob ^ (((ob >> 9) & 1) << 5)); }
__host__ __device__ __forceinline__ void stage_rc(int b, int& R, int& C) { const int st = b / 1024, sb = b % 1024, swz = sb ^ (((sb >> 9) & 1) << 5); R = (st >> 1) * 16 + swz / 64; C = (st & 1) * 32 + (swz % 64) / 2; }
__host__ __device__ __forceinline__ int perm32(int rho) { const int n = rho >> 4, i = rho & 15; return 8 * (i >> 2) + 4 * n + (i & 3); }

struct Unit { int pm, pn, z; };
struct Order {
    int nM, nN, nZ, per, G, c, wgm;
    const char* A; const char* B; size_t a_pm, a_z, b_pn, b_z; int lda, ldb, K;
    __device__ __forceinline__ bool next(int i, Unit& u) const {
        const long L = (long)i * G + c; if (L >= (long)per * nZ) return false;
        u.z = (int)(L / per); int wgid = (int)(L % per);
        { const int q = per / NXCD, r = per % NXCD, xcd = wgid % NXCD, off = wgid / NXCD; wgid = (xcd < r ? xcd * (q + 1) : r * (q + 1) + (xcd - r) * q) + off; }
        const int nig = wgm * nN, gid = wgid / nig, fm = gid * wgm, gsz = (nM - fm) < wgm ? (nM - fm) : wgm;
        u.pm = fm + ((wgid % nig) % gsz); u.pn = (wgid % nig) / gsz; return true;
    }
    __device__ __forceinline__ const char* aptr(const Unit& u) const { return A + (size_t)u.pm * a_pm + (size_t)u.z * a_z; }
    __device__ __forceinline__ const char* bptr(const Unit& u) const { return B + (size_t)u.pn * b_pn + (size_t)u.z * b_z; }
};
__device__ __forceinline__ Order make_order(const void* A, int lda, const void* Bt, int ldb, int Mrows, int N, int K) {
    Order o; o.nM = Mrows / BM; o.nN = N / BM; o.nZ = 1; o.per = o.nM * o.nN; o.G = gridDim.x; o.c = blockIdx.x; o.wgm = WGM;
    o.A = (const char*)A; o.B = (const char*)Bt; o.a_pm = (size_t)BM * lda * 2; o.a_z = 0; o.b_pn = (size_t)BM * ldb * 2; o.b_z = 0; o.lda = lda; o.ldb = ldb; o.K = K; return o;
}

template <class Epi>
__device__ __forceinline__ void gemm_phase(LAS unsigned char* lds, const Order& S, const Epi& E, int wv) {
    const int tid = otid(wv), wid = __builtin_amdgcn_readfirstlane(tid >> 6), lane = tid & 63, wr = wid >> 2, wc = wid & 3, fr = lane & 15, fq = lane >> 4;
    const int nt = S.K / BK;
    unsigned voffA[2], voffB[2];
#pragma unroll
    for (int i = 0; i < 2; ++i) { int R, C; stage_rc(tid * 16 + i * 8192, R, C); const int Rb = Epi::PERM ? ((R & ~31) + perm32(R & 31)) : R;
        voffA[i] = (unsigned)(R * S.lda + C) * 2u; voffB[i] = (unsigned)(Rb * S.ldb + C) * 2u; }
    const size_t kstep = (size_t)(BK * 2);
    const size_t hstepA = (size_t)HALF * S.lda * 2, hstepB = (size_t)HALF * S.ldb * 2;
    const unsigned ldsw = (unsigned)wid * 1024u;
    const int aoff = lds_byte(wr * 64 + fr, fq * 8), boff = lds_byte(wc * 32 + fr, fq * 8);
#define PG8_SA(b, h) (((b) * 2 + (h)) * HTB)
#define PG8_SB(b, h) ((4 + (b) * 2 + (h)) * HTB)
#define PG8_STAGE(bufoff, gbase, voff) do { _Pragma("unroll") for (int _i = 0; _i < 2; ++_i) \
        __builtin_amdgcn_global_load_lds((const unsigned*)((const char*)(gbase) + (voff)[_i]), (LAS unsigned*)(lds + (bufoff) + ldsw + _i * 8192), 16, 0, 0); } while (0)
#define PG8_LDA(dst, b, h) do { _Pragma("unroll") for (int m = 0; m < 4; ++m) _Pragma("unroll") for (int k = 0; k < 2; ++k) dst[m][k] = *(const LAS bf16x8*)(lds + PG8_SA(b, h) + aoff + m * 2048 + k * 1024); } while (0)
#define PG8_LDB(dst, b, h) do { _Pragma("unroll") for (int n = 0; n < 2; ++n) _Pragma("unroll") for (int k = 0; k < 2; ++k) dst[n][k] = *(const LAS bf16x8*)(lds + PG8_SB(b, h) + boff + n * 2048 + k * 1024); } while (0)
#define PG8_MMA(ai, bj, At, Bt) do { __builtin_amdgcn_s_setprio(1); _Pragma("unroll") for (int m = 0; m < 4; ++m) _Pragma("unroll") for (int n = 0; n < 2; ++n) _Pragma("unroll") for (int k = 0; k < 2; ++k) \
        acc[ai][bj][m][n] = __builtin_amdgcn_mfma_f32_16x16x32_bf16(Bt[n][k], At[m][k], acc[ai][bj][m][n], 0, 0, 0); __builtin_amdgcn_s_setprio(0); } while (0)
#define PG8_WAIT_V(n) asm volatile("s_waitcnt vmcnt(" #n ")" ::: "memory")
#define PG8_WAIT_L(n) asm volatile("s_waitcnt lgkmcnt(" #n ")" ::: "memory")
#define PG8_BAR __builtin_amdgcn_s_barrier()
#define PG8_SCHED __builtin_amdgcn_sched_barrier(0)
    Unit cur, nxt; int ui = 0;
    if (!S.next(0, cur)) return;
    f32x4 acc[2][2][4][2];
#pragma unroll
    for (int a = 0; a < 2; ++a)
#pragma unroll
        for (int b = 0; b < 2; ++b)
#pragma unroll
            for (int m = 0; m < 4; ++m)
#pragma unroll
                for (int n = 0; n < 2; ++n) acc[a][b][m][n] = (f32x4){0.f, 0.f, 0.f, 0.f};
    bf16x8 At[4][2], B0[2][2], B1[2][2];
    const char* cA = S.aptr(cur); const char* cB = S.bptr(cur);
    PG8_STAGE(PG8_SB(0, 0), cB, voffB); PG8_STAGE(PG8_SA(0, 0), cA, voffA); PG8_STAGE(PG8_SB(0, 1), cB + hstepB, voffB); PG8_STAGE(PG8_SA(0, 1), cA + hstepA, voffA);
    if (wr == 1) PG8_BAR;
    PG8_WAIT_V(4); PG8_BAR;
    PG8_STAGE(PG8_SB(1, 0), cB + kstep, voffB); PG8_STAGE(PG8_SA(1, 0), cA + kstep, voffA); PG8_STAGE(PG8_SB(1, 1), cB + hstepB + kstep, voffB);
    PG8_WAIT_V(6); PG8_BAR;
    for (;;) {
        const bool has_next = S.next(ui + 1, nxt);
        const char* nA = has_next ? S.aptr(nxt) : cA; const char* nB = has_next ? S.bptr(nxt) : cB;
        for (int t = 0; t < nt; t += 2) {
            const bool last = (t == nt - 2);
            const char* a1 = cA + (size_t)(t + 1) * kstep;
            const char* a2 = last ? nA : cA + (size_t)(t + 2) * kstep; const char* b2 = last ? nB : cB + (size_t)(t + 2) * kstep;
            const char* a3 = a2 + kstep; const char* b3 = b2 + kstep;
            PG8_LDB(B0, 0, 0); PG8_SCHED; PG8_LDA(At, 0, 0); PG8_STAGE(PG8_SA(1, 1), a1 + hstepA, voffA);
            PG8_WAIT_L(8); PG8_BAR; PG8_WAIT_L(0); PG8_MMA(0, 0, At, B0); PG8_BAR; PG8_SCHED;
            PG8_LDB(B1, 0, 1); PG8_STAGE(PG8_SB(0, 0), b2, voffB);
            PG8_BAR; PG8_WAIT_L(0); PG8_MMA(0, 1, At, B1); PG8_BAR;
            PG8_LDA(At, 0, 1); PG8_STAGE(PG8_SA(0, 0), a2, voffA);
            PG8_BAR; PG8_WAIT_L(0); PG8_MMA(1, 0, At, B0); PG8_BAR; PG8_SCHED;
            PG8_STAGE(PG8_SB(0, 1), b2 + hstepB, voffB);
            PG8_WAIT_V(6); PG8_BAR; PG8_MMA(1, 1, At, B1); PG8_BAR;
            PG8_LDB(B0, 1, 0); PG8_SCHED; PG8_LDA(At, 1, 0); PG8_STAGE(PG8_SA(0, 1), a2 + hstepA, voffA);
            PG8_WAIT_L(8); PG8_BAR; PG8_WAIT_L(0); PG8_MMA(0, 0, At, B0); PG8_BAR; PG8_SCHED;
            PG8_LDB(B1, 1, 1); PG8_STAGE(PG8_SB(1, 0), b3, voffB);
            PG8_BAR; PG8_WAIT_L(0); PG8_MMA(0, 1, At, B1); PG8_BAR;
            PG8_LDA(At, 1, 1); PG8_STAGE(PG8_SA(1, 0), a3, voffA);
            PG8_BAR; PG8_WAIT_L(0); PG8_MMA(1, 0, At, B0); PG8_BAR; PG8_SCHED;
            PG8_STAGE(PG8_SB(1, 1), b3 + hstepB, voffB);
            PG8_WAIT_V(6); PG8_BAR; PG8_MMA(1, 1, At, B1); PG8_BAR;
        }
        E(acc, cur, wr, wc, fr, fq);
        if (!has_next) break;
#pragma unroll
        for (int a = 0; a < 2; ++a)
#pragma unroll
            for (int b = 0; b < 2; ++b)
#pragma unroll
                for (int m = 0; m < 4; ++m)
#pragma unroll
                    for (int n = 0; n < 2; ++n) acc[a][b][m][n] = (f32x4){0.f, 0.f, 0.f, 0.f};
        cur = nxt; cA = nA; cB = nB; ++ui;
    }
    PG8_WAIT_V(0);
    if (wr == 0) PG8_BAR;
    PG8_BAR;
#undef PG8_SA
#undef PG8_SB
#undef PG8_STAGE
#undef PG8_LDA
#undef PG8_LDB
#undef PG8_MMA
#undef PG8_WAIT_V
#undef PG8_WAIT_L
#undef PG8_BAR
#undef PG8_SCHED
}
}
using pg8::Unit;
typedef f32x4 Acc[2][2][4][2];

typedef unsigned long long fix_t;
__device__ __forceinline__ fix_t to_fix(float v) { return (fix_t)(long long)(v * 4294967296.0f); }
__device__ __forceinline__ float from_fix(fix_t v) { return fmaf((float)(unsigned)v, 2.3283064365386963e-10f, (float)(int)(v >> 32)); }
__device__ __forceinline__ void fix_add(fix_t* p, float v) { __hip_atomic_fetch_add(p, to_fix(v), __ATOMIC_RELAXED, __HIP_MEMORY_SCOPE_AGENT); }
__device__ __forceinline__ f32x4 ld_fix4(const fix_t* p) { typedef unsigned long long u64x2 __attribute__((ext_vector_type(2))); const u64x2 a = *(const u64x2*)p, b = *(const u64x2*)(p + 2);
    return (f32x4){from_fix(a.x), from_fix(a.y), from_fix(b.x), from_fix(b.y)}; }
__device__ __forceinline__ void row_ln(const fix_t* st, int row, float& mu, float& rs) { const float s1 = from_fix(st[row]), s2 = from_fix(st[M_ + row]); mu = s1 * (1.0f / 2048.0f); rs = __builtin_amdgcn_rsqf(s2 * (1.0f / 2048.0f) - mu * mu + LN_EPS); }
template <bool PERM>
__device__ __forceinline__ void ln_correct(f32x4 (&acc)[2][2][4][2], const fix_t* st, const float* cs, const float* bw, int row0, int colbase) {
    f32x4 c4[2][2], b4[2][2];
#pragma unroll
    for (int bj = 0; bj < 2; ++bj)
#pragma unroll
        for (int n = 0; n < 2; ++n) { const int col = colbase + bj * 128 + (PERM ? 4 * n : 16 * n); c4[bj][n] = *(const f32x4*)(cs + col); b4[bj][n] = *(const f32x4*)(bw + col); }
#pragma unroll
    for (int ai = 0; ai < 2; ++ai) { fix_t r1[4], r2[4];
#pragma unroll
        for (int m = 0; m < 4; ++m) { const int row = row0 + ai * 128 + m * 16; r1[m] = st[row]; r2[m] = st[M_ + row]; }
#pragma unroll
        for (int m = 0; m < 4; ++m) { const float mu = from_fix(r1[m]) * (1.0f / 2048.0f), rs = __builtin_amdgcn_rsqf(from_fix(r2[m]) * (1.0f / 2048.0f) - mu * mu + LN_EPS);
#pragma unroll
            for (int bj = 0; bj < 2; ++bj)
#pragma unroll
                for (int n = 0; n < 2; ++n) acc[ai][bj][m][n] = (acc[ai][bj][m][n] - c4[bj][n] * mu) * rs + b4[bj][n]; } }
}

struct EpiIn {
    static constexpr bool PERM = true;
    bf16_t *cq, *ckv, *xl, *gg, *kpe; float* ssq; const float *cosT, *sinT; const fix_t* st; const float *cs, *bw;
    __device__ __forceinline__ void operator()(Acc& acc, const Unit& u, int wr, int wc, int fr, int fq) const {
        const int row0 = u.pm * 256 + wr * 64 + fr, pn = u.pn;
        ln_correct<true>(acc, st, cs, bw, row0, pn * 256 + wc * 32 + 8 * fq);
        if (pn < 4) {
            bf16_t* base = (pn < 2 ? cq : ckv); const int col0 = (pn & 1) * 256 + wc * 32 + 8 * fq;
#pragma unroll
            for (int ai = 0; ai < 2; ++ai)
#pragma unroll
                for (int m = 0; m < 4; ++m) { const int row = row0 + ai * 128 + m * 16; float s = 0.f;
#pragma unroll
                    for (int bj = 0; bj < 2; ++bj) { const f32x4 v0 = acc[ai][bj][m][0], v1 = acc[ai][bj][m][1];
                        s += (v0[0] * v0[0] + v0[1] * v0[1]) + (v0[2] * v0[2] + v0[3] * v0[3]) + (v1[0] * v1[0] + v1[1] * v1[1]) + (v1[2] * v1[2] + v1[3] * v1[3]);
                        *(u32x4*)(base + (size_t)row * 512 + col0 + bj * 128) = pack8(v0, v1); }
                    s = sum_fq(s);
                    if (fq == 0) ssq[(size_t)row * 16 + pn * 4 + wc] = s; }
        } else if (pn < 8) {
            const int col0 = (pn - 4) * 256 + wc * 32 + 8 * fq;
#pragma unroll
            for (int ai = 0; ai < 2; ++ai)
#pragma unroll
                for (int m = 0; m < 4; ++m) { const int row = row0 + ai * 128 + m * 16;
#pragma unroll
                    for (int bj = 0; bj < 2; ++bj) *(u32x4*)(xl + (size_t)row * 1024 + col0 + bj * 128) = pack8(acc[ai][bj][m][0], acc[ai][bj][m][1]); }
        } else if (pn < 12) {
            const int col0 = (pn - 8) * 256 + wc * 32 + 8 * fq;
#pragma unroll
            for (int ai = 0; ai < 2; ++ai)
#pragma unroll
                for (int m = 0; m < 4; ++m) { const int row = row0 + ai * 128 + m * 16;
#pragma unroll
                    for (int bj = 0; bj < 2; ++bj) { f32x4 v0 = acc[ai][bj][m][0], v1 = acc[ai][bj][m][1];
#pragma unroll
                        for (int j = 0; j < 4; ++j) { v0[j] = gelu_tanh(v0[j]); v1[j] = gelu_tanh(v1[j]); }
                        *(u32x4*)(gg + (size_t)row * 1024 + col0 + bj * 128) = pack8(v0, v1); } }
        } else if (wc == 0) {
#pragma unroll
            for (int ai = 0; ai < 2; ++ai) { f32x4 c0[4], c1[4], s0[4], s1[4];
#pragma unroll
                for (int m = 0; m < 4; ++m) { const size_t t = (size_t)(row0 + ai * 128 + m * 16) * 32 + 8 * fq;
                    c0[m] = *(const f32x4*)(cosT + t); c1[m] = *(const f32x4*)(cosT + t + 4); s0[m] = *(const f32x4*)(sinT + t); s1[m] = *(const f32x4*)(sinT + t + 4); }
#pragma unroll
                for (int m = 0; m < 4; ++m) { const int row = row0 + ai * 128 + m * 16;
                    const f32x4 a0 = acc[ai][0][m][0], a1 = acc[ai][0][m][1], b0 = acc[ai][1][m][0], b1 = acc[ai][1][m][1];
                    *(u32x4*)(kpe + (size_t)row * 64 + 8 * fq) = pack8(a0 * c0[m] - b0 * s0[m], a1 * c1[m] - b1 * s1[m]);
                    *(u32x4*)(kpe + (size_t)row * 64 + 32 + 8 * fq) = pack8(b0 * c0[m] + a0 * s0[m], b1 * c1[m] + a1 * s1[m]); } }
        }
    }
};
__device__ __forceinline__ void rows_rstd(const float* ssq8, int row0, float (&rs)[8]) {
#pragma unroll
    for (int h = 0; h < 2; ++h) { f32x4 a[4], b[4];
#pragma unroll
        for (int k = 0; k < 4; ++k) { const float* p = ssq8 + (size_t)(row0 + h * 128 + k * 16) * 16; a[k] = *(const f32x4*)p; b[k] = *(const f32x4*)(p + 4); }
#pragma unroll
        for (int k = 0; k < 4; ++k) { const float s = ((a[k][0] + a[k][1]) + (a[k][2] + a[k][3])) + ((b[k][0] + b[k][1]) + (b[k][2] + b[k][3])); rs[h * 4 + k] = __builtin_amdgcn_rsqf(s * (1.0f / 512.0f) + RMS_EPS); } }
}
struct EpiQ {
    static constexpr bool PERM = true;
    bf16_t* q; const float* ssq; const float *cosT, *sinT;
    __device__ __forceinline__ void operator()(Acc& acc, const Unit& u, int wr, int wc, int fr, int fq) const {
        const int row0 = u.pm * 256 + wr * 64 + fr, pn = u.pn;
        float rs[8]; rows_rstd(ssq, row0, rs);
        if (pn < 4) {
            const int col0 = pn * 256 + wc * 32 + 8 * fq;
#pragma unroll
            for (int ai = 0; ai < 2; ++ai)
#pragma unroll
                for (int m = 0; m < 4; ++m) { const int row = row0 + ai * 128 + m * 16; const float r = rs[ai * 4 + m];
#pragma unroll
                    for (int bj = 0; bj < 2; ++bj) *(u32x4*)(q + (size_t)row * 1536 + col0 + bj * 128) = pack8(acc[ai][bj][m][0] * r, acc[ai][bj][m][1] * r); }
        } else {
            const int head = 4 * (pn - 4) + wc;
#pragma unroll
            for (int kb = 0; kb < 4; ++kb) { f32x4 c0[2], c1[2], s0[2], s1[2];
#pragma unroll
                for (int j = 0; j < 2; ++j) { const int k = kb * 2 + j; const size_t t = (size_t)(row0 + (k >> 2) * 128 + (k & 3) * 16) * 32 + 8 * fq;
                    c0[j] = *(const f32x4*)(cosT + t); c1[j] = *(const f32x4*)(cosT + t + 4); s0[j] = *(const f32x4*)(sinT + t); s1[j] = *(const f32x4*)(sinT + t + 4); }
#pragma unroll
                for (int j = 0; j < 2; ++j) { const int k = kb * 2 + j, ai = k >> 2, m = k & 3; const int row = row0 + ai * 128 + m * 16; const float r = rs[k];
                    const f32x4 a0 = acc[ai][0][m][0] * r, a1 = acc[ai][0][m][1] * r, b0 = acc[ai][1][m][0] * r, b1 = acc[ai][1][m][1] * r;
                    *(u32x4*)(q + (size_t)row * 1536 + 1024 + head * 64 + 8 * fq) = pack8(a0 * c0[j] - b0 * s0[j], a1 * c1[j] - b1 * s1[j]);
                    *(u32x4*)(q + (size_t)row * 1536 + 1024 + head * 64 + 32 + 8 * fq) = pack8(b0 * c0[j] + a0 * s0[j], b1 * c1[j] + a1 * s1[j]); } }
        }
    }
};
struct EpiKV {
    static constexpr bool PERM = true;
    bf16_t* kv; const float* ssq;
    __device__ __forceinline__ void operator()(Acc& acc, const Unit& u, int wr, int wc, int fr, int fq) const {
        const int row0 = u.pm * 256 + wr * 64 + fr, col0 = u.pn * 256 + wc * 32 + 8 * fq;
        float rs[8]; rows_rstd(ssq + 8, row0, rs);
#pragma unroll
        for (int ai = 0; ai < 2; ++ai)
#pragma unroll
            for (int m = 0; m < 4; ++m) { const int row = row0 + ai * 128 + m * 16; const float r = rs[ai * 4 + m];
#pragma unroll
                for (int bj = 0; bj < 2; ++bj) *(u32x4*)(kv + (size_t)row * 2048 + col0 + bj * 128) = pack8(acc[ai][bj][m][0] * r, acc[ai][bj][m][1] * r); }
    }
};
struct EpiGate {
    static constexpr bool PERM = true;
    unsigned* au; const bf16_t* xc; const float *ba, *bi, *sp;
    __device__ __forceinline__ void operator()(Acc& acc, const Unit& u, int wr, int wc, int fr, int fq) const {
        const int row0 = u.pm * 256 + wr * 64 + fr, d = u.pn, ch0 = u.z * 128 + wc * 32 + 8 * fq;
        unsigned* aud = au + (size_t)d * M_ * 1024;
#pragma unroll
        for (int n = 0; n < 2; ++n) {
            const int ch = ch0 + 4 * n;
            const f32x4 bav = *(const f32x4*)(ba + d * 1024 + ch), biv = *(const f32x4*)(bi + d * 1024 + ch), spv = *(const f32x4*)(sp + d * 1024 + ch) * (-8.0f * 1.4426950408889634f);
            u32x2 xws[8];
#pragma unroll
            for (int k = 0; k < 8; ++k) xws[k] = *(const u32x2*)(xc + (size_t)(row0 + (k >> 2) * 128 + (k & 3) * 16) * 1024 + ch);
#pragma unroll
            for (int ai = 0; ai < 2; ++ai)
#pragma unroll
                for (int m = 0; m < 4; ++m) { const int row = row0 + ai * 128 + m * 16;
                    const u32x2 xw = xws[ai * 4 + m];
                    const float xv[4] = {bf_lo(xw.x), bf_hi(xw.x), bf_lo(xw.y), bf_hi(xw.y)};
                    u32x4 o;
#pragma unroll
                    for (int j = 0; j < 4; ++j) {
                        const float r = sigmoidf_(acc[ai][0][m][n][j] + bav[j]);
                        const float ig = sigmoidf_(acc[ai][1][m][n][j] + biv[j]);
                        const float a = __builtin_amdgcn_exp2f(r * spv[j]);
                        const float oma = 1.0f - a;
                        const float uu = __builtin_amdgcn_sqrtf(oma * (1.0f + a)) * ig * xv[j];
                        o[j] = cvt_pk_bf16(oma, uu); }
                    *(u32x4*)(aud + (size_t)row * 1024 + ch) = o; }
        }
    }
};
#ifndef RES_PF
#define RES_PF 2
#endif
struct EpiRes {
    static constexpr bool PERM = false;
    bf16_t* hb; const fix_t* st_old; const float *g, *b; fix_t* st_new;
    __device__ __forceinline__ void operator()(Acc& acc, const Unit& u, int wr, int wc, int fr, int fq) const {
        const int row0 = u.pm * 256 + wr * 64 + fr, col0 = u.pn * 256 + wc * 32 + 4 * fq;
        f32x4 gv[4], bv[4]; u32x2 P[RES_PF + 1][4]; float mus[8], rss[8];
#define RES_LOAD(k) do { const size_t off_ = (size_t)(row0 + ((k) >> 2) * 128 + ((k) & 3) * 16) * 2048 + col0; _Pragma("unroll") for (int c = 0; c < 4; ++c) P[(k) % (RES_PF + 1)][c] = *(const u32x2*)(hb + off_ + (c >> 1) * 128 + (c & 1) * 16); } while (0)
#pragma unroll
        for (int k = 0; k < RES_PF; ++k) RES_LOAD(k);
#pragma unroll
        for (int c = 0; c < 4; ++c) { gv[c] = *(const f32x4*)(g + col0 + (c >> 1) * 128 + (c & 1) * 16); bv[c] = *(const f32x4*)(b + col0 + (c >> 1) * 128 + (c & 1) * 16); }
#pragma unroll
        for (int h = 0; h < 2; ++h) { fix_t r1[4], r2[4];
#pragma unroll
            for (int k = 0; k < 4; ++k) { const int row = row0 + h * 128 + k * 16; r1[k] = st_old[row]; r2[k] = st_old[M_ + row]; }
#pragma unroll
            for (int k = 0; k < 4; ++k) { mus[h * 4 + k] = from_fix(r1[k]) * (1.0f / 2048.0f); rss[h * 4 + k] = __builtin_amdgcn_rsqf(from_fix(r2[k]) * (1.0f / 2048.0f) - mus[h * 4 + k] * mus[h * 4 + k] + LN_EPS); } }
#pragma unroll
        for (int k = 0; k < 8; ++k) {
            if (k + RES_PF < 8) RES_LOAD(k + RES_PF);
            const int ai = k >> 2, m = k & 3; const size_t off = (size_t)(row0 + ai * 128 + m * 16) * 2048 + col0;
            const float mu = mus[k], rs = rss[k];
            float a1 = 0.f, a2 = 0.f;
#pragma unroll
            for (int c = 0; c < 4; ++c) { const int cc = (c >> 1) * 128 + (c & 1) * 16; const u32x2 pw = P[k % (RES_PF + 1)][c];
                const f32x4 Pf = {bf_lo(pw.x), bf_hi(pw.x), bf_lo(pw.y), bf_hi(pw.y)};
                const f32x4 v = ((Pf - mu) * rs * gv[c] + bv[c]) * ALPHA + acc[ai][c >> 1][m][c & 1];
                u32x2 w; w.x = cvt_pk_bf16(v[0], v[1]); w.y = cvt_pk_bf16(v[2], v[3]); *(u32x2*)(hb + off + cc) = w;
                a1 += (v[0] + v[1]) + (v[2] + v[3]); a2 += (v[0] * v[0] + v[1] * v[1]) + (v[2] * v[2] + v[3] * v[3]); }
            a1 = sum_fq(a1); a2 = sum_fq(a2);
            { const int row = row0 + ai * 128 + m * 16; if (fq == 0) fix_add(st_new + row, a1); else if (fq == 1) fix_add(st_new + M_ + row, a2); }
        }
#undef RES_LOAD
    }
};
struct EpiUp {
    static constexpr bool PERM = true;
    bf16_t* f; const fix_t* st; const float *cs, *bw;
    __device__ __forceinline__ void operator()(Acc& acc, const Unit& u, int wr, int wc, int fr, int fq) const {
        const int row0 = u.pm * 256 + wr * 64 + fr, col0 = u.pn * 256 + wc * 32 + 8 * fq;
        ln_correct<true>(acc, st, cs, bw, row0, col0);
#pragma unroll
        for (int ai = 0; ai < 2; ++ai)
#pragma unroll
            for (int m = 0; m < 4; ++m) { const int row = row0 + ai * 128 + m * 16;
#pragma unroll
                for (int bj = 0; bj < 2; ++bj) { f32x4 v0 = acc[ai][bj][m][0], v1 = acc[ai][bj][m][1];
#pragma unroll
                    for (int j = 0; j < 4; ++j) { const float a = fmaxf(v0[j], 0.f), b = fmaxf(v1[j], 0.f); v0[j] = a * a; v1[j] = b * b; }
                    __builtin_nontemporal_store(pack8(v0, v1), (u32x4*)(f + (size_t)row * 8192 + col0 + bj * 128)); } }
    }
};

namespace att {
constexpr int NW = 8, QBLK = 32, KVBLK = 64;
constexpr float SCALE = 0.07216878364870323f;
constexpr float THR = 8.f;
#ifndef ATT_SDEPTH
#define ATT_SDEPTH 1
#endif
constexpr int SDEPTH = ATT_SDEPTH;
constexpr int SHM_V = KVBLK * 128 * 2, SHM_K = KVBLK * 128 * 2, SHM_R = KVBLK * 64 * 2;
constexpr int OFF_V = 0, OFF_K = 2 * SHM_V, OFF_R = OFF_K + 2 * SHM_K, OFF_WS = OFF_R + 2 * SHM_R, OFF_QR = OFF_WS + NW * 64 * 4, SHM_ATTN = OFF_QR + 256 * 128;
#define KSWZ(row, colB) ((row) * 256 + ((colB) ^ (((row) & 7) << 4)))
#define RSWZ(row, colB) ((row) * 128 + ((colB) ^ (((row) & 7) << 4)))
#define SBAR() __builtin_amdgcn_sched_barrier(0)
__device__ __forceinline__ int crow(int r, int hi) { return (r & 3) + 8 * (r >> 2) + 4 * hi; }
__device__ __forceinline__ void partialSM(f32x16& p0, f32x16& p1, float& m_reg, float& mn, float& alpha) {
    constexpr float C = SCALE * 1.4426950408889634f;
    float pmax = p0[0];
#pragma unroll
    for (int r = 1; r < 16; ++r) pmax = fmaxf(pmax, p0[r]);
#pragma unroll
    for (int r = 0; r < 16; ++r) pmax = fmaxf(pmax, p1[r]);
    { auto rr = __builtin_amdgcn_permlane32_swap(__float_as_uint(pmax), __float_as_uint(pmax), false, false);
      pmax = fmaxf(__uint_as_float(rr[0]), __uint_as_float(rr[1])); }
    if (__builtin_expect(__all(pmax - m_reg <= THR / SCALE), 1)) { mn = m_reg; alpha = 1.f; }
    else { mn = fmaxf(m_reg, pmax); alpha = __builtin_amdgcn_exp2f((m_reg - mn) * C); m_reg = mn; }
    const float mnC = -mn * C;
#pragma unroll
    for (int r = 0; r < 16; ++r) p0[r] = fmaf(p0[r], C, mnC);
#pragma unroll
    for (int r = 0; r < 16; ++r) p1[r] = fmaf(p1[r], C, mnC);
#pragma unroll
    for (int r = 0; r < 16; ++r) p0[r] = __builtin_amdgcn_exp2f(p0[r]);
}
__device__ __forceinline__ void finishSM(f32x16& p0, f32x16& p1, float alpha, float& l_reg, bf16x8& pa0, bf16x8& pa1, bf16x8& pa2, bf16x8& pa3) {
#pragma unroll
    for (int r = 0; r < 16; ++r) p1[r] = __builtin_amdgcn_exp2f(p1[r]);
    float ps = 0;
#pragma unroll
    for (int r = 0; r < 16; ++r) ps += p0[r];
#pragma unroll
    for (int r = 0; r < 16; ++r) ps += p1[r];
    { auto rr = __builtin_amdgcn_permlane32_swap(__float_as_uint(ps), __float_as_uint(ps), false, false);
      ps = __uint_as_float(rr[0]) + __uint_as_float(rr[1]); }
    l_reg = l_reg * alpha + ps;
#define PK4(P, BASE, OUT) do { unsigned a0 = cvt_pk_bf16(P[BASE + 0], P[BASE + 1]), a1 = cvt_pk_bf16(P[BASE + 2], P[BASE + 3]);   \
    unsigned b0 = cvt_pk_bf16(P[BASE + 4], P[BASE + 5]), b1 = cvt_pk_bf16(P[BASE + 6], P[BASE + 7]);                              \
    auto r0 = __builtin_amdgcn_permlane32_swap(a0, b0, false, false); auto r1 = __builtin_amdgcn_permlane32_swap(a1, b1, false, false); \
    u32x4 w = {r0[0], r1[0], r0[1], r1[1]}; OUT = *reinterpret_cast<bf16x8*>(&w); } while (0)
    PK4(p0, 0, pa0); PK4(p0, 8, pa1); PK4(p1, 0, pa2); PK4(p1, 8, pa3);
#undef PK4
}
__device__ __forceinline__ void qkt(f32x16& p0, f32x16& p1, const char* Ks, const char* Rs, const bf16x8* qr, const char* Qrl, int r32, int hi) {
    p0 = f32x16{}; p1 = f32x16{};
#pragma unroll
    for (int d0 = 0; d0 < 8; ++d0) { const int cb = (d0 * 16 + hi * 8) * 2;
        const bf16x8 b0 = *reinterpret_cast<const bf16x8*>(Ks + KSWZ(r32, cb));
        const bf16x8 b1 = *reinterpret_cast<const bf16x8*>(Ks + KSWZ(32 + r32, cb));
        p0 = __builtin_amdgcn_mfma_f32_32x32x16_bf16(b0, qr[d0], p0, 0, 0, 0);
        p1 = __builtin_amdgcn_mfma_f32_32x32x16_bf16(b1, qr[d0], p1, 0, 0, 0); }
#pragma unroll
    for (int d0 = 0; d0 < 4; ++d0) { const int cb = (d0 * 16 + hi * 8) * 2;
        const bf16x8 b0 = *reinterpret_cast<const bf16x8*>(Rs + RSWZ(r32, cb));
        const bf16x8 b1 = *reinterpret_cast<const bf16x8*>(Rs + RSWZ(32 + r32, cb));
        const bf16x8 qv = *reinterpret_cast<const bf16x8*>(Qrl + (cb ^ ((r32 & 7) << 4)));
        p0 = __builtin_amdgcn_mfma_f32_32x32x16_bf16(b0, qv, p0, 0, 0, 0);
        p1 = __builtin_amdgcn_mfma_f32_32x32x16_bf16(b1, qv, p1, 0, 0, 0); }
}
__device__ __forceinline__ int v_st(int k, int c) { const int kk = (k & ~0xC) | ((k & 4) << 1) | ((k & 8) >> 1); return ((kk >> 3) * 4 + (c >> 5)) * 512 + ((kk & 7) * 32 + (c & 31)) * 2; }
__device__ __forceinline__ int v_rd_base(int lane) { return ((lane & 3) << 3) | (((lane >> 2) & 3) << 6) | (((lane >> 4) & 1) << 5) | (((lane >> 5) & 1) << 8); }
constexpr int v_rd_off(int d0, int ks, int half) { return d0 * 512 + ks * 4096 + half * 2048; }
template <int OFF> __device__ __forceinline__ s16x4 tr_read(int vb) {
    s16x4 r; asm volatile("ds_read_b64_tr_b16 %0, %1 offset:%2" : "=&v"(r) : "v"(vb), "i"(OFF) : "memory"); return r;
}
template <int D0> __device__ __forceinline__ void pv_one(f32x16& od, int vb, bf16x8 pa0, bf16x8 pa1, bf16x8 pa2, bf16x8 pa3) {
    const s16x4 l0 = tr_read<v_rd_off(D0, 0, 0)>(vb), h0 = tr_read<v_rd_off(D0, 0, 1)>(vb), l1 = tr_read<v_rd_off(D0, 1, 0)>(vb), h1 = tr_read<v_rd_off(D0, 1, 1)>(vb);
    const s16x4 l2 = tr_read<v_rd_off(D0, 2, 0)>(vb), h2 = tr_read<v_rd_off(D0, 2, 1)>(vb), l3 = tr_read<v_rd_off(D0, 3, 0)>(vb), h3 = tr_read<v_rd_off(D0, 3, 1)>(vb);
    asm volatile("s_waitcnt lgkmcnt(0)" ::: "memory"); SBAR();
#define PK(L, H) (bf16x8){L[0], L[1], L[2], L[3], H[0], H[1], H[2], H[3]}
    od = __builtin_amdgcn_mfma_f32_32x32x16_bf16(pa0, PK(l0, h0), od, 0, 0, 0);
    od = __builtin_amdgcn_mfma_f32_32x32x16_bf16(pa1, PK(l1, h1), od, 0, 0, 0);
    od = __builtin_amdgcn_mfma_f32_32x32x16_bf16(pa2, PK(l2, h2), od, 0, 0, 0);
    od = __builtin_amdgcn_mfma_f32_32x32x16_bf16(pa3, PK(l3, h3), od, 0, 0, 0);
#undef PK
}
__device__ __forceinline__ void pv_d0(f32x16* o, int vb, bf16x8 pa0, bf16x8 pa1, bf16x8 pa2, bf16x8 pa3) {
    pv_one<0>(o[0], vb, pa0, pa1, pa2, pa3); pv_one<1>(o[1], vb, pa0, pa1, pa2, pa3); pv_one<2>(o[2], vb, pa0, pa1, pa2, pa3); pv_one<3>(o[3], vb, pa0, pa1, pa2, pa3);
}
__device__ __forceinline__ void attn_unit(const bf16_t* __restrict__ Qn, const bf16_t* __restrict__ Qr, const bf16_t* __restrict__ Kh, const bf16_t* __restrict__ Rh,
                                          bf16_t* __restrict__ Ob, int seq, char* lds, int wv) {
    const int tid = otid(wv), wid = tid >> 6, lane = tid & 63, r32 = lane & 31, hi = lane >> 5;
    char* V_lds = lds + OFF_V; char* K_lds = lds + OFF_K; char* R_lds = lds + OFF_R;
    float* ws = (float*)(lds + OFF_WS) + wid * 64; float* li_l = ws; float* al_l = ws + 32;
    float m_reg = -1e30f, l_reg = 0; f32x16 o[4] = {}; bf16x8 qr[8];
    char* Qrl = lds + OFF_QR + (wid * QBLK + r32) * 128;
    {
        const bf16_t* Qw = Qn + (size_t)(wid * QBLK + r32) * 1536 + hi * 8;
#pragma unroll
        for (int d0 = 0; d0 < 8; ++d0) qr[d0] = *reinterpret_cast<const bf16x8*>(Qw + d0 * 16);
        const bf16_t* Qw2 = Qr + (size_t)(wid * QBLK + r32) * 1536 + hi * 8;
#pragma unroll
        for (int d0 = 0; d0 < 4; ++d0) { const bf16x8 t = *reinterpret_cast<const bf16x8*>(Qw2 + d0 * 16); *reinterpret_cast<bf16x8*>(Qrl + (((d0 * 16 + hi * 8) * 2) ^ ((r32 & 7) << 4))) = t; }
    }
    const int sr = tid >> 4, sc = (tid & 15) * 8, vst0 = v_st(sr, sc), vst1 = v_st(32 + sr, sc);
    const int rr_ = tid >> 3, rc = (tid & 7) * 8;
    const int vb0 = (int)(uintptr_t)V_lds + v_rd_base(lane);
    struct { bf16x8 vs0, vs1, ks0, ks1, rs; } sr_[SDEPTH];
#define SLOAD(i, k0) do { sr_[i].vs0 = *(const bf16x8*)(&Kh[(size_t)((k0) + sr) * 2048 + 128 + sc]); sr_[i].vs1 = *(const bf16x8*)(&Kh[(size_t)((k0) + 32 + sr) * 2048 + 128 + sc]); \
    sr_[i].ks0 = *(const bf16x8*)(&Kh[(size_t)((k0) + sr) * 2048 + sc]); sr_[i].ks1 = *(const bf16x8*)(&Kh[(size_t)((k0) + 32 + sr) * 2048 + sc]); \
    sr_[i].rs = *(const bf16x8*)(&Rh[(size_t)((k0) + rr_) * 64 + rc]); } while (0)
#define SWRITE(b, i) do { *(bf16x8*)(V_lds + (b) * SHM_V + vst0) = sr_[i].vs0;          \
    *(bf16x8*)(V_lds + (b) * SHM_V + vst1) = sr_[i].vs1; const int kc = sc * 2;               \
    *(bf16x8*)(K_lds + (b) * SHM_K + KSWZ(sr, kc)) = sr_[i].ks0;                       \
    *(bf16x8*)(K_lds + (b) * SHM_K + KSWZ(32 + sr, kc)) = sr_[i].ks1;                  \
    *(bf16x8*)(R_lds + (b) * SHM_R + RSWZ(rr_, rc * 2)) = sr_[i].rs; } while (0)
#define SWAIT() do { if constexpr (SDEPTH == 2) asm volatile("s_waitcnt vmcnt(5)" ::: "memory"); else asm volatile("s_waitcnt vmcnt(0)" ::: "memory"); } while (0)
#define RESC(a) do { if (__any((a) < 1.f)) { if (hi == 0) al_l[r32] = (a); asm volatile("s_waitcnt lgkmcnt(0)" ::: "memory"); \
    _Pragma("unroll") for (int d = 0; d < 4; ++d) _Pragma("unroll") for (int r = 0; r < 16; ++r) o[d][r] *= al_l[crow(r, hi)]; } } while (0)
    f32x16 pA0, pA1, pB0, pB1; float mnA, mnB, alA, alB; bf16x8 pa0, pa1, pa2, pa3; const int NT = seq / KVBLK;
    constexpr int SE = 0, SO = SDEPTH - 1;
    SLOAD(SE, 0); asm volatile("s_waitcnt vmcnt(0)" ::: "memory"); SWRITE(0, SE); __syncthreads();
    qkt(pA0, pA1, K_lds, R_lds, qr, Qrl, r32, hi); partialSM(pA0, pA1, m_reg, mnA, alA);
    SLOAD(SO, KVBLK); if constexpr (SDEPTH == 2) { if (2 < NT) SLOAD(SE, 2 * KVBLK); }
    SWAIT(); SWRITE(1, SO); __syncthreads();
    for (int j = 1; j + 1 < NT; j += 2) {
        SBAR(); qkt(pB0, pB1, K_lds + SHM_K, R_lds + SHM_R, qr, Qrl, r32, hi);
        finishSM(pA0, pA1, alA, l_reg, pa0, pa1, pa2, pa3); SBAR();
        SLOAD(SO, (j + SDEPTH) * KVBLK); SBAR();
        pv_d0(o, vb0, pa0, pa1, pa2, pa3); partialSM(pB0, pB1, m_reg, mnB, alB);
        __syncthreads(); SWAIT(); SWRITE(0, SE);
        RESC(alB); __syncthreads();
        SBAR(); qkt(pA0, pA1, K_lds, R_lds, qr, Qrl, r32, hi);
        finishSM(pB0, pB1, alB, l_reg, pa0, pa1, pa2, pa3); SBAR();
        if (SDEPTH == 1 || j + 3 < NT) SLOAD(SE, (j + 1 + SDEPTH) * KVBLK); SBAR();
        pv_d0(o, vb0 + (int)SHM_V, pa0, pa1, pa2, pa3); partialSM(pA0, pA1, m_reg, mnA, alA);
        __syncthreads(); SWAIT(); SWRITE(1, SO);
        RESC(alA); __syncthreads();
    }
    SBAR(); qkt(pB0, pB1, K_lds + SHM_K, R_lds + SHM_R, qr, Qrl, r32, hi);
    finishSM(pA0, pA1, alA, l_reg, pa0, pa1, pa2, pa3); SBAR();
    pv_d0(o, vb0, pa0, pa1, pa2, pa3); partialSM(pB0, pB1, m_reg, mnB, alB);
    __syncthreads(); RESC(alB);
    finishSM(pB0, pB1, alB, l_reg, pa0, pa1, pa2, pa3); SBAR();
    pv_d0(o, vb0 + (int)SHM_V, pa0, pa1, pa2, pa3);
    if (hi == 0) li_l[r32] = l_reg; asm volatile("s_waitcnt lgkmcnt(0)" ::: "memory");
    float rli[16];
#pragma unroll
    for (int r = 0; r < 16; ++r) rli[r] = __builtin_amdgcn_rcpf(li_l[crow(r, hi)]);
    bf16_t* Ow = Ob + (size_t)(wid * QBLK) * 2048;
#pragma unroll
    for (int r = 0; r < 16; ++r) { const int orow = crow(r, hi);
#pragma unroll
        for (int d0 = 0; d0 < 4; ++d0) Ow[(size_t)orow * 2048 + d0 * 32 + r32] = (bf16_t)(cvt_pk_bf16(o[d0][r] * rli[r], 0.f) & 0xffffu); }
#undef SLOAD
#undef SWRITE
#undef SWAIT
#undef RESC
}
}

__device__ __forceinline__ void x_pass(const float* src, bf16_t* dstb, fix_t* st, int wv) {
    const int tid_ = otid(wv), lane = tid_ & 63, wave = tid_ >> 6;
    for (int row = blockIdx.x * 8 + wave; row < M_; row += gridDim.x * 8) {
        const float* s = src + (size_t)row * 2048; f32x4 v[8]; float s1 = 0.f, s2 = 0.f;
#pragma unroll
        for (int i = 0; i < 8; ++i) { v[i] = __builtin_nontemporal_load((const f32x4*)(s + i * 256 + lane * 4)); s1 += (v[i][0] + v[i][1]) + (v[i][2] + v[i][3]); s2 += (v[i][0] * v[i][0] + v[i][1] * v[i][1]) + (v[i][2] * v[i][2] + v[i][3] * v[i][3]); }
        s1 = wave_sum(s1, lane); s2 = wave_sum(s2, lane);
        if (lane == 0) { st[row] = to_fix(s1); st[M_ + row] = to_fix(s2); }
#pragma unroll
        for (int i = 0; i < 8; ++i) { u32x2 w; w.x = cvt_pk_bf16(v[i][0], v[i][1]); w.y = cvt_pk_bf16(v[i][2], v[i][3]); *(u32x2*)(dstb + (size_t)row * 2048 + i * 256 + lane * 4) = w; }
    }
}
__device__ __forceinline__ void ln_final(float* out, const bf16_t* hb, const fix_t* st, const float* g, const float* b, int wv) {
    const int tid = otid(wv);
    for (int i = blockIdx.x * 512 + tid; i < M_ * 512; i += gridDim.x * 512) {
        const int row = i >> 9, c = (i & 511) * 4; float mu, rs; row_ln(st, row, mu, rs);
        const u32x2 pw = *(const u32x2*)(hb + (size_t)i * 4); const f32x4 P = {bf_lo(pw.x), bf_hi(pw.x), bf_lo(pw.y), bf_hi(pw.y)}, g4 = *(const f32x4*)(g + c), b4 = *(const f32x4*)(b + c);
        *(f32x4*)(out + (size_t)i * 4) = (P - mu) * rs * g4 + b4;
    }
}
__device__ __forceinline__ int colmap(int mode, int n) {
    if (mode == 0) { if (n < 1024) return n; if (n < 2048) return 1088 + (n - 1024); if (n < 3072) return 2112 + (n - 2048);
        const int t = n - 3072, bj = t >> 7, r = t & 127; return r < 32 ? 1024 + bj * 32 + r : -1; }
    if (mode == 1) { if (n < 1024) return (n >> 7) * 192 + (n & 127);
        const int t = n - 1024, tile = t >> 8, bj = (t >> 7) & 1, wc = (t >> 5) & 3, i = t & 31; return (4 * tile + wc) * 192 + 128 + bj * 32 + i; }
    return n;
}
__device__ __forceinline__ void cvt_tile(const float* W, int ldw, bf16_t* Bt, int ldb, int n0, int k0, int mode, const float* kscale, float* T, int wv) {
    const int tid = otid(wv), n4 = (tid & 31) * 4, kq = tid >> 5, src = colmap(mode, n0 + n4);
    f32x4 v[8];
#pragma unroll
    for (int i = 0; i < 8; ++i) { const int kk = kq + 16 * i; v[i] = __builtin_nontemporal_load((const f32x4*)(W + (size_t)(k0 + kk) * ldw + (src >= 0 ? src : 0))); }
    float ksc[8];
#pragma unroll
    for (int i = 0; i < 8; ++i) ksc[i] = kscale ? kscale[k0 + kq + 16 * i] : 1.0f;
#pragma unroll
    for (int i = 0; i < 8; ++i) v[i] = v[i] * (src >= 0 ? ksc[i] : 0.0f);
#pragma unroll
    for (int i = 0; i < 8; ++i)
#pragma unroll
        for (int j = 0; j < 4; ++j) T[(n4 + j) * 129 + kq + 16 * i] = v[i][j];
    __syncthreads();
    { const int n2 = tid >> 2, ks = (tid & 3) * 32; const float* t = T + n2 * 129 + ks; bf16_t* dst = Bt + (size_t)(n0 + n2) * ldb + k0 + ks;
#pragma unroll
      for (int i = 0; i < 4; ++i) { u32x4 w; w.x = cvt_pk_bf16(t[i * 8 + 0], t[i * 8 + 1]); w.y = cvt_pk_bf16(t[i * 8 + 2], t[i * 8 + 3]); w.z = cvt_pk_bf16(t[i * 8 + 4], t[i * 8 + 5]); w.w = cvt_pk_bf16(t[i * 8 + 6], t[i * 8 + 7]);
          *(u32x4*)(dst + i * 8) = w; } }
    __syncthreads();
}
constexpr int CT0 = 26 * 16, CT1 = CT0 + 12 * 4, CT2 = CT1 + 16 * 4, CT3 = CT2 + 32, CT4 = CT3 + 16 * 16, CT5 = CT4 + 64 * 16, CT6 = CT5 + 16 * 64;
__device__ __forceinline__ void convert_weights(const Params& p, int l, int t0, int t1, float* T, int wv) {
    unsigned char* ws = p.ws;
    const float* ing = l == 0 ? p.in[2] : p.in[21] + (size_t)(l - 1) * 2048;
    for (int t = t0 + blockIdx.x; t < t1; t += gridDim.x) {
        if (t < CT0) { const int nt = t % 26, kt = t / 26; cvt_tile(p.in[4] + (size_t)l * 2048 * NIN, NIN, (bf16_t*)(ws + W_IN), 2048, nt * 128, kt * 128, 0, ing, T, wv); }
        else if (t < CT1) { const int u = t - CT0, nt = u % 12, kt = u / 12; cvt_tile(p.in[7] + (size_t)l * 512 * 1536, 1536, (bf16_t*)(ws + W_UQ), 512, nt * 128, kt * 128, 1, p.in[5] + l * 512, T, wv); }
        else if (t < CT2) { const int u = t - CT1, nt = u % 16, kt = u / 16; cvt_tile(p.in[8] + (size_t)l * 512 * 2048, 2048, (bf16_t*)(ws + W_UKV), 512, nt * 128, kt * 128, 2, p.in[6] + l * 512, T, wv); }
        else if (t < CT3) { const int mat = t - CT2, gate = mat & 1, h = (mat >> 1) & 7, d = mat >> 4;
            cvt_tile((gate ? p.in[13] : p.in[11]) + ((size_t)((l * 2 + d) * 8 + h)) * 128 * 128, 128, (bf16_t*)(ws + W_G) + (size_t)(h * 512 + d * 256 + gate * 128) * 128, 128, 0, 0, 2, nullptr, T, wv); }
        else if (t < CT4) { const int u = t - CT3, nt = u % 16, kt = u / 16; cvt_tile(p.in[16] + (size_t)l * 2048 * 2048, 2048, (bf16_t*)(ws + W_OUT), 2048, nt * 128, kt * 128, 2, nullptr, T, wv); }
        else if (t < CT5) { const int u = t - CT4, nt = u % 64, kt = u / 64; cvt_tile(p.in[19] + (size_t)l * 2048 * 8192, 8192, (bf16_t*)(ws + W_UP), 2048, nt * 128, kt * 128, 2, p.in[17] + (size_t)l * 2048, T, wv); }
        else { const int u = t - CT5, nt = u % 16, kt = u / 16; cvt_tile(p.in[20] + (size_t)l * 8192 * 2048, 2048, (bf16_t*)(ws + W_DN), 8192, nt * 128, kt * 128, 2, nullptr, T, wv); }
    }
}
__device__ __forceinline__ void colsum_pass(const bf16_t* Bt, int N, const float* lg, const float* lb, float* cs, float* bw, int wv) {
    const int tid = otid(wv), lane = tid & 63, wave = tid >> 6;
    float ratio[32];
#pragma unroll
    for (int i = 0; i < 4; ++i)
#pragma unroll
        for (int j = 0; j < 8; ++j) { const int k = i * 512 + lane * 8 + j; ratio[i * 8 + j] = lb[k] * __builtin_amdgcn_rcpf(lg[k]); }
    for (int n = blockIdx.x * 8 + wave; n < N; n += gridDim.x * 8) {
        u32x4 w[4];
#pragma unroll
        for (int i = 0; i < 4; ++i) w[i] = *(const u32x4*)(Bt + (size_t)n * 2048 + i * 512 + lane * 8);
        float c = 0.f, bb = 0.f;
#pragma unroll
        for (int i = 0; i < 4; ++i) { const float v[8] = {bf_lo(w[i].x), bf_hi(w[i].x), bf_lo(w[i].y), bf_hi(w[i].y), bf_lo(w[i].z), bf_hi(w[i].z), bf_lo(w[i].w), bf_hi(w[i].w)};
#pragma unroll
            for (int j = 0; j < 8; ++j) { c += v[j]; bb += v[j] * ratio[i * 8 + j]; } }
        c = wave_sum(c, lane); bb = wave_sum(bb, lane);
        if (lane == 0) { cs[n] = c; bw[n] = bb; }
    }
}
__device__ __forceinline__ void colsum_in(const Params& p, int l, int wv) { float* csb = (float*)(p.ws + WS_CSB) + (size_t)l * CSB_L;
    colsum_pass((const bf16_t*)(p.ws + W_IN), NINP, l == 0 ? p.in[2] : p.in[21] + (size_t)(l - 1) * 2048, l == 0 ? p.in[3] : p.in[22] + (size_t)(l - 1) * 2048, csb + CSB_IN, csb + CSB_IN + NINP, wv); }
__device__ __forceinline__ void colsum_up(const Params& p, int l, int wv) { float* csb = (float*)(p.ws + WS_CSB) + (size_t)l * CSB_L;
    colsum_pass((const bf16_t*)(p.ws + W_UP), DFF, p.in[17] + (size_t)l * 2048, p.in[18] + (size_t)l * 2048, csb + CSB_UP, csb + CSB_UP + DFF, wv); }
__device__ __forceinline__ void make_tables(const Params& p, int wv) {
    const int* pos = (const int*)p.in[1]; float* cosT = (float*)(p.ws + WS_COS); float* sinT = (float*)(p.ws + WS_SIN); float* sp = (float*)(p.ws + WS_SP);
    const int tid = otid(wv);
    for (int i = blockIdx.x * 512 + tid; i < M_ * 32; i += gridDim.x * 512) {
        const int row = i >> 5, k = i & 31; const float inv = powf(10000.0f, -(float)(2 * k) / 64.0f); const float ang = (float)pos[row] * inv;
        cosT[i] = cosf(ang); sinT[i] = sinf(ang); }
    for (int i = blockIdx.x * 512 + tid; i < DEPTH * 2 * 1024; i += gridDim.x * 512) { const float x = -p.in[15][i];
        sp[i] = fmaxf(x, 0.f) + log1pf(expf(-fabsf(x))); }
}
__device__ __forceinline__ void conv_phase(const Params& p, int l, int wv) {
    const bf16_t* __restrict__ xl = (const bf16_t*)(p.ws + WS_XL); bf16_t* __restrict__ xc = (bf16_t*)(p.ws + WS_XC);
    const float* cw = p.in[9] + (size_t)l * 4 * 1024; const float* cb = p.in[10] + (size_t)l * 1024;
    const int tid = otid(wv);
    for (int i = blockIdx.x * 512 + tid; i < M_ * 128; i += gridDim.x * 512) {
        const int row = i >> 7, c0 = (i & 127) * 8, t = row & (SEQ - 1);
        u32x4 xw[4]; f32x4 w0[4], w1[4];
#pragma unroll
        for (int k = 0; k < 4; ++k) { const int tt = t - 2 + k; const bool ok = (tt >= 0) && (tt < SEQ); const int rr = ok ? row - 2 + k : row;
            xw[k] = *(const u32x4*)(xl + (size_t)rr * 1024 + c0);
            w0[k] = *(const f32x4*)(cw + k * 1024 + c0); w1[k] = *(const f32x4*)(cw + k * 1024 + c0 + 4);
            if (!ok) { w0[k] = (f32x4){0.f, 0.f, 0.f, 0.f}; w1[k] = (f32x4){0.f, 0.f, 0.f, 0.f}; } }
        const f32x4 b0 = *(const f32x4*)(cb + c0), b1 = *(const f32x4*)(cb + c0 + 4);
        float acc[8] = {b0[0], b0[1], b0[2], b0[3], b1[0], b1[1], b1[2], b1[3]};
#pragma unroll
        for (int k = 0; k < 4; ++k) {
            acc[0] += w0[k][0] * bf_lo(xw[k].x); acc[1] += w0[k][1] * bf_hi(xw[k].x); acc[2] += w0[k][2] * bf_lo(xw[k].y); acc[3] += w0[k][3] * bf_hi(xw[k].y);
            acc[4] += w1[k][0] * bf_lo(xw[k].z); acc[5] += w1[k][1] * bf_hi(xw[k].z); acc[6] += w1[k][2] * bf_lo(xw[k].w); acc[7] += w1[k][3] * bf_hi(xw[k].w); }
        u32x4 o; o.x = cvt_pk_bf16(acc[0], acc[1]); o.y = cvt_pk_bf16(acc[2], acc[3]); o.z = cvt_pk_bf16(acc[4], acc[5]); o.w = cvt_pk_bf16(acc[6], acc[7]);
        *(u32x4*)(xc + (size_t)row * 1024 + c0) = o;
    }
}
__device__ __forceinline__ void scan_local(const Params& p, int wv) {
    const unsigned* au = (const unsigned*)(p.ws + WS_AU); f32x4* ph = (f32x4*)(p.ws + WS_PH); const int tid = otid(wv);
    for (int it = blockIdx.x; it < 2 * 8 * 64; it += gridDim.x) {
        const int c = it & 63, b = (it >> 6) & 7, d = it >> 9;
        const u32x2* __restrict__ src = (const u32x2*)(au + (size_t)d * M_ * 1024 + (size_t)(b * SEQ + c * 64) * 1024) + tid;
        float h0 = 0.f, h1 = 0.f, P0 = 1.f, P1 = 1.f;
        const long step = d ? -512 : 512; const u32x2* q = src + (d ? (size_t)63 * 512 : 0);
        u32x2 wa[16], wb[16];
#pragma unroll
        for (int j = 0; j < 16; ++j) wa[j] = q[(long)j * step];
#pragma unroll
        for (int bt = 0; bt < 4; bt += 2) {
#pragma unroll
            for (int j = 0; j < 16; ++j) wb[j] = q[(long)((bt + 1) * 16 + j) * step];
#pragma unroll
            for (int j = 0; j < 16; ++j) { const float a0 = 1.0f - bf_lo(wa[j].x), a1 = 1.0f - bf_lo(wa[j].y); h0 = a0 * h0 + bf_hi(wa[j].x); h1 = a1 * h1 + bf_hi(wa[j].y); P0 *= a0; P1 *= a1; }
            if (bt + 2 < 4) {
#pragma unroll
                for (int j = 0; j < 16; ++j) wa[j] = q[(long)((bt + 2) * 16 + j) * step]; }
#pragma unroll
            for (int j = 0; j < 16; ++j) { const float a0 = 1.0f - bf_lo(wb[j].x), a1 = 1.0f - bf_lo(wb[j].y); h0 = a0 * h0 + bf_hi(wb[j].x); h1 = a1 * h1 + bf_hi(wb[j].y); P0 *= a0; P1 *= a1; }
        }
        ph[(size_t)((d * 8 + b) * 64 + c) * 512 + tid] = (f32x4){P0, h0, P1, h1};
    }
}
__device__ __forceinline__ void scan_apply(const Params& p, int wv) {
    const unsigned* au = (const unsigned*)(p.ws + WS_AU); const f32x4* ph = (const f32x4*)(p.ws + WS_PH);
    const bf16_t* gg = (const bf16_t*)(p.ws + WS_GG); bf16_t* ycat = (bf16_t*)(p.ws + WS_YCAT); const int tid = otid(wv);
    for (int it = blockIdx.x; it < 8 * 64; it += gridDim.x) {
        const int c = it & 63, b = it >> 6;
        float Hf0 = 0.f, Hf1 = 0.f, Hb0 = 0.f, Hb1 = 0.f;
        { const f32x4* pf = ph + (size_t)((0 * 8 + b) * 64) * 512 + tid;
          for (int c0 = 0; c0 < c; c0 += 8) { f32x4 e[8];
#pragma unroll
              for (int j = 0; j < 8; ++j) e[j] = pf[(size_t)min(c0 + j, c - 1) * 512];
#pragma unroll
              for (int j = 0; j < 8; ++j) if (c0 + j >= c) e[j] = (f32x4){1.f, 0.f, 1.f, 0.f};
#pragma unroll
              for (int j = 0; j < 8; ++j) { Hf0 = e[j][0] * Hf0 + e[j][1]; Hf1 = e[j][2] * Hf1 + e[j][3]; } }
          const f32x4* pb = ph + (size_t)((1 * 8 + b) * 64) * 512 + tid;
          for (int c0 = 63; c0 > c; c0 -= 8) { f32x4 e[8];
#pragma unroll
              for (int j = 0; j < 8; ++j) e[j] = pb[(size_t)max(c0 - j, c + 1) * 512];
#pragma unroll
              for (int j = 0; j < 8; ++j) if (c0 - j <= c) e[j] = (f32x4){1.f, 0.f, 1.f, 0.f};
#pragma unroll
              for (int j = 0; j < 8; ++j) { Hb0 = e[j][0] * Hb0 + e[j][1]; Hb1 = e[j][2] * Hb1 + e[j][3]; } } }
        const size_t r0 = (size_t)(b * SEQ + c * 64);
        const u32x2* __restrict__ s0 = (const u32x2*)(au + r0 * 1024) + tid; const u32x2* __restrict__ s1 = (const u32x2*)(au + (size_t)M_ * 1024 + r0 * 1024) + tid;
        const unsigned* __restrict__ gp = (const unsigned*)(gg + r0 * 1024) + tid; unsigned* __restrict__ yp = (unsigned*)(ycat + r0 * 2048 + 1024) + tid;
        float hf0[64], hf1[64];
        { u32x2 wa[8], wb[8];
#pragma unroll
          for (int j = 0; j < 8; ++j) wa[j] = s0[(size_t)j * 512];
#pragma unroll
          for (int bt = 0; bt < 8; bt += 2) {
#pragma unroll
              for (int j = 0; j < 8; ++j) wb[j] = s0[(size_t)((bt + 1) * 8 + j) * 512];
#pragma unroll
              for (int j = 0; j < 8; ++j) { const int t = bt * 8 + j; Hf0 = (1.0f - bf_lo(wa[j].x)) * Hf0 + bf_hi(wa[j].x); Hf1 = (1.0f - bf_lo(wa[j].y)) * Hf1 + bf_hi(wa[j].y); hf0[t] = Hf0; hf1[t] = Hf1; }
              if (bt + 2 < 8) {
#pragma unroll
                  for (int j = 0; j < 8; ++j) wa[j] = s0[(size_t)((bt + 2) * 8 + j) * 512]; }
#pragma unroll
              for (int j = 0; j < 8; ++j) { const int t = (bt + 1) * 8 + j; Hf0 = (1.0f - bf_lo(wb[j].x)) * Hf0 + bf_hi(wb[j].x); Hf1 = (1.0f - bf_lo(wb[j].y)) * Hf1 + bf_hi(wb[j].y); hf0[t] = Hf0; hf1[t] = Hf1; }
          } }
        { u32x2 wa[8], wb[8]; unsigned ga[8], gb[8];
#pragma unroll
          for (int j = 0; j < 8; ++j) { wa[j] = s1[(size_t)(63 - j) * 512]; ga[j] = gp[(size_t)(63 - j) * 512]; }
#pragma unroll
          for (int bt = 0; bt < 8; bt += 2) {
#pragma unroll
              for (int j = 0; j < 8; ++j) { const int t = 63 - ((bt + 1) * 8 + j); wb[j] = s1[(size_t)t * 512]; gb[j] = gp[(size_t)t * 512]; }
#pragma unroll
              for (int j = 0; j < 8; ++j) { const int t = 63 - (bt * 8 + j); Hb0 = (1.0f - bf_lo(wa[j].x)) * Hb0 + bf_hi(wa[j].x); Hb1 = (1.0f - bf_lo(wa[j].y)) * Hb1 + bf_hi(wa[j].y);
                  yp[(size_t)t * 1024] = cvt_pk_bf16(bf_lo(ga[j]) * (hf0[t] + Hb0), bf_hi(ga[j]) * (hf1[t] + Hb1)); }
              if (bt + 2 < 8) {
#pragma unroll
                  for (int j = 0; j < 8; ++j) { const int t = 63 - ((bt + 2) * 8 + j); wa[j] = s1[(size_t)t * 512]; ga[j] = gp[(size_t)t * 512]; } }
#pragma unroll
              for (int j = 0; j < 8; ++j) { const int t = 63 - ((bt + 1) * 8 + j); Hb0 = (1.0f - bf_lo(wb[j].x)) * Hb0 + bf_hi(wb[j].x); Hb1 = (1.0f - bf_lo(wb[j].y)) * Hb1 + bf_hi(wb[j].y);
                  yp[(size_t)t * 1024] = cvt_pk_bf16(bf_lo(gb[j]) * (hf0[t] + Hb0), bf_hi(gb[j]) * (hf1[t] + Hb1)); }
          } }
    }
}

#define XB_TMO      128
#define XB_XCNT(j)  (256  + 64 * (j))
#define XB_XSUB(j)  (1280 + 64 * (j))
#define XB_XGEN(j)  (2304 + 64 * (j))
#define XB_TOP      3328
#define XB_TOPGEN   3392
#define XCD_BAR_WORDS 3456
#define XB_SPIN_CAP (1u << 20)
__device__ __forceinline__ unsigned xb_ld(unsigned* p)              { return __hip_atomic_load(p, __ATOMIC_RELAXED, __HIP_MEMORY_SCOPE_AGENT); }
__device__ __forceinline__ unsigned xb_add(unsigned* p, unsigned v) { return __hip_atomic_fetch_add(p, v, __ATOMIC_RELAXED, __HIP_MEMORY_SCOPE_AGENT); }
__device__ __forceinline__ unsigned xb_xcc_id() { unsigned x; asm volatile("s_getreg_b32 %0, hwreg(20, 0, 4)" : "=s"(x)); return x & 0xFu; }
#define XB_SPIN(cond, bar) do { unsigned _sp = 0; while (cond) { __builtin_amdgcn_s_sleep(1); \
    if ((++_sp & 255u) == 0u) { if (xb_ld(&(bar)[XB_TMO])) break; if (_sp > XB_SPIN_CAP) { atomicAdd(&(bar)[XB_TMO], 1u); break; } } } } while (0)
struct XcdBarrier { unsigned* bar; unsigned x; volatile LAS unsigned* st; };
__device__ __forceinline__ XcdBarrier xcd_barrier_post(unsigned* bar, volatile LAS unsigned* st, int wv) {
    XcdBarrier b; b.bar = bar; b.x = (unsigned)__builtin_amdgcn_readfirstlane((int)xb_xcc_id()); b.st = st;
    if (otid(wv) == 0) (void)xb_add(&bar[XB_XCNT(b.x)], 1u);
    return b;
}
__device__ __forceinline__ void xcd_barrier_complete(unsigned* bar, unsigned x, unsigned& nloc, unsigned& nx) {
    const unsigned G = gridDim.x * gridDim.y * gridDim.z;
    unsigned sum, cnt, mine, sp = 0u;
    for (;;) {
        sum = 0u; cnt = 0u; mine = 0u;
#pragma unroll
        for (unsigned j = 0; j < 16; ++j) { const unsigned c = xb_ld(&bar[XB_XCNT(j)]); sum += c; cnt += (c > 0u) ? 1u : 0u; mine = (j == x) ? c : mine; }
        if (sum == G) break;
        __builtin_amdgcn_s_sleep(1);
        if ((++sp & 255u) == 0u) { if (xb_ld(&bar[XB_TMO])) break; if (sp > XB_SPIN_CAP) { atomicAdd(&bar[XB_TMO], 1u); break; } }
    }
    nloc = mine > 0u ? mine : 1u; nx = cnt > 0u ? cnt : 1u;
}
__device__ __forceinline__ void xcd_barrier(const XcdBarrier& b, unsigned* barp, int wv) {
    asm volatile("s_waitcnt vmcnt(0) lgkmcnt(0)" ::: "memory");
    __syncthreads();
    if (otid(wv) == 0) {
        const unsigned bx_ = xb_xcc_id();
        unsigned* bar = barp;
        __builtin_amdgcn_s_waitcnt(0);
        unsigned nloc = b.st[0], nx = b.st[1];
        if (nloc == 0u) { xcd_barrier_complete(bar, bx_, nloc, nx); b.st[0] = nloc; b.st[1] = nx; }
        const unsigned old = xb_add(&bar[XB_XSUB(bx_)], 1u);
        const unsigned gen = old / nloc;
        if (old + 1u == (gen + 1u) * nloc) {
            __builtin_amdgcn_fence(__ATOMIC_RELEASE, "agent");
            asm volatile("s_waitcnt vmcnt(0)" ::: "memory");
            const unsigned og = xb_add(&bar[XB_TOP], 1u);
            const unsigned tg = og / nx;
            if (og + 1u == (tg + 1u) * nx) xb_add(&bar[XB_TOPGEN], 1u);
            else XB_SPIN(xb_ld(&bar[XB_TOPGEN]) == tg, bar);
            __builtin_amdgcn_fence(__ATOMIC_ACQUIRE, "agent");
            xb_add(&bar[XB_XGEN(bx_)], 1u);
            asm volatile("s_waitcnt vmcnt(0)" ::: "memory");
        } else {
            XB_SPIN(xb_ld(&bar[XB_XGEN(bx_)]) == gen, bar);
            __builtin_amdgcn_fence(__ATOMIC_ACQUIRE, "agent");
            asm volatile("s_waitcnt vmcnt(0)" ::: "memory");
        }
    }
    __syncthreads();
}
__global__ void __launch_bounds__(512, 2) mega_fwd(Params p) {
    extern __shared__ __attribute__((aligned(16))) unsigned char lds[];
    cg::grid_group grid = cg::this_grid();
    const int wv = __builtin_amdgcn_readfirstlane((int)threadIdx.x >> 6);
    unsigned char* ws = p.ws;
    LAS unsigned char* ldsl = (LAS unsigned char*)lds;
    bf16_t* hb = (bf16_t*)(ws + WS_HB);
    const float* cosT = (const float*)(ws + WS_COS); const float* sinT = (const float*)(ws + WS_SIN);

    volatile LAS unsigned* xst = (volatile LAS unsigned*)(ldsl + pg8::STAGE_BYTES);
    { const int t_ = otid(wv); if (t_ < 4) xst[t_] = 0u; }
    __syncthreads();
    XcdBarrier xb = xcd_barrier_post((unsigned*)(ws + WS_BAR), xst, wv);
    fix_t* stats0 = (fix_t*)(ws + WS_ST);
#define stats stats0
    { const int tid = otid(wv);
      for (int i = blockIdx.x * 512 + tid; i < 8 * 2 * M_; i += gridDim.x * 512) stats[(size_t)2 * M_ + i] = 0ull;
    }
    make_tables(p, wv);
    x_pass(p.in[0], hb, stats, wv);
    grid.sync();
    convert_weights(p, 0, 0, CT6, (float*)lds, wv);
    xcd_barrier(xb, (unsigned*)(ws + WS_BAR), wv);
    colsum_in(p, 0, wv); colsum_up(p, 0, wv);
    xcd_barrier(xb, (unsigned*)(ws + WS_BAR), wv);

#pragma unroll 1
    for (int l = 0; l < DEPTH; ++l) {
        { typedef __attribute__((address_space(1))) unsigned char gu8; uintptr_t w_ = (uintptr_t)p.ws; asm volatile("" : "+s"(w_)); ws = (unsigned char*)(gu8*)w_; }
        const float* csb = (const float*)(ws + WS_CSB) + (size_t)l * CSB_L;
        fix_t* st0 = (fix_t*)(ws + WS_ST) + (size_t)(2 * l) * 2 * M_; fix_t* st1 = st0 + 2 * M_; fix_t* st2 = st1 + 2 * M_;
        if (l > 0) { colsum_up(p, l, wv); convert_weights(p, l, CT5, CT6, (float*)lds, wv); }
        { pg8::Order S = pg8::make_order(hb, 2048, ws + W_IN, 2048, M_, NINP, 2048);
          EpiIn E{(bf16_t*)(ws + WS_CQ), (bf16_t*)(ws + WS_CKV), (bf16_t*)(ws + WS_XL), (bf16_t*)(ws + WS_GG), (bf16_t*)(ws + WS_KPE), (float*)(ws + WS_SSQ), cosT, sinT, st0, csb + CSB_IN, csb + CSB_IN + NINP};
          pg8::gemm_phase(ldsl, S, E, wv); }
        xcd_barrier(xb, (unsigned*)(ws + WS_BAR), wv);
        conv_phase(p, l, wv);
        { pg8::Order S = pg8::make_order(ws + WS_CQ, 512, ws + W_UQ, 512, M_, 1536, 512);
          EpiQ E{(bf16_t*)(ws + WS_Q), (const float*)(ws + WS_SSQ), cosT, sinT};
          pg8::gemm_phase(ldsl, S, E, wv); }
        { pg8::Order S = pg8::make_order(ws + WS_CKV, 512, ws + W_UKV, 512, M_, 2048, 512);
          EpiKV E{(bf16_t*)(ws + WS_KV), (const float*)(ws + WS_SSQ)};
          pg8::gemm_phase(ldsl, S, E, wv); }
        xcd_barrier(xb, (unsigned*)(ws + WS_BAR), wv);
        {
            const bf16_t* Q = (const bf16_t*)(ws + WS_Q); const bf16_t* KV = (const bf16_t*)(ws + WS_KV); const bf16_t* KPE = (const bf16_t*)(ws + WS_KPE); bf16_t* ycat = (bf16_t*)(ws + WS_YCAT);
            const int G = gridDim.x, bx = blockIdx.x;
            for (int L = bx; L < 1024; L += G) {
                int pair, qb;
                if (G == 256) { const int i = L >> 8, c = L & 255, xcd = c & 7, j = c >> 3; pair = i * 16 + xcd * 2 + (j >> 4); qb = j & 15; } else { pair = L >> 4; qb = L & 15; }
                const int b = pair >> 3, h = pair & 7; const size_t row0 = (size_t)b * SEQ + (size_t)qb * 256;
                __syncthreads();
                att::attn_unit(Q + row0 * 1536 + h * 128, Q + row0 * 1536 + 1024 + h * 64, KV + (size_t)b * SEQ * 2048 + h * 256, KPE + (size_t)b * SEQ * 64, ycat + row0 * 2048 + h * 128, SEQ, (char*)lds, wv);
            }
            __syncthreads();
        }
        { pg8::Order S = pg8::make_order(ws + WS_XC, 1024, ws + W_G, 128, M_, 512, 128);
          S.nZ = 8; S.a_z = 128 * 2; S.b_z = (size_t)512 * 128 * 2;
          EpiGate E{(unsigned*)(ws + WS_AU), (const bf16_t*)(ws + WS_XC), p.in[12] + (size_t)l * 2048, p.in[14] + (size_t)l * 2048, (const float*)(ws + WS_SP) + (size_t)l * 2048};
          pg8::gemm_phase(ldsl, S, E, wv); }
        xcd_barrier(xb, (unsigned*)(ws + WS_BAR), wv);
        scan_local(p, wv);
        if (l + 1 < DEPTH) { __syncthreads(); convert_weights(p, l + 1, 0, CT3, (float*)lds, wv); }
        xcd_barrier(xb, (unsigned*)(ws + WS_BAR), wv);
        if (l + 1 < DEPTH) colsum_in(p, l + 1, wv);
        scan_apply(p, wv);
        xcd_barrier(xb, (unsigned*)(ws + WS_BAR), wv);
        { pg8::Order S = pg8::make_order(ws + WS_YCAT, 2048, ws + W_OUT, 2048, M_, 2048, 2048); S.wgm = 4;
          EpiRes E{hb, st0, l == 0 ? p.in[2] : p.in[21] + (size_t)(l - 1) * 2048, l == 0 ? p.in[3] : p.in[22] + (size_t)(l - 1) * 2048, st1};
          pg8::gemm_phase(ldsl, S, E, wv); }
        xcd_barrier(xb, (unsigned*)(ws + WS_BAR), wv);
        if (l + 1 < DEPTH) { convert_weights(p, l + 1, CT3, CT4, (float*)lds, wv); }
        { pg8::Order S = pg8::make_order(hb, 2048, ws + W_UP, 2048, M_, DFF, 2048);
          EpiUp E{(bf16_t*)(ws + WS_F), st1, csb + CSB_UP, csb + CSB_UP + DFF}; pg8::gemm_phase(ldsl, S, E, wv); }
        xcd_barrier(xb, (unsigned*)(ws + WS_BAR), wv);
        if (l + 1 < DEPTH) { convert_weights(p, l + 1, CT4, CT5, (float*)lds, wv); }
        { pg8::Order S = pg8::make_order(ws + WS_F, 8192, ws + W_DN, 8192, M_, 2048, 8192); S.wgm = 4;
          EpiRes E{hb, st1, p.in[17] + (size_t)l * 2048, p.in[18] + (size_t)l * 2048, st2};
          pg8::gemm_phase(ldsl, S, E, wv); }
        xcd_barrier(xb, (unsigned*)(ws + WS_BAR), wv);
    }
    ln_final(p.out, (const bf16_t*)(p.ws + WS_HB), (const fix_t*)(p.ws + WS_ST) + (size_t)(2 * DEPTH) * 2 * M_, p.in[21] + (size_t)(DEPTH - 1) * 2048, p.in[22] + (size_t)(DEPTH - 1) * 2048, wv);
}

extern "C" void kernel_launch(void* const* d_in, const int* in_sizes, int n_in, void* d_out, int out_size, void* d_ws, size_t ws_size, hipStream_t stream) {
    constexpr int LDS_BYTES = pg8::STAGE_BYTES + 16;
    static int grid_blocks = 0;
    if (grid_blocks == 0) {
        if (n_in != 23 || in_sizes[0] != M_ * DM || out_size != M_ * DM || ws_size < WS_END) {
            fprintf(stderr, "kernel_launch: shape mismatch (n_in %d, in0 %d, out %d, ws %zu, need %zu)\n", n_in, n_in > 0 ? in_sizes[0] : -1, out_size, ws_size, (size_t)WS_END); grid_blocks = -1; return; }
        int dev = 0, cus = 0, per_cu = 0;
        hipGetDevice(&dev); hipDeviceGetAttribute(&cus, hipDeviceAttributeMultiprocessorCount, dev);
        if (hipFuncSetAttribute((const void*)mega_fwd, hipFuncAttributeMaxDynamicSharedMemorySize, LDS_BYTES) != hipSuccess) { fprintf(stderr, "kernel_launch: hipFuncSetAttribute failed\n"); grid_blocks = -1; return; }
        if (hipOccupancyMaxActiveBlocksPerMultiprocessor(&per_cu, (const void*)mega_fwd, 512, LDS_BYTES) != hipSuccess || per_cu < 1) { fprintf(stderr, "kernel_launch: occupancy query says %d\n", per_cu); per_cu = 1; }
        (void)hipGetLastError();
        grid_blocks = cus * 1;
    }
    if (grid_blocks < 0) return;
    Params p{};
    for (int i = 0; i < 23; ++i) p.in[i] = (const float*)d_in[i];
    p.out = (float*)d_out; p.ws = (unsigned char*)d_ws;
    (void)hipMemsetAsync((char*)d_ws + WS_BAR, 0, XCD_BAR_WORDS * 4, stream);
    void* args[] = {&p};
    hipError_t e = hipLaunchCooperativeKernel((const void*)mega_fwd, dim3(grid_blocks), dim3(512), args, LDS_BYTES, stream);
    if (e != hipSuccess) fprintf(stderr, "kernel_launch: cooperative launch failed: %s (grid %d)\n", hipGetErrorString(e), grid_blocks);
}
```

```cpp
#include <hip/hip_runtime.h>
#include <hip/hip_cooperative_groups.h>
#include <cstdio>
#include <cstdint>
namespace cg = cooperative_groups;

#define LAS __attribute__((address_space(3)))
typedef unsigned short bf16_t;
typedef short bf16x8 __attribute__((ext_vector_type(8)));
typedef short s16x4 __attribute__((ext_vector_type(4)));
typedef float f32x4 __attribute__((ext_vector_type(4)));
typedef float f32x2 __attribute__((ext_vector_type(2)));
typedef float f32x16 __attribute__((ext_vector_type(16)));
typedef unsigned u32x4 __attribute__((ext_vector_type(4)));
typedef unsigned u32x2 __attribute__((ext_vector_type(2)));

constexpr int M_ = 32768, DM = 2048, SEQ = 4096, NBATCH = 8, DEPTH = 4;
constexpr int NIN = 3136, NINP = 3328, DFF = 8192;
constexpr float ALPHA = 1.6817928305074290f;
constexpr float LN_EPS = 1e-5f, RMS_EPS = 1e-6f;
constexpr size_t MiB = 1ull << 20;
constexpr size_t WS_HB = 0;
constexpr size_t WS_W = 128 * MiB;
constexpr size_t W_IN = WS_W, W_UQ = W_IN + (size_t)NINP * 2048 * 2, W_UKV = W_UQ + 1536ull * 512 * 2, W_G = W_UKV + 2048ull * 512 * 2,
                 W_OUT = W_G + 8ull * 512 * 128 * 2, W_UP = W_OUT + 2048ull * 2048 * 2, W_DN = W_UP + 8192ull * 2048 * 2, W_END = W_DN + 8192ull * 2048 * 2;
static_assert(W_END <= 218 * MiB, "weights region");
constexpr size_t WS_COS = 218 * MiB, WS_SIN = 222 * MiB, WS_SP = 226 * MiB;
constexpr size_t WS_CSB = 226 * MiB + 65536;
constexpr int CSB_L = 2 * 3328 + 2 * 8192, CSB_IN = 0, CSB_UP = 2 * 3328;
constexpr size_t WS_BAR = 226 * MiB + 49152;
constexpr size_t WS_ST = 227 * MiB;
constexpr size_t WS_BIG = 232 * MiB;
constexpr size_t WS_F = WS_BIG;
constexpr size_t WS_GG = WS_BIG, WS_XC = WS_BIG + 64 * MiB, WS_YCAT = WS_BIG + 128 * MiB, WS_SSQ = WS_BIG + 256 * MiB, WS_KPE = WS_BIG + 258 * MiB,
                 WS_CQ = WS_BIG + 262 * MiB, WS_CKV = WS_BIG + 294 * MiB, WS_XL = WS_BIG + 326 * MiB, WS_AU = WS_BIG + 262 * MiB  ,
                 WS_Q = WS_BIG + 518 * MiB, WS_KV = WS_BIG + 614 * MiB, WS_PH = WS_BIG + 742 * MiB, WS_END = WS_BIG + 750 * MiB;
static_assert(WS_END <= 1024 * MiB, "workspace");

struct Params { const float* in[23]; float* out; unsigned char* ws; };

__device__ __forceinline__ int otid(int wv) { int t; asm volatile("v_mbcnt_lo_u32_b32 %0, -1, 0\n\tv_mbcnt_hi_u32_b32 %0, -1, %0" : "=v"(t)); return (wv << 6) | t; }
__device__ __forceinline__ unsigned cvt_pk_bf16(float lo, float hi) { unsigned r; asm volatile("v_cvt_pk_bf16_f32 %0, %1, %2" : "=v"(r) : "v"(lo), "v"(hi)); return r; }
__device__ __forceinline__ float sum_fq(float x) {
    auto a = __builtin_amdgcn_permlane16_swap(__float_as_uint(x), __float_as_uint(x), false, false); x = __uint_as_float(a[0]) + __uint_as_float(a[1]);
    auto b = __builtin_amdgcn_permlane32_swap(__float_as_uint(x), __float_as_uint(x), false, false); return __uint_as_float(b[0]) + __uint_as_float(b[1]); }
__device__ __forceinline__ float wave_sum(float x, int lane) {
#pragma unroll
    for (int o = 32; o >= 1; o >>= 1) x += __int_as_float(__builtin_amdgcn_ds_bpermute((lane ^ o) << 2, __float_as_int(x)));
    return x; }
__device__ __forceinline__ float bf_lo(unsigned w) { return __uint_as_float(w << 16); }
__device__ __forceinline__ float bf_hi(unsigned w) { return __uint_as_float(w & 0xffff0000u); }
__device__ __forceinline__ float sigmoidf_(float x) { return __builtin_amdgcn_rcpf(1.0f + __builtin_amdgcn_exp2f(-1.4426950408889634f * x)); }
__device__ __forceinline__ float gelu_tanh(float x) { const float z = 0.7978845608028654f * (x + 0.044715f * x * x * x); return x * sigmoidf_(2.0f * z); }
__device__ __forceinline__ u32x4 pack8(const f32x4 a, const f32x4 b) { u32x4 w; w.x = cvt_pk_bf16(a[0], a[1]); w.y = cvt_pk_bf16(a[2], a[3]); w.z = cvt_pk_bf16(b[0], b[1]); w.w = cvt_pk_bf16(b[2], b[3]); return w; }

namespace pg8 {
constexpr int BM = 256, BK = 64, HALF = 128, HTB = HALF * BK * 2, STAGE_BYTES = 8 * HTB, NXCD = 8, WGM = 8;
__host__ __device__ __forceinline__ int lds_byte(int r, int c) { const int st = (r >> 4) * 2 + (c >> 5), rr = r & 15, cc = c & 31, ob = rr * 64 + cc * 2; return st * 1024 + (ob ^ (((ob >> 9) & 1) << 5)); }
__host__ __device__ __forceinline__ void stage_rc(int b, int& R, int& C) { const int st = b / 1024, sb = b % 1024, swz = sb ^ (((sb >> 9) & 1) << 5); R = (st >> 1) * 16 + swz / 64; C = (st & 1) * 32 + (swz % 64) / 2; }
__host__ __device__ __forceinline__ int perm32(int rho) { const int n = rho >> 4, i = rho & 15; return 8 * (i >> 2) + 4 * n + (i & 3); }

struct Unit { int pm, pn, z; };
struct Order {
    int nM, nN, nZ, per, G, c, wgm;
    const char* A; const char* B; size_t a_pm, a_z, b_pn, b_z; int lda, ldb, K;
    __device__ __forceinline__ bool next(int i, Unit& u) const {
        const long L = (long)i * G + c; if (L >= (long)per * nZ) return false;
        u.z = (int)(L / per); int wgid = (int)(L % per);
        { const int q = per / NXCD, r = per % NXCD, xcd = wgid % NXCD, off = wgid / NXCD; wgid = (xcd < r ? xcd * (q + 1) : r * (q + 1) + (xcd - r) * q) + off; }
        const int nig = wgm * nN, gid = wgid / nig, fm = gid * wgm, gsz = (nM - fm) < wgm ? (nM - fm) : wgm;
        u.pm = fm + ((wgid % nig) % gsz); u.pn = (wgid % nig) / gsz; return true;
    }
    __device__ __forceinline__ const char* aptr(const Unit& u) const { return A + (size_t)u.pm * a_pm + (size_t)u.z * a_z; }
    __device__ __forceinline__ const char* bptr(const Unit& u) const { return B + (size_t)u.pn * b_pn + (size_t)u.z * b_z; }
};
__device__ __forceinline__ Order make_order(const void* A, int lda, const void* Bt, int ldb, int Mrows, int N, int K) {
    Order o; o.nM = Mrows / BM; o.nN = N / BM; o.nZ = 1; o.per = o.nM * o.nN; o.G = gridDim.x; o.c = blockIdx.x; o.wgm = WGM;
    o.A = (const char*)A; o.B = (const char*)Bt; o.a_pm = (size_t)BM * lda * 2; o.a_z = 0; o.b_pn = (size_t)BM * ldb * 2; o.b_z = 0; o.lda = lda; o.ldb = ldb; o.K = K; return o;
}

template <class Epi>
__device__ __forceinline__ void gemm_phase(LAS unsigned char* lds, const Order& S, const Epi& E, int wv) {
    const int tid = otid(wv), wid = __builtin_amdgcn_readfirstlane(tid >> 6), lane = tid & 63, wr = wid >> 2, wc = wid & 3, fr = lane & 15, fq = lane >> 4;
    const int nt = S.K / BK;
    unsigned voffA[2], voffB[2];
#pragma unroll
    for (int i = 0; i < 2; ++i) { int R, C; stage_rc(tid * 16 + i * 8192, R, C); const int Rb = Epi::PERM ? ((R & ~31) + perm32(R & 31)) : R;
        voffA[i] = (unsigned)(R * S.lda + C) * 2u; voffB[i] = (unsigned)(Rb * S.ldb + C) * 2u; }
    const size_t kstep = (size_t)(BK * 2);
    const size_t hstepA = (size_t)HALF * S.lda * 2, hstepB = (size_t)HALF * S.ldb * 2;
    const unsigned ldsw = (unsigned)wid * 1024u;
    const int aoff = lds_byte(wr * 64 + fr, fq * 8), boff = lds_byte(wc * 32 + fr, fq * 8);
#define PG8_SA(b, h) (((b) * 2 + (h)) * HTB)
#define PG8_SB(b, h) ((4 + (b) * 2 + (h)) * HTB)
#define PG8_STAGE(bufoff, gbase, voff) do { _Pragma("unroll") for (int _i = 0; _i < 2; ++_i) \
        __builtin_amdgcn_global_load_lds((const unsigned*)((const char*)(gbase) + (voff)[_i]), (LAS unsigned*)(lds + (bufoff) + ldsw + _i * 8192), 16, 0, 0); } while (0)
#define PG8_LDA(dst, b, h) do { _Pragma("unroll") for (int m = 0; m < 4; ++m) _Pragma("unroll") for (int k = 0; k < 2; ++k) dst[m][k] = *(const LAS bf16x8*)(lds + PG8_SA(b, h) + aoff + m * 2048 + k * 1024); } while (0)
#define PG8_LDB(dst, b, h) do { _Pragma("unroll") for (int n = 0; n < 2; ++n) _Pragma("unroll") for (int k = 0; k < 2; ++k) dst[n][k] = *(const LAS bf16x8*)(lds + PG8_SB(b, h) + boff + n * 2048 + k * 1024); } while (0)
#define PG8_MMA(ai, bj, At, Bt) do { __builtin_amdgcn_s_setprio(1); _Pragma("unroll") for (int m = 0; m < 4; ++m) _Pragma("unroll") for (int n = 0; n < 2; ++n) _Pragma("unroll") for (int k = 0; k < 2; ++k) \
        acc[ai][bj][m][n] = __builtin_amdgcn_mfma_f32_16x16x32_bf16(Bt[n][k], At[m][k], acc[ai][bj][m][n], 0, 0, 0); __builtin_amdgcn_s_setprio(0); } while (0)
#define PG8_WAIT_V(n) asm volatile("s_waitcnt vmcnt(" #n ")" ::: "memory")
#define PG8_WAIT_L(n) asm volatile("s_waitcnt lgkmcnt(" #n ")" ::: "memory")
#define PG8_BAR __builtin_amdgcn_s_barrier()
#define PG8_SCHED __builtin_amdgcn_sched_barrier(0)
    Unit cur, nxt; int ui = 0;
    if (!S.next(0, cur)) return;
    f32x4 acc[2][2][4][2];
#pragma unroll
    for (int a = 0; a < 2; ++a)
#pragma unroll
        for (int b = 0; b < 2; ++b)
#pragma unroll
            for (int m = 0; m < 4; ++m)
#pragma unroll
                for (int n = 0; n < 2; ++n) acc[a][b][m][n] = (f32x4){0.f, 0.f, 0.f, 0.f};
    bf16x8 At[4][2], B0[2][2], B1[2][2];
    const char* cA = S.aptr(cur); const char* cB = S.bptr(cur);
    PG8_STAGE(PG8_SB(0, 0), cB, voffB); PG8_STAGE(PG8_SA(0, 0), cA, voffA); PG8_STAGE(PG8_SB(0, 1), cB + hstepB, voffB); PG8_STAGE(PG8_SA(0, 1), cA + hstepA, voffA);
    if (wr == 1) PG8_BAR;
    PG8_WAIT_V(4); PG8_BAR;
    PG8_STAGE(PG8_SB(1, 0), cB + kstep, voffB); PG8_STAGE(PG8_SA(1, 0), cA + kstep, voffA); PG8_STAGE(PG8_SB(1, 1), cB + hstepB + kstep, voffB);
    PG8_WAIT_V(6); PG8_BAR;
    for (;;) {
        const bool has_next = S.next(ui + 1, nxt);
        const char* nA = has_next ? S.aptr(nxt) : cA; const char* nB = has_next ? S.bptr(nxt) : cB;
        for (int t = 0; t < nt; t += 2) {
            const bool last = (t == nt - 2);
            const char* a1 = cA + (size_t)(t + 1) * kstep;
            const char* a2 = last ? nA : cA + (size_t)(t + 2) * kstep; const char* b2 = last ? nB : cB + (size_t)(t + 2) * kstep;
            const char* a3 = a2 + kstep; const char* b3 = b2 + kstep;
            PG8_LDB(B0, 0, 0); PG8_SCHED; PG8_LDA(At, 0, 0); PG8_STAGE(PG8_SA(1, 1), a1 + hstepA, voffA);
            PG8_WAIT_L(8); PG8_BAR; PG8_WAIT_L(0); PG8_MMA(0, 0, At, B0); PG8_BAR; PG8_SCHED;
            PG8_LDB(B1, 0, 1); PG8_STAGE(PG8_SB(0, 0), b2, voffB);
            PG8_BAR; PG8_WAIT_L(0); PG8_MMA(0, 1, At, B1); PG8_BAR;
            PG8_LDA(At, 0, 1); PG8_STAGE(PG8_SA(0, 0), a2, voffA);
            PG8_BAR; PG8_WAIT_L(0); PG8_MMA(1, 0, At, B0); PG8_BAR; PG8_SCHED;
            PG8_STAGE(PG8_SB(0, 1), b2 + hstepB, voffB);
            PG8_WAIT_V(6); PG8_BAR; PG8_MMA(1, 1, At, B1); PG8_BAR;
            PG8_LDB(B0, 1, 0); PG8_SCHED; PG8_LDA(At, 1, 0); PG8_STAGE(PG8_SA(0, 1), a2 + hstepA, voffA);
            PG8_WAIT_L(8); PG8_BAR; PG8_WAIT_L(0); PG8_MMA(0, 0, At, B0); PG8_BAR; PG8_SCHED;
            PG8_LDB(B1, 1, 1); PG8_STAGE(PG8_SB(1, 0), b3, voffB);
            PG8_BAR; PG8_WAIT_L(0); PG8_MMA(0, 1, At, B1); PG8_BAR;
            PG8_LDA(At, 1, 1); PG8_STAGE(PG8_SA(1, 0), a3, voffA);
            PG8_BAR; PG8_WAIT_L(0); PG8_MMA(1, 0, At, B0); PG8_BAR; PG8_SCHED;
            PG8_STAGE(PG8_SB(1, 1), b3 + hstepB, voffB);
            PG8_WAIT_V(6); PG8_BAR; PG8_MMA(1, 1, At, B1); PG8_BAR;
        }
        E(acc, cur, wr, wc, fr, fq);
        if (!has_next) break;
#pragma unroll
        for (int a = 0; a < 2; ++a)
#pragma unroll
            for (int b = 0; b < 2; ++b)
#pragma unroll
                for (int m = 0; m < 4; ++m)
#pragma unroll
                    for (int n = 0; n < 2; ++n) acc[a][b][m][n] = (f32x4){0.f, 0.f, 0.f, 0.f};
        cur = nxt; cA = nA; cB = nB; ++ui;
    }
    PG8_WAIT_V(0);
    if (wr == 0) PG8_BAR;
    PG8_BAR;
#undef PG8_SA
#undef PG8_SB
#undef PG8_STAGE
#undef PG8_LDA
#undef PG8_LDB
#undef PG8_MMA
#undef PG8_WAIT_V
#undef PG8_WAIT_L
#undef PG8_BAR
#undef PG8_SCHED
}
}
using pg8::Unit;
typedef f32x4 Acc[2][2][4][2];

typedef unsigned long long fix_t;
__device__ __forceinline__ fix_t to_fix(float v) { return (fix_t)(long long)(v * 4294967296.0f); }
__device__ __forceinline__ float from_fix(fix_t v) { return fmaf((float)(unsigned)v, 2.3283064365386963e-10f, (float)(int)(v >> 32)); }
__device__ __forceinline__ void fix_add(fix_t* p, float v) { __hip_atomic_fetch_add(p, to_fix(v), __ATOMIC_RELAXED, __HIP_MEMORY_SCOPE_AGENT); }
__device__ __forceinline__ f32x4 ld_fix4(const fix_t* p) { typedef unsigned long long u64x2 __attribute__((ext_vector_type(2))); const u64x2 a = *(const u64x2*)p, b = *(const u64x2*)(p + 2);
    return (f32x4){from_fix(a.x), from_fix(a.y), from_fix(b.x), from_fix(b.y)}; }
__device__ __forceinline__ void row_ln(const fix_t* st, int row, float& mu, float& rs) { const float s1 = from_fix(st[row]), s2 = from_fix(st[M_ + row]); mu = s1 * (1.0f / 2048.0f); rs = __builtin_amdgcn_rsqf(s2 * (1.0f / 2048.0f) - mu * mu + LN_EPS); }
template <bool PERM>
__device__ __forceinline__ void ln_correct(f32x4 (&acc)[2][2][4][2], const fix_t* st, const float* cs, const float* bw, int row0, int colbase) {
    f32x4 c4[2][2], b4[2][2];
#pragma unroll
    for (int bj = 0; bj < 2; ++bj)
#pragma unroll
        for (int n = 0; n < 2; ++n) { const int col = colbase + bj * 128 + (PERM ? 4 * n : 16 * n); c4[bj][n] = *(const f32x4*)(cs + col); b4[bj][n] = *(const f32x4*)(bw + col); }
#pragma unroll
    for (int ai = 0; ai < 2; ++ai) { fix_t r1[4], r2[4];
#pragma unroll
        for (int m = 0; m < 4; ++m) { const int row = row0 + ai * 128 + m * 16; r1[m] = st[row]; r2[m] = st[M_ + row]; }
#pragma unroll
        for (int m = 0; m < 4; ++m) { const float mu = from_fix(r1[m]) * (1.0f / 2048.0f), rs = __builtin_amdgcn_rsqf(from_fix(r2[m]) * (1.0f / 2048.0f) - mu * mu + LN_EPS);
#pragma unroll
            for (int bj = 0; bj < 2; ++bj)
#pragma unroll
                for (int n = 0; n < 2; ++n) acc[ai][bj][m][n] = (acc[ai][bj][m][n] - c4[bj][n] * mu) * rs + b4[bj][n]; } }
}

struct EpiIn {
    static constexpr bool PERM = true;
    bf16_t *cq, *ckv, *xl, *gg, *kpe; float* ssq; const float *cosT, *sinT; const fix_t* st; const float *cs, *bw;
    __device__ __forceinline__ void operator()(Acc& acc, const Unit& u, int wr, int wc, int fr, int fq) const {
        const int row0 = u.pm * 256 + wr * 64 + fr, pn = u.pn;
        ln_correct<true>(acc, st, cs, bw, row0, pn * 256 + wc * 32 + 8 * fq);
        if (pn < 4) {
            bf16_t* base = (pn < 2 ? cq : ckv); const int col0 = (pn & 1) * 256 + wc * 32 + 8 * fq;
#pragma unroll
            for (int ai = 0; ai < 2; ++ai)
#pragma unroll
                for (int m = 0; m < 4; ++m) { const int row = row0 + ai * 128 + m * 16; float s = 0.f;
#pragma unroll
                    for (int bj = 0; bj < 2; ++bj) { const f32x4 v0 = acc[ai][bj][m][0], v1 = acc[ai][bj][m][1];
                        s += (v0[0] * v0[0] + v0[1] * v0[1]) + (v0[2] * v0[2] + v0[3] * v0[3]) + (v1[0] * v1[0] + v1[1] * v1[1]) + (v1[2] * v1[2] + v1[3] * v1[3]);
                        *(u32x4*)(base + (size_t)row * 512 + col0 + bj * 128) = pack8(v0, v1); }
                    s = sum_fq(s);
                    if (fq == 0) ssq[(size_t)row * 16 + pn * 4 + wc] = s; }
        } else if (pn < 8) {
            const int col0 = (pn - 4) * 256 + wc * 32 + 8 * fq;
#pragma unroll
            for (int ai = 0; ai < 2; ++ai)
#pragma unroll
                for (int m = 0; m < 4; ++m) { const int row = row0 + ai * 128 + m * 16;
#pragma unroll
                    for (int bj = 0; bj < 2; ++bj) *(u32x4*)(xl + (size_t)row * 1024 + col0 + bj * 128) = pack8(acc[ai][bj][m][0], acc[ai][bj][m][1]); }
        } else if (pn < 12) {
            const int col0 = (pn - 8) * 256 + wc * 32 + 8 * fq;
#pragma unroll
            for (int ai = 0; ai < 2; ++ai)
#pragma unroll
                for (int m = 0; m < 4; ++m) { const int row = row0 + ai * 128 + m * 16;
#pragma unroll
                    for (int bj = 0; bj < 2; ++bj) { f32x4 v0 = acc[ai][bj][m][0], v1 = acc[ai][bj][m][1];
#pragma unroll
                        for (int j = 0; j < 4; ++j) { v0[j] = gelu_tanh(v0[j]); v1[j] = gelu_tanh(v1[j]); }
                        *(u32x4*)(gg + (size_t)row * 1024 + col0 + bj * 128) = pack8(v0, v1); } }
        } else if (wc == 0) {
#pragma unroll
            for (int ai = 0; ai < 2; ++ai) { f32x4 c0[4], c1[4], s0[4], s1[4];
#pragma unroll
                for (int m = 0; m < 4; ++m) { const size_t t = (size_t)(row0 + ai * 128 + m * 16) * 32 + 8 * fq;
                    c0[m] = *(const f32x4*)(cosT + t); c1[m] = *(const f32x4*)(cosT + t + 4); s0[m] = *(const f32x4*)(sinT + t); s1[m] = *(const f32x4*)(sinT + t + 4); }
#pragma unroll
                for (int m = 0; m < 4; ++m) { const int row = row0 + ai * 128 + m * 16;
                    const f32x4 a0 = acc[ai][0][m][0], a1 = acc[ai][0][m][1], b0 = acc[ai][1][m][0], b1 = acc[ai][1][m][1];
                    *(u32x4*)(kpe + (size_t)row * 64 + 8 * fq) = pack8(a0 * c0[m] - b0 * s0[m], a1 * c1[m] - b1 * s1[m]);
                    *(u32x4*)(kpe + (size_t)row * 64 + 32 + 8 * fq) = pack8(b0 * c0[m] + a0 * s0[m], b1 * c1[m] + a1 * s1[m]); } }
        }
    }
};
__device__ __forceinline__ void rows_rstd(const float* ssq8, int row0, float (&rs)[8]) {
#pragma unroll
    for (int h = 0; h < 2; ++h) { f32x4 a[4], b[4];
#pragma unroll
        for (int k = 0; k < 4; ++k) { const float* p = ssq8 + (size_t)(row0 + h * 128 + k * 16) * 16; a[k] = *(const f32x4*)p; b[k] = *(const f32x4*)(p + 4); }
#pragma unroll
        for (int k = 0; k < 4; ++k) { const float s = ((a[k][0] + a[k][1]) + (a[k][2] + a[k][3])) + ((b[k][0] + b[k][1]) + (b[k][2] + b[k][3])); rs[h * 4 + k] = __builtin_amdgcn_rsqf(s * (1.0f / 512.0f) + RMS_EPS); } }
}
struct EpiQ {
    static constexpr bool PERM = true;
    bf16_t* q; const float* ssq; const float *cosT, *sinT;
    __device__ __forceinline__ void operator()(Acc& acc, const Unit& u, int wr, int wc, int fr, int fq) const {
        const int row0 = u.pm * 256 + wr * 64 + fr, pn = u.pn;
        float rs[8]; rows_rstd(ssq, row0, rs);
        if (pn < 4) {
            const int col0 = pn * 256 + wc * 32 + 8 * fq;
#pragma unroll
            for (int ai = 0; ai < 2; ++ai)
#pragma unroll
                for (int m = 0; m < 4; ++m) { const int row = row0 + ai * 128 + m * 16; const float r = rs[ai * 4 + m];
#pragma unroll
                    for (int bj = 0; bj < 2; ++bj) *(u32x4*)(q + (size_t)row * 1536 + col0 + bj * 128) = pack8(acc[ai][bj][m][0] * r, acc[ai][bj][m][1] * r); }
        } else {
            const int head = 4 * (pn - 4) + wc;
#pragma unroll
            for (int kb = 0; kb < 4; ++kb) { f32x4 c0[2], c1[2], s0[2], s1[2];
#pragma unroll
                for (int j = 0; j < 2; ++j) { const int k = kb * 2 + j; const size_t t = (size_t)(row0 + (k >> 2) * 128 + (k & 3) * 16) * 32 + 8 * fq;
                    c0[j] = *(const f32x4*)(cosT + t); c1[j] = *(const f32x4*)(cosT + t + 4); s0[j] = *(const f32x4*)(sinT + t); s1[j] = *(const f32x4*)(sinT + t + 4); }
#pragma unroll
                for (int j = 0; j < 2; ++j) { const int k = kb * 2 + j, ai = k >> 2, m = k & 3; const int row = row0 + ai * 128 + m * 16; const float r = rs[k];
                    const f32x4 a0 = acc[ai][0][m][0] * r, a1 = acc[ai][0][m][1] * r, b0 = acc[ai][1][m][0] * r, b1 = acc[ai][1][m][1] * r;
                    *(u32x4*)(q + (size_t)row * 1536 + 1024 + head * 64 + 8 * fq) = pack8(a0 * c0[j] - b0 * s0[j], a1 * c1[j] - b1 * s1[j]);
                    *(u32x4*)(q + (size_t)row * 1536 + 1024 + head * 64 + 32 + 8 * fq) = pack8(b0 * c0[j] + a0 * s0[j], b1 * c1[j] + a1 * s1[j]); } }
        }
    }
};
struct EpiKV {
    static constexpr bool PERM = true;
    bf16_t* kv; const float* ssq;
    __device__ __forceinline__ void operator()(Acc& acc, const Unit& u, int wr, int wc, int fr, int fq) const {
        const int row0 = u.pm * 256 + wr * 64 + fr, col0 = u.pn * 256 + wc * 32 + 8 * fq;
        float rs[8]; rows_rstd(ssq + 8, row0, rs);
#pragma unroll
        for (int ai = 0; ai < 2; ++ai)
#pragma unroll
            for (int m = 0; m < 4; ++m) { const int row = row0 + ai * 128 + m * 16; const float r = rs[ai * 4 + m];
#pragma unroll
                for (int bj = 0; bj < 2; ++bj) *(u32x4*)(kv + (size_t)row * 2048 + col0 + bj * 128) = pack8(acc[ai][bj][m][0] * r, acc[ai][bj][m][1] * r); }
    }
};
constexpr size_t AU_RPLANE = 128 * MiB;
struct EpiGate {
    static constexpr bool PERM = true;
    bf16_t* up; unsigned char* rp; const bf16_t* xc; const float *ba, *bi, *sp;
    __device__ __forceinline__ void operator()(Acc& acc, const Unit& u, int wr, int wc, int fr, int fq) const {
        const int row0 = u.pm * 256 + wr * 64 + fr, d = u.pn, ch0 = u.z * 128 + wc * 32 + 8 * fq;
        const size_t dbase = (size_t)d * M_ * 1024;
#pragma unroll
        for (int n = 0; n < 2; ++n) {
            const int ch = ch0 + 4 * n;
            const f32x4 bav = *(const f32x4*)(ba + d * 1024 + ch), biv = *(const f32x4*)(bi + d * 1024 + ch), spv = *(const f32x4*)(sp + d * 1024 + ch) * (-8.0f * 1.4426950408889634f);
            u32x2 xws[8];
#pragma unroll
            for (int k = 0; k < 8; ++k) xws[k] = *(const u32x2*)(xc + (size_t)(row0 + (k >> 2) * 128 + (k & 3) * 16) * 1024 + ch);
#pragma unroll
            for (int ai = 0; ai < 2; ++ai)
#pragma unroll
                for (int m = 0; m < 4; ++m) { const int row = row0 + ai * 128 + m * 16;
                    const u32x2 xw = xws[ai * 4 + m];
                    const float xv[4] = {bf_lo(xw.x), bf_hi(xw.x), bf_lo(xw.y), bf_hi(xw.y)};
                    float uf[4]; unsigned rb = 0u;
#pragma unroll
                    for (int j = 0; j < 4; ++j) {
                        const float r = sigmoidf_(acc[ai][0][m][n][j] + bav[j]);
                        const float ig = sigmoidf_(acc[ai][1][m][n][j] + biv[j]);
                        const float rq = __builtin_rintf(r * 255.0f);
                        const float a = __builtin_amdgcn_exp2f((rq * (1.0f / 255.0f)) * spv[j]);
                        const float oma = 1.0f - a;
                        uf[j] = __builtin_amdgcn_sqrtf(oma * (1.0f + a)) * ig * xv[j];
                        rb |= (unsigned)rq << (8 * j); }
                    u32x2 uw; uw.x = cvt_pk_bf16(uf[0], uf[1]); uw.y = cvt_pk_bf16(uf[2], uf[3]);
                    *(u32x2*)(up + dbase + (size_t)row * 1024 + ch) = uw;
                    *(unsigned*)(rp + dbase + (size_t)row * 1024 + ch) = rb; }
        }
    }
};
#ifndef RES_PF
#define RES_PF 2
#endif
struct EpiRes {
    static constexpr bool PERM = false;
    bf16_t* hb; const fix_t* st_old; const float *g, *b; fix_t* st_new;
    __device__ __forceinline__ void operator()(Acc& acc, const Unit& u, int wr, int wc, int fr, int fq) const {
        const int row0 = u.pm * 256 + wr * 64 + fr, col0 = u.pn * 256 + wc * 32 + 4 * fq;
        f32x4 gv[4], bv[4]; u32x2 P[RES_PF + 1][4]; float mus[8], rss[8];
#define RES_LOAD(k) do { const size_t off_ = (size_t)(row0 + ((k) >> 2) * 128 + ((k) & 3) * 16) * 2048 + col0; _Pragma("unroll") for (int c = 0; c < 4; ++c) P[(k) % (RES_PF + 1)][c] = *(const u32x2*)(hb + off_ + (c >> 1) * 128 + (c & 1) * 16); } while (0)
#pragma unroll
        for (int k = 0; k < RES_PF; ++k) RES_LOAD(k);
#pragma unroll
        for (int c = 0; c < 4; ++c) { gv[c] = *(const f32x4*)(g + col0 + (c >> 1) * 128 + (c & 1) * 16); bv[c] = *(const f32x4*)(b + col0 + (c >> 1) * 128 + (c & 1) * 16); }
#pragma unroll
        for (int h = 0; h < 2; ++h) { fix_t r1[4], r2[4];
#pragma unroll
            for (int k = 0; k < 4; ++k) { const int row = row0 + h * 128 + k * 16; r1[k] = st_old[row]; r2[k] = st_old[M_ + row]; }
#pragma unroll
            for (int k = 0; k < 4; ++k) { mus[h * 4 + k] = from_fix(r1[k]) * (1.0f / 2048.0f); rss[h * 4 + k] = __builtin_amdgcn_rsqf(from_fix(r2[k]) * (1.0f / 2048.0f) - mus[h * 4 + k] * mus[h * 4 + k] + LN_EPS); } }
#pragma unroll
        for (int k = 0; k < 8; ++k) {
            if (k + RES_PF < 8) RES_LOAD(k + RES_PF);
            const int ai = k >> 2, m = k & 3; const size_t off = (size_t)(row0 + ai * 128 + m * 16) * 2048 + col0;
            const float mu = mus[k], rs = rss[k];
            float a1 = 0.f, a2 = 0.f;
#pragma unroll
            for (int c = 0; c < 4; ++c) { const int cc = (c >> 1) * 128 + (c & 1) * 16; const u32x2 pw = P[k % (RES_PF + 1)][c];
                const f32x4 Pf = {bf_lo(pw.x), bf_hi(pw.x), bf_lo(pw.y), bf_hi(pw.y)};
                const f32x4 v = ((Pf - mu) * rs * gv[c] + bv[c]) * ALPHA + acc[ai][c >> 1][m][c & 1];
                u32x2 w; w.x = cvt_pk_bf16(v[0], v[1]); w.y = cvt_pk_bf16(v[2], v[3]); *(u32x2*)(hb + off + cc) = w;
                a1 += (v[0] + v[1]) + (v[2] + v[3]); a2 += (v[0] * v[0] + v[1] * v[1]) + (v[2] * v[2] + v[3] * v[3]); }
            a1 = sum_fq(a1); a2 = sum_fq(a2);
            { const int row = row0 + ai * 128 + m * 16; if (fq == 0) fix_add(st_new + row, a1); else if (fq == 1) fix_add(st_new + M_ + row, a2); }
        }
#undef RES_LOAD
    }
};
struct EpiUp {
    static constexpr bool PERM = true;
    bf16_t* f; const fix_t* st; const float *cs, *bw;
    __device__ __forceinline__ void operator()(Acc& acc, const Unit& u, int wr, int wc, int fr, int fq) const {
        const int row0 = u.pm * 256 + wr * 64 + fr, col0 = u.pn * 256 + wc * 32 + 8 * fq;
        ln_correct<true>(acc, st, cs, bw, row0, col0);
#pragma unroll
        for (int ai = 0; ai < 2; ++ai)
#pragma unroll
            for (int m = 0; m < 4; ++m) { const int row = row0 + ai * 128 + m * 16;
#pragma unroll
                for (int bj = 0; bj < 2; ++bj) { f32x4 v0 = acc[ai][bj][m][0], v1 = acc[ai][bj][m][1];
#pragma unroll
                    for (int j = 0; j < 4; ++j) { const float a = fmaxf(v0[j], 0.f), b = fmaxf(v1[j], 0.f); v0[j] = a * a; v1[j] = b * b; }
                    __builtin_nontemporal_store(pack8(v0, v1), (u32x4*)(f + (size_t)row * 8192 + col0 + bj * 128)); } }
    }
};

namespace att {
constexpr int NW = 8, QBLK = 32, KVBLK = 64;
constexpr float SCALE = 0.07216878364870323f;
constexpr float THR = 8.f;
#ifndef ATT_SDEPTH
#define ATT_SDEPTH 1
#endif
constexpr int SDEPTH = ATT_SDEPTH;
constexpr int SHM_V = KVBLK * 128 * 2, SHM_K = KVBLK * 128 * 2, SHM_R = KVBLK * 64 * 2;
constexpr int OFF_V = 0, OFF_K = 2 * SHM_V, OFF_R = OFF_K + 2 * SHM_K, OFF_WS = OFF_R + 2 * SHM_R, OFF_QR = OFF_WS + NW * 64 * 4, SHM_ATTN = OFF_QR + 256 * 128;
#define KSWZ(row, colB) ((row) * 256 + ((colB) ^ (((row) & 7) << 4)))
#define RSWZ(row, colB) ((row) * 128 + ((colB) ^ (((row) & 7) << 4)))
#define SBAR() __builtin_amdgcn_sched_barrier(0)
__device__ __forceinline__ int crow(int r, int hi) { return (r & 3) + 8 * (r >> 2) + 4 * hi; }
__device__ __forceinline__ void partialSM(f32x16& p0, f32x16& p1, float& m_reg, float& mn, float& alpha) {
    constexpr float C = SCALE * 1.4426950408889634f;
    float pmax = p0[0];
#pragma unroll
    for (int r = 1; r < 16; ++r) pmax = fmaxf(pmax, p0[r]);
#pragma unroll
    for (int r = 0; r < 16; ++r) pmax = fmaxf(pmax, p1[r]);
    { auto rr = __builtin_amdgcn_permlane32_swap(__float_as_uint(pmax), __float_as_uint(pmax), false, false);
      pmax = fmaxf(__uint_as_float(rr[0]), __uint_as_float(rr[1])); }
    if (__builtin_expect(__all(pmax - m_reg <= THR / SCALE), 1)) { mn = m_reg; alpha = 1.f; }
    else { mn = fmaxf(m_reg, pmax); alpha = __builtin_amdgcn_exp2f((m_reg - mn) * C); m_reg = mn; }
    const float mnC = -mn * C;
#pragma unroll
    for (int r = 0; r < 16; ++r) p0[r] = fmaf(p0[r], C, mnC);
#pragma unroll
    for (int r = 0; r < 16; ++r) p1[r] = fmaf(p1[r], C, mnC);
#pragma unroll
    for (int r = 0; r < 16; ++r) p0[r] = __builtin_amdgcn_exp2f(p0[r]);
}
__device__ __forceinline__ void finishSM(f32x16& p0, f32x16& p1, float alpha, float& l_reg, bf16x8& pa0, bf16x8& pa1, bf16x8& pa2, bf16x8& pa3) {
#pragma unroll
    for (int r = 0; r < 16; ++r) p1[r] = __builtin_amdgcn_exp2f(p1[r]);
    float ps = 0;
#pragma unroll
    for (int r = 0; r < 16; ++r) ps += p0[r];
#pragma unroll
    for (int r = 0; r < 16; ++r) ps += p1[r];
    { auto rr = __builtin_amdgcn_permlane32_swap(__float_as_uint(ps), __float_as_uint(ps), false, false);
      ps = __uint_as_float(rr[0]) + __uint_as_float(rr[1]); }
    l_reg = l_reg * alpha + ps;
#define PK4(P, BASE, OUT) do { unsigned a0 = cvt_pk_bf16(P[BASE + 0], P[BASE + 1]), a1 = cvt_pk_bf16(P[BASE + 2], P[BASE + 3]);   \
    unsigned b0 = cvt_pk_bf16(P[BASE + 4], P[BASE + 5]), b1 = cvt_pk_bf16(P[BASE + 6], P[BASE + 7]);                              \
    auto r0 = __builtin_amdgcn_permlane32_swap(a0, b0, false, false); auto r1 = __builtin_amdgcn_permlane32_swap(a1, b1, false, false); \
    u32x4 w = {r0[0], r1[0], r0[1], r1[1]}; OUT = *reinterpret_cast<bf16x8*>(&w); } while (0)
    PK4(p0, 0, pa0); PK4(p0, 8, pa1); PK4(p1, 0, pa2); PK4(p1, 8, pa3);
#undef PK4
}
__device__ __forceinline__ void qkt(f32x16& p0, f32x16& p1, const char* Ks, const char* Rs, const bf16x8* qr, const char* Qrl, int r32, int hi) {
    p0 = f32x16{}; p1 = f32x16{};
#pragma unroll
    for (int d0 = 0; d0 < 8; ++d0) { const int cb = (d0 * 16 + hi * 8) * 2;
        const bf16x8 b0 = *reinterpret_cast<const bf16x8*>(Ks + KSWZ(r32, cb));
        const bf16x8 b1 = *reinterpret_cast<const bf16x8*>(Ks + KSWZ(32 + r32, cb));
        p0 = __builtin_amdgcn_mfma_f32_32x32x16_bf16(b0, qr[d0], p0, 0, 0, 0);
        p1 = __builtin_amdgcn_mfma_f32_32x32x16_bf16(b1, qr[d0], p1, 0, 0, 0); }
#pragma unroll
    for (int d0 = 0; d0 < 4; ++d0) { const int cb = (d0 * 16 + hi * 8) * 2;
        const bf16x8 b0 = *reinterpret_cast<const bf16x8*>(Rs + RSWZ(r32, cb));
        const bf16x8 b1 = *reinterpret_cast<const bf16x8*>(Rs + RSWZ(32 + r32, cb));
        const bf16x8 qv = *reinterpret_cast<const bf16x8*>(Qrl + (cb ^ ((r32 & 7) << 4)));
        p0 = __builtin_amdgcn_mfma_f32_32x32x16_bf16(b0, qv, p0, 0, 0, 0);
        p1 = __builtin_amdgcn_mfma_f32_32x32x16_bf16(b1, qv, p1, 0, 0, 0); }
}
__device__ __forceinline__ int v_st(int k, int c) { const int kk = (k & ~0xC) | ((k & 4) << 1) | ((k & 8) >> 1); return ((kk >> 3) * 4 + (c >> 5)) * 512 + ((kk & 7) * 32 + (c & 31)) * 2; }
__device__ __forceinline__ int v_rd_base(int lane) { return ((lane & 3) << 3) | (((lane >> 2) & 3) << 6) | (((lane >> 4) & 1) << 5) | (((lane >> 5) & 1) << 8); }
constexpr int v_rd_off(int d0, int ks, int half) { return d0 * 512 + ks * 4096 + half * 2048; }
template <int OFF> __device__ __forceinline__ s16x4 tr_read(int vb) {
    s16x4 r; asm volatile("ds_read_b64_tr_b16 %0, %1 offset:%2" : "=&v"(r) : "v"(vb), "i"(OFF) : "memory"); return r;
}
template <int D0> __device__ __forceinline__ void pv_one(f32x16& od, int vb, bf16x8 pa0, bf16x8 pa1, bf16x8 pa2, bf16x8 pa3) {
    const s16x4 l0 = tr_read<v_rd_off(D0, 0, 0)>(vb), h0 = tr_read<v_rd_off(D0, 0, 1)>(vb), l1 = tr_read<v_rd_off(D0, 1, 0)>(vb), h1 = tr_read<v_rd_off(D0, 1, 1)>(vb);
    const s16x4 l2 = tr_read<v_rd_off(D0, 2, 0)>(vb), h2 = tr_read<v_rd_off(D0, 2, 1)>(vb), l3 = tr_read<v_rd_off(D0, 3, 0)>(vb), h3 = tr_read<v_rd_off(D0, 3, 1)>(vb);
    asm volatile("s_waitcnt lgkmcnt(0)" ::: "memory"); SBAR();
#define PK(L, H) (bf16x8){L[0], L[1], L[2], L[3], H[0], H[1], H[2], H[3]}
    od = __builtin_amdgcn_mfma_f32_32x32x16_bf16(pa0, PK(l0, h0), od, 0, 0, 0);
    od = __builtin_amdgcn_mfma_f32_32x32x16_bf16(pa1, PK(l1, h1), od, 0, 0, 0);
    od = __builtin_amdgcn_mfma_f32_32x32x16_bf16(pa2, PK(l2, h2), od, 0, 0, 0);
    od = __builtin_amdgcn_mfma_f32_32x32x16_bf16(pa3, PK(l3, h3), od, 0, 0, 0);
#undef PK
}
__device__ __forceinline__ void pv_d0(f32x16* o, int vb, bf16x8 pa0, bf16x8 pa1, bf16x8 pa2, bf16x8 pa3) {
    pv_one<0>(o[0], vb, pa0, pa1, pa2, pa3); pv_one<1>(o[1], vb, pa0, pa1, pa2, pa3); pv_one<2>(o[2], vb, pa0, pa1, pa2, pa3); pv_one<3>(o[3], vb, pa0, pa1, pa2, pa3);
}
__device__ __forceinline__ void attn_unit(const bf16_t* __restrict__ Qn, const bf16_t* __restrict__ Qr, const bf16_t* __restrict__ Kh, const bf16_t* __restrict__ Rh,
                                          bf16_t* __restrict__ Ob, int seq, char* lds, int wv) {
    const int tid = otid(wv), wid = tid >> 6, lane = tid & 63, r32 = lane & 31, hi = lane >> 5;
    char* V_lds = lds + OFF_V; char* K_lds = lds + OFF_K; char* R_lds = lds + OFF_R;
    float* ws = (float*)(lds + OFF_WS) + wid * 64; float* li_l = ws; float* al_l = ws + 32;
    float m_reg = -1e30f, l_reg = 0; f32x16 o[4] = {}; bf16x8 qr[8];
    char* Qrl = lds + OFF_QR + (wid * QBLK + r32) * 128;
    {
        const bf16_t* Qw = Qn + (size_t)(wid * QBLK + r32) * 1536 + hi * 8;
#pragma unroll
        for (int d0 = 0; d0 < 8; ++d0) qr[d0] = *reinterpret_cast<const bf16x8*>(Qw + d0 * 16);
        const bf16_t* Qw2 = Qr + (size_t)(wid * QBLK + r32) * 1536 + hi * 8;
#pragma unroll
        for (int d0 = 0; d0 < 4; ++d0) { const bf16x8 t = *reinterpret_cast<const bf16x8*>(Qw2 + d0 * 16); *reinterpret_cast<bf16x8*>(Qrl + (((d0 * 16 + hi * 8) * 2) ^ ((r32 & 7) << 4))) = t; }
    }
    const int sr = tid >> 4, sc = (tid & 15) * 8, vst0 = v_st(sr, sc), vst1 = v_st(32 + sr, sc);
    const int rr_ = tid >> 3, rc = (tid & 7) * 8;
    const int vb0 = (int)(uintptr_t)V_lds + v_rd_base(lane);
    struct { bf16x8 vs0, vs1, ks0, ks1, rs; } sr_[SDEPTH];
#define SLOAD(i, k0) do { sr_[i].vs0 = *(const bf16x8*)(&Kh[(size_t)((k0) + sr) * 2048 + 128 + sc]); sr_[i].vs1 = *(const bf16x8*)(&Kh[(size_t)((k0) + 32 + sr) * 2048 + 128 + sc]); \
    sr_[i].ks0 = *(const bf16x8*)(&Kh[(size_t)((k0) + sr) * 2048 + sc]); sr_[i].ks1 = *(const bf16x8*)(&Kh[(size_t)((k0) + 32 + sr) * 2048 + sc]); \
    sr_[i].rs = *(const bf16x8*)(&Rh[(size_t)((k0) + rr_) * 64 + rc]); } while (0)
#define SWRITE(b, i) do { *(bf16x8*)(V_lds + (b) * SHM_V + vst0) = sr_[i].vs0;          \
    *(bf16x8*)(V_lds + (b) * SHM_V + vst1) = sr_[i].vs1; const int kc = sc * 2;               \
    *(bf16x8*)(K_lds + (b) * SHM_K + KSWZ(sr, kc)) = sr_[i].ks0;                       \
    *(bf16x8*)(K_lds + (b) * SHM_K + KSWZ(32 + sr, kc)) = sr_[i].ks1;                  \
    *(bf16x8*)(R_lds + (b) * SHM_R + RSWZ(rr_, rc * 2)) = sr_[i].rs; } while (0)
#define SWAIT() do { if constexpr (SDEPTH == 2) asm volatile("s_waitcnt vmcnt(5)" ::: "memory"); else asm volatile("s_waitcnt vmcnt(0)" ::: "memory"); } while (0)
#define RESC(a) do { if (__any((a) < 1.f)) { if (hi == 0) al_l[r32] = (a); asm volatile("s_waitcnt lgkmcnt(0)" ::: "memory"); \
    _Pragma("unroll") for (int d = 0; d < 4; ++d) _Pragma("unroll") for (int r = 0; r < 16; ++r) o[d][r] *= al_l[crow(r, hi)]; } } while (0)
    f32x16 pA0, pA1, pB0, pB1; float mnA, mnB, alA, alB; bf16x8 pa0, pa1, pa2, pa3; const int NT = seq / KVBLK;
    constexpr int SE = 0, SO = SDEPTH - 1;
    SLOAD(SE, 0); asm volatile("s_waitcnt vmcnt(0)" ::: "memory"); SWRITE(0, SE); __syncthreads();
    qkt(pA0, pA1, K_lds, R_lds, qr, Qrl, r32, hi); partialSM(pA0, pA1, m_reg, mnA, alA);
    SLOAD(SO, KVBLK); if constexpr (SDEPTH == 2) { if (2 < NT) SLOAD(SE, 2 * KVBLK); }
    SWAIT(); SWRITE(1, SO); __syncthreads();
    for (int j = 1; j + 1 < NT; j += 2) {
        SBAR(); qkt(pB0, pB1, K_lds + SHM_K, R_lds + SHM_R, qr, Qrl, r32, hi);
        finishSM(pA0, pA1, alA, l_reg, pa0, pa1, pa2, pa3); SBAR();
        SLOAD(SO, (j + SDEPTH) * KVBLK); SBAR();
        pv_d0(o, vb0, pa0, pa1, pa2, pa3); partialSM(pB0, pB1, m_reg, mnB, alB);
        __syncthreads(); SWAIT(); SWRITE(0, SE);
        RESC(alB); __syncthreads();
        SBAR(); qkt(pA0, pA1, K_lds, R_lds, qr, Qrl, r32, hi);
        finishSM(pB0, pB1, alB, l_reg, pa0, pa1, pa2, pa3); SBAR();
        if (SDEPTH == 1 || j + 3 < NT) SLOAD(SE, (j + 1 + SDEPTH) * KVBLK); SBAR();
        pv_d0(o, vb0 + (int)SHM_V, pa0, pa1, pa2, pa3); partialSM(pA0, pA1, m_reg, mnA, alA);
        __syncthreads(); SWAIT(); SWRITE(1, SO);
        RESC(alA); __syncthreads();
    }
    SBAR(); qkt(pB0, pB1, K_lds + SHM_K, R_lds + SHM_R, qr, Qrl, r32, hi);
    finishSM(pA0, pA1, alA, l_reg, pa0, pa1, pa2, pa3); SBAR();
    pv_d0(o, vb0, pa0, pa1, pa2, pa3); partialSM(pB0, pB1, m_reg, mnB, alB);
    __syncthreads(); RESC(alB);
    finishSM(pB0, pB1, alB, l_reg, pa0, pa1, pa2, pa3); SBAR();
    pv_d0(o, vb0 + (int)SHM_V, pa0, pa1, pa2, pa3);
    if (hi == 0) li_l[r32] = l_reg; asm volatile("s_waitcnt lgkmcnt(0)" ::: "memory");
    float rli[16];
#pragma unroll
    for (int r = 0; r < 16; ++r) rli[r] = __builtin_amdgcn_rcpf(li_l[crow(r, hi)]);
    bf16_t* Ow = Ob + (size_t)(wid * QBLK) * 2048;
#pragma unroll
    for (int r = 0; r < 16; ++r) { const int orow = crow(r, hi);
#pragma unroll
        for (int d0 = 0; d0 < 4; ++d0) Ow[(size_t)orow * 2048 + d0 * 32 + r32] = (bf16_t)(cvt_pk_bf16(o[d0][r] * rli[r], 0.f) & 0xffffu); }
#undef SLOAD
#undef SWRITE
#undef SWAIT
#undef RESC
}
}

__device__ __forceinline__ void x_pass(const float* src, bf16_t* dstb, fix_t* st, int wv) {
    const int tid_ = otid(wv), lane = tid_ & 63, wave = tid_ >> 6;
    for (int row = blockIdx.x * 8 + wave; row < M_; row += gridDim.x * 8) {
        const float* s = src + (size_t)row * 2048; f32x4 v[8]; float s1 = 0.f, s2 = 0.f;
#pragma unroll
        for (int i = 0; i < 8; ++i) { v[i] = __builtin_nontemporal_load((const f32x4*)(s + i * 256 + lane * 4)); s1 += (v[i][0] + v[i][1]) + (v[i][2] + v[i][3]); s2 += (v[i][0] * v[i][0] + v[i][1] * v[i][1]) + (v[i][2] * v[i][2] + v[i][3] * v[i][3]); }
        s1 = wave_sum(s1, lane); s2 = wave_sum(s2, lane);
        if (lane == 0) { st[row] = to_fix(s1); st[M_ + row] = to_fix(s2); }
#pragma unroll
        for (int i = 0; i < 8; ++i) { u32x2 w; w.x = cvt_pk_bf16(v[i][0], v[i][1]); w.y = cvt_pk_bf16(v[i][2], v[i][3]); *(u32x2*)(dstb + (size_t)row * 2048 + i * 256 + lane * 4) = w; }
    }
}
__device__ __forceinline__ void ln_final(float* out, const bf16_t* hb, const fix_t* st, const float* g, const float* b, int wv) {
    const int tid = otid(wv);
    for (int i = blockIdx.x * 512 + tid; i < M_ * 512; i += gridDim.x * 512) {
        const int row = i >> 9, c = (i & 511) * 4; float mu, rs; row_ln(st, row, mu, rs);
        const u32x2 pw = *(const u32x2*)(hb + (size_t)i * 4); const f32x4 P = {bf_lo(pw.x), bf_hi(pw.x), bf_lo(pw.y), bf_hi(pw.y)}, g4 = *(const f32x4*)(g + c), b4 = *(const f32x4*)(b + c);
        *(f32x4*)(out + (size_t)i * 4) = (P - mu) * rs * g4 + b4;
    }
}
__device__ __forceinline__ int colmap(int mode, int n) {
    if (mode == 0) { if (n < 1024) return n; if (n < 2048) return 1088 + (n - 1024); if (n < 3072) return 2112 + (n - 2048);
        const int t = n - 3072, bj = t >> 7, r = t & 127; return r < 32 ? 1024 + bj * 32 + r : -1; }
    if (mode == 1) { if (n < 1024) return (n >> 7) * 192 + (n & 127);
        const int t = n - 1024, tile = t >> 8, bj = (t >> 7) & 1, wc = (t >> 5) & 3, i = t & 31; return (4 * tile + wc) * 192 + 128 + bj * 32 + i; }
    return n;
}
__device__ __forceinline__ void cvt_tile(const float* W, int ldw, bf16_t* Bt, int ldb, int n0, int k0, int mode, const float* kscale, float* T, int wv) {
    const int tid = otid(wv), n4 = (tid & 31) * 4, kq = tid >> 5, src = colmap(mode, n0 + n4);
    f32x4 v[8];
#pragma unroll
    for (int i = 0; i < 8; ++i) { const int kk = kq + 16 * i; v[i] = __builtin_nontemporal_load((const f32x4*)(W + (size_t)(k0 + kk) * ldw + (src >= 0 ? src : 0))); }
    float ksc[8];
#pragma unroll
    for (int i = 0; i < 8; ++i) ksc[i] = kscale ? kscale[k0 + kq + 16 * i] : 1.0f;
#pragma unroll
    for (int i = 0; i < 8; ++i) v[i] = v[i] * (src >= 0 ? ksc[i] : 0.0f);
#pragma unroll
    for (int i = 0; i < 8; ++i)
#pragma unroll
        for (int j = 0; j < 4; ++j) T[(n4 + j) * 129 + kq + 16 * i] = v[i][j];
    __syncthreads();
    { const int n2 = tid >> 2, ks = (tid & 3) * 32; const float* t = T + n2 * 129 + ks; bf16_t* dst = Bt + (size_t)(n0 + n2) * ldb + k0 + ks;
#pragma unroll
      for (int i = 0; i < 4; ++i) { u32x4 w; w.x = cvt_pk_bf16(t[i * 8 + 0], t[i * 8 + 1]); w.y = cvt_pk_bf16(t[i * 8 + 2], t[i * 8 + 3]); w.z = cvt_pk_bf16(t[i * 8 + 4], t[i * 8 + 5]); w.w = cvt_pk_bf16(t[i * 8 + 6], t[i * 8 + 7]);
          *(u32x4*)(dst + i * 8) = w; } }
    __syncthreads();
}
constexpr int CT0 = 26 * 16, CT1 = CT0 + 12 * 4, CT2 = CT1 + 16 * 4, CT3 = CT2 + 32, CT4 = CT3 + 16 * 16, CT5 = CT4 + 64 * 16, CT6 = CT5 + 16 * 64;
__device__ __forceinline__ void convert_weights(const Params& p, int l, int t0, int t1, float* T, int wv) {
    unsigned char* ws = p.ws;
    const float* ing = l == 0 ? p.in[2] : p.in[21] + (size_t)(l - 1) * 2048;
    for (int t = t0 + blockIdx.x; t < t1; t += gridDim.x) {
        if (t < CT0) { const int nt = t % 26, kt = t / 26; cvt_tile(p.in[4] + (size_t)l * 2048 * NIN, NIN, (bf16_t*)(ws + W_IN), 2048, nt * 128, kt * 128, 0, ing, T, wv); }
        else if (t < CT1) { const int u = t - CT0, nt = u % 12, kt = u / 12; cvt_tile(p.in[7] + (size_t)l * 512 * 1536, 1536, (bf16_t*)(ws + W_UQ), 512, nt * 128, kt * 128, 1, p.in[5] + l * 512, T, wv); }
        else if (t < CT2) { const int u = t - CT1, nt = u % 16, kt = u / 16; cvt_tile(p.in[8] + (size_t)l * 512 * 2048, 2048, (bf16_t*)(ws + W_UKV), 512, nt * 128, kt * 128, 2, p.in[6] + l * 512, T, wv); }
        else if (t < CT3) { const int mat = t - CT2, gate = mat & 1, h = (mat >> 1) & 7, d = mat >> 4;
            cvt_tile((gate ? p.in[13] : p.in[11]) + ((size_t)((l * 2 + d) * 8 + h)) * 128 * 128, 128, (bf16_t*)(ws + W_G) + (size_t)(h * 512 + d * 256 + gate * 128) * 128, 128, 0, 0, 2, nullptr, T, wv); }
        else if (t < CT4) { const int u = t - CT3, nt = u % 16, kt = u / 16; cvt_tile(p.in[16] + (size_t)l * 2048 * 2048, 2048, (bf16_t*)(ws + W_OUT), 2048, nt * 128, kt * 128, 2, nullptr, T, wv); }
        else if (t < CT5) { const int u = t - CT4, nt = u % 64, kt = u / 64; cvt_tile(p.in[19] + (size_t)l * 2048 * 8192, 8192, (bf16_t*)(ws + W_UP), 2048, nt * 128, kt * 128, 2, p.in[17] + (size_t)l * 2048, T, wv); }
        else { const int u = t - CT5, nt = u % 16, kt = u / 16; cvt_tile(p.in[20] + (size_t)l * 8192 * 2048, 2048, (bf16_t*)(ws + W_DN), 8192, nt * 128, kt * 128, 2, nullptr, T, wv); }
    }
}
__device__ __forceinline__ void colsum_pass(const bf16_t* Bt, int N, const float* lg, const float* lb, float* cs, float* bw, int wv) {
    const int tid = otid(wv), lane = tid & 63, wave = tid >> 6;
    float ratio[32];
#pragma unroll
    for (int i = 0; i < 4; ++i)
#pragma unroll
        for (int j = 0; j < 8; ++j) { const int k = i * 512 + lane * 8 + j; ratio[i * 8 + j] = lb[k] * __builtin_amdgcn_rcpf(lg[k]); }
    for (int n = blockIdx.x * 8 + wave; n < N; n += gridDim.x * 8) {
        u32x4 w[4];
#pragma unroll
        for (int i = 0; i < 4; ++i) w[i] = *(const u32x4*)(Bt + (size_t)n * 2048 + i * 512 + lane * 8);
        float c = 0.f, bb = 0.f;
#pragma unroll
        for (int i = 0; i < 4; ++i) { const float v[8] = {bf_lo(w[i].x), bf_hi(w[i].x), bf_lo(w[i].y), bf_hi(w[i].y), bf_lo(w[i].z), bf_hi(w[i].z), bf_lo(w[i].w), bf_hi(w[i].w)};
#pragma unroll
            for (int j = 0; j < 8; ++j) { c += v[j]; bb += v[j] * ratio[i * 8 + j]; } }
        c = wave_sum(c, lane); bb = wave_sum(bb, lane);
        if (lane == 0) { cs[n] = c; bw[n] = bb; }
    }
}
__device__ __forceinline__ void colsum_in(const Params& p, int l, int wv) { float* csb = (float*)(p.ws + WS_CSB) + (size_t)l * CSB_L;
    colsum_pass((const bf16_t*)(p.ws + W_IN), NINP, l == 0 ? p.in[2] : p.in[21] + (size_t)(l - 1) * 2048, l == 0 ? p.in[3] : p.in[22] + (size_t)(l - 1) * 2048, csb + CSB_IN, csb + CSB_IN + NINP, wv); }
__device__ __forceinline__ void colsum_up(const Params& p, int l, int wv) { float* csb = (float*)(p.ws + WS_CSB) + (size_t)l * CSB_L;
    colsum_pass((const bf16_t*)(p.ws + W_UP), DFF, p.in[17] + (size_t)l * 2048, p.in[18] + (size_t)l * 2048, csb + CSB_UP, csb + CSB_UP + DFF, wv); }
__device__ __forceinline__ void make_tables(const Params& p, int wv) {
    const int* pos = (const int*)p.in[1]; float* cosT = (float*)(p.ws + WS_COS); float* sinT = (float*)(p.ws + WS_SIN); float* sp = (float*)(p.ws + WS_SP);
    const int tid = otid(wv);
    for (int i = blockIdx.x * 512 + tid; i < M_ * 32; i += gridDim.x * 512) {
        const int row = i >> 5, k = i & 31; const float inv = powf(10000.0f, -(float)(2 * k) / 64.0f); const float ang = (float)pos[row] * inv;
        cosT[i] = cosf(ang); sinT[i] = sinf(ang); }
    for (int i = blockIdx.x * 512 + tid; i < DEPTH * 2 * 1024; i += gridDim.x * 512) { const float x = -p.in[15][i];
        sp[i] = fmaxf(x, 0.f) + log1pf(expf(-fabsf(x))); }
}
__device__ __forceinline__ void conv_phase(const Params& p, int l, int wv) {
    const bf16_t* __restrict__ xl = (const bf16_t*)(p.ws + WS_XL); bf16_t* __restrict__ xc = (bf16_t*)(p.ws + WS_XC);
    const float* cw = p.in[9] + (size_t)l * 4 * 1024; const float* cb = p.in[10] + (size_t)l * 1024;
    const int tid = otid(wv);
    for (int i = blockIdx.x * 512 + tid; i < M_ * 128; i += gridDim.x * 512) {
        const int row = i >> 7, c0 = (i & 127) * 8, t = row & (SEQ - 1);
        u32x4 xw[4]; f32x4 w0[4], w1[4];
#pragma unroll
        for (int k = 0; k < 4; ++k) { const int tt = t - 2 + k; const bool ok = (tt >= 0) && (tt < SEQ); const int rr = ok ? row - 2 + k : row;
            xw[k] = *(const u32x4*)(xl + (size_t)rr * 1024 + c0);
            w0[k] = *(const f32x4*)(cw + k * 1024 + c0); w1[k] = *(const f32x4*)(cw + k * 1024 + c0 + 4);
            if (!ok) { w0[k] = (f32x4){0.f, 0.f, 0.f, 0.f}; w1[k] = (f32x4){0.f, 0.f, 0.f, 0.f}; } }
        const f32x4 b0 = *(const f32x4*)(cb + c0), b1 = *(const f32x4*)(cb + c0 + 4);
        float acc[8] = {b0[0], b0[1], b0[2], b0[3], b1[0], b1[1], b1[2], b1[3]};
#pragma unroll
        for (int k = 0; k < 4; ++k) {
            acc[0] += w0[k][0] * bf_lo(xw[k].x); acc[1] += w0[k][1] * bf_hi(xw[k].x); acc[2] += w0[k][2] * bf_lo(xw[k].y); acc[3] += w0[k][3] * bf_hi(xw[k].y);
            acc[4] += w1[k][0] * bf_lo(xw[k].z); acc[5] += w1[k][1] * bf_hi(xw[k].z); acc[6] += w1[k][2] * bf_lo(xw[k].w); acc[7] += w1[k][3] * bf_hi(xw[k].w); }
        u32x4 o; o.x = cvt_pk_bf16(acc[0], acc[1]); o.y = cvt_pk_bf16(acc[2], acc[3]); o.z = cvt_pk_bf16(acc[4], acc[5]); o.w = cvt_pk_bf16(acc[6], acc[7]);
        *(u32x4*)(xc + (size_t)row * 1024 + c0) = o;
    }
}
#define SCAN_STEP(W, R, H0, H1, A0, A1) do { A0 = __builtin_amdgcn_exp2f((float)((R) & 255u) * k0); A1 = __builtin_amdgcn_exp2f((float)((R) >> 8) * k1); \
    H0 = A0 * H0 + bf_lo(W); H1 = A1 * H1 + bf_hi(W); } while (0)
__device__ __forceinline__ void scan_local(const Params& p, int l, int wv) {
    const unsigned* up = (const unsigned*)(p.ws + WS_AU); const unsigned short* rp = (const unsigned short*)(p.ws + WS_AU + AU_RPLANE); f32x4* ph = (f32x4*)(p.ws + WS_PH); const int tid = otid(wv);
    const float* spl = (const float*)(p.ws + WS_SP) + (size_t)l * 2048;
    for (int it = blockIdx.x; it < 2 * 8 * 64; it += gridDim.x) {
        const int c = it & 63, b = (it >> 6) & 7, d = it >> 9;
        const float k0 = spl[d * 1024 + 2 * tid] * (-8.0f * 1.4426950408889634f / 255.0f), k1 = spl[d * 1024 + 2 * tid + 1] * (-8.0f * 1.4426950408889634f / 255.0f);
        const size_t e0 = ((size_t)d * M_ + (size_t)(b * SEQ + c * 64)) * 512 + tid;
        const unsigned* __restrict__ us = up + e0; const unsigned short* __restrict__ rs = rp + e0;
        float h0 = 0.f, h1 = 0.f, P0 = 1.f, P1 = 1.f;
        const long step = d ? -512 : 512; const long q0 = d ? (long)63 * 512 : 0;
        unsigned wa[16], wb[16]; unsigned ra[16], rb[16];
#pragma unroll
        for (int j = 0; j < 16; ++j) { wa[j] = us[q0 + (long)j * step]; ra[j] = rs[q0 + (long)j * step]; }
#pragma unroll
        for (int bt = 0; bt < 4; bt += 2) {
#pragma unroll
            for (int j = 0; j < 16; ++j) { wb[j] = us[q0 + (long)((bt + 1) * 16 + j) * step]; rb[j] = rs[q0 + (long)((bt + 1) * 16 + j) * step]; }
#pragma unroll
            for (int j = 0; j < 16; ++j) { float a0, a1; SCAN_STEP(wa[j], ra[j], h0, h1, a0, a1); P0 *= a0; P1 *= a1; }
            if (bt + 2 < 4) {
#pragma unroll
                for (int j = 0; j < 16; ++j) { wa[j] = us[q0 + (long)((bt + 2) * 16 + j) * step]; ra[j] = rs[q0 + (long)((bt + 2) * 16 + j) * step]; } }
#pragma unroll
            for (int j = 0; j < 16; ++j) { float a0, a1; SCAN_STEP(wb[j], rb[j], h0, h1, a0, a1); P0 *= a0; P1 *= a1; }
        }
        ph[(size_t)((d * 8 + b) * 64 + c) * 512 + tid] = (f32x4){P0, h0, P1, h1};
    }
}
__device__ __forceinline__ void scan_apply(const Params& p, int l, int wv) {
    const unsigned* up = (const unsigned*)(p.ws + WS_AU); const unsigned short* rp = (const unsigned short*)(p.ws + WS_AU + AU_RPLANE); const f32x4* ph = (const f32x4*)(p.ws + WS_PH);
    const bf16_t* gg = (const bf16_t*)(p.ws + WS_GG); bf16_t* ycat = (bf16_t*)(p.ws + WS_YCAT); const int tid = otid(wv);
    const float* spl = (const float*)(p.ws + WS_SP) + (size_t)l * 2048;
    const float kf0 = spl[2 * tid] * (-8.0f * 1.4426950408889634f / 255.0f), kf1 = spl[2 * tid + 1] * (-8.0f * 1.4426950408889634f / 255.0f);
    const float kb0 = spl[1024 + 2 * tid] * (-8.0f * 1.4426950408889634f / 255.0f), kb1 = spl[1024 + 2 * tid + 1] * (-8.0f * 1.4426950408889634f / 255.0f);
    for (int it = blockIdx.x; it < 8 * 64; it += gridDim.x) {
        const int c = it & 63, b = it >> 6;
        float Hf0 = 0.f, Hf1 = 0.f, Hb0 = 0.f, Hb1 = 0.f;
        { const f32x4* pf = ph + (size_t)((0 * 8 + b) * 64) * 512 + tid;
          for (int c0 = 0; c0 < c; c0 += 8) { f32x4 e[8];
#pragma unroll
              for (int j = 0; j < 8; ++j) e[j] = pf[(size_t)min(c0 + j, c - 1) * 512];
#pragma unroll
              for (int j = 0; j < 8; ++j) if (c0 + j >= c) e[j] = (f32x4){1.f, 0.f, 1.f, 0.f};
#pragma unroll
              for (int j = 0; j < 8; ++j) { Hf0 = e[j][0] * Hf0 + e[j][1]; Hf1 = e[j][2] * Hf1 + e[j][3]; } }
          const f32x4* pb = ph + (size_t)((1 * 8 + b) * 64) * 512 + tid;
          for (int c0 = 63; c0 > c; c0 -= 8) { f32x4 e[8];
#pragma unroll
              for (int j = 0; j < 8; ++j) e[j] = pb[(size_t)max(c0 - j, c + 1) * 512];
#pragma unroll
              for (int j = 0; j < 8; ++j) if (c0 - j <= c) e[j] = (f32x4){1.f, 0.f, 1.f, 0.f};
#pragma unroll
              for (int j = 0; j < 8; ++j) { Hb0 = e[j][0] * Hb0 + e[j][1]; Hb1 = e[j][2] * Hb1 + e[j][3]; } } }
        const size_t r0 = (size_t)(b * SEQ + c * 64);
        const unsigned* __restrict__ s0 = up + r0 * 512 + tid; const unsigned* __restrict__ s1 = up + ((size_t)M_ + r0) * 512 + tid;
        const unsigned short* __restrict__ q0p = rp + r0 * 512 + tid; const unsigned short* __restrict__ q1p = rp + ((size_t)M_ + r0) * 512 + tid;
        const unsigned* __restrict__ gp = (const unsigned*)(gg + r0 * 1024) + tid; unsigned* __restrict__ yp = (unsigned*)(ycat + r0 * 2048 + 1024) + tid;
        float hf0[64], hf1[64];
        { const float k0 = kf0, k1 = kf1; unsigned wa[8], wb[8], ra[8], rb[8];
#pragma unroll
          for (int j = 0; j < 8; ++j) { wa[j] = s0[(size_t)j * 512]; ra[j] = q0p[(size_t)j * 512]; }
#pragma unroll
          for (int bt = 0; bt < 8; bt += 2) {
#pragma unroll
              for (int j = 0; j < 8; ++j) { wb[j] = s0[(size_t)((bt + 1) * 8 + j) * 512]; rb[j] = q0p[(size_t)((bt + 1) * 8 + j) * 512]; }
#pragma unroll
              for (int j = 0; j < 8; ++j) { const int t = bt * 8 + j; float a0, a1; SCAN_STEP(wa[j], ra[j], Hf0, Hf1, a0, a1); hf0[t] = Hf0; hf1[t] = Hf1; }
              if (bt + 2 < 8) {
#pragma unroll
                  for (int j = 0; j < 8; ++j) { wa[j] = s0[(size_t)((bt + 2) * 8 + j) * 512]; ra[j] = q0p[(size_t)((bt + 2) * 8 + j) * 512]; } }
#pragma unroll
              for (int j = 0; j < 8; ++j) { const int t = (bt + 1) * 8 + j; float a0, a1; SCAN_STEP(wb[j], rb[j], Hf0, Hf1, a0, a1); hf0[t] = Hf0; hf1[t] = Hf1; }
          } }
        { const float k0 = kb0, k1 = kb1; unsigned wa[8], wb[8], ra[8], rb[8]; unsigned ga[8], gb[8];
#pragma unroll
          for (int j = 0; j < 8; ++j) { wa[j] = s1[(size_t)(63 - j) * 512]; ra[j] = q1p[(size_t)(63 - j) * 512]; ga[j] = gp[(size_t)(63 - j) * 512]; }
#pragma unroll
          for (int bt = 0; bt < 8; bt += 2) {
#pragma unroll
              for (int j = 0; j < 8; ++j) { const int t = 63 - ((bt + 1) * 8 + j); wb[j] = s1[(size_t)t * 512]; rb[j] = q1p[(size_t)t * 512]; gb[j] = gp[(size_t)t * 512]; }
#pragma unroll
              for (int j = 0; j < 8; ++j) { const int t = 63 - (bt * 8 + j); float a0, a1; SCAN_STEP(wa[j], ra[j], Hb0, Hb1, a0, a1);
                  yp[(size_t)t * 1024] = cvt_pk_bf16(bf_lo(ga[j]) * (hf0[t] + Hb0), bf_hi(ga[j]) * (hf1[t] + Hb1)); }
              if (bt + 2 < 8) {
#pragma unroll
                  for (int j = 0; j < 8; ++j) { const int t = 63 - ((bt + 2) * 8 + j); wa[j] = s1[(size_t)t * 512]; ra[j] = q1p[(size_t)t * 512]; ga[j] = gp[(size_t)t * 512]; } }
#pragma unroll
              for (int j = 0; j < 8; ++j) { const int t = 63 - ((bt + 1) * 8 + j); float a0, a1; SCAN_STEP(wb[j], rb[j], Hb0, Hb1, a0, a1);
                  yp[(size_t)t * 1024] = cvt_pk_bf16(bf_lo(gb[j]) * (hf0[t] + Hb0), bf_hi(gb[j]) * (hf1[t] + Hb1)); }
          } }
    }
}
#undef SCAN_STEP

#define XB_TMO      128
#define XB_XCNT(j)  (256  + 64 * (j))
#define XB_XSUB(j)  (1280 + 64 * (j))
#define XB_XGEN(j)  (2304 + 64 * (j))
#define XB_TOP      3328
#define XB_TOPGEN   3392
#define XCD_BAR_WORDS 3456
#define XB_SPIN_CAP (1u << 20)
__device__ __forceinline__ unsigned xb_ld(unsigned* p)              { return __hip_atomic_load(p, __ATOMIC_RELAXED, __HIP_MEMORY_SCOPE_AGENT); }
__device__ __forceinline__ unsigned xb_add(unsigned* p, unsigned v) { return __hip_atomic_fetch_add(p, v, __ATOMIC_RELAXED, __HIP_MEMORY_SCOPE_AGENT); }
__device__ __forceinline__ unsigned xb_xcc_id() { unsigned x; asm volatile("s_getreg_b32 %0, hwreg(20, 0, 4)" : "=s"(x)); return x & 0xFu; }
#define XB_SPIN(cond, bar) do { unsigned _sp = 0; while (cond) { __builtin_amdgcn_s_sleep(1); \
    if ((++_sp & 255u) == 0u) { if (xb_ld(&(bar)[XB_TMO])) break; if (_sp > XB_SPIN_CAP) { atomicAdd(&(bar)[XB_TMO], 1u); break; } } } } while (0)
struct XcdBarrier { unsigned* bar; unsigned x; volatile LAS unsigned* st; };
__device__ __forceinline__ XcdBarrier xcd_barrier_post(unsigned* bar, volatile LAS unsigned* st, int wv) {
    XcdBarrier b; b.bar = bar; b.x = (unsigned)__builtin_amdgcn_readfirstlane((int)xb_xcc_id()); b.st = st;
    if (otid(wv) == 0) (void)xb_add(&bar[XB_XCNT(b.x)], 1u);
    return b;
}
__device__ __forceinline__ void xcd_barrier_complete(unsigned* bar, unsigned x, unsigned& nloc, unsigned& nx) {
    const unsigned G = gridDim.x * gridDim.y * gridDim.z;
    unsigned sum, cnt, mine, sp = 0u;
    for (;;) {
        sum = 0u; cnt = 0u; mine = 0u;
#pragma unroll
        for (unsigned j = 0; j < 16; ++j) { const unsigned c = xb_ld(&bar[XB_XCNT(j)]); sum += c; cnt += (c > 0u) ? 1u : 0u; mine = (j == x) ? c : mine; }
        if (sum == G) break;
        __builtin_amdgcn_s_sleep(1);
        if ((++sp & 255u) == 0u) { if (xb_ld(&bar[XB_TMO])) break; if (sp > XB_SPIN_CAP) { atomicAdd(&bar[XB_TMO], 1u); break; } }
    }
    nloc = mine > 0u ? mine : 1u; nx = cnt > 0u ? cnt : 1u;
}
__device__ __forceinline__ void xcd_barrier(const XcdBarrier& b, unsigned* barp, int wv) {
    asm volatile("s_waitcnt vmcnt(0) lgkmcnt(0)" ::: "memory");
    __syncthreads();
    if (otid(wv) == 0) {
        const unsigned bx_ = xb_xcc_id();
        unsigned* bar = barp;
        __builtin_amdgcn_s_waitcnt(0);
        unsigned nloc = b.st[0], nx = b.st[1];
        if (nloc == 0u) { xcd_barrier_complete(bar, bx_, nloc, nx); b.st[0] = nloc; b.st[1] = nx; }
        const unsigned old = xb_add(&bar[XB_XSUB(bx_)], 1u);
        const unsigned gen = old / nloc;
        if (old + 1u == (gen + 1u) * nloc) {
            __builtin_amdgcn_fence(__ATOMIC_RELEASE, "agent");
            asm volatile("s_waitcnt vmcnt(0)" ::: "memory");
            const unsigned og = xb_add(&bar[XB_TOP], 1u);
            const unsigned tg = og / nx;
            if (og + 1u == (tg + 1u) * nx) xb_add(&bar[XB_TOPGEN], 1u);
            else XB_SPIN(xb_ld(&bar[XB_TOPGEN]) == tg, bar);
            __builtin_amdgcn_fence(__ATOMIC_ACQUIRE, "agent");
            xb_add(&bar[XB_XGEN(bx_)], 1u);
            asm volatile("s_waitcnt vmcnt(0)" ::: "memory");
        } else {
            XB_SPIN(xb_ld(&bar[XB_XGEN(bx_)]) == gen, bar);
            __builtin_amdgcn_fence(__ATOMIC_ACQUIRE, "agent");
            asm volatile("s_waitcnt vmcnt(0)" ::: "memory");
        }
    }
    __syncthreads();
}
__global__ void __launch_bounds__(512, 2) mega_fwd(Params p) {
    extern __shared__ __attribute__((aligned(16))) unsigned char lds[];
    cg::grid_group grid = cg::this_grid();
    const int wv = __builtin_amdgcn_readfirstlane((int)threadIdx.x >> 6);
    unsigned char* ws = p.ws;
    LAS unsigned char* ldsl = (LAS unsigned char*)lds;
    bf16_t* hb = (bf16_t*)(ws + WS_HB);
    const float* cosT = (const float*)(ws + WS_COS); const float* sinT = (const float*)(ws + WS_SIN);

    volatile LAS unsigned* xst = (volatile LAS unsigned*)(ldsl + pg8::STAGE_BYTES);
    { const int t_ = otid(wv); if (t_ < 4) xst[t_] = 0u; }
    __syncthreads();
    XcdBarrier xb = xcd_barrier_post((unsigned*)(ws + WS_BAR), xst, wv);
    fix_t* stats0 = (fix_t*)(ws + WS_ST);
#define stats stats0
    { const int tid = otid(wv);
      for (int i = blockIdx.x * 512 + tid; i < 8 * 2 * M_; i += gridDim.x * 512) stats[(size_t)2 * M_ + i] = 0ull;
    }
    make_tables(p, wv);
    x_pass(p.in[0], hb, stats, wv);
    grid.sync();
    convert_weights(p, 0, 0, CT6, (float*)lds, wv);
    xcd_barrier(xb, (unsigned*)(ws + WS_BAR), wv);
    colsum_in(p, 0, wv); colsum_up(p, 0, wv);
    xcd_barrier(xb, (unsigned*)(ws + WS_BAR), wv);

#pragma unroll 1
    for (int l = 0; l < DEPTH; ++l) {
        { typedef __attribute__((address_space(1))) unsigned char gu8; uintptr_t w_ = (uintptr_t)p.ws; asm volatile("" : "+s"(w_)); ws = (unsigned char*)(gu8*)w_; }
        const float* csb = (const float*)(ws + WS_CSB) + (size_t)l * CSB_L;
        fix_t* st0 = (fix_t*)(ws + WS_ST) + (size_t)(2 * l) * 2 * M_; fix_t* st1 = st0 + 2 * M_; fix_t* st2 = st1 + 2 * M_;
        if (l > 0) { colsum_up(p, l, wv); convert_weights(p, l, CT5, CT6, (float*)lds, wv); }
        { pg8::Order S = pg8::make_order(hb, 2048, ws + W_IN, 2048, M_, NINP, 2048);
          EpiIn E{(bf16_t*)(ws + WS_CQ), (bf16_t*)(ws + WS_CKV), (bf16_t*)(ws + WS_XL), (bf16_t*)(ws + WS_GG), (bf16_t*)(ws + WS_KPE), (float*)(ws + WS_SSQ), cosT, sinT, st0, csb + CSB_IN, csb + CSB_IN + NINP};
          pg8::gemm_phase(ldsl, S, E, wv); }
        xcd_barrier(xb, (unsigned*)(ws + WS_BAR), wv);
        conv_phase(p, l, wv);
        { pg8::Order S = pg8::make_order(ws + WS_CQ, 512, ws + W_UQ, 512, M_, 1536, 512);
          EpiQ E{(bf16_t*)(ws + WS_Q), (const float*)(ws + WS_SSQ), cosT, sinT};
          pg8::gemm_phase(ldsl, S, E, wv); }
        { pg8::Order S = pg8::make_order(ws + WS_CKV, 512, ws + W_UKV, 512, M_, 2048, 512);
          EpiKV E{(bf16_t*)(ws + WS_KV), (const float*)(ws + WS_SSQ)};
          pg8::gemm_phase(ldsl, S, E, wv); }
        xcd_barrier(xb, (unsigned*)(ws + WS_BAR), wv);
        {
            const bf16_t* Q = (const bf16_t*)(ws + WS_Q); const bf16_t* KV = (const bf16_t*)(ws + WS_KV); const bf16_t* KPE = (const bf16_t*)(ws + WS_KPE); bf16_t* ycat = (bf16_t*)(ws + WS_YCAT);
            const int G = gridDim.x, bx = blockIdx.x;
            for (int L = bx; L < 1024; L += G) {
                int pair, qb;
                if (G == 256) { const int i = L >> 8, c = L & 255, xcd = c & 7, j = c >> 3; pair = i * 16 + xcd * 2 + (j >> 4); qb = j & 15; } else { pair = L >> 4; qb = L & 15; }
                const int b = pair >> 3, h = pair & 7; const size_t row0 = (size_t)b * SEQ + (size_t)qb * 256;
                __syncthreads();
                att::attn_unit(Q + row0 * 1536 + h * 128, Q + row0 * 1536 + 1024 + h * 64, KV + (size_t)b * SEQ * 2048 + h * 256, KPE + (size_t)b * SEQ * 64, ycat + row0 * 2048 + h * 128, SEQ, (char*)lds, wv);
            }
            __syncthreads();
        }
        { pg8::Order S = pg8::make_order(ws + WS_XC, 1024, ws + W_G, 128, M_, 512, 128);
          S.nZ = 8; S.a_z = 128 * 2; S.b_z = (size_t)512 * 128 * 2;
          EpiGate E{(bf16_t*)(ws + WS_AU), ws + WS_AU + AU_RPLANE, (const bf16_t*)(ws + WS_XC), p.in[12] + (size_t)l * 2048, p.in[14] + (size_t)l * 2048, (const float*)(ws + WS_SP) + (size_t)l * 2048};
          pg8::gemm_phase(ldsl, S, E, wv); }
        xcd_barrier(xb, (unsigned*)(ws + WS_BAR), wv);
        scan_local(p, l, wv);
        if (l + 1 < DEPTH) { __syncthreads(); convert_weights(p, l + 1, 0, CT3, (float*)lds, wv); }
        xcd_barrier(xb, (unsigned*)(ws + WS_BAR), wv);
        if (l + 1 < DEPTH) colsum_in(p, l + 1, wv);
        scan_apply(p, l, wv);
        xcd_barrier(xb, (unsigned*)(ws + WS_BAR), wv);
        { pg8::Order S = pg8::make_order(ws + WS_YCAT, 2048, ws + W_OUT, 2048, M_, 2048, 2048); S.wgm = 4;
          EpiRes E{hb, st0, l == 0 ? p.in[2] : p.in[21] + (size_t)(l - 1) * 2048, l == 0 ? p.in[3] : p.in[22] + (size_t)(l - 1) * 2048, st1};
          pg8::gemm_phase(ldsl, S, E, wv); }
        xcd_barrier(xb, (unsigned*)(ws + WS_BAR), wv);
        if (l + 1 < DEPTH) { convert_weights(p, l + 1, CT3, CT4, (float*)lds, wv); }
        { pg8::Order S = pg8::make_order(hb, 2048, ws + W_UP, 2048, M_, DFF, 2048);
          EpiUp E{(bf16_t*)(ws + WS_F), st1, csb + CSB_UP, csb + CSB_UP + DFF}; pg8::gemm_phase(ldsl, S, E, wv); }
        xcd_barrier(xb, (unsigned*)(ws + WS_BAR), wv);
        if (l + 1 < DEPTH) { convert_weights(p, l + 1, CT4, CT5, (float*)lds, wv); }
        { pg8::Order S = pg8::make_order(ws + WS_F, 8192, ws + W_DN, 8192, M_, 2048, 8192); S.wgm = 4;
          EpiRes E{hb, st1, p.in[17] + (size_t)l * 2048, p.in[18] + (size_t)l * 2048, st2};
          pg8::gemm_phase(ldsl, S, E, wv); }
        xcd_barrier(xb, (unsigned*)(ws + WS_BAR), wv);
    }
    ln_final(p.out, (const bf16_t*)(p.ws + WS_HB), (const fix_t*)(p.ws + WS_ST) + (size_t)(2 * DEPTH) * 2 * M_, p.in[21] + (size_t)(DEPTH - 1) * 2048, p.in[22] + (size_t)(DEPTH - 1) * 2048, wv);
}

extern "C" void kernel_launch(void* const* d_in, const int* in_sizes, int n_in, void* d_out, int out_size, void* d_ws, size_t ws_size, hipStream_t stream) {
    constexpr int LDS_BYTES = pg8::STAGE_BYTES + 16;
    static int grid_blocks = 0;
    if (grid_blocks == 0) {
        if (n_in != 23 || in_sizes[0] != M_ * DM || out_size != M_ * DM || ws_size < WS_END) {
            fprintf(stderr, "kernel_launch: shape mismatch (n_in %d, in0 %d, out %d, ws %zu, need %zu)\n", n_in, n_in > 0 ? in_sizes[0] : -1, out_size, ws_size, (size_t)WS_END); grid_blocks = -1; return; }
        int dev = 0, cus = 0, per_cu = 0;
        hipGetDevice(&dev); hipDeviceGetAttribute(&cus, hipDeviceAttributeMultiprocessorCount, dev);
        if (hipFuncSetAttribute((const void*)mega_fwd, hipFuncAttributeMaxDynamicSharedMemorySize, LDS_BYTES) != hipSuccess) { fprintf(stderr, "kernel_launch: hipFuncSetAttribute failed\n"); grid_blocks = -1; return; }
        if (hipOccupancyMaxActiveBlocksPerMultiprocessor(&per_cu, (const void*)mega_fwd, 512, LDS_BYTES) != hipSuccess || per_cu < 1) { fprintf(stderr, "kernel_launch: occupancy query says %d\n", per_cu); per_cu = 1; }
        (void)hipGetLastError();
        grid_blocks = cus * 1;
    }
    if (grid_blocks < 0) return;
    Params p{};
    for (int i = 0; i < 23; ++i) p.in[i] = (const float*)d_in[i];
    p.out = (float*)d_out; p.ws = (unsigned char*)d_ws;
    (void)hipMemsetAsync((char*)d_ws + WS_BAR, 0, XCD_BAR_WORDS * 4, stream);
    void* args[] = {&p};
    hipError_t e = hipLaunchCooperativeKernel((const void*)mega_fwd, dim3(grid_blocks), dim3(512), args, LDS_BYTES, stream);
    if (e != hipSuccess) fprintf(stderr, "kernel_launch: cooperative launch failed: %s (grid %d)\n", hipGetErrorString(e), grid_blocks);
}
```

```cpp
#include <hip/hip_runtime.h>
#include <hip/hip_cooperative_groups.h>
#include <cstdio>
#include <cstdint>
namespace cg = cooperative_groups;

#define LAS __attribute__((address_space(3)))
typedef unsigned short bf16_t;
typedef short bf16x8 __attribute__((ext_vector_type(8)));
typedef short s16x4 __attribute__((ext_vector_type(4)));
typedef float f32x4 __attribute__((ext_vector_type(4)));
typedef float f32x2 __attribute__((ext_vector_type(2)));
typedef float f32x16 __attribute__((ext_vector_type(16)));
typedef unsigned u32x4 __attribute__((ext_vector_type(4)));
typedef unsigned u32x2 __attribute__((ext_vector_type(2)));

constexpr int M_ = 32768, DM = 2048, SEQ = 4096, NBATCH = 8, DEPTH = 4;
constexpr int NIN = 3136, NINP = 3328, DFF = 8192;
constexpr float ALPHA = 1.6817928305074290f;
constexpr float LN_EPS = 1e-5f, RMS_EPS = 1e-6f;
constexpr size_t MiB = 1ull << 20;
constexpr size_t WS_HB = 0;
constexpr size_t WS_W = 128 * MiB;
constexpr size_t W_IN = WS_W, W_UQ = W_IN + (size_t)NINP * 2048 * 2, W_UKV = W_UQ + 1536ull * 512 * 2, W_G = W_UKV + 2048ull * 512 * 2,
                 W_OUT = W_G + 8ull * 512 * 128 * 2, W_UP = W_OUT + 2048ull * 2048 * 2, W_DN = W_UP + 8192ull * 2048 * 2, W_END = W_DN + 8192ull * 2048 * 2;
static_assert(W_END <= 218 * MiB, "weights region");
constexpr size_t WS_COS = 218 * MiB, WS_SIN = 222 * MiB, WS_SP = 226 * MiB;
constexpr size_t WS_CSB = 226 * MiB + 65536;
constexpr int CSB_L = 2 * 3328 + 2 * 8192, CSB_IN = 0, CSB_UP = 2 * 3328;
constexpr size_t WS_BAR = 226 * MiB + 49152;
constexpr size_t WS_ST = 227 * MiB;
constexpr size_t WS_BIG = 232 * MiB;
constexpr size_t WS_F = WS_BIG;
constexpr size_t WS_GG = WS_BIG, WS_XC = WS_BIG + 64 * MiB, WS_YCAT = WS_BIG + 128 * MiB, WS_SSQ = WS_BIG + 256 * MiB, WS_KPE = WS_BIG + 258 * MiB,
                 WS_CQ = WS_BIG + 262 * MiB, WS_CKV = WS_BIG + 294 * MiB, WS_XL = WS_BIG + 326 * MiB, WS_AU = WS_BIG + 262 * MiB  ,
                 WS_Q = WS_BIG + 518 * MiB, WS_KV = WS_BIG + 614 * MiB, WS_PH = WS_BIG + 742 * MiB, WS_END = WS_BIG + 750 * MiB;
static_assert(WS_END <= 1024 * MiB, "workspace");

struct Params { const float* in[23]; float* out; unsigned char* ws; };

__device__ __forceinline__ int otid(int wv) { int t; asm volatile("v_mbcnt_lo_u32_b32 %0, -1, 0\n\tv_mbcnt_hi_u32_b32 %0, -1, %0" : "=v"(t)); return (wv << 6) | t; }
__device__ __forceinline__ unsigned cvt_pk_bf16(float lo, float hi) { unsigned r; asm volatile("v_cvt_pk_bf16_f32 %0, %1, %2" : "=v"(r) : "v"(lo), "v"(hi)); return r; }
__device__ __forceinline__ float sum_fq(float x) {
    auto a = __builtin_amdgcn_permlane16_swap(__float_as_uint(x), __float_as_uint(x), false, false); x = __uint_as_float(a[0]) + __uint_as_float(a[1]);
    auto b = __builtin_amdgcn_permlane32_swap(__float_as_uint(x), __float_as_uint(x), false, false); return __uint_as_float(b[0]) + __uint_as_float(b[1]); }
__device__ __forceinline__ float wave_sum(float x, int lane) {
#pragma unroll
    for (int o = 32; o >= 1; o >>= 1) x += __int_as_float(__builtin_amdgcn_ds_bpermute((lane ^ o) << 2, __float_as_int(x)));
    return x; }
__device__ __forceinline__ float bf_lo(unsigned w) { return __uint_as_float(w << 16); }
__device__ __forceinline__ float bf_hi(unsigned w) { return __uint_as_float(w & 0xffff0000u); }
__device__ __forceinline__ float sigmoidf_(float x) { return __builtin_amdgcn_rcpf(1.0f + __builtin_amdgcn_exp2f(-1.4426950408889634f * x)); }
__device__ __forceinline__ float gelu_tanh(float x) { const float z = 0.7978845608028654f * (x + 0.044715f * x * x * x); return x * sigmoidf_(2.0f * z); }
__device__ __forceinline__ u32x4 pack8(const f32x4 a, const f32x4 b) { u32x4 w; w.x = cvt_pk_bf16(a[0], a[1]); w.y = cvt_pk_bf16(a[2], a[3]); w.z = cvt_pk_bf16(b[0], b[1]); w.w = cvt_pk_bf16(b[2], b[3]); return w; }

namespace pg8 {
constexpr int BM = 256, BK = 64, HALF = 128, HTB = HALF * BK * 2, STAGE_BYTES = 8 * HTB, NXCD = 8, WGM = 8;
__host__ __device__ __forceinline__ int lds_byte(int r, int c) { const int st = (r >> 4) * 2 + (c >> 5), rr = r & 15, cc = c & 31, ob = rr * 64 + cc * 2; return st * 1024 + (ob ^ (((ob >> 9) & 1) << 5)); }
__host__ __device__ __forceinline__ void stage_rc(int b, int& R, int& C) { const int st = b / 1024, sb = b % 1024, swz = sb ^ (((sb >> 9) & 1) << 5); R = (st >> 1) * 16 + swz / 64; C = (st & 1) * 32 + (swz % 64) / 2; }
__host__ __device__ __forceinline__ int perm32(int rho) { const int n = rho >> 4, i = rho & 15; return 8 * (i >> 2) + 4 * n + (i & 3); }

struct Unit { int pm, pn, z; };
struct Order {
    int nM, nN, nZ, per, G, c, wgm;
    const char* A; const char* B; size_t a_pm, a_z, b_pn, b_z; int lda, ldb, K;
    __device__ __forceinline__ bool next(int i, Unit& u) const {
        const long L = (long)i * G + c; if (L >= (long)per * nZ) return false;
        u.z = (int)(L / per); int wgid = (int)(L % per);
        { const int q = per / NXCD, r = per % NXCD, xcd = wgid % NXCD, off = wgid / NXCD; wgid = (xcd < r ? xcd * (q + 1) : r * (q + 1) + (xcd - r) * q) + off; }
        const int nig = wgm * nN, gid = wgid / nig, fm = gid * wgm, gsz = (nM - fm) < wgm ? (nM - fm) : wgm;
        u.pm = fm + ((wgid % nig) % gsz); u.pn = (wgid % nig) / gsz; return true;
    }
    __device__ __forceinline__ const char* aptr(const Unit& u) const { return A + (size_t)u.pm * a_pm + (size_t)u.z * a_z; }
    __device__ __forceinline__ const char* bptr(const Unit& u) const { return B + (size_t)u.pn * b_pn + (size_t)u.z * b_z; }
};
__device__ __forceinline__ Order make_order(const void* A, int lda, const void* Bt, int ldb, int Mrows, int N, int K) {
    Order o; o.nM = Mrows / BM; o.nN = N / BM; o.nZ = 1; o.per = o.nM * o.nN; o.G = gridDim.x; o.c = blockIdx.x; o.wgm = WGM;
    o.A = (const char*)A; o.B = (const char*)Bt; o.a_pm = (size_t)BM * lda * 2; o.a_z = 0; o.b_pn = (size_t)BM * ldb * 2; o.b_z = 0; o.lda = lda; o.ldb = ldb; o.K = K; return o;
}

template <class Epi>
__device__ __forceinline__ void gemm_phase(LAS unsigned char* lds, const Order& S, const Epi& E, int wv) {
    const int tid = otid(wv), wid = __builtin_amdgcn_readfirstlane(tid >> 6), lane = tid & 63, wr = wid >> 2, wc = wid & 3, fr = lane & 15, fq = lane >> 4;
    const int nt = S.K / BK;
    unsigned voffA[2], voffB[2];
#pragma unroll
    for (int i = 0; i < 2; ++i) { int R, C; stage_rc(tid * 16 + i * 8192, R, C); const int Rb = Epi::PERM ? ((R & ~31) + perm32(R & 31)) : R;
        voffA[i] = (unsigned)(R * S.lda + C) * 2u; voffB[i] = (unsigned)(Rb * S.ldb + C) * 2u; }
    const size_t kstep = (size_t)(BK * 2);
    const size_t hstepA = (size_t)HALF * S.lda * 2, hstepB = (size_t)HALF * S.ldb * 2;
    const unsigned ldsw = (unsigned)wid * 1024u;
    const int aoff = lds_byte(wr * 64 + fr, fq * 8), boff = lds_byte(wc * 32 + fr, fq * 8);
#define PG8_SA(b, h) (((b) * 2 + (h)) * HTB)
#define PG8_SB(b, h) ((4 + (b) * 2 + (h)) * HTB)
#define PG8_STAGE(bufoff, gbase, voff) do { _Pragma("unroll") for (int _i = 0; _i < 2; ++_i) \
        __builtin_amdgcn_global_load_lds((const unsigned*)((const char*)(gbase) + (voff)[_i]), (LAS unsigned*)(lds + (bufoff) + ldsw + _i * 8192), 16, 0, 0); } while (0)
#define PG8_LDA(dst, b, h) do { _Pragma("unroll") for (int m = 0; m < 4; ++m) _Pragma("unroll") for (int k = 0; k < 2; ++k) dst[m][k] = *(const LAS bf16x8*)(lds + PG8_SA(b, h) + aoff + m * 2048 + k * 1024); } while (0)
#define PG8_LDB(dst, b, h) do { _Pragma("unroll") for (int n = 0; n < 2; ++n) _Pragma("unroll") for (int k = 0; k < 2; ++k) dst[n][k] = *(const LAS bf16x8*)(lds + PG8_SB(b, h) + boff + n * 2048 + k * 1024); } while (0)
#define PG8_MMA(ai, bj, At, Bt) do { __builtin_amdgcn_s_setprio(1); _Pragma("unroll") for (int m = 0; m < 4; ++m) _Pragma("unroll") for (int n = 0; n < 2; ++n) _Pragma("unroll") for (int k = 0; k < 2; ++k) \
        acc[ai][bj][m][n] = __builtin_amdgcn_mfma_f32_16x16x32_bf16(Bt[n][k], At[m][k], acc[ai][bj][m][n], 0, 0, 0); __builtin_amdgcn_s_setprio(0); } while (0)
#define PG8_WAIT_V(n) asm volatile("s_waitcnt vmcnt(" #n ")" ::: "memory")
#define PG8_WAIT_L(n) asm volatile("s_waitcnt lgkmcnt(" #n ")" ::: "memory")
#define PG8_BAR __builtin_amdgcn_s_barrier()
#define PG8_SCHED __builtin_amdgcn_sched_barrier(0)
    Unit cur, nxt; int ui = 0;
    if (!S.next(0, cur)) return;
    f32x4 acc[2][2][4][2];
#pragma unroll
    for (int a = 0; a < 2; ++a)
#pragma unroll
        for (int b = 0; b < 2; ++b)
#pragma unroll
            for (int m = 0; m < 4; ++m)
#pragma unroll
                for (int n = 0; n < 2; ++n) acc[a][b][m][n] = (f32x4){0.f, 0.f, 0.f, 0.f};
    bf16x8 At[4][2], B0[2][2], B1[2][2];
    const char* cA = S.aptr(cur); const char* cB = S.bptr(cur);
    PG8_STAGE(PG8_SB(0, 0), cB, voffB); PG8_STAGE(PG8_SA(0, 0), cA, voffA); PG8_STAGE(PG8_SB(0, 1), cB + hstepB, voffB); PG8_STAGE(PG8_SA(0, 1), cA + hstepA, voffA);
    if (wr == 1) PG8_BAR;
    PG8_WAIT_V(4); PG8_BAR;
    PG8_STAGE(PG8_SB(1, 0), cB + kstep, voffB); PG8_STAGE(PG8_SA(1, 0), cA + kstep, voffA); PG8_STAGE(PG8_SB(1, 1), cB + hstepB + kstep, voffB);
    PG8_WAIT_V(6); PG8_BAR;
    for (;;) {
        const bool has_next = S.next(ui + 1, nxt);
        const char* nA = has_next ? S.aptr(nxt) : cA; const char* nB = has_next ? S.bptr(nxt) : cB;
        for (int t = 0; t < nt; t += 2) {
            const bool last = (t == nt - 2);
            const char* a1 = cA + (size_t)(t + 1) * kstep;
            const char* a2 = last ? nA : cA + (size_t)(t + 2) * kstep; const char* b2 = last ? nB : cB + (size_t)(t + 2) * kstep;
            const char* a3 = a2 + kstep; const char* b3 = b2 + kstep;
            PG8_LDB(B0, 0, 0); PG8_SCHED; PG8_LDA(At, 0, 0); PG8_STAGE(PG8_SA(1, 1), a1 + hstepA, voffA);
            PG8_WAIT_L(8); PG8_BAR; PG8_WAIT_L(0); PG8_MMA(0, 0, At, B0); PG8_BAR; PG8_SCHED;
            PG8_LDB(B1, 0, 1); PG8_STAGE(PG8_SB(0, 0), b2, voffB);
            PG8_BAR; PG8_WAIT_L(0); PG8_MMA(0, 1, At, B1); PG8_BAR;
            PG8_LDA(At, 0, 1); PG8_STAGE(PG8_SA(0, 0), a2, voffA);
            PG8_BAR; PG8_WAIT_L(0); PG8_MMA(1, 0, At, B0); PG8_BAR; PG8_SCHED;
            PG8_STAGE(PG8_SB(0, 1), b2 + hstepB, voffB);
            PG8_WAIT_V(6); PG8_BAR; PG8_MMA(1, 1, At, B1); PG8_BAR;
            PG8_LDB(B0, 1, 0); PG8_SCHED; PG8_LDA(At, 1, 0); PG8_STAGE(PG8_SA(0, 1), a2 + hstepA, voffA);
            PG8_WAIT_L(8); PG8_BAR; PG8_WAIT_L(0); PG8_MMA(0, 0, At, B0); PG8_BAR; PG8_SCHED;
            PG8_LDB(B1, 1, 1); PG8_STAGE(PG8_SB(1, 0), b3, voffB);
            PG8_BAR; PG8_WAIT_L(0); PG8_MMA(0, 1, At, B1); PG8_BAR;
            PG8_LDA(At, 1, 1); PG8_STAGE(PG8_SA(1, 0), a3, voffA);
            PG8_BAR; PG8_WAIT_L(0); PG8_MMA(1, 0, At, B0); PG8_BAR; PG8_SCHED;
            PG8_STAGE(PG8_SB(1, 1), b3 + hstepB, voffB);
            PG8_WAIT_V(6); PG8_BAR; PG8_MMA(1, 1, At, B1); PG8_BAR;
        }
        E(acc, cur, wr, wc, fr, fq);
        if (!has_next) break;
#pragma unroll
        for (int a = 0; a < 2; ++a)
#pragma unroll
            for (int b = 0; b < 2; ++b)
#pragma unroll
                for (int m = 0; m < 4; ++m)
#pragma unroll
                    for (int n = 0; n < 2; ++n) acc[a][b][m][n] = (f32x4){0.f, 0.f, 0.f, 0.f};
        cur = nxt; cA = nA; cB = nB; ++ui;
    }
    PG8_WAIT_V(0);
    if (wr == 0) PG8_BAR;
    PG8_BAR;
#undef PG8_SA
#undef PG8_SB
#undef PG8_STAGE
#undef PG8_LDA
#undef PG8_LDB
#undef PG8_MMA
#undef PG8_WAIT_V
#undef PG8_WAIT_L
#undef PG8_BAR
#undef PG8_SCHED
}
}
using pg8::Unit;
typedef f32x4 Acc[2][2][4][2];

typedef unsigned long long fix_t;
__device__ __forceinline__ fix_t to_fix(float v) { return (fix_t)(long long)(v * 4294967296.0f); }
__device__ __forceinline__ float from_fix(fix_t v) { return fmaf((float)(unsigned)v, 2.3283064365386963e-10f, (float)(int)(v >> 32)); }
__device__ __forceinline__ void fix_add(fix_t* p, float v) { __hip_atomic_fetch_add(p, to_fix(v), __ATOMIC_RELAXED, __HIP_MEMORY_SCOPE_AGENT); }
__device__ __forceinline__ f32x4 ld_fix4(const fix_t* p) { typedef unsigned long long u64x2 __attribute__((ext_vector_type(2))); const u64x2 a = *(const u64x2*)p, b = *(const u64x2*)(p + 2);
    return (f32x4){from_fix(a.x), from_fix(a.y), from_fix(b.x), from_fix(b.y)}; }
__device__ __forceinline__ void row_ln(const fix_t* st, int row, float& mu, float& rs) { const float s1 = from_fix(st[row]), s2 = from_fix(st[M_ + row]); mu = s1 * (1.0f / 2048.0f); rs = __builtin_amdgcn_rsqf(s2 * (1.0f / 2048.0f) - mu * mu + LN_EPS); }
template <bool PERM>
__device__ __forceinline__ void ln_correct(f32x4 (&acc)[2][2][4][2], const fix_t* st, const float* cs, const float* bw, int row0, int colbase) {
    f32x4 c4[2][2], b4[2][2];
#pragma unroll
    for (int bj = 0; bj < 2; ++bj)
#pragma unroll
        for (int n = 0; n < 2; ++n) { const int col = colbase + bj * 128 + (PERM ? 4 * n : 16 * n); c4[bj][n] = *(const f32x4*)(cs + col); b4[bj][n] = *(const f32x4*)(bw + col); }
#pragma unroll
    for (int ai = 0; ai < 2; ++ai) { fix_t r1[4], r2[4];
#pragma unroll
        for (int m = 0; m < 4; ++m) { const int row = row0 + ai * 128 + m * 16; r1[m] = st[row]; r2[m] = st[M_ + row]; }
#pragma unroll
        for (int m = 0; m < 4; ++m) { const float mu = from_fix(r1[m]) * (1.0f / 2048.0f), rs = __builtin_amdgcn_rsqf(from_fix(r2[m]) * (1.0f / 2048.0f) - mu * mu + LN_EPS);
#pragma unroll
            for (int bj = 0; bj < 2; ++bj)
#pragma unroll
                for (int n = 0; n < 2; ++n) acc[ai][bj][m][n] = (acc[ai][bj][m][n] - c4[bj][n] * mu) * rs + b4[bj][n]; } }
}

struct EpiIn {
    static constexpr bool PERM = true;
    bf16_t *cq, *ckv, *xl, *gg, *kpe; float* ssq; const float *cosT, *sinT; const fix_t* st; const float *cs, *bw;
    __device__ __forceinline__ void operator()(Acc& acc, const Unit& u, int wr, int wc, int fr, int fq) const {
        const int row0 = u.pm * 256 + wr * 64 + fr, pn = u.pn;
        ln_correct<true>(acc, st, cs, bw, row0, pn * 256 + wc * 32 + 8 * fq);
        if (pn < 4) {
            bf16_t* base = (pn < 2 ? cq : ckv); const int col0 = (pn & 1) * 256 + wc * 32 + 8 * fq;
#pragma unroll
            for (int ai = 0; ai < 2; ++ai)
#pragma unroll
                for (int m = 0; m < 4; ++m) { const int row = row0 + ai * 128 + m * 16; float s = 0.f;
#pragma unroll
                    for (int bj = 0; bj < 2; ++bj) { const f32x4 v0 = acc[ai][bj][m][0], v1 = acc[ai][bj][m][1];
                        s += (v0[0] * v0[0] + v0[1] * v0[1]) + (v0[2] * v0[2] + v0[3] * v0[3]) + (v1[0] * v1[0] + v1[1] * v1[1]) + (v1[2] * v1[2] + v1[3] * v1[3]);
                        *(u32x4*)(base + (size_t)row * 512 + col0 + bj * 128) = pack8(v0, v1); }
                    s = sum_fq(s);
                    if (fq == 0) ssq[(size_t)row * 16 + pn * 4 + wc] = s; }
        } else if (pn < 8) {
            const int col0 = (pn - 4) * 256 + wc * 32 + 8 * fq;
#pragma unroll
            for (int ai = 0; ai < 2; ++ai)
#pragma unroll
                for (int m = 0; m < 4; ++m) { const int row = row0 + ai * 128 + m * 16;
#pragma unroll
                    for (int bj = 0; bj < 2; ++bj) *(u32x4*)(xl + (size_t)row * 1024 + col0 + bj * 128) = pack8(acc[ai][bj][m][0], acc[ai][bj][m][1]); }
        } else if (pn < 12) {
            const int col0 = (pn - 8) * 256 + wc * 32 + 8 * fq;
#pragma unroll
            for (int ai = 0; ai < 2; ++ai)
#pragma unroll
                for (int m = 0; m < 4; ++m) { const int row = row0 + ai * 128 + m * 16;
#pragma unroll
                    for (int bj = 0; bj < 2; ++bj) { f32x4 v0 = acc[ai][bj][m][0], v1 = acc[ai][bj][m][1];
#pragma unroll
                        for (int j = 0; j < 4; ++j) { v0[j] = gelu_tanh(v0[j]); v1[j] = gelu_tanh(v1[j]); }
                        *(u32x4*)(gg + (size_t)row * 1024 + col0 + bj * 128) = pack8(v0, v1); } }
        } else if (wc == 0) {
#pragma unroll
            for (int ai = 0; ai < 2; ++ai) { f32x4 c0[4], c1[4], s0[4], s1[4];
#pragma unroll
                for (int m = 0; m < 4; ++m) { const size_t t = (size_t)(row0 + ai * 128 + m * 16) * 32 + 8 * fq;
                    c0[m] = *(const f32x4*)(cosT + t); c1[m] = *(const f32x4*)(cosT + t + 4); s0[m] = *(const f32x4*)(sinT + t); s1[m] = *(const f32x4*)(sinT + t + 4); }
#pragma unroll
                for (int m = 0; m < 4; ++m) { const int row = row0 + ai * 128 + m * 16;
                    const f32x4 a0 = acc[ai][0][m][0], a1 = acc[ai][0][m][1], b0 = acc[ai][1][m][0], b1 = acc[ai][1][m][1];
                    *(u32x4*)(kpe + (size_t)row * 64 + 8 * fq) = pack8(a0 * c0[m] - b0 * s0[m], a1 * c1[m] - b1 * s1[m]);
                    *(u32x4*)(kpe + (size_t)row * 64 + 32 + 8 * fq) = pack8(b0 * c0[m] + a0 * s0[m], b1 * c1[m] + a1 * s1[m]); } }
        }
    }
};
__device__ __forceinline__ void rows_rstd(const float* ssq8, int row0, float (&rs)[8]) {
#pragma unroll
    for (int h = 0; h < 2; ++h) { f32x4 a[4], b[4];
#pragma unroll
        for (int k = 0; k < 4; ++k) { const float* p = ssq8 + (size_t)(row0 + h * 128 + k * 16) * 16; a[k] = *(const f32x4*)p; b[k] = *(const f32x4*)(p + 4); }
#pragma unroll
        for (int k = 0; k < 4; ++k) { const float s = ((a[k][0] + a[k][1]) + (a[k][2] + a[k][3])) + ((b[k][0] + b[k][1]) + (b[k][2] + b[k][3])); rs[h * 4 + k] = __builtin_amdgcn_rsqf(s * (1.0f / 512.0f) + RMS_EPS); } }
}
struct EpiQ {
    static constexpr bool PERM = true;
    bf16_t* q; const float* ssq; const float *cosT, *sinT;
    __device__ __forceinline__ void operator()(Acc& acc, const Unit& u, int wr, int wc, int fr, int fq) const {
        const int row0 = u.pm * 256 + wr * 64 + fr, pn = u.pn;
        float rs[8]; rows_rstd(ssq, row0, rs);
        if (pn < 4) {
            const int col0 = pn * 256 + wc * 32 + 8 * fq;
#pragma unroll
            for (int ai = 0; ai < 2; ++ai)
#pragma unroll
                for (int m = 0; m < 4; ++m) { const int row = row0 + ai * 128 + m * 16; const float r = rs[ai * 4 + m];
#pragma unroll
                    for (int bj = 0; bj < 2; ++bj) *(u32x4*)(q + (size_t)row * 1536 + col0 + bj * 128) = pack8(acc[ai][bj][m][0] * r, acc[ai][bj][m][1] * r); }
        } else {
            const int head = 4 * (pn - 4) + wc;
#pragma unroll
            for (int kb = 0; kb < 4; ++kb) { f32x4 c0[2], c1[2], s0[2], s1[2];
#pragma unroll
                for (int j = 0; j < 2; ++j) { const int k = kb * 2 + j; const size_t t = (size_t)(row0 + (k >> 2) * 128 + (k & 3) * 16) * 32 + 8 * fq;
                    c0[j] = *(const f32x4*)(cosT + t); c1[j] = *(const f32x4*)(cosT + t + 4); s0[j] = *(const f32x4*)(sinT + t); s1[j] = *(const f32x4*)(sinT + t + 4); }
#pragma unroll
                for (int j = 0; j < 2; ++j) { const int k = kb * 2 + j, ai = k >> 2, m = k & 3; const int row = row0 + ai * 128 + m * 16; const float r = rs[k];
                    const f32x4 a0 = acc[ai][0][m][0] * r, a1 = acc[ai][0][m][1] * r, b0 = acc[ai][1][m][0] * r, b1 = acc[ai][1][m][1] * r;
                    *(u32x4*)(q + (size_t)row * 1536 + 1024 + head * 64 + 8 * fq) = pack8(a0 * c0[j] - b0 * s0[j], a1 * c1[j] - b1 * s1[j]);
                    *(u32x4*)(q + (size_t)row * 1536 + 1024 + head * 64 + 32 + 8 * fq) = pack8(b0 * c0[j] + a0 * s0[j], b1 * c1[j] + a1 * s1[j]); } }
        }
    }
};
struct EpiKV {
    static constexpr bool PERM = true;
    bf16_t* kv; const float* ssq;
    __device__ __forceinline__ void operator()(Acc& acc, const Unit& u, int wr, int wc, int fr, int fq) const {
        const int row0 = u.pm * 256 + wr * 64 + fr, col0 = u.pn * 256 + wc * 32 + 8 * fq;
        float rs[8]; rows_rstd(ssq + 8, row0, rs);
#pragma unroll
        for (int ai = 0; ai < 2; ++ai)
#pragma unroll
            for (int m = 0; m < 4; ++m) { const int row = row0 + ai * 128 + m * 16; const float r = rs[ai * 4 + m];
#pragma unroll
                for (int bj = 0; bj < 2; ++bj) *(u32x4*)(kv + (size_t)row * 2048 + col0 + bj * 128) = pack8(acc[ai][bj][m][0] * r, acc[ai][bj][m][1] * r); }
    }
};
constexpr size_t AU_RPLANE = 128 * MiB;
struct EpiGate {
    static constexpr bool PERM = true;
    bf16_t* up; unsigned char* rp; const bf16_t* xc; const float *ba, *bi, *sp;
    __device__ __forceinline__ void operator()(Acc& acc, const Unit& u, int wr, int wc, int fr, int fq) const {
        const int row0 = u.pm * 256 + wr * 64 + fr, d = u.pn, ch0 = u.z * 128 + wc * 32 + 8 * fq;
        const size_t dbase = (size_t)d * M_ * 1024;
#pragma unroll
        for (int n = 0; n < 2; ++n) {
            const int ch = ch0 + 4 * n;
            const f32x4 bav = *(const f32x4*)(ba + d * 1024 + ch), biv = *(const f32x4*)(bi + d * 1024 + ch), spv = *(const f32x4*)(sp + d * 1024 + ch) * (-8.0f * 1.4426950408889634f);
            u32x2 xws[8];
#pragma unroll
            for (int k = 0; k < 8; ++k) xws[k] = *(const u32x2*)(xc + (size_t)(row0 + (k >> 2) * 128 + (k & 3) * 16) * 1024 + ch);
#pragma unroll
            for (int ai = 0; ai < 2; ++ai)
#pragma unroll
                for (int m = 0; m < 4; ++m) { const int row = row0 + ai * 128 + m * 16;
                    const u32x2 xw = xws[ai * 4 + m];
                    const float xv[4] = {bf_lo(xw.x), bf_hi(xw.x), bf_lo(xw.y), bf_hi(xw.y)};
                    float uf[4]; unsigned rb = 0u;
#pragma unroll
                    for (int j = 0; j < 4; ++j) {
                        const float r = sigmoidf_(acc[ai][0][m][n][j] + bav[j]);
                        const float ig = sigmoidf_(acc[ai][1][m][n][j] + biv[j]);
                        const float rq = __builtin_rintf(r * 255.0f);
                        const float a = __builtin_amdgcn_exp2f((rq * (1.0f / 255.0f)) * spv[j]);
                        const float oma = 1.0f - a;
                        uf[j] = __builtin_amdgcn_sqrtf(oma * (1.0f + a)) * ig * xv[j];
                        rb |= (unsigned)rq << (8 * j); }
                    u32x2 uw; uw.x = cvt_pk_bf16(uf[0], uf[1]); uw.y = cvt_pk_bf16(uf[2], uf[3]);
                    *(u32x2*)(up + dbase + (size_t)row * 1024 + ch) = uw;
                    *(unsigned*)(rp + dbase + (size_t)row * 1024 + ch) = rb; }
        }
    }
};
#ifndef RES_PF
#define RES_PF 2
#endif
struct EpiRes {
    static constexpr bool PERM = false;
    bf16_t* hb; const fix_t* st_old; const float *g, *b; fix_t* st_new;
    __device__ __forceinline__ void operator()(Acc& acc, const Unit& u, int wr, int wc, int fr, int fq) const {
        const int row0 = u.pm * 256 + wr * 64 + fr, col0 = u.pn * 256 + wc * 32 + 4 * fq;
        f32x4 gv[4], bv[4]; u32x2 P[RES_PF + 1][4]; float mus[8], rss[8];
#define RES_LOAD(k) do { const size_t off_ = (size_t)(row0 + ((k) >> 2) * 128 + ((k) & 3) * 16) * 2048 + col0; _Pragma("unroll") for (int c = 0; c < 4; ++c) P[(k) % (RES_PF + 1)][c] = *(const u32x2*)(hb + off_ + (c >> 1) * 128 + (c & 1) * 16); } while (0)
#pragma unroll
        for (int k = 0; k < RES_PF; ++k) RES_LOAD(k);
#pragma unroll
        for (int c = 0; c < 4; ++c) { gv[c] = *(const f32x4*)(g + col0 + (c >> 1) * 128 + (c & 1) * 16); bv[c] = *(const f32x4*)(b + col0 + (c >> 1) * 128 + (c & 1) * 16); }
#pragma unroll
        for (int h = 0; h < 2; ++h) { fix_t r1[4], r2[4];
#pragma unroll
            for (int k = 0; k < 4; ++k) { const int row = row0 + h * 128 + k * 16; r1[k] = st_old[row]; r2[k] = st_old[M_ + row]; }
#pragma unroll
            for (int k = 0; k < 4; ++k) { mus[h * 4 + k] = from_fix(r1[k]) * (1.0f / 2048.0f); rss[h * 4 + k] = __builtin_amdgcn_rsqf(from_fix(r2[k]) * (1.0f / 2048.0f) - mus[h * 4 + k] * mus[h * 4 + k] + LN_EPS); } }
#pragma unroll
        for (int k = 0; k < 8; ++k) {
            if (k + RES_PF < 8) RES_LOAD(k + RES_PF);
            const int ai = k >> 2, m = k & 3; const size_t off = (size_t)(row0 + ai * 128 + m * 16) * 2048 + col0;
            const float mu = mus[k], rs = rss[k];
            float a1 = 0.f, a2 = 0.f;
#pragma unroll
            for (int c = 0; c < 4; ++c) { const int cc = (c >> 1) * 128 + (c & 1) * 16; const u32x2 pw = P[k % (RES_PF + 1)][c];
                const f32x4 Pf = {bf_lo(pw.x), bf_hi(pw.x), bf_lo(pw.y), bf_hi(pw.y)};
                const f32x4 v = ((Pf - mu) * rs * gv[c] + bv[c]) * ALPHA + acc[ai][c >> 1][m][c & 1];
                u32x2 w; w.x = cvt_pk_bf16(v[0], v[1]); w.y = cvt_pk_bf16(v[2], v[3]); *(u32x2*)(hb + off + cc) = w;
                a1 += (v[0] + v[1]) + (v[2] + v[3]); a2 += (v[0] * v[0] + v[1] * v[1]) + (v[2] * v[2] + v[3] * v[3]); }
            a1 = sum_fq(a1); a2 = sum_fq(a2);
            { const int row = row0 + ai * 128 + m * 16; if (fq == 0) fix_add(st_new + row, a1); else if (fq == 1) fix_add(st_new + M_ + row, a2); }
        }
#undef RES_LOAD
    }
};
struct EpiUp {
    static constexpr bool PERM = true;
    bf16_t* f; const fix_t* st; const float *cs, *bw;
    __device__ __forceinline__ void operator()(Acc& acc, const Unit& u, int wr, int wc, int fr, int fq) const {
        const int row0 = u.pm * 256 + wr * 64 + fr, col0 = u.pn * 256 + wc * 32 + 8 * fq;
        ln_correct<true>(acc, st, cs, bw, row0, col0);
#pragma unroll
        for (int ai = 0; ai < 2; ++ai)
#pragma unroll
            for (int m = 0; m < 4; ++m) { const int row = row0 + ai * 128 + m * 16;
#pragma unroll
                for (int bj = 0; bj < 2; ++bj) { f32x4 v0 = acc[ai][bj][m][0], v1 = acc[ai][bj][m][1];
#pragma unroll
                    for (int j = 0; j < 4; ++j) { const float a = fmaxf(v0[j], 0.f), b = fmaxf(v1[j], 0.f); v0[j] = a * a; v1[j] = b * b; }
                    __builtin_nontemporal_store(pack8(v0, v1), (u32x4*)(f + (size_t)row * 8192 + col0 + bj * 128)); } }
    }
};

namespace att {
constexpr int NW = 8, QBLK = 32, KVBLK = 64;
constexpr float SCALE = 0.07216878364870323f;
constexpr float THR = 8.f;
#ifndef ATT_SDEPTH
#define ATT_SDEPTH 1
#endif
constexpr int SDEPTH = ATT_SDEPTH;
constexpr int SHM_V = KVBLK * 128 * 2, SHM_K = KVBLK * 128 * 2, SHM_R = KVBLK * 64 * 2;
constexpr int OFF_V = 0, OFF_K = 2 * SHM_V, OFF_R = OFF_K + 2 * SHM_K, OFF_WS = OFF_R + 2 * SHM_R, OFF_QR = OFF_WS + NW * 64 * 4, SHM_ATTN = OFF_QR + 256 * 128;
#define KSWZ(row, colB) ((row) * 256 + ((colB) ^ (((row) & 7) << 4)))
#define RSWZ(row, colB) ((row) * 128 + ((colB) ^ (((row) & 7) << 4)))
#define SBAR() __builtin_amdgcn_sched_barrier(0)
__device__ __forceinline__ int crow(int r, int hi) { return (r & 3) + 8 * (r >> 2) + 4 * hi; }
__device__ __forceinline__ void partialSM(f32x16& p0, f32x16& p1, float& m_reg, float& mn, float& alpha) {
    constexpr float C = SCALE * 1.4426950408889634f;
    float pmax = p0[0];
#pragma unroll
    for (int r = 1; r < 16; ++r) pmax = fmaxf(pmax, p0[r]);
#pragma unroll
    for (int r = 0; r < 16; ++r) pmax = fmaxf(pmax, p1[r]);
    { auto rr = __builtin_amdgcn_permlane32_swap(__float_as_uint(pmax), __float_as_uint(pmax), false, false);
      pmax = fmaxf(__uint_as_float(rr[0]), __uint_as_float(rr[1])); }
    if (__builtin_expect(__all(pmax - m_reg <= THR / SCALE), 1)) { mn = m_reg; alpha = 1.f; }
    else { mn = fmaxf(m_reg, pmax); alpha = __builtin_amdgcn_exp2f((m_reg - mn) * C); m_reg = mn; }
    const float mnC = -mn * C;
#pragma unroll
    for (int r = 0; r < 16; ++r) p0[r] = fmaf(p0[r], C, mnC);
#pragma unroll
    for (int r = 0; r < 16; ++r) p1[r] = fmaf(p1[r], C, mnC);
#pragma unroll
    for (int r = 0; r < 16; ++r) p0[r] = __builtin_amdgcn_exp2f(p0[r]);
}
__device__ __forceinline__ void finishSM(f32x16& p0, f32x16& p1, float alpha, float& l_reg, bf16x8& pa0, bf16x8& pa1, bf16x8& pa2, bf16x8& pa3) {
#pragma unroll
    for (int r = 0; r < 16; ++r) p1[r] = __builtin_amdgcn_exp2f(p1[r]);
    float ps = 0;
#pragma unroll
    for (int r = 0; r < 16; ++r) ps += p0[r];
#pragma unroll
    for (int r = 0; r < 16; ++r) ps += p1[r];
    { auto rr = __builtin_amdgcn_permlane32_swap(__float_as_uint(ps), __float_as_uint(ps), false, false);
      ps = __uint_as_float(rr[0]) + __uint_as_float(rr[1]); }
    l_reg = l_reg * alpha + ps;
#define PK4(P, BASE, OUT) do { unsigned a0 = cvt_pk_bf16(P[BASE + 0], P[BASE + 1]), a1 = cvt_pk_bf16(P[BASE + 2], P[BASE + 3]);   \
    unsigned b0 = cvt_pk_bf16(P[BASE + 4], P[BASE + 5]), b1 = cvt_pk_bf16(P[BASE + 6], P[BASE + 7]);                              \
    auto r0 = __builtin_amdgcn_permlane32_swap(a0, b0, false, false); auto r1 = __builtin_amdgcn_permlane32_swap(a1, b1, false, false); \
    u32x4 w = {r0[0], r1[0], r0[1], r1[1]}; OUT = *reinterpret_cast<bf16x8*>(&w); } while (0)
    PK4(p0, 0, pa0); PK4(p0, 8, pa1); PK4(p1, 0, pa2); PK4(p1, 8, pa3);
#undef PK4
}
__device__ __forceinline__ void qkt(f32x16& p0, f32x16& p1, const char* Ks, const char* Rs, const bf16x8* qr, const char* Qrl, int r32, int hi) {
    p0 = f32x16{}; p1 = f32x16{};
#pragma unroll
    for (int d0 = 0; d0 < 8; ++d0) { const int cb = (d0 * 16 + hi * 8) * 2;
        const bf16x8 b0 = *reinterpret_cast<const bf16x8*>(Ks + KSWZ(r32, cb));
        const bf16x8 b1 = *reinterpret_cast<const bf16x8*>(Ks + KSWZ(32 + r32, cb));
        p0 = __builtin_amdgcn_mfma_f32_32x32x16_bf16(b0, qr[d0], p0, 0, 0, 0);
        p1 = __builtin_amdgcn_mfma_f32_32x32x16_bf16(b1, qr[d0], p1, 0, 0, 0); }
#pragma unroll
    for (int d0 = 0; d0 < 4; ++d0) { const int cb = (d0 * 16 + hi * 8) * 2;
        const bf16x8 b0 = *reinterpret_cast<const bf16x8*>(Rs + RSWZ(r32, cb));
        const bf16x8 b1 = *reinterpret_cast<const bf16x8*>(Rs + RSWZ(32 + r32, cb));
        const bf16x8 qv = *reinterpret_cast<const bf16x8*>(Qrl + (cb ^ ((r32 & 7) << 4)));
        p0 = __builtin_amdgcn_mfma_f32_32x32x16_bf16(b0, qv, p0, 0, 0, 0);
        p1 = __builtin_amdgcn_mfma_f32_32x32x16_bf16(b1, qv, p1, 0, 0, 0); }
}
__device__ __forceinline__ int v_st(int k, int c) { const int kk = (k & ~0xC) | ((k & 4) << 1) | ((k & 8) >> 1); return ((kk >> 3) * 4 + (c >> 5)) * 512 + ((kk & 7) * 32 + (c & 31)) * 2; }
__device__ __forceinline__ int v_rd_base(int lane) { return ((lane & 3) << 3) | (((lane >> 2) & 3) << 6) | (((lane >> 4) & 1) << 5) | (((lane >> 5) & 1) << 8); }
constexpr int v_rd_off(int d0, int ks, int half) { return d0 * 512 + ks * 4096 + half * 2048; }
template <int OFF> __device__ __forceinline__ s16x4 tr_read(int vb) {
    s16x4 r; asm volatile("ds_read_b64_tr_b16 %0, %1 offset:%2" : "=&v"(r) : "v"(vb), "i"(OFF) : "memory"); return r;
}
template <int D0> __device__ __forceinline__ void pv_one(f32x16& od, int vb, bf16x8 pa0, bf16x8 pa1, bf16x8 pa2, bf16x8 pa3) {
    const s16x4 l0 = tr_read<v_rd_off(D0, 0, 0)>(vb), h0 = tr_read<v_rd_off(D0, 0, 1)>(vb), l1 = tr_read<v_rd_off(D0, 1, 0)>(vb), h1 = tr_read<v_rd_off(D0, 1, 1)>(vb);
    const s16x4 l2 = tr_read<v_rd_off(D0, 2, 0)>(vb), h2 = tr_read<v_rd_off(D0, 2, 1)>(vb), l3 = tr_read<v_rd_off(D0, 3, 0)>(vb), h3 = tr_read<v_rd_off(D0, 3, 1)>(vb);
    asm volatile("s_waitcnt lgkmcnt(0)" ::: "memory"); SBAR();
#define PK(L, H) (bf16x8){L[0], L[1], L[2], L[3], H[0], H[1], H[2], H[3]}
    od = __builtin_amdgcn_mfma_f32_32x32x16_bf16(pa0, PK(l0, h0), od, 0, 0, 0);
    od = __builtin_amdgcn_mfma_f32_32x32x16_bf16(pa1, PK(l1, h1), od, 0, 0, 0);
    od = __builtin_amdgcn_mfma_f32_32x32x16_bf16(pa2, PK(l2, h2), od, 0, 0, 0);
    od = __builtin_amdgcn_mfma_f32_32x32x16_bf16(pa3, PK(l3, h3), od, 0, 0, 0);
#undef PK
}
__device__ __forceinline__ void pv_d0(f32x16* o, int vb, bf16x8 pa0, bf16x8 pa1, bf16x8 pa2, bf16x8 pa3) {
    pv_one<0>(o[0], vb, pa0, pa1, pa2, pa3); pv_one<1>(o[1], vb, pa0, pa1, pa2, pa3); pv_one<2>(o[2], vb, pa0, pa1, pa2, pa3); pv_one<3>(o[3], vb, pa0, pa1, pa2, pa3);
}
__device__ __forceinline__ void attn_unit(const bf16_t* __restrict__ Qn, const bf16_t* __restrict__ Qr, const bf16_t* __restrict__ Kh, const bf16_t* __restrict__ Rh,
                                          bf16_t* __restrict__ Ob, int seq, char* lds, int wv) {
    const int tid = otid(wv), wid = tid >> 6, lane = tid & 63, r32 = lane & 31, hi = lane >> 5;
    char* V_lds = lds + OFF_V; char* K_lds = lds + OFF_K; char* R_lds = lds + OFF_R;
    float* ws = (float*)(lds + OFF_WS) + wid * 64; float* li_l = ws; float* al_l = ws + 32;
    float m_reg = -1e30f, l_reg = 0; f32x16 o[4] = {}; bf16x8 qr[8];
    char* Qrl = lds + OFF_QR + (wid * QBLK + r32) * 128;
    const int sr = tid >> 4, sc = (tid & 15) * 8, vst0 = v_st(sr, sc), vst1 = v_st(32 + sr, sc);
    const int rr_ = tid >> 3, rc = (tid & 7) * 8;
    const int vb0 = (int)(uintptr_t)V_lds + v_rd_base(lane);
    struct { bf16x8 vs0, vs1, ks0, ks1, rs; } sr_[SDEPTH];
#define SLOAD(i, k0) do { sr_[i].vs0 = *(const bf16x8*)(&Kh[(size_t)((k0) + sr) * 2048 + 128 + sc]); sr_[i].vs1 = *(const bf16x8*)(&Kh[(size_t)((k0) + 32 + sr) * 2048 + 128 + sc]); \
    sr_[i].ks0 = *(const bf16x8*)(&Kh[(size_t)((k0) + sr) * 2048 + sc]); sr_[i].ks1 = *(const bf16x8*)(&Kh[(size_t)((k0) + 32 + sr) * 2048 + sc]); \
    sr_[i].rs = *(const bf16x8*)(&Rh[(size_t)((k0) + rr_) * 64 + rc]); } while (0)
#define SWRITE(b, i) do { *(bf16x8*)(V_lds + (b) * SHM_V + vst0) = sr_[i].vs0;          \
    *(bf16x8*)(V_lds + (b) * SHM_V + vst1) = sr_[i].vs1; const int kc = sc * 2;               \
    *(bf16x8*)(K_lds + (b) * SHM_K + KSWZ(sr, kc)) = sr_[i].ks0;                       \
    *(bf16x8*)(K_lds + (b) * SHM_K + KSWZ(32 + sr, kc)) = sr_[i].ks1;                  \
    *(bf16x8*)(R_lds + (b) * SHM_R + RSWZ(rr_, rc * 2)) = sr_[i].rs; } while (0)
#define SWAIT() do { if constexpr (SDEPTH == 2) asm volatile("s_waitcnt vmcnt(5)" ::: "memory"); else asm volatile("s_waitcnt vmcnt(0)" ::: "memory"); } while (0)
#define RESC(a) do { if (__any((a) < 1.f)) { if (hi == 0) al_l[r32] = (a); asm volatile("s_waitcnt lgkmcnt(0)" ::: "memory"); \
    _Pragma("unroll") for (int d = 0; d < 4; ++d) _Pragma("unroll") for (int r = 0; r < 16; ++r) o[d][r] *= al_l[crow(r, hi)]; } } while (0)
    f32x16 pA0, pA1, pB0, pB1; float mnA, mnB, alA, alB; bf16x8 pa0, pa1, pa2, pa3; const int NT = seq / KVBLK;
    constexpr int SE = 0, SO = SDEPTH - 1;
    SLOAD(SE, 0);
    {
        const bf16_t* Qw = Qn + (size_t)(wid * QBLK + r32) * 1536 + hi * 8;
#pragma unroll
        for (int d0 = 0; d0 < 8; ++d0) qr[d0] = *reinterpret_cast<const bf16x8*>(Qw + d0 * 16);
        const bf16_t* Qw2 = Qr + (size_t)(wid * QBLK + r32) * 1536 + hi * 8;
#pragma unroll
        for (int d0 = 0; d0 < 4; ++d0) { const bf16x8 t = *reinterpret_cast<const bf16x8*>(Qw2 + d0 * 16); *reinterpret_cast<bf16x8*>(Qrl + (((d0 * 16 + hi * 8) * 2) ^ ((r32 & 7) << 4))) = t; }
    }
    asm volatile("s_waitcnt vmcnt(0)" ::: "memory"); SWRITE(0, SE); __syncthreads();
    if constexpr (SDEPTH == 1) SLOAD(SO, KVBLK);
    qkt(pA0, pA1, K_lds, R_lds, qr, Qrl, r32, hi); partialSM(pA0, pA1, m_reg, mnA, alA);
    if constexpr (SDEPTH == 2) { SLOAD(SO, KVBLK); if (2 < NT) SLOAD(SE, 2 * KVBLK); }
    SWAIT(); SWRITE(1, SO); __syncthreads();
    for (int j = 1; j + 1 < NT; j += 2) {
        SBAR(); qkt(pB0, pB1, K_lds + SHM_K, R_lds + SHM_R, qr, Qrl, r32, hi);
        finishSM(pA0, pA1, alA, l_reg, pa0, pa1, pa2, pa3); SBAR();
        SLOAD(SO, (j + SDEPTH) * KVBLK); SBAR();
        pv_d0(o, vb0, pa0, pa1, pa2, pa3); partialSM(pB0, pB1, m_reg, mnB, alB);
        __syncthreads(); SWAIT(); SWRITE(0, SE);
        RESC(alB); __syncthreads();
        SBAR(); qkt(pA0, pA1, K_lds, R_lds, qr, Qrl, r32, hi);
        finishSM(pB0, pB1, alB, l_reg, pa0, pa1, pa2, pa3); SBAR();
        if (SDEPTH == 1 || j + 3 < NT) SLOAD(SE, (j + 1 + SDEPTH) * KVBLK); SBAR();
        pv_d0(o, vb0 + (int)SHM_V, pa0, pa1, pa2, pa3); partialSM(pA0, pA1, m_reg, mnA, alA);
        __syncthreads(); SWAIT(); SWRITE(1, SO);
        RESC(alA); __syncthreads();
    }
    SBAR(); qkt(pB0, pB1, K_lds + SHM_K, R_lds + SHM_R, qr, Qrl, r32, hi);
    finishSM(pA0, pA1, alA, l_reg, pa0, pa1, pa2, pa3); SBAR();
    pv_d0(o, vb0, pa0, pa1, pa2, pa3); partialSM(pB0, pB1, m_reg, mnB, alB);
    __syncthreads(); RESC(alB);
    finishSM(pB0, pB1, alB, l_reg, pa0, pa1, pa2, pa3); SBAR();
    pv_d0(o, vb0 + (int)SHM_V, pa0, pa1, pa2, pa3);
    if (hi == 0) li_l[r32] = l_reg; asm volatile("s_waitcnt lgkmcnt(0)" ::: "memory");
    float rli[16];
#pragma unroll
    for (int r = 0; r < 16; ++r) rli[r] = __builtin_amdgcn_rcpf(li_l[crow(r, hi)]);
    bf16_t* Ow = Ob + (size_t)(wid * QBLK) * 2048;
#pragma unroll
    for (int r = 0; r < 16; ++r) { const int orow = crow(r, hi);
#pragma unroll
        for (int d0 = 0; d0 < 4; ++d0) Ow[(size_t)orow * 2048 + d0 * 32 + r32] = (bf16_t)(cvt_pk_bf16(o[d0][r] * rli[r], 0.f) & 0xffffu); }
#undef SLOAD
#undef SWRITE
#undef SWAIT
#undef RESC
}
}

__device__ __forceinline__ void x_pass(const float* src, bf16_t* dstb, fix_t* st, int wv) {
    const int tid_ = otid(wv), lane = tid_ & 63, wave = tid_ >> 6;
    for (int row = blockIdx.x * 8 + wave; row < M_; row += gridDim.x * 8) {
        const float* s = src + (size_t)row * 2048; f32x4 v[8]; float s1 = 0.f, s2 = 0.f;
#pragma unroll
        for (int i = 0; i < 8; ++i) { v[i] = __builtin_nontemporal_load((const f32x4*)(s + i * 256 + lane * 4)); s1 += (v[i][0] + v[i][1]) + (v[i][2] + v[i][3]); s2 += (v[i][0] * v[i][0] + v[i][1] * v[i][1]) + (v[i][2] * v[i][2] + v[i][3] * v[i][3]); }
        s1 = wave_sum(s1, lane); s2 = wave_sum(s2, lane);
        if (lane == 0) { st[row] = to_fix(s1); st[M_ + row] = to_fix(s2); }
#pragma unroll
        for (int i = 0; i < 8; ++i) { u32x2 w; w.x = cvt_pk_bf16(v[i][0], v[i][1]); w.y = cvt_pk_bf16(v[i][2], v[i][3]); *(u32x2*)(dstb + (size_t)row * 2048 + i * 256 + lane * 4) = w; }
    }
}
__device__ __forceinline__ void ln_final(float* out, const bf16_t* hb, const fix_t* st, const float* g, const float* b, int wv) {
    const int tid = otid(wv);
    for (int i = blockIdx.x * 512 + tid; i < M_ * 512; i += gridDim.x * 512) {
        const int row = i >> 9, c = (i & 511) * 4; float mu, rs; row_ln(st, row, mu, rs);
        const u32x2 pw = *(const u32x2*)(hb + (size_t)i * 4); const f32x4 P = {bf_lo(pw.x), bf_hi(pw.x), bf_lo(pw.y), bf_hi(pw.y)}, g4 = *(const f32x4*)(g + c), b4 = *(const f32x4*)(b + c);
        *(f32x4*)(out + (size_t)i * 4) = (P - mu) * rs * g4 + b4;
    }
}
__device__ __forceinline__ int colmap(int mode, int n) {
    if (mode == 0) { if (n < 1024) return n; if (n < 2048) return 1088 + (n - 1024); if (n < 3072) return 2112 + (n - 2048);
        const int t = n - 3072, bj = t >> 7, r = t & 127; return r < 32 ? 1024 + bj * 32 + r : -1; }
    if (mode == 1) { if (n < 1024) return (n >> 7) * 192 + (n & 127);
        const int t = n - 1024, tile = t >> 8, bj = (t >> 7) & 1, wc = (t >> 5) & 3, i = t & 31; return (4 * tile + wc) * 192 + 128 + bj * 32 + i; }
    return n;
}
__device__ __forceinline__ void cvt_tile(const float* W, int ldw, bf16_t* Bt, int ldb, int n0, int k0, int mode, const float* kscale, float* T, int wv) {
    const int tid = otid(wv), n4 = (tid & 31) * 4, kq = tid >> 5, src = colmap(mode, n0 + n4);
    f32x4 v[8];
#pragma unroll
    for (int i = 0; i < 8; ++i) { const int kk = kq + 16 * i; v[i] = __builtin_nontemporal_load((const f32x4*)(W + (size_t)(k0 + kk) * ldw + (src >= 0 ? src : 0))); }
    float ksc[8];
#pragma unroll
    for (int i = 0; i < 8; ++i) ksc[i] = kscale ? kscale[k0 + kq + 16 * i] : 1.0f;
#pragma unroll
    for (int i = 0; i < 8; ++i) v[i] = v[i] * (src >= 0 ? ksc[i] : 0.0f);
#pragma unroll
    for (int i = 0; i < 8; ++i)
#pragma unroll
        for (int j = 0; j < 4; ++j) T[(n4 + j) * 129 + kq + 16 * i] = v[i][j];
    __syncthreads();
    { const int n2 = tid >> 2, ks = (tid & 3) * 32; const float* t = T + n2 * 129 + ks; bf16_t* dst = Bt + (size_t)(n0 + n2) * ldb + k0 + ks;
#pragma unroll
      for (int i = 0; i < 4; ++i) { u32x4 w; w.x = cvt_pk_bf16(t[i * 8 + 0], t[i * 8 + 1]); w.y = cvt_pk_bf16(t[i * 8 + 2], t[i * 8 + 3]); w.z = cvt_pk_bf16(t[i * 8 + 4], t[i * 8 + 5]); w.w = cvt_pk_bf16(t[i * 8 + 6], t[i * 8 + 7]);
          *(u32x4*)(dst + i * 8) = w; } }
    __syncthreads();
}
constexpr int CT0 = 26 * 16, CT1 = CT0 + 12 * 4, CT2 = CT1 + 16 * 4, CT3 = CT2 + 32, CT4 = CT3 + 16 * 16, CT5 = CT4 + 64 * 16, CT6 = CT5 + 16 * 64;
__device__ __forceinline__ void convert_weights(const Params& p, int l, int t0, int t1, float* T, int wv) {
    unsigned char* ws = p.ws;
    const float* ing = l == 0 ? p.in[2] : p.in[21] + (size_t)(l - 1) * 2048;
    for (int t = t0 + blockIdx.x; t < t1; t += gridDim.x) {
        if (t < CT0) { const int nt = t % 26, kt = t / 26; cvt_tile(p.in[4] + (size_t)l * 2048 * NIN, NIN, (bf16_t*)(ws + W_IN), 2048, nt * 128, kt * 128, 0, ing, T, wv); }
        else if (t < CT1) { const int u = t - CT0, nt = u % 12, kt = u / 12; cvt_tile(p.in[7] + (size_t)l * 512 * 1536, 1536, (bf16_t*)(ws + W_UQ), 512, nt * 128, kt * 128, 1, p.in[5] + l * 512, T, wv); }
        else if (t < CT2) { const int u = t - CT1, nt = u % 16, kt = u / 16; cvt_tile(p.in[8] + (size_t)l * 512 * 2048, 2048, (bf16_t*)(ws + W_UKV), 512, nt * 128, kt * 128, 2, p.in[6] + l * 512, T, wv); }
        else if (t < CT3) { const int mat = t - CT2, gate = mat & 1, h = (mat >> 1) & 7, d = mat >> 4;
            cvt_tile((gate ? p.in[13] : p.in[11]) + ((size_t)((l * 2 + d) * 8 + h)) * 128 * 128, 128, (bf16_t*)(ws + W_G) + (size_t)(h * 512 + d * 256 + gate * 128) * 128, 128, 0, 0, 2, nullptr, T, wv); }
        else if (t < CT4) { const int u = t - CT3, nt = u % 16, kt = u / 16; cvt_tile(p.in[16] + (size_t)l * 2048 * 2048, 2048, (bf16_t*)(ws + W_OUT), 2048, nt * 128, kt * 128, 2, nullptr, T, wv); }
        else if (t < CT5) { const int u = t - CT4, nt = u % 64, kt = u / 64; cvt_tile(p.in[19] + (size_t)l * 2048 * 8192, 8192, (bf16_t*)(ws + W_UP), 2048, nt * 128, kt * 128, 2, p.in[17] + (size_t)l * 2048, T, wv); }
        else { const int u = t - CT5, nt = u % 16, kt = u / 16; cvt_tile(p.in[20] + (size_t)l * 8192 * 2048, 2048, (bf16_t*)(ws + W_DN), 8192, nt * 128, kt * 128, 2, nullptr, T, wv); }
    }
}
__device__ __forceinline__ void colsum_pass(const bf16_t* Bt, int N, const float* lg, const float* lb, float* cs, float* bw, int wv) {
    const int tid = otid(wv), lane = tid & 63, wave = tid >> 6;
    float ratio[32];
#pragma unroll
    for (int i = 0; i < 4; ++i)
#pragma unroll
        for (int j = 0; j < 8; ++j) { const int k = i * 512 + lane * 8 + j; ratio[i * 8 + j] = lb[k] * __builtin_amdgcn_rcpf(lg[k]); }
    for (int n = blockIdx.x * 8 + wave; n < N; n += gridDim.x * 8) {
        u32x4 w[4];
#pragma unroll
        for (int i = 0; i < 4; ++i) w[i] = *(const u32x4*)(Bt + (size_t)n * 2048 + i * 512 + lane * 8);
        float c = 0.f, bb = 0.f;
#pragma unroll
        for (int i = 0; i < 4; ++i) { const float v[8] = {bf_lo(w[i].x), bf_hi(w[i].x), bf_lo(w[i].y), bf_hi(w[i].y), bf_lo(w[i].z), bf_hi(w[i].z), bf_lo(w[i].w), bf_hi(w[i].w)};
#pragma unroll
            for (int j = 0; j < 8; ++j) { c += v[j]; bb += v[j] * ratio[i * 8 + j]; } }
        c = wave_sum(c, lane); bb = wave_sum(bb, lane);
        if (lane == 0) { cs[n] = c; bw[n] = bb; }
    }
}
__device__ __forceinline__ void colsum_in(const Params& p, int l, int wv) { float* csb = (float*)(p.ws + WS_CSB) + (size_t)l * CSB_L;
    colsum_pass((const bf16_t*)(p.ws + W_IN), NINP, l == 0 ? p.in[2] : p.in[21] + (size_t)(l - 1) * 2048, l == 0 ? p.in[3] : p.in[22] + (size_t)(l - 1) * 2048, csb + CSB_IN, csb + CSB_IN + NINP, wv); }
__device__ __forceinline__ void colsum_up(const Params& p, int l, int wv) { float* csb = (float*)(p.ws + WS_CSB) + (size_t)l * CSB_L;
    colsum_pass((const bf16_t*)(p.ws + W_UP), DFF, p.in[17] + (size_t)l * 2048, p.in[18] + (size_t)l * 2048, csb + CSB_UP, csb + CSB_UP + DFF, wv); }
__device__ __forceinline__ void make_tables(const Params& p, int wv) {
    const int* pos = (const int*)p.in[1]; float* cosT = (float*)(p.ws + WS_COS); float* sinT = (float*)(p.ws + WS_SIN); float* sp = (float*)(p.ws + WS_SP);
    const int tid = otid(wv);
    for (int i = blockIdx.x * 512 + tid; i < M_ * 32; i += gridDim.x * 512) {
        const int row = i >> 5, k = i & 31; const float inv = powf(10000.0f, -(float)(2 * k) / 64.0f); const float ang = (float)pos[row] * inv;
        cosT[i] = cosf(ang); sinT[i] = sinf(ang); }
    for (int i = blockIdx.x * 512 + tid; i < DEPTH * 2 * 1024; i += gridDim.x * 512) { const float x = -p.in[15][i];
        sp[i] = fmaxf(x, 0.f) + log1pf(expf(-fabsf(x))); }
}
__device__ __forceinline__ void conv_phase(const Params& p, int l, int wv) {
    const bf16_t* __restrict__ xl = (const bf16_t*)(p.ws + WS_XL); bf16_t* __restrict__ xc = (bf16_t*)(p.ws + WS_XC);
    const float* cw = p.in[9] + (size_t)l * 4 * 1024; const float* cb = p.in[10] + (size_t)l * 1024;
    const int tid = otid(wv);
    for (int i = blockIdx.x * 512 + tid; i < M_ * 128; i += gridDim.x * 512) {
        const int row = i >> 7, c0 = (i & 127) * 8, t = row & (SEQ - 1);
        u32x4 xw[4]; f32x4 w0[4], w1[4];
#pragma unroll
        for (int k = 0; k < 4; ++k) { const int tt = t - 2 + k; const bool ok = (tt >= 0) && (tt < SEQ); const int rr = ok ? row - 2 + k : row;
            xw[k] = *(const u32x4*)(xl + (size_t)rr * 1024 + c0);
            w0[k] = *(const f32x4*)(cw + k * 1024 + c0); w1[k] = *(const f32x4*)(cw + k * 1024 + c0 + 4);
            if (!ok) { w0[k] = (f32x4){0.f, 0.f, 0.f, 0.f}; w1[k] = (f32x4){0.f, 0.f, 0.f, 0.f}; } }
        const f32x4 b0 = *(const f32x4*)(cb + c0), b1 = *(const f32x4*)(cb + c0 + 4);
        float acc[8] = {b0[0], b0[1], b0[2], b0[3], b1[0], b1[1], b1[2], b1[3]};
#pragma unroll
        for (int k = 0; k < 4; ++k) {
            acc[0] += w0[k][0] * bf_lo(xw[k].x); acc[1] += w0[k][1] * bf_hi(xw[k].x); acc[2] += w0[k][2] * bf_lo(xw[k].y); acc[3] += w0[k][3] * bf_hi(xw[k].y);
            acc[4] += w1[k][0] * bf_lo(xw[k].z); acc[5] += w1[k][1] * bf_hi(xw[k].z); acc[6] += w1[k][2] * bf_lo(xw[k].w); acc[7] += w1[k][3] * bf_hi(xw[k].w); }
        u32x4 o; o.x = cvt_pk_bf16(acc[0], acc[1]); o.y = cvt_pk_bf16(acc[2], acc[3]); o.z = cvt_pk_bf16(acc[4], acc[5]); o.w = cvt_pk_bf16(acc[6], acc[7]);
        *(u32x4*)(xc + (size_t)row * 1024 + c0) = o;
    }
}
#define SCAN_STEP(W, R, H0, H1, A0, A1) do { A0 = __builtin_amdgcn_exp2f((float)((R) & 255u) * k0); A1 = __builtin_amdgcn_exp2f((float)((R) >> 8) * k1); \
    H0 = A0 * H0 + bf_lo(W); H1 = A1 * H1 + bf_hi(W); } while (0)
__device__ __forceinline__ void scan_local(const Params& p, int l, int wv) {
    const unsigned* up = (const unsigned*)(p.ws + WS_AU); const unsigned short* rp = (const unsigned short*)(p.ws + WS_AU + AU_RPLANE); f32x4* ph = (f32x4*)(p.ws + WS_PH); const int tid = otid(wv);
    const float* spl = (const float*)(p.ws + WS_SP) + (size_t)l * 2048;
    for (int it = blockIdx.x; it < 2 * 8 * 64; it += gridDim.x) {
        const int c = it & 63, b = (it >> 6) & 7, d = it >> 9;
        const float k0 = spl[d * 1024 + 2 * tid] * (-8.0f * 1.4426950408889634f / 255.0f), k1 = spl[d * 1024 + 2 * tid + 1] * (-8.0f * 1.4426950408889634f / 255.0f);
        const size_t e0 = ((size_t)d * M_ + (size_t)(b * SEQ + c * 64)) * 512 + tid;
        const unsigned* __restrict__ us = up + e0; const unsigned short* __restrict__ rs = rp + e0;
        float h0 = 0.f, h1 = 0.f, P0 = 1.f, P1 = 1.f;
        const long step = d ? -512 : 512; const long q0 = d ? (long)63 * 512 : 0;
        unsigned wa[16], wb[16]; unsigned ra[16], rb[16];
#pragma unroll
        for (int j = 0; j < 16; ++j) { wa[j] = us[q0 + (long)j * step]; ra[j] = rs[q0 + (long)j * step]; }
#pragma unroll
        for (int bt = 0; bt < 4; bt += 2) {
#pragma unroll
            for (int j = 0; j < 16; ++j) { wb[j] = us[q0 + (long)((bt + 1) * 16 + j) * step]; rb[j] = rs[q0 + (long)((bt + 1) * 16 + j) * step]; }
#pragma unroll
            for (int j = 0; j < 16; ++j) { float a0, a1; SCAN_STEP(wa[j], ra[j], h0, h1, a0, a1); P0 *= a0; P1 *= a1; }
            if (bt + 2 < 4) {
#pragma unroll
                for (int j = 0; j < 16; ++j) { wa[j] = us[q0 + (long)((bt + 2) * 16 + j) * step]; ra[j] = rs[q0 + (long)((bt + 2) * 16 + j) * step]; } }
#pragma unroll
            for (int j = 0; j < 16; ++j) { float a0, a1; SCAN_STEP(wb[j], rb[j], h0, h1, a0, a1); P0 *= a0; P1 *= a1; }
        }
        ph[(size_t)((d * 8 + b) * 64 + c) * 512 + tid] = (f32x4){P0, h0, P1, h1};
    }
}
__device__ __forceinline__ void scan_apply(const Params& p, int l, int wv) {
    const unsigned* up = (const unsigned*)(p.ws + WS_AU); const unsigned short* rp = (const unsigned short*)(p.ws + WS_AU + AU_RPLANE); const f32x4* ph = (const f32x4*)(p.ws + WS_PH);
    const bf16_t* gg = (const bf16_t*)(p.ws + WS_GG); bf16_t* ycat = (bf16_t*)(p.ws + WS_YCAT); const int tid = otid(wv);
    const float* spl = (const float*)(p.ws + WS_SP) + (size_t)l * 2048;
    const float kf0 = spl[2 * tid] * (-8.0f * 1.4426950408889634f / 255.0f), kf1 = spl[2 * tid + 1] * (-8.0f * 1.4426950408889634f / 255.0f);
    const float kb0 = spl[1024 + 2 * tid] * (-8.0f * 1.4426950408889634f / 255.0f), kb1 = spl[1024 + 2 * tid + 1] * (-8.0f * 1.4426950408889634f / 255.0f);
    for (int it = blockIdx.x; it < 8 * 64; it += gridDim.x) {
        const int c = it & 63, b = it >> 6;
        float Hf0 = 0.f, Hf1 = 0.f, Hb0 = 0.f, Hb1 = 0.f;
        { const f32x4* pf = ph + (size_t)((0 * 8 + b) * 64) * 512 + tid;
          for (int c0 = 0; c0 < c; c0 += 8) { f32x4 e[8];
#pragma unroll
              for (int j = 0; j < 8; ++j) e[j] = pf[(size_t)min(c0 + j, c - 1) * 512];
#pragma unroll
              for (int j = 0; j < 8; ++j) if (c0 + j >= c) e[j] = (f32x4){1.f, 0.f, 1.f, 0.f};
#pragma unroll
              for (int j = 0; j < 8; ++j) { Hf0 = e[j][0] * Hf0 + e[j][1]; Hf1 = e[j][2] * Hf1 + e[j][3]; } }
          const f32x4* pb = ph + (size_t)((1 * 8 + b) * 64) * 512 + tid;
          for (int c0 = 63; c0 > c; c0 -= 8) { f32x4 e[8];
#pragma unroll
              for (int j = 0; j < 8; ++j) e[j] = pb[(size_t)max(c0 - j, c + 1) * 512];
#pragma unroll
              for (int j = 0; j < 8; ++j) if (c0 - j <= c) e[j] = (f32x4){1.f, 0.f, 1.f, 0.f};
#pragma unroll
              for (int j = 0; j < 8; ++j) { Hb0 = e[j][0] * Hb0 + e[j][1]; Hb1 = e[j][2] * Hb1 + e[j][3]; } } }
        const size_t r0 = (size_t)(b * SEQ + c * 64);
        const unsigned* __restrict__ s0 = up + r0 * 512 + tid; const unsigned* __restrict__ s1 = up + ((size_t)M_ + r0) * 512 + tid;
        const unsigned short* __restrict__ q0p = rp + r0 * 512 + tid; const unsigned short* __restrict__ q1p = rp + ((size_t)M_ + r0) * 512 + tid;
        const unsigned* __restrict__ gp = (const unsigned*)(gg + r0 * 1024) + tid; unsigned* __restrict__ yp = (unsigned*)(ycat + r0 * 2048 + 1024) + tid;
        float hf0[64], hf1[64];
        { const float k0 = kf0, k1 = kf1; unsigned wa[8], wb[8], ra[8], rb[8];
#pragma unroll
          for (int j = 0; j < 8; ++j) { wa[j] = s0[(size_t)j * 512]; ra[j] = q0p[(size_t)j * 512]; }
#pragma unroll
          for (int bt = 0; bt < 8; bt += 2) {
#pragma unroll
              for (int j = 0; j < 8; ++j) { wb[j] = s0[(size_t)((bt + 1) * 8 + j) * 512]; rb[j] = q0p[(size_t)((bt + 1) * 8 + j) * 512]; }
#pragma unroll
              for (int j = 0; j < 8; ++j) { const int t = bt * 8 + j; float a0, a1; SCAN_STEP(wa[j], ra[j], Hf0, Hf1, a0, a1); hf0[t] = Hf0; hf1[t] = Hf1; }
              if (bt + 2 < 8) {
#pragma unroll
                  for (int j = 0; j < 8; ++j) { wa[j] = s0[(size_t)((bt + 2) * 8 + j) * 512]; ra[j] = q0p[(size_t)((bt + 2) * 8 + j) * 512]; } }
#pragma unroll
              for (int j = 0; j < 8; ++j) { const int t = (bt + 1) * 8 + j; float a0, a1; SCAN_STEP(wb[j], rb[j], Hf0, Hf1, a0, a1); hf0[t] = Hf0; hf1[t] = Hf1; }
          } }
        { const float k0 = kb0, k1 = kb1; unsigned wa[8], wb[8], ra[8], rb[8]; unsigned ga[8], gb[8];
#pragma unroll
          for (int j = 0; j < 8; ++j) { wa[j] = s1[(size_t)(63 - j) * 512]; ra[j] = q1p[(size_t)(63 - j) * 512]; ga[j] = gp[(size_t)(63 - j) * 512]; }
#pragma unroll
          for (int bt = 0; bt < 8; bt += 2) {
#pragma unroll
              for (int j = 0; j < 8; ++j) { const int t = 63 - ((bt + 1) * 8 + j); wb[j] = s1[(size_t)t * 512]; rb[j] = q1p[(size_t)t * 512]; gb[j] = gp[(size_t)t * 512]; }
#pragma unroll
              for (int j = 0; j < 8; ++j) { const int t = 63 - (bt * 8 + j); float a0, a1; SCAN_STEP(wa[j], ra[j], Hb0, Hb1, a0, a1);
                  yp[(size_t)t * 1024] = cvt_pk_bf16(bf_lo(ga[j]) * (hf0[t] + Hb0), bf_hi(ga[j]) * (hf1[t] + Hb1)); }
              if (bt + 2 < 8) {
#pragma unroll
                  for (int j = 0; j < 8; ++j) { const int t = 63 - ((bt + 2) * 8 + j); wa[j] = s1[(size_t)t * 512]; ra[j] = q1p[(size_t)t * 512]; ga[j] = gp[(size_t)t * 512]; } }
#pragma unroll
              for (int j = 0; j < 8; ++j) { const int t = 63 - ((bt + 1) * 8 + j); float a0, a1; SCAN_STEP(wb[j], rb[j], Hb0, Hb1, a0, a1);
                  yp[(size_t)t * 1024] = cvt_pk_bf16(bf_lo(gb[j]) * (hf0[t] + Hb0), bf_hi(gb[j]) * (hf1[t] + Hb1)); }
          } }
    }
}
#undef SCAN_STEP

#define XB_TMO      128
#define XB_XCNT(j)  (256  + 64 * (j))
#define XB_XSUB(j)  (1280 + 64 * (j))
#define XB_XGEN(j)  (2304 + 64 * (j))
#define XB_TOP      3328
#define XB_TOPGEN   3392
#define XCD_BAR_WORDS 3456
#define XB_SPIN_CAP (1u << 20)
__device__ __forceinline__ unsigned xb_ld(unsigned* p)              { return __hip_atomic_load(p, __ATOMIC_RELAXED, __HIP_MEMORY_SCOPE_AGENT); }
__device__ __forceinline__ unsigned xb_add(unsigned* p, unsigned v) { return __hip_atomic_fetch_add(p, v, __ATOMIC_RELAXED, __HIP_MEMORY_SCOPE_AGENT); }
__device__ __forceinline__ unsigned xb_xcc_id() { unsigned x; asm volatile("s_getreg_b32 %0, hwreg(20, 0, 4)" : "=s"(x)); return x & 0xFu; }
#define XB_SPIN(cond, bar) do { unsigned _sp = 0; while (cond) { __builtin_amdgcn_s_sleep(1); \
    if ((++_sp & 255u) == 0u) { if (xb_ld(&(bar)[XB_TMO])) break; if (_sp > XB_SPIN_CAP) { atomicAdd(&(bar)[XB_TMO], 1u); break; } } } } while (0)
struct XcdBarrier { unsigned* bar; unsigned x; volatile LAS unsigned* st; };
__device__ __forceinline__ XcdBarrier xcd_barrier_post(unsigned* bar, volatile LAS unsigned* st, int wv) {
    XcdBarrier b; b.bar = bar; b.x = (unsigned)__builtin_amdgcn_readfirstlane((int)xb_xcc_id()); b.st = st;
    if (otid(wv) == 0) (void)xb_add(&bar[XB_XCNT(b.x)], 1u);
    return b;
}
__device__ __forceinline__ void xcd_barrier_complete(unsigned* bar, unsigned x, unsigned& nloc, unsigned& nx) {
    const unsigned G = gridDim.x * gridDim.y * gridDim.z;
    unsigned sum, cnt, mine, sp = 0u;
    for (;;) {
        sum = 0u; cnt = 0u; mine = 0u;
#pragma unroll
        for (unsigned j = 0; j < 16; ++j) { const unsigned c = xb_ld(&bar[XB_XCNT(j)]); sum += c; cnt += (c > 0u) ? 1u : 0u; mine = (j == x) ? c : mine; }
        if (sum == G) break;
        __builtin_amdgcn_s_sleep(1);
        if ((++sp & 255u) == 0u) { if (xb_ld(&bar[XB_TMO])) break; if (sp > XB_SPIN_CAP) { atomicAdd(&bar[XB_TMO], 1u); break; } }
    }
    nloc = mine > 0u ? mine : 1u; nx = cnt > 0u ? cnt : 1u;
}
__device__ __forceinline__ void xcd_barrier(const XcdBarrier& b, unsigned* barp, int wv) {
    asm volatile("s_waitcnt vmcnt(0) lgkmcnt(0)" ::: "memory");
    __syncthreads();
    if (otid(wv) == 0) {
        const unsigned bx_ = xb_xcc_id();
        unsigned* bar = barp;
        __builtin_amdgcn_s_waitcnt(0);
        unsigned nloc = b.st[0], nx = b.st[1];
        if (nloc == 0u) { xcd_barrier_complete(bar, bx_, nloc, nx); b.st[0] = nloc; b.st[1] = nx; }
        const unsigned old = xb_add(&bar[XB_XSUB(bx_)], 1u);
        const unsigned gen = old / nloc;
        if (old + 1u == (gen + 1u) * nloc) {
            __builtin_amdgcn_fence(__ATOMIC_RELEASE, "agent");
            asm volatile("s_waitcnt vmcnt(0)" ::: "memory");
            const unsigned og = xb_add(&bar[XB_TOP], 1u);
            const unsigned tg = og / nx;
            if (og + 1u == (tg + 1u) * nx) xb_add(&bar[XB_TOPGEN], 1u);
            else XB_SPIN(xb_ld(&bar[XB_TOPGEN]) == tg, bar);
            __builtin_amdgcn_fence(__ATOMIC_ACQUIRE, "agent");
            xb_add(&bar[XB_XGEN(bx_)], 1u);
            asm volatile("s_waitcnt vmcnt(0)" ::: "memory");
        } else {
            XB_SPIN(xb_ld(&bar[XB_XGEN(bx_)]) == gen, bar);
            __builtin_amdgcn_fence(__ATOMIC_ACQUIRE, "agent");
            asm volatile("s_waitcnt vmcnt(0)" ::: "memory");
        }
    }
    __syncthreads();
}
__global__ void __launch_bounds__(512, 2) mega_fwd(Params p) {
    extern __shared__ __attribute__((aligned(16))) unsigned char lds[];
    cg::grid_group grid = cg::this_grid();
    const int wv = __builtin_amdgcn_readfirstlane((int)threadIdx.x >> 6);
    unsigned char* ws = p.ws;
    LAS unsigned char* ldsl = (LAS unsigned char*)lds;
    bf16_t* hb = (bf16_t*)(ws + WS_HB);
    const float* cosT = (const float*)(ws + WS_COS); const float* sinT = (const float*)(ws + WS_SIN);

    volatile LAS unsigned* xst = (volatile LAS unsigned*)(ldsl + pg8::STAGE_BYTES);
    { const int t_ = otid(wv); if (t_ < 4) xst[t_] = 0u; }
    __syncthreads();
    XcdBarrier xb = xcd_barrier_post((unsigned*)(ws + WS_BAR), xst, wv);
    fix_t* stats0 = (fix_t*)(ws + WS_ST);
#define stats stats0
    { const int tid = otid(wv);
      for (int i = blockIdx.x * 512 + tid; i < 8 * 2 * M_; i += gridDim.x * 512) stats[(size_t)2 * M_ + i] = 0ull;
    }
    make_tables(p, wv);
    x_pass(p.in[0], hb, stats, wv);
    grid.sync();
    convert_weights(p, 0, 0, CT6, (float*)lds, wv);
    xcd_barrier(xb, (unsigned*)(ws + WS_BAR), wv);
    colsum_in(p, 0, wv); colsum_up(p, 0, wv);
    xcd_barrier(xb, (unsigned*)(ws + WS_BAR), wv);

#pragma unroll 1
    for (int l = 0; l < DEPTH; ++l) {
        { typedef __attribute__((address_space(1))) unsigned char gu8; uintptr_t w_ = (uintptr_t)p.ws; asm volatile("" : "+s"(w_)); ws = (unsigned char*)(gu8*)w_; }
        const float* csb = (const float*)(ws + WS_CSB) + (size_t)l * CSB_L;
        fix_t* st0 = (fix_t*)(ws + WS_ST) + (size_t)(2 * l) * 2 * M_; fix_t* st1 = st0 + 2 * M_; fix_t* st2 = st1 + 2 * M_;
        if (l > 0) { colsum_up(p, l, wv); convert_weights(p, l, CT5, CT6, (float*)lds, wv); }
        { pg8::Order S = pg8::make_order(hb, 2048, ws + W_IN, 2048, M_, NINP, 2048);
          EpiIn E{(bf16_t*)(ws + WS_CQ), (bf16_t*)(ws + WS_CKV), (bf16_t*)(ws + WS_XL), (bf16_t*)(ws + WS_GG), (bf16_t*)(ws + WS_KPE), (float*)(ws + WS_SSQ), cosT, sinT, st0, csb + CSB_IN, csb + CSB_IN + NINP};
          pg8::gemm_phase(ldsl, S, E, wv); }
        xcd_barrier(xb, (unsigned*)(ws + WS_BAR), wv);
        conv_phase(p, l, wv);
        { pg8::Order S = pg8::make_order(ws + WS_CQ, 512, ws + W_UQ, 512, M_, 1536, 512); S.wgm = 4;
          EpiQ E{(bf16_t*)(ws + WS_Q), (const float*)(ws + WS_SSQ), cosT, sinT};
          pg8::gemm_phase(ldsl, S, E, wv); }
        { pg8::Order S = pg8::make_order(ws + WS_CKV, 512, ws + W_UKV, 512, M_, 2048, 512); S.wgm = 4;
          EpiKV E{(bf16_t*)(ws + WS_KV), (const float*)(ws + WS_SSQ)};
          pg8::gemm_phase(ldsl, S, E, wv); }
        xcd_barrier(xb, (unsigned*)(ws + WS_BAR), wv);
        {
            const bf16_t* Q = (const bf16_t*)(ws + WS_Q); const bf16_t* KV = (const bf16_t*)(ws + WS_KV); const bf16_t* KPE = (const bf16_t*)(ws + WS_KPE); bf16_t* ycat = (bf16_t*)(ws + WS_YCAT);
            const int G = gridDim.x, bx = blockIdx.x;
            for (int L = bx; L < 1024; L += G) {
                int pair, qb;
                if (G == 256) { const int i = L >> 8, c = L & 255, xcd = c & 7, j = c >> 3; pair = i * 16 + xcd * 2 + (j >> 4); qb = j & 15; } else { pair = L >> 4; qb = L & 15; }
                const int b = pair >> 3, h = pair & 7; const size_t row0 = (size_t)b * SEQ + (size_t)qb * 256;
                __syncthreads();
                att::attn_unit(Q + row0 * 1536 + h * 128, Q + row0 * 1536 + 1024 + h * 64, KV + (size_t)b * SEQ * 2048 + h * 256, KPE + (size_t)b * SEQ * 64, ycat + row0 * 2048 + h * 128, SEQ, (char*)lds, wv);
            }
            __syncthreads();
        }
        { pg8::Order S = pg8::make_order(ws + WS_XC, 1024, ws + W_G, 128, M_, 512, 128);
          S.nZ = 8; S.a_z = 128 * 2; S.b_z = (size_t)512 * 128 * 2;
          EpiGate E{(bf16_t*)(ws + WS_AU), ws + WS_AU + AU_RPLANE, (const bf16_t*)(ws + WS_XC), p.in[12] + (size_t)l * 2048, p.in[14] + (size_t)l * 2048, (const float*)(ws + WS_SP) + (size_t)l * 2048};
          pg8::gemm_phase(ldsl, S, E, wv); }
        xcd_barrier(xb, (unsigned*)(ws + WS_BAR), wv);
        scan_local(p, l, wv);
        if (l + 1 < DEPTH) { __syncthreads(); convert_weights(p, l + 1, 0, CT3, (float*)lds, wv); }
        xcd_barrier(xb, (unsigned*)(ws + WS_BAR), wv);
        if (l + 1 < DEPTH) colsum_in(p, l + 1, wv);
        scan_apply(p, l, wv);
        xcd_barrier(xb, (unsigned*)(ws + WS_BAR), wv);
        { pg8::Order S = pg8::make_order(ws + WS_YCAT, 2048, ws + W_OUT, 2048, M_, 2048, 2048); S.wgm = 4;
          EpiRes E{hb, st0, l == 0 ? p.in[2] : p.in[21] + (size_t)(l - 1) * 2048, l == 0 ? p.in[3] : p.in[22] + (size_t)(l - 1) * 2048, st1};
          pg8::gemm_phase(ldsl, S, E, wv); }
        xcd_barrier(xb, (unsigned*)(ws + WS_BAR), wv);
        if (l + 1 < DEPTH) { convert_weights(p, l + 1, CT3, CT4, (float*)lds, wv); }
        { pg8::Order S = pg8::make_order(hb, 2048, ws + W_UP, 2048, M_, DFF, 2048);
          EpiUp E{(bf16_t*)(ws + WS_F), st1, csb + CSB_UP, csb + CSB_UP + DFF}; pg8::gemm_phase(ldsl, S, E, wv); }
        xcd_barrier(xb, (unsigned*)(ws + WS_BAR), wv);
        if (l + 1 < DEPTH) { convert_weights(p, l + 1, CT4, CT5, (float*)lds, wv); }
        { pg8::Order S = pg8::make_order(ws + WS_F, 8192, ws + W_DN, 8192, M_, 2048, 8192); S.wgm = 4;
          EpiRes E{hb, st1, p.in[17] + (size_t)l * 2048, p.in[18] + (size_t)l * 2048, st2};
          pg8::gemm_phase(ldsl, S, E, wv); }
        xcd_barrier(xb, (unsigned*)(ws + WS_BAR), wv);
    }
    ln_final(p.out, (const bf16_t*)(p.ws + WS_HB), (const fix_t*)(p.ws + WS_ST) + (size_t)(2 * DEPTH) * 2 * M_, p.in[21] + (size_t)(DEPTH - 1) * 2048, p.in[22] + (size_t)(DEPTH - 1) * 2048, wv);
}

extern "C" void kernel_launch(void* const* d_in, const int* in_sizes, int n_in, void* d_out, int out_size, void* d_ws, size_t ws_size, hipStream_t stream) {
    constexpr int LDS_BYTES = pg8::STAGE_BYTES + 16;
    static int grid_blocks = 0;
    if (grid_blocks == 0) {
        if (n_in != 23 || in_sizes[0] != M_ * DM || out_size != M_ * DM || ws_size < WS_END) {
            fprintf(stderr, "kernel_launch: shape mismatch (n_in %d, in0 %d, out %d, ws %zu, need %zu)\n", n_in, n_in > 0 ? in_sizes[0] : -1, out_size, ws_size, (size_t)WS_END); grid_blocks = -1; return; }
        int dev = 0, cus = 0, per_cu = 0;
        hipGetDevice(&dev); hipDeviceGetAttribute(&cus, hipDeviceAttributeMultiprocessorCount, dev);
        if (hipFuncSetAttribute((const void*)mega_fwd, hipFuncAttributeMaxDynamicSharedMemorySize, LDS_BYTES) != hipSuccess) { fprintf(stderr, "kernel_launch: hipFuncSetAttribute failed\n"); grid_blocks = -1; return; }
        if (hipOccupancyMaxActiveBlocksPerMultiprocessor(&per_cu, (const void*)mega_fwd, 512, LDS_BYTES) != hipSuccess || per_cu < 1) { fprintf(stderr, "kernel_launch: occupancy query says %d\n", per_cu); per_cu = 1; }
        (void)hipGetLastError();
        grid_blocks = cus * 1;
    }
    if (grid_blocks < 0) return;
    Params p{};
    for (int i = 0; i < 23; ++i) p.in[i] = (const float*)d_in[i];
    p.out = (float*)d_out; p.ws = (unsigned char*)d_ws;
    (void)hipMemsetAsync((char*)d_ws + WS_BAR, 0, XCD_BAR_WORDS * 4, stream);
    void* args[] = {&p};
    hipError_t e = hipLaunchCooperativeKernel((const void*)mega_fwd, dim3(grid_blocks), dim3(512), args, LDS_BYTES, stream);
    if (e != hipSuccess) fprintf(stderr, "kernel_launch: cooperative launch failed: %s (grid %d)\n", hipGetErrorString(e), grid_blocks);
}
```

```cpp
#include <hip/hip_runtime.h>
#include <hip/hip_cooperative_groups.h>
#include <cstdio>
#include <cstdint>
namespace cg = cooperative_groups;

#define LAS __attribute__((address_space(3)))
typedef unsigned short bf16_t;
typedef short bf16x8 __attribute__((ext_vector_type(8)));
typedef short s16x4 __attribute__((ext_vector_type(4)));
typedef float f32x4 __attribute__((ext_vector_type(4)));
typedef float f32x2 __attribute__((ext_vector_type(2)));
typedef float f32x16 __attribute__((ext_vector_type(16)));
typedef unsigned u32x4 __attribute__((ext_vector_type(4)));
typedef unsigned u32x2 __attribute__((ext_vector_type(2)));

constexpr int M_ = 32768, DM = 2048, SEQ = 4096, NBATCH = 8, DEPTH = 4;
constexpr int NIN = 3136, NINP = 3328, DFF = 8192;
constexpr float ALPHA = 1.6817928305074290f;
constexpr float LN_EPS = 1e-5f, RMS_EPS = 1e-6f;
constexpr size_t MiB = 1ull << 20;
constexpr size_t WS_HB = 0;
constexpr size_t WS_W = 128 * MiB;
constexpr size_t W_IN = WS_W, W_UQ = W_IN + (size_t)NINP * 2048 * 2, W_UKV = W_UQ + 1536ull * 512 * 2, W_G = W_UKV + 2048ull * 512 * 2,
                 W_OUT = W_G + 8ull * 512 * 128 * 2, W_UP = W_OUT + 2048ull * 2048 * 2, W_DN = W_UP + 8192ull * 2048 * 2, W_END = W_DN + 8192ull * 2048 * 2;
static_assert(W_END <= 218 * MiB, "weights region");
constexpr size_t WS_COS = 218 * MiB, WS_SIN = 222 * MiB, WS_SP = 226 * MiB;
constexpr size_t WS_CSB = 226 * MiB + 65536;
constexpr int CSB_L = 2 * 3328 + 2 * 8192, CSB_IN = 0, CSB_UP = 2 * 3328;
constexpr size_t WS_BAR = 226 * MiB + 49152;
constexpr size_t WS_ST = 227 * MiB;
constexpr size_t WS_BIG = 232 * MiB;
constexpr size_t WS_F = WS_BIG;
constexpr size_t WS_GG = WS_BIG, WS_XC = WS_BIG + 64 * MiB, WS_YCAT = WS_BIG + 128 * MiB, WS_SSQ = WS_BIG + 256 * MiB, WS_KPE = WS_BIG + 258 * MiB,
                 WS_CQ = WS_BIG + 262 * MiB, WS_CKV = WS_BIG + 294 * MiB, WS_XL = WS_BIG + 326 * MiB, WS_AU = WS_BIG + 262 * MiB  ,
                 WS_Q = WS_BIG + 518 * MiB, WS_KV = WS_BIG + 614 * MiB, WS_PH = WS_BIG + 742 * MiB, WS_END = WS_BIG + 750 * MiB;
static_assert(WS_END <= 1024 * MiB, "workspace");

struct Params { const float* in[23]; float* out; unsigned char* ws; };

__device__ __forceinline__ int otid(int wv) { int t; asm volatile("v_mbcnt_lo_u32_b32 %0, -1, 0\n\tv_mbcnt_hi_u32_b32 %0, -1, %0" : "=v"(t)); return (wv << 6) | t; }
__device__ __forceinline__ unsigned cvt_pk_bf16(float lo, float hi) { unsigned r; asm volatile("v_cvt_pk_bf16_f32 %0, %1, %2" : "=v"(r) : "v"(lo), "v"(hi)); return r; }
__device__ __forceinline__ float sum_fq(float x) {
    auto a = __builtin_amdgcn_permlane16_swap(__float_as_uint(x), __float_as_uint(x), false, false); x = __uint_as_float(a[0]) + __uint_as_float(a[1]);
    auto b = __builtin_amdgcn_permlane32_swap(__float_as_uint(x), __float_as_uint(x), false, false); return __uint_as_float(b[0]) + __uint_as_float(b[1]); }
__device__ __forceinline__ float wave_sum(float x, int lane) {
#pragma unroll
    for (int o = 32; o >= 1; o >>= 1) x += __int_as_float(__builtin_amdgcn_ds_bpermute((lane ^ o) << 2, __float_as_int(x)));
    return x; }
__device__ __forceinline__ float bf_lo(unsigned w) { return __uint_as_float(w << 16); }
__device__ __forceinline__ float bf_hi(unsigned w) { return __uint_as_float(w & 0xffff0000u); }
__device__ __forceinline__ float sigmoidf_(float x) { return __builtin_amdgcn_rcpf(1.0f + __builtin_amdgcn_exp2f(-1.4426950408889634f * x)); }
__device__ __forceinline__ float gelu_tanh(float x) { const float z = 0.7978845608028654f * (x + 0.044715f * x * x * x); return x * sigmoidf_(2.0f * z); }
__device__ __forceinline__ u32x4 pack8(const f32x4 a, const f32x4 b) { u32x4 w; w.x = cvt_pk_bf16(a[0], a[1]); w.y = cvt_pk_bf16(a[2], a[3]); w.z = cvt_pk_bf16(b[0], b[1]); w.w = cvt_pk_bf16(b[2], b[3]); return w; }

namespace pg8 {
constexpr int BM = 256, BK = 64, HALF = 128, HTB = HALF * BK * 2, STAGE_BYTES = 8 * HTB, NXCD = 8, WGM = 8;
__host__ __device__ __forceinline__ int lds_byte(int r, int c) { const int st = (r >> 4) * 2 + (c >> 5), rr = r & 15, cc = c & 31, ob = rr * 64 + cc * 2; return st * 1024 + (ob ^ (((ob >> 9) & 1) << 5)); }
__host__ __device__ __forceinline__ void stage_rc(int b, int& R, int& C) { const int st = b / 1024, sb = b % 1024, swz = sb ^ (((sb >> 9) & 1) << 5); R = (st >> 1) * 16 + swz / 64; C = (st & 1) * 32 + (swz % 64) / 2; }
__host__ __device__ __forceinline__ int perm32(int rho) { const int n = rho >> 4, i = rho & 15; return 8 * (i >> 2) + 4 * n + (i & 3); }

struct Unit { int pm, pn, z; };
struct Order {
    int nM, nN, nZ, per, G, c, wgm;
    const char* A; const char* B; size_t a_pm, a_z, b_pn, b_z; int lda, ldb, K;
    __device__ __forceinline__ bool next(int i, Unit& u) const {
        const long L = (long)i * G + c; if (L >= (long)per * nZ) return false;
        u.z = (int)(L / per); int wgid = (int)(L % per);
        { const int q = per / NXCD, r = per % NXCD, xcd = wgid % NXCD, off = wgid / NXCD; wgid = (xcd < r ? xcd * (q + 1) : r * (q + 1) + (xcd - r) * q) + off; }
        const int nig = wgm * nN, gid = wgid / nig, fm = gid * wgm, gsz = (nM - fm) < wgm ? (nM - fm) : wgm;
        u.pm = fm + ((wgid % nig) % gsz); u.pn = (wgid % nig) / gsz; return true;
    }
    __device__ __forceinline__ const char* aptr(const Unit& u) const { return A + (size_t)u.pm * a_pm + (size_t)u.z * a_z; }
    __device__ __forceinline__ const char* bptr(const Unit& u) const { return B + (size_t)u.pn * b_pn + (size_t)u.z * b_z; }
};
__device__ __forceinline__ Order make_order(const void* A, int lda, const void* Bt, int ldb, int Mrows, int N, int K) {
    Order o; o.nM = Mrows / BM; o.nN = N / BM; o.nZ = 1; o.per = o.nM * o.nN; o.G = gridDim.x; o.c = blockIdx.x; o.wgm = WGM;
    o.A = (const char*)A; o.B = (const char*)Bt; o.a_pm = (size_t)BM * lda * 2; o.a_z = 0; o.b_pn = (size_t)BM * ldb * 2; o.b_z = 0; o.lda = lda; o.ldb = ldb; o.K = K; return o;
}

template <class Epi>
__device__ __forceinline__ void gemm_phase(LAS unsigned char* lds, const Order& S, const Epi& E, int wv) {
    const int tid = otid(wv), wid = __builtin_amdgcn_readfirstlane(tid >> 6), lane = tid & 63, wr = wid >> 2, wc = wid & 3, fr = lane & 15, fq = lane >> 4;
    const int nt = S.K / BK;
    unsigned voffA[2], voffB[2];
#pragma unroll
    for (int i = 0; i < 2; ++i) { int R, C; stage_rc(tid * 16 + i * 8192, R, C); const int Rb = Epi::PERM ? ((R & ~31) + perm32(R & 31)) : R;
        voffA[i] = (unsigned)(R * S.lda + C) * 2u; voffB[i] = (unsigned)(Rb * S.ldb + C) * 2u; }
    const size_t kstep = (size_t)(BK * 2);
    const size_t hstepA = (size_t)HALF * S.lda * 2, hstepB = (size_t)HALF * S.ldb * 2;
    const unsigned ldsw = (unsigned)wid * 1024u;
    const int aoff = lds_byte(wr * 64 + fr, fq * 8), boff = lds_byte(wc * 32 + fr, fq * 8);
#define PG8_SA(b, h) (((b) * 2 + (h)) * HTB)
#define PG8_SB(b, h) ((4 + (b) * 2 + (h)) * HTB)
#define PG8_STAGE(bufoff, gbase, voff) do { _Pragma("unroll") for (int _i = 0; _i < 2; ++_i) \
        __builtin_amdgcn_global_load_lds((const unsigned*)((const char*)(gbase) + (voff)[_i]), (LAS unsigned*)(lds + (bufoff) + ldsw + _i * 8192), 16, 0, 0); } while (0)
#define PG8_LDA(dst, b, h) do { _Pragma("unroll") for (int m = 0; m < 4; ++m) _Pragma("unroll") for (int k = 0; k < 2; ++k) dst[m][k] = *(const LAS bf16x8*)(lds + PG8_SA(b, h) + aoff + m * 2048 + k * 1024); } while (0)
#define PG8_LDB(dst, b, h) do { _Pragma("unroll") for (int n = 0; n < 2; ++n) _Pragma("unroll") for (int k = 0; k < 2; ++k) dst[n][k] = *(const LAS bf16x8*)(lds + PG8_SB(b, h) + boff + n * 2048 + k * 1024); } while (0)
#define PG8_MMA(ai, bj, At, Bt) do { __builtin_amdgcn_s_setprio(1); _Pragma("unroll") for (int m = 0; m < 4; ++m) _Pragma("unroll") for (int n = 0; n < 2; ++n) _Pragma("unroll") for (int k = 0; k < 2; ++k) \
        acc[ai][bj][m][n] = __builtin_amdgcn_mfma_f32_16x16x32_bf16(Bt[n][k], At[m][k], acc[ai][bj][m][n], 0, 0, 0); __builtin_amdgcn_s_setprio(0); } while (0)
#define PG8_WAIT_V(n) asm volatile("s_waitcnt vmcnt(" #n ")" ::: "memory")
#define PG8_WAIT_L(n) asm volatile("s_waitcnt lgkmcnt(" #n ")" ::: "memory")
#define PG8_BAR __builtin_amdgcn_s_barrier()
#define PG8_SCHED __builtin_amdgcn_sched_barrier(0)
    Unit cur, nxt; int ui = 0;
    if (!S.next(0, cur)) return;
    f32x4 acc[2][2][4][2];
#pragma unroll
    for (int a = 0; a < 2; ++a)
#pragma unroll
        for (int b = 0; b < 2; ++b)
#pragma unroll
            for (int m = 0; m < 4; ++m)
#pragma unroll
                for (int n = 0; n < 2; ++n) acc[a][b][m][n] = (f32x4){0.f, 0.f, 0.f, 0.f};
    bf16x8 At[4][2], B0[2][2], B1[2][2];
    const char* cA = S.aptr(cur); const char* cB = S.bptr(cur);
    PG8_STAGE(PG8_SB(0, 0), cB, voffB); PG8_STAGE(PG8_SA(0, 0), cA, voffA); PG8_STAGE(PG8_SB(0, 1), cB + hstepB, voffB); PG8_STAGE(PG8_SA(0, 1), cA + hstepA, voffA);
    if (wr == 1) PG8_BAR;
    PG8_WAIT_V(4); PG8_BAR;
    PG8_STAGE(PG8_SB(1, 0), cB + kstep, voffB); PG8_STAGE(PG8_SA(1, 0), cA + kstep, voffA); PG8_STAGE(PG8_SB(1, 1), cB + hstepB + kstep, voffB);
    PG8_WAIT_V(6); PG8_BAR;
    for (;;) {
        const bool has_next = S.next(ui + 1, nxt);
        const char* nA = has_next ? S.aptr(nxt) : cA; const char* nB = has_next ? S.bptr(nxt) : cB;
        for (int t = 0; t < nt; t += 2) {
            const bool last = (t == nt - 2);
            const char* a1 = cA + (size_t)(t + 1) * kstep;
            const char* a2 = last ? nA : cA + (size_t)(t + 2) * kstep; const char* b2 = last ? nB : cB + (size_t)(t + 2) * kstep;
            const char* a3 = a2 + kstep; const char* b3 = b2 + kstep;
            PG8_LDB(B0, 0, 0); PG8_SCHED; PG8_LDA(At, 0, 0); PG8_STAGE(PG8_SA(1, 1), a1 + hstepA, voffA);
            PG8_WAIT_L(8); PG8_BAR; PG8_WAIT_L(0); PG8_MMA(0, 0, At, B0); PG8_BAR; PG8_SCHED;
            PG8_LDB(B1, 0, 1); PG8_STAGE(PG8_SB(0, 0), b2, voffB);
            PG8_BAR; PG8_WAIT_L(0); PG8_MMA(0, 1, At, B1); PG8_BAR;
            PG8_LDA(At, 0, 1); PG8_STAGE(PG8_SA(0, 0), a2, voffA);
            PG8_BAR; PG8_WAIT_L(0); PG8_MMA(1, 0, At, B0); PG8_BAR; PG8_SCHED;
            PG8_STAGE(PG8_SB(0, 1), b2 + hstepB, voffB);
            PG8_WAIT_V(6); PG8_BAR; PG8_MMA(1, 1, At, B1); PG8_BAR;
            PG8_LDB(B0, 1, 0); PG8_SCHED; PG8_LDA(At, 1, 0); PG8_STAGE(PG8_SA(0, 1), a2 + hstepA, voffA);
            PG8_WAIT_L(8); PG8_BAR; PG8_WAIT_L(0); PG8_MMA(0, 0, At, B0); PG8_BAR; PG8_SCHED;
            PG8_LDB(B1, 1, 1); PG8_STAGE(PG8_SB(1, 0), b3, voffB);
            PG8_BAR; PG8_WAIT_L(0); PG8_MMA(0, 1, At, B1); PG8_BAR;
            PG8_LDA(At, 1, 1); PG8_STAGE(PG8_SA(1, 0), a3, voffA);
            PG8_BAR; PG8_WAIT_L(0); PG8_MMA(1, 0, At, B0); PG8_BAR; PG8_SCHED;
            PG8_STAGE(PG8_SB(1, 1), b3 + hstepB, voffB);
            PG8_WAIT_V(6); PG8_BAR; PG8_MMA(1, 1, At, B1); PG8_BAR;
        }
        E(acc, cur, wr, wc, fr, fq);
        if (!has_next) break;
#pragma unroll
        for (int a = 0; a < 2; ++a)
#pragma unroll
            for (int b = 0; b < 2; ++b)
#pragma unroll
                for (int m = 0; m < 4; ++m)
#pragma unroll
                    for (int n = 0; n < 2; ++n) acc[a][b][m][n] = (f32x4){0.f, 0.f, 0.f, 0.f};
        cur = nxt; cA = nA; cB = nB; ++ui;
    }
    PG8_WAIT_V(0);
    if (wr == 0) PG8_BAR;
    PG8_BAR;
#undef PG8_SA
#undef PG8_SB
#undef PG8_STAGE
#undef PG8_LDA
#undef PG8_LDB
#undef PG8_MMA
#undef PG8_WAIT_V
#undef PG8_WAIT_L
#undef PG8_BAR
#undef PG8_SCHED
}
}
using pg8::Unit;
typedef f32x4 Acc[2][2][4][2];

typedef unsigned long long fix_t;
__device__ __forceinline__ fix_t to_fix(float v) { return (fix_t)(long long)(v * 4294967296.0f); }
__device__ __forceinline__ float from_fix(fix_t v) { return fmaf((float)(unsigned)v, 2.3283064365386963e-10f, (float)(int)(v >> 32)); }
__device__ __forceinline__ void fix_add(fix_t* p, float v) { __hip_atomic_fetch_add(p, to_fix(v), __ATOMIC_RELAXED, __HIP_MEMORY_SCOPE_AGENT); }
__device__ __forceinline__ f32x4 ld_fix4(const fix_t* p) { typedef unsigned long long u64x2 __attribute__((ext_vector_type(2))); const u64x2 a = *(const u64x2*)p, b = *(const u64x2*)(p + 2);
    return (f32x4){from_fix(a.x), from_fix(a.y), from_fix(b.x), from_fix(b.y)}; }
__device__ __forceinline__ void row_ln(const fix_t* st, int row, float& mu, float& rs) { const float s1 = from_fix(st[row]), s2 = from_fix(st[M_ + row]); mu = s1 * (1.0f / 2048.0f); rs = __builtin_amdgcn_rsqf(s2 * (1.0f / 2048.0f) - mu * mu + LN_EPS); }
template <bool PERM>
__device__ __forceinline__ void ln_correct(f32x4 (&acc)[2][2][4][2], const fix_t* st, const float* cs, const float* bw, int row0, int colbase) {
    f32x4 c4[2][2], b4[2][2];
#pragma unroll
    for (int bj = 0; bj < 2; ++bj)
#pragma unroll
        for (int n = 0; n < 2; ++n) { const int col = colbase + bj * 128 + (PERM ? 4 * n : 16 * n); c4[bj][n] = *(const f32x4*)(cs + col); b4[bj][n] = *(const f32x4*)(bw + col); }
#pragma unroll
    for (int ai = 0; ai < 2; ++ai) { fix_t r1[4], r2[4];
#pragma unroll
        for (int m = 0; m < 4; ++m) { const int row = row0 + ai * 128 + m * 16; r1[m] = st[row]; r2[m] = st[M_ + row]; }
#pragma unroll
        for (int m = 0; m < 4; ++m) { const float mu = from_fix(r1[m]) * (1.0f / 2048.0f), rs = __builtin_amdgcn_rsqf(from_fix(r2[m]) * (1.0f / 2048.0f) - mu * mu + LN_EPS);
#pragma unroll
            for (int bj = 0; bj < 2; ++bj)
#pragma unroll
                for (int n = 0; n < 2; ++n) acc[ai][bj][m][n] = (acc[ai][bj][m][n] - c4[bj][n] * mu) * rs + b4[bj][n]; } }
}

struct EpiIn {
    static constexpr bool PERM = true;
    bf16_t *cq, *ckv, *xl, *gg, *kpe; float* ssq; const float *cosT, *sinT; const fix_t* st; const float *cs, *bw;
    __device__ __forceinline__ void operator()(Acc& acc, const Unit& u, int wr, int wc, int fr, int fq) const {
        const int row0 = u.pm * 256 + wr * 64 + fr, pn = u.pn;
        ln_correct<true>(acc, st, cs, bw, row0, pn * 256 + wc * 32 + 8 * fq);
        if (pn < 4) {
            bf16_t* base = (pn < 2 ? cq : ckv); const int col0 = (pn & 1) * 256 + wc * 32 + 8 * fq;
#pragma unroll
            for (int ai = 0; ai < 2; ++ai)
#pragma unroll
                for (int m = 0; m < 4; ++m) { const int row = row0 + ai * 128 + m * 16; float s = 0.f;
#pragma unroll
                    for (int bj = 0; bj < 2; ++bj) { const f32x4 v0 = acc[ai][bj][m][0], v1 = acc[ai][bj][m][1];
                        s += (v0[0] * v0[0] + v0[1] * v0[1]) + (v0[2] * v0[2] + v0[3] * v0[3]) + (v1[0] * v1[0] + v1[1] * v1[1]) + (v1[2] * v1[2] + v1[3] * v1[3]);
                        *(u32x4*)(base + (size_t)row * 512 + col0 + bj * 128) = pack8(v0, v1); }
                    s = sum_fq(s);
                    if (fq == 0) ssq[(size_t)row * 16 + pn * 4 + wc] = s; }
        } else if (pn < 8) {
            const int col0 = (pn - 4) * 256 + wc * 32 + 8 * fq;
#pragma unroll
            for (int ai = 0; ai < 2; ++ai)
#pragma unroll
                for (int m = 0; m < 4; ++m) { const int row = row0 + ai * 128 + m * 16;
#pragma unroll
                    for (int bj = 0; bj < 2; ++bj) *(u32x4*)(xl + (size_t)row * 1024 + col0 + bj * 128) = pack8(acc[ai][bj][m][0], acc[ai][bj][m][1]); }
        } else if (pn < 12) {
            const int col0 = (pn - 8) * 256 + wc * 32 + 8 * fq;
#pragma unroll
            for (int ai = 0; ai < 2; ++ai)
#pragma unroll
                for (int m = 0; m < 4; ++m) { const int row = row0 + ai * 128 + m * 16;
#pragma unroll
                    for (int bj = 0; bj < 2; ++bj) { f32x4 v0 = acc[ai][bj][m][0], v1 = acc[ai][bj][m][1];
#pragma unroll
                        for (int j = 0; j < 4; ++j) { v0[j] = gelu_tanh(v0[j]); v1[j] = gelu_tanh(v1[j]); }
                        *(u32x4*)(gg + (size_t)row * 1024 + col0 + bj * 128) = pack8(v0, v1); } }
        } else if (wc == 0) {
#pragma unroll
            for (int ai = 0; ai < 2; ++ai) { f32x4 c0[4], c1[4], s0[4], s1[4];
#pragma unroll
                for (int m = 0; m < 4; ++m) { const size_t t = (size_t)(row0 + ai * 128 + m * 16) * 32 + 8 * fq;
                    c0[m] = *(const f32x4*)(cosT + t); c1[m] = *(const f32x4*)(cosT + t + 4); s0[m] = *(const f32x4*)(sinT + t); s1[m] = *(const f32x4*)(sinT + t + 4); }
#pragma unroll
                for (int m = 0; m < 4; ++m) { const int row = row0 + ai * 128 + m * 16;
                    const f32x4 a0 = acc[ai][0][m][0], a1 = acc[ai][0][m][1], b0 = acc[ai][1][m][0], b1 = acc[ai][1][m][1];
                    *(u32x4*)(kpe + (size_t)row * 64 + 8 * fq) = pack8(a0 * c0[m] - b0 * s0[m], a1 * c1[m] - b1 * s1[m]);
                    *(u32x4*)(kpe + (size_t)row * 64 + 32 + 8 * fq) = pack8(b0 * c0[m] + a0 * s0[m], b1 * c1[m] + a1 * s1[m]); } }
        }
    }
};
__device__ __forceinline__ void rows_rstd(const float* ssq8, int row0, float (&rs)[8]) {
#pragma unroll
    for (int h = 0; h < 2; ++h) { f32x4 a[4], b[4];
#pragma unroll
        for (int k = 0; k < 4; ++k) { const float* p = ssq8 + (size_t)(row0 + h * 128 + k * 16) * 16; a[k] = *(const f32x4*)p; b[k] = *(const f32x4*)(p + 4); }
#pragma unroll
        for (int k = 0; k < 4; ++k) { const float s = ((a[k][0] + a[k][1]) + (a[k][2] + a[k][3])) + ((b[k][0] + b[k][1]) + (b[k][2] + b[k][3])); rs[h * 4 + k] = __builtin_amdgcn_rsqf(s * (1.0f / 512.0f) + RMS_EPS); } }
}
struct EpiQ {
    static constexpr bool PERM = true;
    bf16_t* q; const float* ssq; const float *cosT, *sinT;
    __device__ __forceinline__ void operator()(Acc& acc, const Unit& u, int wr, int wc, int fr, int fq) const {
        const int row0 = u.pm * 256 + wr * 64 + fr, pn = u.pn;
        float rs[8]; rows_rstd(ssq, row0, rs);
        if (pn < 4) {
            const int col0 = pn * 256 + wc * 32 + 8 * fq;
#pragma unroll
            for (int ai = 0; ai < 2; ++ai)
#pragma unroll
                for (int m = 0; m < 4; ++m) { const int row = row0 + ai * 128 + m * 16; const float r = rs[ai * 4 + m];
#pragma unroll
                    for (int bj = 0; bj < 2; ++bj) *(u32x4*)(q + (size_t)row * 1536 + col0 + bj * 128) = pack8(acc[ai][bj][m][0] * r, acc[ai][bj][m][1] * r); }
        } else {
            const int head = 4 * (pn - 4) + wc;
#pragma unroll
            for (int kb = 0; kb < 4; ++kb) { f32x4 c0[2], c1[2], s0[2], s1[2];
#pragma unroll
                for (int j = 0; j < 2; ++j) { const int k = kb * 2 + j; const size_t t = (size_t)(row0 + (k >> 2) * 128 + (k & 3) * 16) * 32 + 8 * fq;
                    c0[j] = *(const f32x4*)(cosT + t); c1[j] = *(const f32x4*)(cosT + t + 4); s0[j] = *(const f32x4*)(sinT + t); s1[j] = *(const f32x4*)(sinT + t + 4); }
#pragma unroll
                for (int j = 0; j < 2; ++j) { const int k = kb * 2 + j, ai = k >> 2, m = k & 3; const int row = row0 + ai * 128 + m * 16; const float r = rs[k];
                    const f32x4 a0 = acc[ai][0][m][0] * r, a1 = acc[ai][0][m][1] * r, b0 = acc[ai][1][m][0] * r, b1 = acc[ai][1][m][1] * r;
                    *(u32x4*)(q + (size_t)row * 1536 + 1024 + head * 64 + 8 * fq) = pack8(a0 * c0[j] - b0 * s0[j], a1 * c1[j] - b1 * s1[j]);
                    *(u32x4*)(q + (size_t)row * 1536 + 1024 + head * 64 + 32 + 8 * fq) = pack8(b0 * c0[j] + a0 * s0[j], b1 * c1[j] + a1 * s1[j]); } }
        }
    }
};
struct EpiKV {
    static constexpr bool PERM = true;
    bf16_t* kv; const float* ssq;
    __device__ __forceinline__ void operator()(Acc& acc, const Unit& u, int wr, int wc, int fr, int fq) const {
        const int row0 = u.pm * 256 + wr * 64 + fr, col0 = u.pn * 256 + wc * 32 + 8 * fq;
        float rs[8]; rows_rstd(ssq + 8, row0, rs);
#pragma unroll
        for (int ai = 0; ai < 2; ++ai)
#pragma unroll
            for (int m = 0; m < 4; ++m) { const int row = row0 + ai * 128 + m * 16; const float r = rs[ai * 4 + m];
#pragma unroll
                for (int bj = 0; bj < 2; ++bj) *(u32x4*)(kv + (size_t)row * 2048 + col0 + bj * 128) = pack8(acc[ai][bj][m][0] * r, acc[ai][bj][m][1] * r); }
    }
};
constexpr size_t AU_RPLANE = 128 * MiB;
struct EpiGate {
    static constexpr bool PERM = true;
    bf16_t* up; unsigned char* rp; const bf16_t* xc; const float *ba, *bi, *sp;
    __device__ __forceinline__ void operator()(Acc& acc, const Unit& u, int wr, int wc, int fr, int fq) const {
        const int row0 = u.pm * 256 + wr * 64 + fr, d = u.pn, ch0 = u.z * 128 + wc * 32 + 8 * fq;
        const size_t dbase = (size_t)d * M_ * 1024;
#pragma unroll
        for (int n = 0; n < 2; ++n) {
            const int ch = ch0 + 4 * n;
            const f32x4 bav = *(const f32x4*)(ba + d * 1024 + ch), biv = *(const f32x4*)(bi + d * 1024 + ch), spv = *(const f32x4*)(sp + d * 1024 + ch) * (-8.0f * 1.4426950408889634f);
            u32x2 xws[8];
#pragma unroll
            for (int k = 0; k < 8; ++k) xws[k] = *(const u32x2*)(xc + (size_t)(row0 + (k >> 2) * 128 + (k & 3) * 16) * 1024 + ch);
#pragma unroll
            for (int ai = 0; ai < 2; ++ai)
#pragma unroll
                for (int m = 0; m < 4; ++m) { const int row = row0 + ai * 128 + m * 16;
                    const u32x2 xw = xws[ai * 4 + m];
                    const float xv[4] = {bf_lo(xw.x), bf_hi(xw.x), bf_lo(xw.y), bf_hi(xw.y)};
                    float uf[4]; unsigned rb = 0u;
#pragma unroll
                    for (int j = 0; j < 4; ++j) {
                        const float r = sigmoidf_(acc[ai][0][m][n][j] + bav[j]);
                        const float ig = sigmoidf_(acc[ai][1][m][n][j] + biv[j]);
                        const float rq = __builtin_rintf(r * 255.0f);
                        const float a = __builtin_amdgcn_exp2f((rq * (1.0f / 255.0f)) * spv[j]);
                        const float oma = 1.0f - a;
                        uf[j] = __builtin_amdgcn_sqrtf(oma * (1.0f + a)) * ig * xv[j];
                        rb |= (unsigned)rq << (8 * j); }
                    u32x2 uw; uw.x = cvt_pk_bf16(uf[0], uf[1]); uw.y = cvt_pk_bf16(uf[2], uf[3]);
                    *(u32x2*)(up + dbase + (size_t)row * 1024 + ch) = uw;
                    *(unsigned*)(rp + dbase + (size_t)row * 1024 + ch) = rb; }
        }
    }
};
#ifndef RES_PF
#define RES_PF 2
#endif
struct EpiRes {
    static constexpr bool PERM = false;
    bf16_t* hb; const fix_t* st_old; const float *g, *b; fix_t* st_new;
    __device__ __forceinline__ void operator()(Acc& acc, const Unit& u, int wr, int wc, int fr, int fq) const {
        const int row0 = u.pm * 256 + wr * 64 + fr, col0 = u.pn * 256 + wc * 32 + 4 * fq;
        f32x4 gv[4], bv[4]; u32x2 P[RES_PF + 1][4]; float mus[8], rss[8];
#define RES_LOAD(k) do { const size_t off_ = (size_t)(row0 + ((k) >> 2) * 128 + ((k) & 3) * 16) * 2048 + col0; _Pragma("unroll") for (int c = 0; c < 4; ++c) P[(k) % (RES_PF + 1)][c] = *(const u32x2*)(hb + off_ + (c >> 1) * 128 + (c & 1) * 16); } while (0)
#pragma unroll
        for (int k = 0; k < RES_PF; ++k) RES_LOAD(k);
#pragma unroll
        for (int c = 0; c < 4; ++c) { gv[c] = *(const f32x4*)(g + col0 + (c >> 1) * 128 + (c & 1) * 16); bv[c] = *(const f32x4*)(b + col0 + (c >> 1) * 128 + (c & 1) * 16); }
#pragma unroll
        for (int h = 0; h < 2; ++h) { fix_t r1[4], r2[4];
#pragma unroll
            for (int k = 0; k < 4; ++k) { const int row = row0 + h * 128 + k * 16; r1[k] = st_old[row]; r2[k] = st_old[M_ + row]; }
#pragma unroll
            for (int k = 0; k < 4; ++k) { mus[h * 4 + k] = from_fix(r1[k]) * (1.0f / 2048.0f); rss[h * 4 + k] = __builtin_amdgcn_rsqf(from_fix(r2[k]) * (1.0f / 2048.0f) - mus[h * 4 + k] * mus[h * 4 + k] + LN_EPS); } }
#pragma unroll
        for (int k = 0; k < 8; ++k) {
            if (k + RES_PF < 8) RES_LOAD(k + RES_PF);
            const int ai = k >> 2, m = k & 3; const size_t off = (size_t)(row0 + ai * 128 + m * 16) * 2048 + col0;
            const float mu = mus[k], rs = rss[k];
            float a1 = 0.f, a2 = 0.f;
#pragma unroll
            for (int c = 0; c < 4; ++c) { const int cc = (c >> 1) * 128 + (c & 1) * 16; const u32x2 pw = P[k % (RES_PF + 1)][c];
                const f32x4 Pf = {bf_lo(pw.x), bf_hi(pw.x), bf_lo(pw.y), bf_hi(pw.y)};
                const f32x4 v = ((Pf - mu) * rs * gv[c] + bv[c]) * ALPHA + acc[ai][c >> 1][m][c & 1];
                u32x2 w; w.x = cvt_pk_bf16(v[0], v[1]); w.y = cvt_pk_bf16(v[2], v[3]); *(u32x2*)(hb + off + cc) = w;
                a1 += (v[0] + v[1]) + (v[2] + v[3]); a2 += (v[0] * v[0] + v[1] * v[1]) + (v[2] * v[2] + v[3] * v[3]); }
            a1 = sum_fq(a1); a2 = sum_fq(a2);
            { const int row = row0 + ai * 128 + m * 16; if (fq == 0) fix_add(st_new + row, a1); else if (fq == 1) fix_add(st_new + M_ + row, a2); }
        }
#undef RES_LOAD
    }
};
struct EpiUp {
    static constexpr bool PERM = true;
    bf16_t* f; const fix_t* st; const float *cs, *bw;
    __device__ __forceinline__ void operator()(Acc& acc, const Unit& u, int wr, int wc, int fr, int fq) const {
        const int row0 = u.pm * 256 + wr * 64 + fr, col0 = u.pn * 256 + wc * 32 + 8 * fq;
        ln_correct<true>(acc, st, cs, bw, row0, col0);
#pragma unroll
        for (int ai = 0; ai < 2; ++ai)
#pragma unroll
            for (int m = 0; m < 4; ++m) { const int row = row0 + ai * 128 + m * 16;
#pragma unroll
                for (int bj = 0; bj < 2; ++bj) { f32x4 v0 = acc[ai][bj][m][0], v1 = acc[ai][bj][m][1];
#pragma unroll
                    for (int j = 0; j < 4; ++j) { const float a = fmaxf(v0[j], 0.f), b = fmaxf(v1[j], 0.f); v0[j] = a * a; v1[j] = b * b; }
                    __builtin_nontemporal_store(pack8(v0, v1), (u32x4*)(f + (size_t)row * 8192 + col0 + bj * 128)); } }
    }
};

namespace att {
constexpr int NW = 8, QBLK = 32, KVBLK = 64;
constexpr float SCALE = 0.07216878364870323f;
constexpr float THR = 8.f;
#ifndef ATT_SDEPTH
#define ATT_SDEPTH 1
#endif
constexpr int SDEPTH = ATT_SDEPTH;
constexpr int SHM_V = KVBLK * 128 * 2, SHM_K = KVBLK * 128 * 2, SHM_R = KVBLK * 64 * 2;
constexpr int OFF_V = 0, OFF_K = 2 * SHM_V, OFF_R = OFF_K + 2 * SHM_K, OFF_WS = OFF_R + 2 * SHM_R, OFF_QR = OFF_WS + NW * 64 * 4, SHM_ATTN = OFF_QR + 256 * 128;
#define KSWZ(row, colB) ((row) * 256 + ((colB) ^ (((row) & 7) << 4)))
#define RSWZ(row, colB) ((row) * 128 + ((colB) ^ (((row) & 7) << 4)))
#define SBAR() __builtin_amdgcn_sched_barrier(0)
__device__ __forceinline__ int crow(int r, int hi) { return (r & 3) + 8 * (r >> 2) + 4 * hi; }
__device__ __forceinline__ void partialSM(f32x16& p0, f32x16& p1, float& m_reg, float& mn, float& alpha) {
    constexpr float C = SCALE * 1.4426950408889634f;
    float pmax = p0[0];
#pragma unroll
    for (int r = 1; r < 16; ++r) pmax = fmaxf(pmax, p0[r]);
#pragma unroll
    for (int r = 0; r < 16; ++r) pmax = fmaxf(pmax, p1[r]);
    { auto rr = __builtin_amdgcn_permlane32_swap(__float_as_uint(pmax), __float_as_uint(pmax), false, false);
      pmax = fmaxf(__uint_as_float(rr[0]), __uint_as_float(rr[1])); }
    if (__builtin_expect(__all(pmax - m_reg <= THR / SCALE), 1)) { mn = m_reg; alpha = 1.f; }
    else { mn = fmaxf(m_reg, pmax); alpha = __builtin_amdgcn_exp2f((m_reg - mn) * C); m_reg = mn; }
    const float mnC = -mn * C;
#pragma unroll
    for (int r = 0; r < 16; ++r) p0[r] = fmaf(p0[r], C, mnC);
#pragma unroll
    for (int r = 0; r < 16; ++r) p1[r] = fmaf(p1[r], C, mnC);
#pragma unroll
    for (int r = 0; r < 16; ++r) p0[r] = __builtin_amdgcn_exp2f(p0[r]);
}
__device__ __forceinline__ void finishSM(f32x16& p0, f32x16& p1, float alpha, float& l_reg, bf16x8& pa0, bf16x8& pa1, bf16x8& pa2, bf16x8& pa3) {
#pragma unroll
    for (int r = 0; r < 16; ++r) p1[r] = __builtin_amdgcn_exp2f(p1[r]);
    float ps = 0;
#pragma unroll
    for (int r = 0; r < 16; ++r) ps += p0[r];
#pragma unroll
    for (int r = 0; r < 16; ++r) ps += p1[r];
    { auto rr = __builtin_amdgcn_permlane32_swap(__float_as_uint(ps), __float_as_uint(ps), false, false);
      ps = __uint_as_float(rr[0]) + __uint_as_float(rr[1]); }
    l_reg = l_reg * alpha + ps;
#define PK4(P, BASE, OUT) do { unsigned a0 = cvt_pk_bf16(P[BASE + 0], P[BASE + 1]), a1 = cvt_pk_bf16(P[BASE + 2], P[BASE + 3]);   \
    unsigned b0 = cvt_pk_bf16(P[BASE + 4], P[BASE + 5]), b1 = cvt_pk_bf16(P[BASE + 6], P[BASE + 7]);                              \
    auto r0 = __builtin_amdgcn_permlane32_swap(a0, b0, false, false); auto r1 = __builtin_amdgcn_permlane32_swap(a1, b1, false, false); \
    u32x4 w = {r0[0], r1[0], r0[1], r1[1]}; OUT = *reinterpret_cast<bf16x8*>(&w); } while (0)
    PK4(p0, 0, pa0); PK4(p0, 8, pa1); PK4(p1, 0, pa2); PK4(p1, 8, pa3);
#undef PK4
}
__device__ __forceinline__ void qkt(f32x16& p0, f32x16& p1, const char* Ks, const char* Rs, const bf16x8* qr, const char* Qrl, int r32, int hi) {
    p0 = f32x16{}; p1 = f32x16{};
#pragma unroll
    for (int d0 = 0; d0 < 8; ++d0) { const int cb = (d0 * 16 + hi * 8) * 2;
        const bf16x8 b0 = *reinterpret_cast<const bf16x8*>(Ks + KSWZ(r32, cb));
        const bf16x8 b1 = *reinterpret_cast<const bf16x8*>(Ks + KSWZ(32 + r32, cb));
        p0 = __builtin_amdgcn_mfma_f32_32x32x16_bf16(b0, qr[d0], p0, 0, 0, 0);
        p1 = __builtin_amdgcn_mfma_f32_32x32x16_bf16(b1, qr[d0], p1, 0, 0, 0); }
#pragma unroll
    for (int d0 = 0; d0 < 4; ++d0) { const int cb = (d0 * 16 + hi * 8) * 2;
        const bf16x8 b0 = *reinterpret_cast<const bf16x8*>(Rs + RSWZ(r32, cb));
        const bf16x8 b1 = *reinterpret_cast<const bf16x8*>(Rs + RSWZ(32 + r32, cb));
        const bf16x8 qv = *reinterpret_cast<const bf16x8*>(Qrl + (cb ^ ((r32 & 7) << 4)));
        p0 = __builtin_amdgcn_mfma_f32_32x32x16_bf16(b0, qv, p0, 0, 0, 0);
        p1 = __builtin_amdgcn_mfma_f32_32x32x16_bf16(b1, qv, p1, 0, 0, 0); }
}
__device__ __forceinline__ int v_st(int k, int c) { const int kk = (k & ~0xC) | ((k & 4) << 1) | ((k & 8) >> 1); return ((kk >> 3) * 4 + (c >> 5)) * 512 + ((kk & 7) * 32 + (c & 31)) * 2; }
__device__ __forceinline__ int v_rd_base(int lane) { return ((lane & 3) << 3) | (((lane >> 2) & 3) << 6) | (((lane >> 4) & 1) << 5) | (((lane >> 5) & 1) << 8); }
constexpr int v_rd_off(int d0, int ks, int half) { return d0 * 512 + ks * 4096 + half * 2048; }
template <int OFF> __device__ __forceinline__ s16x4 tr_read(int vb) {
    s16x4 r; asm volatile("ds_read_b64_tr_b16 %0, %1 offset:%2" : "=&v"(r) : "v"(vb), "i"(OFF) : "memory"); return r;
}
template <int D0> __device__ __forceinline__ void pv_one(f32x16& od, int vb, bf16x8 pa0, bf16x8 pa1, bf16x8 pa2, bf16x8 pa3) {
    const s16x4 l0 = tr_read<v_rd_off(D0, 0, 0)>(vb), h0 = tr_read<v_rd_off(D0, 0, 1)>(vb), l1 = tr_read<v_rd_off(D0, 1, 0)>(vb), h1 = tr_read<v_rd_off(D0, 1, 1)>(vb);
    const s16x4 l2 = tr_read<v_rd_off(D0, 2, 0)>(vb), h2 = tr_read<v_rd_off(D0, 2, 1)>(vb), l3 = tr_read<v_rd_off(D0, 3, 0)>(vb), h3 = tr_read<v_rd_off(D0, 3, 1)>(vb);
    asm volatile("s_waitcnt lgkmcnt(0)" ::: "memory"); SBAR();
#define PK(L, H) (bf16x8){L[0], L[1], L[2], L[3], H[0], H[1], H[2], H[3]}
    od = __builtin_amdgcn_mfma_f32_32x32x16_bf16(pa0, PK(l0, h0), od, 0, 0, 0);
    od = __builtin_amdgcn_mfma_f32_32x32x16_bf16(pa1, PK(l1, h1), od, 0, 0, 0);
    od = __builtin_amdgcn_mfma_f32_32x32x16_bf16(pa2, PK(l2, h2), od, 0, 0, 0);
    od = __builtin_amdgcn_mfma_f32_32x32x16_bf16(pa3, PK(l3, h3), od, 0, 0, 0);
#undef PK
}
__device__ __forceinline__ void pv_d0(f32x16* o, int vb, bf16x8 pa0, bf16x8 pa1, bf16x8 pa2, bf16x8 pa3) {
    pv_one<0>(o[0], vb, pa0, pa1, pa2, pa3); pv_one<1>(o[1], vb, pa0, pa1, pa2, pa3); pv_one<2>(o[2], vb, pa0, pa1, pa2, pa3); pv_one<3>(o[3], vb, pa0, pa1, pa2, pa3);
}
__device__ __forceinline__ void attn_unit(const bf16_t* __restrict__ Qn, const bf16_t* __restrict__ Qr, const bf16_t* __restrict__ Kh, const bf16_t* __restrict__ Rh,
                                          bf16_t* __restrict__ Ob, int seq, char* lds, int wv) {
    const int tid = otid(wv), wid = tid >> 6, lane = tid & 63, r32 = lane & 31, hi = lane >> 5;
    char* V_lds = lds + OFF_V; char* K_lds = lds + OFF_K; char* R_lds = lds + OFF_R;
    float* ws = (float*)(lds + OFF_WS) + wid * 64; float* li_l = ws; float* al_l = ws + 32;
    float m_reg = -1e30f, l_reg = 0; f32x16 o[4] = {}; bf16x8 qr[8];
    char* Qrl = lds + OFF_QR + (wid * QBLK + r32) * 128;
    const int sr = tid >> 4, sc = (tid & 15) * 8, vst0 = v_st(sr, sc), vst1 = v_st(32 + sr, sc);
    const int rr_ = tid >> 3, rc = (tid & 7) * 8;
    const int vb0 = (int)(uintptr_t)V_lds + v_rd_base(lane);
    struct { bf16x8 vs0, vs1, ks0, ks1, rs; } sr_[SDEPTH];
#define SLOAD(i, k0) do { sr_[i].vs0 = *(const bf16x8*)(&Kh[(size_t)((k0) + sr) * 2048 + 128 + sc]); sr_[i].vs1 = *(const bf16x8*)(&Kh[(size_t)((k0) + 32 + sr) * 2048 + 128 + sc]); \
    sr_[i].ks0 = *(const bf16x8*)(&Kh[(size_t)((k0) + sr) * 2048 + sc]); sr_[i].ks1 = *(const bf16x8*)(&Kh[(size_t)((k0) + 32 + sr) * 2048 + sc]); \
    sr_[i].rs = *(const bf16x8*)(&Rh[(size_t)((k0) + rr_) * 64 + rc]); } while (0)
#define SWRITE(b, i) do { *(bf16x8*)(V_lds + (b) * SHM_V + vst0) = sr_[i].vs0;          \
    *(bf16x8*)(V_lds + (b) * SHM_V + vst1) = sr_[i].vs1; const int kc = sc * 2;               \
    *(bf16x8*)(K_lds + (b) * SHM_K + KSWZ(sr, kc)) = sr_[i].ks0;                       \
    *(bf16x8*)(K_lds + (b) * SHM_K + KSWZ(32 + sr, kc)) = sr_[i].ks1;                  \
    *(bf16x8*)(R_lds + (b) * SHM_R + RSWZ(rr_, rc * 2)) = sr_[i].rs; } while (0)
#define SWAIT() do { if constexpr (SDEPTH == 2) asm volatile("s_waitcnt vmcnt(5)" ::: "memory"); else asm volatile("s_waitcnt vmcnt(0)" ::: "memory"); } while (0)
#define RESC(a) do { if (__any((a) < 1.f)) { if (hi == 0) al_l[r32] = (a); asm volatile("s_waitcnt lgkmcnt(0)" ::: "memory"); \
    _Pragma("unroll") for (int d = 0; d < 4; ++d) _Pragma("unroll") for (int r = 0; r < 16; ++r) o[d][r] *= al_l[crow(r, hi)]; } } while (0)
    f32x16 pA0, pA1, pB0, pB1; float mnA, mnB, alA, alB; bf16x8 pa0, pa1, pa2, pa3; const int NT = seq / KVBLK;
    constexpr int SE = 0, SO = SDEPTH - 1;
    SLOAD(SE, 0);
    {
        const bf16_t* Qw = Qn + (size_t)(wid * QBLK + r32) * 1536 + hi * 8;
#pragma unroll
        for (int d0 = 0; d0 < 8; ++d0) qr[d0] = *reinterpret_cast<const bf16x8*>(Qw + d0 * 16);
        const bf16_t* Qw2 = Qr + (size_t)(wid * QBLK + r32) * 1536 + hi * 8;
#pragma unroll
        for (int d0 = 0; d0 < 4; ++d0) { const bf16x8 t = *reinterpret_cast<const bf16x8*>(Qw2 + d0 * 16); *reinterpret_cast<bf16x8*>(Qrl + (((d0 * 16 + hi * 8) * 2) ^ ((r32 & 7) << 4))) = t; }
    }
    asm volatile("s_waitcnt vmcnt(0)" ::: "memory"); SWRITE(0, SE); __syncthreads();
    if constexpr (SDEPTH == 1) SLOAD(SO, KVBLK);
    qkt(pA0, pA1, K_lds, R_lds, qr, Qrl, r32, hi); partialSM(pA0, pA1, m_reg, mnA, alA);
    if constexpr (SDEPTH == 2) { SLOAD(SO, KVBLK); if (2 < NT) SLOAD(SE, 2 * KVBLK); }
    SWAIT(); SWRITE(1, SO); __syncthreads();
    for (int j = 1; j + 1 < NT; j += 2) {
        SBAR(); qkt(pB0, pB1, K_lds + SHM_K, R_lds + SHM_R, qr, Qrl, r32, hi);
        finishSM(pA0, pA1, alA, l_reg, pa0, pa1, pa2, pa3); SBAR();
        SLOAD(SO, (j + SDEPTH) * KVBLK); SBAR();
        pv_d0(o, vb0, pa0, pa1, pa2, pa3); partialSM(pB0, pB1, m_reg, mnB, alB);
        __syncthreads(); SWAIT(); SWRITE(0, SE);
        RESC(alB); __syncthreads();
        SBAR(); qkt(pA0, pA1, K_lds, R_lds, qr, Qrl, r32, hi);
        finishSM(pB0, pB1, alB, l_reg, pa0, pa1, pa2, pa3); SBAR();
        if (SDEPTH == 1 || j + 3 < NT) SLOAD(SE, (j + 1 + SDEPTH) * KVBLK); SBAR();
        pv_d0(o, vb0 + (int)SHM_V, pa0, pa1, pa2, pa3); partialSM(pA0, pA1, m_reg, mnA, alA);
        __syncthreads(); SWAIT(); SWRITE(1, SO);
        RESC(alA); __syncthreads();
    }
    SBAR(); qkt(pB0, pB1, K_lds + SHM_K, R_lds + SHM_R, qr, Qrl, r32, hi);
    finishSM(pA0, pA1, alA, l_reg, pa0, pa1, pa2, pa3); SBAR();
    pv_d0(o, vb0, pa0, pa1, pa2, pa3); partialSM(pB0, pB1, m_reg, mnB, alB);
    __syncthreads(); RESC(alB);
    finishSM(pB0, pB1, alB, l_reg, pa0, pa1, pa2, pa3); SBAR();
    pv_d0(o, vb0 + (int)SHM_V, pa0, pa1, pa2, pa3);
    if (hi == 0) li_l[r32] = l_reg; asm volatile("s_waitcnt lgkmcnt(0)" ::: "memory");
    float rli[16];
#pragma unroll
    for (int r = 0; r < 16; ++r) rli[r] = __builtin_amdgcn_rcpf(li_l[crow(r, hi)]);
    bf16_t* Ow = Ob + (size_t)(wid * QBLK) * 2048;
#pragma unroll
    for (int r = 0; r < 16; ++r) { const int orow = crow(r, hi);
#pragma unroll
        for (int d0 = 0; d0 < 4; ++d0) Ow[(size_t)orow * 2048 + d0 * 32 + r32] = (bf16_t)(cvt_pk_bf16(o[d0][r] * rli[r], 0.f) & 0xffffu); }
#undef SLOAD
#undef SWRITE
#undef SWAIT
#undef RESC
}
}

__device__ __forceinline__ void x_pass(const float* src, bf16_t* dstb, fix_t* st, int wv) {
    const int tid_ = otid(wv), lane = tid_ & 63, wave = tid_ >> 6;
    for (int row = blockIdx.x * 8 + wave; row < M_; row += gridDim.x * 8) {
        const float* s = src + (size_t)row * 2048; f32x4 v[8]; float s1 = 0.f, s2 = 0.f;
#pragma unroll
        for (int i = 0; i < 8; ++i) { v[i] = __builtin_nontemporal_load((const f32x4*)(s + i * 256 + lane * 4)); s1 += (v[i][0] + v[i][1]) + (v[i][2] + v[i][3]); s2 += (v[i][0] * v[i][0] + v[i][1] * v[i][1]) + (v[i][2] * v[i][2] + v[i][3] * v[i][3]); }
        s1 = wave_sum(s1, lane); s2 = wave_sum(s2, lane);
        if (lane == 0) { st[row] = to_fix(s1); st[M_ + row] = to_fix(s2); }
#pragma unroll
        for (int i = 0; i < 8; ++i) { u32x2 w; w.x = cvt_pk_bf16(v[i][0], v[i][1]); w.y = cvt_pk_bf16(v[i][2], v[i][3]); *(u32x2*)(dstb + (size_t)row * 2048 + i * 256 + lane * 4) = w; }
    }
}
__device__ __forceinline__ void ln_final(float* out, const bf16_t* hb, const fix_t* st, const float* g, const float* b, int wv) {
    const int tid = otid(wv);
    for (int i = blockIdx.x * 512 + tid; i < M_ * 512; i += gridDim.x * 512) {
        const int row = i >> 9, c = (i & 511) * 4; float mu, rs; row_ln(st, row, mu, rs);
        const u32x2 pw = *(const u32x2*)(hb + (size_t)i * 4); const f32x4 P = {bf_lo(pw.x), bf_hi(pw.x), bf_lo(pw.y), bf_hi(pw.y)}, g4 = *(const f32x4*)(g + c), b4 = *(const f32x4*)(b + c);
        *(f32x4*)(out + (size_t)i * 4) = (P - mu) * rs * g4 + b4;
    }
}
__device__ __forceinline__ int colmap(int mode, int n) {
    if (mode == 0) { if (n < 1024) return n; if (n < 2048) return 1088 + (n - 1024); if (n < 3072) return 2112 + (n - 2048);
        const int t = n - 3072, bj = t >> 7, r = t & 127; return r < 32 ? 1024 + bj * 32 + r : -1; }
    if (mode == 1) { if (n < 1024) return (n >> 7) * 192 + (n & 127);
        const int t = n - 1024, tile = t >> 8, bj = (t >> 7) & 1, wc = (t >> 5) & 3, i = t & 31; return (4 * tile + wc) * 192 + 128 + bj * 32 + i; }
    return n;
}
__device__ __forceinline__ void cvt_tile(const float* W, int ldw, bf16_t* Bt, int ldb, int n0, int k0, int mode, const float* kscale, float* T, int wv) {
    const int tid = otid(wv), n4 = (tid & 31) * 4, kq = tid >> 5, src = colmap(mode, n0 + n4);
    f32x4 v[8];
#pragma unroll
    for (int i = 0; i < 8; ++i) { const int kk = kq + 16 * i; v[i] = __builtin_nontemporal_load((const f32x4*)(W + (size_t)(k0 + kk) * ldw + (src >= 0 ? src : 0))); }
    float ksc[8];
#pragma unroll
    for (int i = 0; i < 8; ++i) ksc[i] = kscale ? kscale[k0 + kq + 16 * i] : 1.0f;
#pragma unroll
    for (int i = 0; i < 8; ++i) v[i] = v[i] * (src >= 0 ? ksc[i] : 0.0f);
#pragma unroll
    for (int i = 0; i < 8; ++i)
#pragma unroll
        for (int j = 0; j < 4; ++j) T[(n4 + j) * 129 + kq + 16 * i] = v[i][j];
    __syncthreads();
    { const int n2 = tid >> 2, ks = (tid & 3) * 32; const float* t = T + n2 * 129 + ks; bf16_t* dst = Bt + (size_t)(n0 + n2) * ldb + k0 + ks;
#pragma unroll
      for (int i = 0; i < 4; ++i) { u32x4 w; w.x = cvt_pk_bf16(t[i * 8 + 0], t[i * 8 + 1]); w.y = cvt_pk_bf16(t[i * 8 + 2], t[i * 8 + 3]); w.z = cvt_pk_bf16(t[i * 8 + 4], t[i * 8 + 5]); w.w = cvt_pk_bf16(t[i * 8 + 6], t[i * 8 + 7]);
          *(u32x4*)(dst + i * 8) = w; } }
    __syncthreads();
}
constexpr int CT0 = 26 * 16, CT1 = CT0 + 12 * 4, CT2 = CT1 + 16 * 4, CT3 = CT2 + 32, CT4 = CT3 + 16 * 16, CT5 = CT4 + 64 * 16, CT6 = CT5 + 16 * 64;
__device__ __forceinline__ void convert_weights(const Params& p, int l, int t0, int t1, float* T, int wv) {
    unsigned char* ws = p.ws;
    const float* ing = l == 0 ? p.in[2] : p.in[21] + (size_t)(l - 1) * 2048;
    for (int t = t0 + blockIdx.x; t < t1; t += gridDim.x) {
        if (t < CT0) { const int nt = t % 26, kt = t / 26; cvt_tile(p.in[4] + (size_t)l * 2048 * NIN, NIN, (bf16_t*)(ws + W_IN), 2048, nt * 128, kt * 128, 0, ing, T, wv); }
        else if (t < CT1) { const int u = t - CT0, nt = u % 12, kt = u / 12; cvt_tile(p.in[7] + (size_t)l * 512 * 1536, 1536, (bf16_t*)(ws + W_UQ), 512, nt * 128, kt * 128, 1, p.in[5] + l * 512, T, wv); }
        else if (t < CT2) { const int u = t - CT1, nt = u % 16, kt = u / 16; cvt_tile(p.in[8] + (size_t)l * 512 * 2048, 2048, (bf16_t*)(ws + W_UKV), 512, nt * 128, kt * 128, 2, p.in[6] + l * 512, T, wv); }
        else if (t < CT3) { const int mat = t - CT2, gate = mat & 1, h = (mat >> 1) & 7, d = mat >> 4;
            cvt_tile((gate ? p.in[13] : p.in[11]) + ((size_t)((l * 2 + d) * 8 + h)) * 128 * 128, 128, (bf16_t*)(ws + W_G) + (size_t)(h * 512 + d * 256 + gate * 128) * 128, 128, 0, 0, 2, nullptr, T, wv); }
        else if (t < CT4) { const int u = t - CT3, nt = u % 16, kt = u / 16; cvt_tile(p.in[16] + (size_t)l * 2048 * 2048, 2048, (bf16_t*)(ws + W_OUT), 2048, nt * 128, kt * 128, 2, nullptr, T, wv); }
        else if (t < CT5) { const int u = t - CT4, nt = u % 64, kt = u / 64; cvt_tile(p.in[19] + (size_t)l * 2048 * 8192, 8192, (bf16_t*)(ws + W_UP), 2048, nt * 128, kt * 128, 2, p.in[17] + (size_t)l * 2048, T, wv); }
        else { const int u = t - CT5, nt = u % 16, kt = u / 16; cvt_tile(p.in[20] + (size_t)l * 8192 * 2048, 2048, (bf16_t*)(ws + W_DN), 8192, nt * 128, kt * 128, 2, nullptr, T, wv); }
    }
}
__device__ __forceinline__ void colsum_pass(const bf16_t* Bt, int N, const float* lg, const float* lb, float* cs, float* bw, int wv) {
    const int tid = otid(wv), lane = tid & 63, wave = tid >> 6;
    float ratio[32];
#pragma unroll
    for (int i = 0; i < 4; ++i)
#pragma unroll
        for (int j = 0; j < 8; ++j) { const int k = i * 512 + lane * 8 + j; ratio[i * 8 + j] = lb[k] * __builtin_amdgcn_rcpf(lg[k]); }
    for (int n = blockIdx.x * 8 + wave; n < N; n += gridDim.x * 8) {
        u32x4 w[4];
#pragma unroll
        for (int i = 0; i < 4; ++i) w[i] = *(const u32x4*)(Bt + (size_t)n * 2048 + i * 512 + lane * 8);
        float c = 0.f, bb = 0.f;
#pragma unroll
        for (int i = 0; i < 4; ++i) { const float v[8] = {bf_lo(w[i].x), bf_hi(w[i].x), bf_lo(w[i].y), bf_hi(w[i].y), bf_lo(w[i].z), bf_hi(w[i].z), bf_lo(w[i].w), bf_hi(w[i].w)};
#pragma unroll
            for (int j = 0; j < 8; ++j) { c += v[j]; bb += v[j] * ratio[i * 8 + j]; } }
        c = wave_sum(c, lane); bb = wave_sum(bb, lane);
        if (lane == 0) { cs[n] = c; bw[n] = bb; }
    }
}
__device__ __forceinline__ void colsum_in(const Params& p, int l, int wv) { float* csb = (float*)(p.ws + WS_CSB) + (size_t)l * CSB_L;
    colsum_pass((const bf16_t*)(p.ws + W_IN), NINP, l == 0 ? p.in[2] : p.in[21] + (size_t)(l - 1) * 2048, l == 0 ? p.in[3] : p.in[22] + (size_t)(l - 1) * 2048, csb + CSB_IN, csb + CSB_IN + NINP, wv); }
__device__ __forceinline__ void colsum_up(const Params& p, int l, int wv) { float* csb = (float*)(p.ws + WS_CSB) + (size_t)l * CSB_L;
    colsum_pass((const bf16_t*)(p.ws + W_UP), DFF, p.in[17] + (size_t)l * 2048, p.in[18] + (size_t)l * 2048, csb + CSB_UP, csb + CSB_UP + DFF, wv); }
__device__ __forceinline__ void make_tables(const Params& p, int wv) {
    const int* pos = (const int*)p.in[1]; float* cosT = (float*)(p.ws + WS_COS); float* sinT = (float*)(p.ws + WS_SIN); float* sp = (float*)(p.ws + WS_SP);
    const int tid = otid(wv);
    for (int i = blockIdx.x * 512 + tid; i < M_ * 32; i += gridDim.x * 512) {
        const int row = i >> 5, k = i & 31; const float inv = powf(10000.0f, -(float)(2 * k) / 64.0f); const float ang = (float)pos[row] * inv;
        cosT[i] = cosf(ang); sinT[i] = sinf(ang); }
    for (int i = blockIdx.x * 512 + tid; i < DEPTH * 2 * 1024; i += gridDim.x * 512) { const float x = -p.in[15][i];
        sp[i] = fmaxf(x, 0.f) + log1pf(expf(-fabsf(x))); }
}
__device__ __forceinline__ void conv_phase(const Params& p, int l, int wv) {
    const bf16_t* __restrict__ xl = (const bf16_t*)(p.ws + WS_XL); bf16_t* __restrict__ xc = (bf16_t*)(p.ws + WS_XC);
    const float* cw = p.in[9] + (size_t)l * 4 * 1024; const float* cb = p.in[10] + (size_t)l * 1024;
    const int tid = otid(wv);
    for (int i = blockIdx.x * 512 + tid; i < M_ * 128; i += gridDim.x * 512) {
        const int row = i >> 7, c0 = (i & 127) * 8, t = row & (SEQ - 1);
        u32x4 xw[4]; f32x4 w0[4], w1[4];
#pragma unroll
        for (int k = 0; k < 4; ++k) { const int tt = t - 2 + k; const bool ok = (tt >= 0) && (tt < SEQ); const int rr = ok ? row - 2 + k : row;
            xw[k] = *(const u32x4*)(xl + (size_t)rr * 1024 + c0);
            w0[k] = *(const f32x4*)(cw + k * 1024 + c0); w1[k] = *(const f32x4*)(cw + k * 1024 + c0 + 4);
            if (!ok) { w0[k] = (f32x4){0.f, 0.f, 0.f, 0.f}; w1[k] = (f32x4){0.f, 0.f, 0.f, 0.f}; } }
        const f32x4 b0 = *(const f32x4*)(cb + c0), b1 = *(const f32x4*)(cb + c0 + 4);
        float acc[8] = {b0[0], b0[1], b0[2], b0[3], b1[0], b1[1], b1[2], b1[3]};
#pragma unroll
        for (int k = 0; k < 4; ++k) {
            acc[0] += w0[k][0] * bf_lo(xw[k].x); acc[1] += w0[k][1] * bf_hi(xw[k].x); acc[2] += w0[k][2] * bf_lo(xw[k].y); acc[3] += w0[k][3] * bf_hi(xw[k].y);
            acc[4] += w1[k][0] * bf_lo(xw[k].z); acc[5] += w1[k][1] * bf_hi(xw[k].z); acc[6] += w1[k][2] * bf_lo(xw[k].w); acc[7] += w1[k][3] * bf_hi(xw[k].w); }
        u32x4 o; o.x = cvt_pk_bf16(acc[0], acc[1]); o.y = cvt_pk_bf16(acc[2], acc[3]); o.z = cvt_pk_bf16(acc[4], acc[5]); o.w = cvt_pk_bf16(acc[6], acc[7]);
        *(u32x4*)(xc + (size_t)row * 1024 + c0) = o;
    }
}
#define SCAN_STEP(W, R, H0, H1, A0, A1) do { A0 = __builtin_amdgcn_exp2f((float)((R) & 255u) * k0); A1 = __builtin_amdgcn_exp2f((float)((R) >> 8) * k1); \
    H0 = A0 * H0 + bf_lo(W); H1 = A1 * H1 + bf_hi(W); } while (0)
__device__ __forceinline__ void scan_local(const Params& p, int l, int wv) {
    const unsigned* up = (const unsigned*)(p.ws + WS_AU); const unsigned short* rp = (const unsigned short*)(p.ws + WS_AU + AU_RPLANE); f32x4* ph = (f32x4*)(p.ws + WS_PH); const int tid = otid(wv);
    const float* spl = (const float*)(p.ws + WS_SP) + (size_t)l * 2048;
    for (int it = blockIdx.x; it < 2 * 8 * 64; it += gridDim.x) {
        const int c = it & 63, b = (it >> 6) & 7, d = it >> 9;
        const float k0 = spl[d * 1024 + 2 * tid] * (-8.0f * 1.4426950408889634f / 255.0f), k1 = spl[d * 1024 + 2 * tid + 1] * (-8.0f * 1.4426950408889634f / 255.0f);
        const size_t e0 = ((size_t)d * M_ + (size_t)(b * SEQ + c * 64)) * 512 + tid;
        const unsigned* __restrict__ us = up + e0; const unsigned short* __restrict__ rs = rp + e0;
        float h0 = 0.f, h1 = 0.f, P0 = 1.f, P1 = 1.f;
        const long step = d ? -512 : 512; const long q0 = d ? (long)63 * 512 : 0;
        unsigned wa[16], wb[16]; unsigned ra[16], rb[16];
#pragma unroll
        for (int j = 0; j < 16; ++j) { wa[j] = us[q0 + (long)j * step]; ra[j] = rs[q0 + (long)j * step]; }
#pragma unroll
        for (int bt = 0; bt < 4; bt += 2) {
#pragma unroll
            for (int j = 0; j < 16; ++j) { wb[j] = us[q0 + (long)((bt + 1) * 16 + j) * step]; rb[j] = rs[q0 + (long)((bt + 1) * 16 + j) * step]; }
#pragma unroll
            for (int j = 0; j < 16; ++j) { float a0, a1; SCAN_STEP(wa[j], ra[j], h0, h1, a0, a1); P0 *= a0; P1 *= a1; }
            if (bt + 2 < 4) {
#pragma unroll
                for (int j = 0; j < 16; ++j) { wa[j] = us[q0 + (long)((bt + 2) * 16 + j) * step]; ra[j] = rs[q0 + (long)((bt + 2) * 16 + j) * step]; } }
#pragma unroll
            for (int j = 0; j < 16; ++j) { float a0, a1; SCAN_STEP(wb[j], rb[j], h0, h1, a0, a1); P0 *= a0; P1 *= a1; }
        }
        ph[(size_t)((d * 8 + b) * 64 + c) * 512 + tid] = (f32x4){P0, h0, P1, h1};
    }
}
__device__ __forceinline__ void scan_apply(const Params& p, int l, int wv) {
    const unsigned* up = (const unsigned*)(p.ws + WS_AU); const unsigned short* rp = (const unsigned short*)(p.ws + WS_AU + AU_RPLANE); const f32x4* ph = (const f32x4*)(p.ws + WS_PH);
    const bf16_t* gg = (const bf16_t*)(p.ws + WS_GG); bf16_t* ycat = (bf16_t*)(p.ws + WS_YCAT); const int tid = otid(wv);
    const float* spl = (const float*)(p.ws + WS_SP) + (size_t)l * 2048;
    const float kf0 = spl[2 * tid] * (-8.0f * 1.4426950408889634f / 255.0f), kf1 = spl[2 * tid + 1] * (-8.0f * 1.4426950408889634f / 255.0f);
    const float kb0 = spl[1024 + 2 * tid] * (-8.0f * 1.4426950408889634f / 255.0f), kb1 = spl[1024 + 2 * tid + 1] * (-8.0f * 1.4426950408889634f / 255.0f);
    for (int it = blockIdx.x; it < 8 * 64; it += gridDim.x) {
        const int c = it & 63, b = it >> 6;
        float Hf0 = 0.f, Hf1 = 0.f, Hb0 = 0.f, Hb1 = 0.f;
        { const f32x4* pf = ph + (size_t)((0 * 8 + b) * 64) * 512 + tid;
          for (int c0 = 0; c0 < c; c0 += 8) { f32x4 e[8];
#pragma unroll
              for (int j = 0; j < 8; ++j) e[j] = pf[(size_t)min(c0 + j, c - 1) * 512];
#pragma unroll
              for (int j = 0; j < 8; ++j) if (c0 + j >= c) e[j] = (f32x4){1.f, 0.f, 1.f, 0.f};
#pragma unroll
              for (int j = 0; j < 8; ++j) { Hf0 = e[j][0] * Hf0 + e[j][1]; Hf1 = e[j][2] * Hf1 + e[j][3]; } }
          const f32x4* pb = ph + (size_t)((1 * 8 + b) * 64) * 512 + tid;
          for (int c0 = 63; c0 > c; c0 -= 8) { f32x4 e[8];
#pragma unroll
              for (int j = 0; j < 8; ++j) e[j] = pb[(size_t)max(c0 - j, c + 1) * 512];
#pragma unroll
              for (int j = 0; j < 8; ++j) if (c0 - j <= c) e[j] = (f32x4){1.f, 0.f, 1.f, 0.f};
#pragma unroll
              for (int j = 0; j < 8; ++j) { Hb0 = e[j][0] * Hb0 + e[j][1]; Hb1 = e[j][2] * Hb1 + e[j][3]; } } }
        const size_t r0 = (size_t)(b * SEQ + c * 64);
        const unsigned* __restrict__ s0 = up + r0 * 512 + tid; const unsigned* __restrict__ s1 = up + ((size_t)M_ + r0) * 512 + tid;
        const unsigned short* __restrict__ q0p = rp + r0 * 512 + tid; const unsigned short* __restrict__ q1p = rp + ((size_t)M_ + r0) * 512 + tid;
        const unsigned* __restrict__ gp = (const unsigned*)(gg + r0 * 1024) + tid; unsigned* __restrict__ yp = (unsigned*)(ycat + r0 * 2048 + 1024) + tid;
        float hf0[64], hf1[64];
        { const float k0 = kf0, k1 = kf1; unsigned wa[8], wb[8], ra[8], rb[8];
#pragma unroll
          for (int j = 0; j < 8; ++j) { wa[j] = __builtin_nontemporal_load(&s0[(size_t)j * 512]); ra[j] = __builtin_nontemporal_load(&q0p[(size_t)j * 512]); }
#pragma unroll
          for (int bt = 0; bt < 8; bt += 2) {
#pragma unroll
              for (int j = 0; j < 8; ++j) { wb[j] = __builtin_nontemporal_load(&s0[(size_t)((bt + 1) * 8 + j) * 512]); rb[j] = __builtin_nontemporal_load(&q0p[(size_t)((bt + 1) * 8 + j) * 512]); }
#pragma unroll
              for (int j = 0; j < 8; ++j) { const int t = bt * 8 + j; float a0, a1; SCAN_STEP(wa[j], ra[j], Hf0, Hf1, a0, a1); hf0[t] = Hf0; hf1[t] = Hf1; }
              if (bt + 2 < 8) {
#pragma unroll
                  for (int j = 0; j < 8; ++j) { wa[j] = __builtin_nontemporal_load(&s0[(size_t)((bt + 2) * 8 + j) * 512]); ra[j] = __builtin_nontemporal_load(&q0p[(size_t)((bt + 2) * 8 + j) * 512]); } }
#pragma unroll
              for (int j = 0; j < 8; ++j) { const int t = (bt + 1) * 8 + j; float a0, a1; SCAN_STEP(wb[j], rb[j], Hf0, Hf1, a0, a1); hf0[t] = Hf0; hf1[t] = Hf1; }
          } }
        { const float k0 = kb0, k1 = kb1; unsigned wa[8], wb[8], ra[8], rb[8]; unsigned ga[8], gb[8];
#pragma unroll
          for (int j = 0; j < 8; ++j) { wa[j] = __builtin_nontemporal_load(&s1[(size_t)(63 - j) * 512]); ra[j] = __builtin_nontemporal_load(&q1p[(size_t)(63 - j) * 512]); ga[j] = __builtin_nontemporal_load(&gp[(size_t)(63 - j) * 512]); }
#pragma unroll
          for (int bt = 0; bt < 8; bt += 2) {
#pragma unroll
              for (int j = 0; j < 8; ++j) { const int t = 63 - ((bt + 1) * 8 + j); wb[j] = __builtin_nontemporal_load(&s1[(size_t)t * 512]); rb[j] = __builtin_nontemporal_load(&q1p[(size_t)t * 512]); gb[j] = __builtin_nontemporal_load(&gp[(size_t)t * 512]); }
#pragma unroll
              for (int j = 0; j < 8; ++j) { const int t = 63 - (bt * 8 + j); float a0, a1; SCAN_STEP(wa[j], ra[j], Hb0, Hb1, a0, a1);
                  yp[(size_t)t * 1024] = cvt_pk_bf16(bf_lo(ga[j]) * (hf0[t] + Hb0), bf_hi(ga[j]) * (hf1[t] + Hb1)); }
              if (bt + 2 < 8) {
#pragma unroll
                  for (int j = 0; j < 8; ++j) { const int t = 63 - ((bt + 2) * 8 + j); wa[j] = __builtin_nontemporal_load(&s1[(size_t)t * 512]); ra[j] = __builtin_nontemporal_load(&q1p[(size_t)t * 512]); ga[j] = __builtin_nontemporal_load(&gp[(size_t)t * 512]); } }
#pragma unroll
              for (int j = 0; j < 8; ++j) { const int t = 63 - ((bt + 1) * 8 + j); float a0, a1; SCAN_STEP(wb[j], rb[j], Hb0, Hb1, a0, a1);
                  yp[(size_t)t * 1024] = cvt_pk_bf16(bf_lo(gb[j]) * (hf0[t] + Hb0), bf_hi(gb[j]) * (hf1[t] + Hb1)); }
          } }
    }
}
#undef SCAN_STEP

#define XB_TMO      128
#define XB_XCNT(j)  (256  + 64 * (j))
#define XB_XSUB(j)  (1280 + 64 * (j))
#define XB_XGEN(j)  (2304 + 64 * (j))
#define XB_TOP      3328
#define XB_TOPGEN   3392
#define XCD_BAR_WORDS 3456
#define XB_SPIN_CAP (1u << 20)
__device__ __forceinline__ unsigned xb_ld(unsigned* p)              { return __hip_atomic_load(p, __ATOMIC_RELAXED, __HIP_MEMORY_SCOPE_AGENT); }
__device__ __forceinline__ unsigned xb_add(unsigned* p, unsigned v) { return __hip_atomic_fetch_add(p, v, __ATOMIC_RELAXED, __HIP_MEMORY_SCOPE_AGENT); }
__device__ __forceinline__ unsigned xb_xcc_id() { unsigned x; asm volatile("s_getreg_b32 %0, hwreg(20, 0, 4)" : "=s"(x)); return x & 0xFu; }
#define XB_SPIN(cond, bar) do { unsigned _sp = 0; while (cond) { __builtin_amdgcn_s_sleep(1); \
    if ((++_sp & 255u) == 0u) { if (xb_ld(&(bar)[XB_TMO])) break; if (_sp > XB_SPIN_CAP) { atomicAdd(&(bar)[XB_TMO], 1u); break; } } } } while (0)
struct XcdBarrier { unsigned* bar; unsigned x; volatile LAS unsigned* st; };
__device__ __forceinline__ XcdBarrier xcd_barrier_post(unsigned* bar, volatile LAS unsigned* st, int wv) {
    XcdBarrier b; b.bar = bar; b.x = (unsigned)__builtin_amdgcn_readfirstlane((int)xb_xcc_id()); b.st = st;
    if (otid(wv) == 0) (void)xb_add(&bar[XB_XCNT(b.x)], 1u);
    return b;
}
__device__ __forceinline__ void xcd_barrier_complete(unsigned* bar, unsigned x, unsigned& nloc, unsigned& nx) {
    const unsigned G = gridDim.x * gridDim.y * gridDim.z;
    unsigned sum, cnt, mine, sp = 0u;
    for (;;) {
        sum = 0u; cnt = 0u; mine = 0u;
#pragma unroll
        for (unsigned j = 0; j < 16; ++j) { const unsigned c = xb_ld(&bar[XB_XCNT(j)]); sum += c; cnt += (c > 0u) ? 1u : 0u; mine = (j == x) ? c : mine; }
        if (sum == G) break;
        __builtin_amdgcn_s_sleep(1);
        if ((++sp & 255u) == 0u) { if (xb_ld(&bar[XB_TMO])) break; if (sp > XB_SPIN_CAP) { atomicAdd(&bar[XB_TMO], 1u); break; } }
    }
    nloc = mine > 0u ? mine : 1u; nx = cnt > 0u ? cnt : 1u;
}
__device__ __forceinline__ void xcd_barrier(const XcdBarrier& b, unsigned* barp, int wv) {
    asm volatile("s_waitcnt vmcnt(0) lgkmcnt(0)" ::: "memory");
    __syncthreads();
    if (otid(wv) == 0) {
        const unsigned bx_ = xb_xcc_id();
        unsigned* bar = barp;
        __builtin_amdgcn_s_waitcnt(0);
        unsigned nloc = b.st[0], nx = b.st[1];
        if (nloc == 0u) { xcd_barrier_complete(bar, bx_, nloc, nx); b.st[0] = nloc; b.st[1] = nx; }
        const unsigned old = xb_add(&bar[XB_XSUB(bx_)], 1u);
        const unsigned gen = old / nloc;
        if (old + 1u == (gen + 1u) * nloc) {
            __builtin_amdgcn_fence(__ATOMIC_RELEASE, "agent");
            asm volatile("s_waitcnt vmcnt(0)" ::: "memory");
            const unsigned og = xb_add(&bar[XB_TOP], 1u);
            const unsigned tg = og / nx;
            if (og + 1u == (tg + 1u) * nx) xb_add(&bar[XB_TOPGEN], 1u);
            else XB_SPIN(xb_ld(&bar[XB_TOPGEN]) == tg, bar);
            __builtin_amdgcn_fence(__ATOMIC_ACQUIRE, "agent");
            xb_add(&bar[XB_XGEN(bx_)], 1u);
            asm volatile("s_waitcnt vmcnt(0)" ::: "memory");
        } else {
            XB_SPIN(xb_ld(&bar[XB_XGEN(bx_)]) == gen, bar);
            __builtin_amdgcn_fence(__ATOMIC_ACQUIRE, "agent");
            asm volatile("s_waitcnt vmcnt(0)" ::: "memory");
        }
    }
    __syncthreads();
}
__global__ void __launch_bounds__(512, 2) mega_fwd(Params p) {
    extern __shared__ __attribute__((aligned(16))) unsigned char lds[];
    cg::grid_group grid = cg::this_grid();
    const int wv = __builtin_amdgcn_readfirstlane((int)threadIdx.x >> 6);
    unsigned char* ws = p.ws;
    LAS unsigned char* ldsl = (LAS unsigned char*)lds;
    bf16_t* hb = (bf16_t*)(ws + WS_HB);
    const float* cosT = (const float*)(ws + WS_COS); const float* sinT = (const float*)(ws + WS_SIN);

    volatile LAS unsigned* xst = (volatile LAS unsigned*)(ldsl + pg8::STAGE_BYTES);
    { const int t_ = otid(wv); if (t_ < 4) xst[t_] = 0u; }
    __syncthreads();
    XcdBarrier xb = xcd_barrier_post((unsigned*)(ws + WS_BAR), xst, wv);
    fix_t* stats0 = (fix_t*)(ws + WS_ST);
#define stats stats0
    { const int tid = otid(wv);
      for (int i = blockIdx.x * 512 + tid; i < 8 * 2 * M_; i += gridDim.x * 512) stats[(size_t)2 * M_ + i] = 0ull;
    }
    make_tables(p, wv);
    x_pass(p.in[0], hb, stats, wv);
    grid.sync();
    convert_weights(p, 0, 0, CT6, (float*)lds, wv);
    xcd_barrier(xb, (unsigned*)(ws + WS_BAR), wv);
    colsum_in(p, 0, wv); colsum_up(p, 0, wv);
    xcd_barrier(xb, (unsigned*)(ws + WS_BAR), wv);

#pragma unroll 1
    for (int l = 0; l < DEPTH; ++l) {
        { typedef __attribute__((address_space(1))) unsigned char gu8; uintptr_t w_ = (uintptr_t)p.ws; asm volatile("" : "+s"(w_)); ws = (unsigned char*)(gu8*)w_; }
        const float* csb = (const float*)(ws + WS_CSB) + (size_t)l * CSB_L;
        fix_t* st0 = (fix_t*)(ws + WS_ST) + (size_t)(2 * l) * 2 * M_; fix_t* st1 = st0 + 2 * M_; fix_t* st2 = st1 + 2 * M_;
        if (l > 0) { colsum_up(p, l, wv); convert_weights(p, l, CT5, CT6, (float*)lds, wv); }
        { pg8::Order S = pg8::make_order(hb, 2048, ws + W_IN, 2048, M_, NINP, 2048);
          EpiIn E{(bf16_t*)(ws + WS_CQ), (bf16_t*)(ws + WS_CKV), (bf16_t*)(ws + WS_XL), (bf16_t*)(ws + WS_GG), (bf16_t*)(ws + WS_KPE), (float*)(ws + WS_SSQ), cosT, sinT, st0, csb + CSB_IN, csb + CSB_IN + NINP};
          pg8::gemm_phase(ldsl, S, E, wv); }
        xcd_barrier(xb, (unsigned*)(ws + WS_BAR), wv);
        conv_phase(p, l, wv);
        { pg8::Order S = pg8::make_order(ws + WS_CQ, 512, ws + W_UQ, 512, M_, 1536, 512); S.wgm = 4;
          EpiQ E{(bf16_t*)(ws + WS_Q), (const float*)(ws + WS_SSQ), cosT, sinT};
          pg8::gemm_phase(ldsl, S, E, wv); }
        { pg8::Order S = pg8::make_order(ws + WS_CKV, 512, ws + W_UKV, 512, M_, 2048, 512); S.wgm = 4;
          EpiKV E{(bf16_t*)(ws + WS_KV), (const float*)(ws + WS_SSQ)};
          pg8::gemm_phase(ldsl, S, E, wv); }
        xcd_barrier(xb, (unsigned*)(ws + WS_BAR), wv);
        {
            const bf16_t* Q = (const bf16_t*)(ws + WS_Q); const bf16_t* KV = (const bf16_t*)(ws + WS_KV); const bf16_t* KPE = (const bf16_t*)(ws + WS_KPE); bf16_t* ycat = (bf16_t*)(ws + WS_YCAT);
            const int G = gridDim.x, bx = blockIdx.x;
            for (int L = bx; L < 1024; L += G) {
                int pair, qb;
                if (G == 256) { const int i = L >> 8, c = L & 255, xcd = c & 7, j = c >> 3; pair = i * 16 + xcd * 2 + (j >> 4); qb = j & 15; } else { pair = L >> 4; qb = L & 15; }
                const int b = pair >> 3, h = pair & 7; const size_t row0 = (size_t)b * SEQ + (size_t)qb * 256;
                __syncthreads();
                att::attn_unit(Q + row0 * 1536 + h * 128, Q + row0 * 1536 + 1024 + h * 64, KV + (size_t)b * SEQ * 2048 + h * 256, KPE + (size_t)b * SEQ * 64, ycat + row0 * 2048 + h * 128, SEQ, (char*)lds, wv);
            }
            __syncthreads();
        }
        { pg8::Order S = pg8::make_order(ws + WS_XC, 1024, ws + W_G, 128, M_, 512, 128);
          S.nZ = 8; S.a_z = 128 * 2; S.b_z = (size_t)512 * 128 * 2;
          EpiGate E{(bf16_t*)(ws + WS_AU), ws + WS_AU + AU_RPLANE, (const bf16_t*)(ws + WS_XC), p.in[12] + (size_t)l * 2048, p.in[14] + (size_t)l * 2048, (const float*)(ws + WS_SP) + (size_t)l * 2048};
          pg8::gemm_phase(ldsl, S, E, wv); }
        xcd_barrier(xb, (unsigned*)(ws + WS_BAR), wv);
        scan_local(p, l, wv);
        if (l + 1 < DEPTH) { __syncthreads(); convert_weights(p, l + 1, 0, CT3, (float*)lds, wv); }
        xcd_barrier(xb, (unsigned*)(ws + WS_BAR), wv);
        if (l + 1 < DEPTH) colsum_in(p, l + 1, wv);
        scan_apply(p, l, wv);
        xcd_barrier(xb, (unsigned*)(ws + WS_BAR), wv);
        { pg8::Order S = pg8::make_order(ws + WS_YCAT, 2048, ws + W_OUT, 2048, M_, 2048, 2048); S.wgm = 4;
          EpiRes E{hb, st0, l == 0 ? p.in[2] : p.in[21] + (size_t)(l - 1) * 2048, l == 0 ? p.in[3] : p.in[22] + (size_t)(l - 1) * 2048, st1};
          pg8::gemm_phase(ldsl, S, E, wv); }
        xcd_barrier(xb, (unsigned*)(ws + WS_BAR), wv);
        if (l + 1 < DEPTH) { convert_weights(p, l + 1, CT3, CT4, (float*)lds, wv); }
        { pg8::Order S = pg8::make_order(hb, 2048, ws + W_UP, 2048, M_, DFF, 2048);
          EpiUp E{(bf16_t*)(ws + WS_F), st1, csb + CSB_UP, csb + CSB_UP + DFF}; pg8::gemm_phase(ldsl, S, E, wv); }
        xcd_barrier(xb, (unsigned*)(ws + WS_BAR), wv);
        if (l + 1 < DEPTH) { convert_weights(p, l + 1, CT4, CT5, (float*)lds, wv); }
        { pg8::Order S = pg8::make_order(ws + WS_F, 8192, ws + W_DN, 8192, M_, 2048, 8192); S.wgm = 4;
          EpiRes E{hb, st1, p.in[17] + (size_t)l * 2048, p.in[18] + (size_t)l * 2048, st2};
          pg8::gemm_phase(ldsl, S, E, wv); }
        xcd_barrier(xb, (unsigned*)(ws + WS_BAR), wv);
    }
    ln_final(p.out, (const bf16_t*)(p.ws + WS_HB), (const fix_t*)(p.ws + WS_ST) + (size_t)(2 * DEPTH) * 2 * M_, p.in[21] + (size_t)(DEPTH - 1) * 2048, p.in[22] + (size_t)(DEPTH - 1) * 2048, wv);
}

extern "C" void kernel_launch(void* const* d_in, const int* in_sizes, int n_in, void* d_out, int out_size, void* d_ws, size_t ws_size, hipStream_t stream) {
    constexpr int LDS_BYTES = pg8::STAGE_BYTES + 16;
    static int grid_blocks = 0;
    if (grid_blocks == 0) {
        if (n_in != 23 || in_sizes[0] != M_ * DM || out_size != M_ * DM || ws_size < WS_END) {
            fprintf(stderr, "kernel_launch: shape mismatch (n_in %d, in0 %d, out %d, ws %zu, need %zu)\n", n_in, n_in > 0 ? in_sizes[0] : -1, out_size, ws_size, (size_t)WS_END); grid_blocks = -1; return; }
        int dev = 0, cus = 0, per_cu = 0;
        hipGetDevice(&dev); hipDeviceGetAttribute(&cus, hipDeviceAttributeMultiprocessorCount, dev);
        if (hipFuncSetAttribute((const void*)mega_fwd, hipFuncAttributeMaxDynamicSharedMemorySize, LDS_BYTES) != hipSuccess) { fprintf(stderr, "kernel_launch: hipFuncSetAttribute failed\n"); grid_blocks = -1; return; }
        if (hipOccupancyMaxActiveBlocksPerMultiprocessor(&per_cu, (const void*)mega_fwd, 512, LDS_BYTES) != hipSuccess || per_cu < 1) { fprintf(stderr, "kernel_launch: occupancy query says %d\n", per_cu); per_cu = 1; }
        (void)hipGetLastError();
        grid_blocks = cus * 1;
    }
    if (grid_blocks < 0) return;
    Params p{};
    for (int i = 0; i < 23; ++i) p.in[i] = (const float*)d_in[i];
    p.out = (float*)d_out; p.ws = (unsigned char*)d_ws;
    (void)hipMemsetAsync((char*)d_ws + WS_BAR, 0, XCD_BAR_WORDS * 4, stream);
    void* args[] = {&p};
    hipError_t e = hipLaunchCooperativeKernel((const void*)mega_fwd, dim3(grid_blocks), dim3(512), args, LDS_BYTES, stream);
    if (e != hipSuccess) fprintf(stderr, "kernel_launch: cooperative launch failed: %s (grid %d)\n", hipGetErrorString(e), grid_blocks);
}
```
